# Optimizing an MI355X kernel written in HIP

```python
import math
import jax
import jax.numpy as jnp
from jax import lax
import numpy as np

D_MODEL = 1024
BATCH = 1
SEQ = 16384
DEPTH = 2
DEC_BATCH = 16
DEC_SEQ = 16
PAST_LEN = 4096

CHUNK = 64
D_MIX = 1024
HEAD_DIM = 64
A_HEADS = 8
A_WIDTH = 512
A_PREV_CHUNKS = 8
REL_CLIP = 128
B_WIDTH = 256
CONV_WIDTH = 3
C_HEADS = 4
C_QK_DIM = 32
C_V_DIM = 64
C_WIDTH = 256
ROPE_DIMS = 8
ROPE_THETA = 500000.0
Q_BLOCK = 128
NORM_EPS = 1e-6
SUBLN_EPS = 1e-5
SPLITS = (512, 512, 512, 512, 256, 256, 256, 256, 256, 256, 256, 256)
D_IN_PROJ = 4096

kernel_name = 'chunk_hybrid_stream_encoder_step'


def rmsnorm(x, g, eps=NORM_EPS):
    xf = x.astype(jnp.float32)
    y = xf * lax.rsqrt(jnp.mean(xf * xf, axis=-1, keepdims=True) + eps)
    return (y * g.astype(jnp.float32)).astype(x.dtype)


def split_projection(h, w_in):
    z = jnp.einsum('bsd,de->bse', h, w_in)
    bounds = np.cumsum(np.array(SPLITS))[:-1].tolist()
    return jnp.split(z, bounds, axis=-1)


def partial_rope(x, pos):
    half = ROPE_DIMS // 2
    inv_freq = ROPE_THETA ** (-jnp.arange(half, dtype=jnp.float32) * (2.0 / ROPE_DIMS))
    ang = pos.astype(jnp.float32)[:, None] * inv_freq[None, :]
    cos = jnp.cos(ang)[:, None, None, :]
    sin = jnp.sin(ang)[:, None, None, :]
    xr = x[..., :ROPE_DIMS].astype(jnp.float32)
    x1, x2 = xr[..., :half], xr[..., half:]
    rot = jnp.concatenate([x1 * cos - x2 * sin, x2 * cos + x1 * sin], axis=-1).astype(x.dtype)
    return jnp.concatenate([rot, x[..., ROPE_DIMS:]], axis=-1)


def rel_bias_lookup(table, dist):
    idx = jnp.clip(dist, -REL_CLIP, REL_CLIP) + REL_CLIP
    return table.astype(jnp.float32)[:, idx]


def band_attention_prompt(q, k, v, rel_bias):
    B, S, H, Dh = q.shape
    nc = S // CHUNK
    band = (A_PREV_CHUNKS + 1) * CHUNK
    pad = ((0, 0), (A_PREV_CHUNKS * CHUNK, 0), (0, 0), (0, 0))
    kp = jnp.pad(k, pad).reshape(B, nc + A_PREV_CHUNKS, CHUNK, H, Dh)
    vp = jnp.pad(v, pad).reshape(B, nc + A_PREV_CHUNKS, CHUNK, H, Dh)
    kb = jnp.concatenate([kp[:, j:j + nc] for j in range(A_PREV_CHUNKS + 1)], axis=2)
    vb = jnp.concatenate([vp[:, j:j + nc] for j in range(A_PREV_CHUNKS + 1)], axis=2)
    qc = q.reshape(B, nc, CHUNK, H, Dh)
    s = jnp.einsum('bcqhd,bckhd->bchqk', qc, kb).astype(jnp.float32) * (Dh ** -0.5)
    r = jnp.arange(band)
    dist = jnp.arange(CHUNK)[:, None] + A_PREV_CHUNKS * CHUNK - r[None, :]
    s = s + rel_bias_lookup(rel_bias, dist)[None, None]
    key_pos = jnp.arange(nc)[:, None] * CHUNK - A_PREV_CHUNKS * CHUNK + r[None, :]
    s = jnp.where((key_pos >= 0)[None, :, None, None, :], s, -jnp.inf)
    p = jax.nn.softmax(s, axis=-1).astype(v.dtype)
    o = jnp.einsum('bchqk,bckhd->bcqhd', p, vb)
    return o.reshape(B, S, H * Dh)


def band_attention_sample(q, k, v, cache_k, cache_v, rel_bias):
    B, T, H, Dh = q.shape
    W = cache_k.shape[1]
    kk = jnp.concatenate([cache_k, k], axis=1)
    vv = jnp.concatenate([cache_v, v], axis=1)
    s = jnp.einsum('bqhd,bkhd->bhqk', q, kk).astype(jnp.float32) * (Dh ** -0.5)
    dist = jnp.arange(T)[:, None] + W - jnp.arange(W + T)[None, :]
    s = s + rel_bias_lookup(rel_bias, dist)[None]
    p = jax.nn.softmax(s, axis=-1).astype(v.dtype)
    o = jnp.einsum('bhqk,bkhd->bqhd', p, vv)
    return o.reshape(B, T, H * Dh)


def causal_conv(up, w, T):
    out = up[:, 0:T] * w[0]
    for j in range(1, CONV_WIDTH):
        out = out + up[:, j:j + T] * w[j]
    return out


def diff_lambda(lq1, lk1, lq2, lk2, lam_init):
    f = lambda a: a.astype(jnp.float32)
    return jnp.exp(jnp.sum(f(lq1) * f(lk1))) - jnp.exp(jnp.sum(f(lq2) * f(lk2))) + lam_init


def diff_combine(s, lam, v):
    p = jax.nn.softmax(s, axis=-1)
    a = p[:, :, 0] - lam * p[:, :, 1]
    return jnp.einsum('bhqk,bkhe->bqhe', a.astype(v.dtype), v)


def diff_attention_prompt(q, k, v, lam):
    B, S, H, _, d = q.shape
    nb = S // Q_BLOCK
    q_blocks = jnp.moveaxis(q.reshape(B, nb, Q_BLOCK, H, 2, d), 1, 0)
    key_chunk = jnp.arange(S) // CHUNK

    def one_block(args):
        qb, bi = args
        q_chunk = (bi * Q_BLOCK + jnp.arange(Q_BLOCK)) // CHUNK
        s = jnp.einsum('bqhmd,bkhmd->bhmqk', qb, k).astype(jnp.float32) * (d ** -0.5)
        s = jnp.where((key_chunk[None, :] <= q_chunk[:, None])[None, None, None], s, -jnp.inf)
        return diff_combine(s, lam, v)

    o = lax.map(one_block, (q_blocks, jnp.arange(nb)))
    return jnp.moveaxis(o, 0, 1).reshape(B, S, H, -1)


def diff_attention_sample(q, k, v, cache_k, cache_v, lam):
    d = q.shape[-1]
    kk = jnp.concatenate([cache_k, k], axis=1)
    vv = jnp.concatenate([cache_v, v], axis=1)
    s = jnp.einsum('bqhmd,bkhmd->bhmqk', q, kk).astype(jnp.float32) * (d ** -0.5)
    return diff_combine(s, lam, vv)


def merge_branches(o_a, a_g, o_b, b_g, o_c, c_g, w_out):
    y = jnp.concatenate([o_a * jax.nn.silu(a_g), o_b * jax.nn.silu(b_g), o_c * jax.nn.silu(c_g)], axis=-1)
    return jnp.einsum('bse,ed->bsd', y, w_out)


def prompt_layer(x, g, w_in, w_out, rel_bias, conv_w, subln_g, lam, lam_init):
    B, S, _ = x.shape
    h = rmsnorm(x, g)
    a_q, a_k, a_v, a_g, b_b, b_c, b_h, b_g, c_q, c_k, c_v, c_g = split_projection(h, w_in)
    k = a_k.reshape(B, S, A_HEADS, HEAD_DIM)
    v = a_v.reshape(B, S, A_HEADS, HEAD_DIM)
    o_a = band_attention_prompt(a_q.reshape(B, S, A_HEADS, HEAD_DIM), k, v, rel_bias)
    keep = min(A_PREV_CHUNKS * CHUNK, S)
    up = jnp.pad(b_c * b_h, ((0, 0), (CONV_WIDTH - 1, 0), (0, 0)))
    o_b = b_b * causal_conv(up, conv_w, S)
    pos = jnp.arange(S)
    cq = partial_rope(c_q.reshape(B, S, C_HEADS, 2, C_QK_DIM), pos)
    ck = partial_rope(c_k.reshape(B, S, C_HEADS, 2, C_QK_DIM), pos)
    cv = c_v.reshape(B, S, C_HEADS, C_V_DIM)
    o = diff_attention_prompt(cq, ck, cv, lam)
    o_c = (rmsnorm(o, subln_g, SUBLN_EPS) * (1.0 - lam_init)).reshape(B, S, C_WIDTH)
    y = x + merge_branches(o_a, a_g, o_b, b_g, o_c, c_g, w_out)
    return y, (k[:, S - keep:], v[:, S - keep:], up[:, -(CONV_WIDTH - 1):], ck, cv)


def sample_layer(x, ca_k, ca_v, c_conv, cc_k, cc_v, g, w_in, w_out, rel_bias, conv_w, subln_g, lam, lam_init):
    B, T, _ = x.shape
    past = cc_k.shape[1]
    h = rmsnorm(x, g)
    a_q, a_k, a_v, a_g, b_b, b_c, b_h, b_g, c_q, c_k, c_v, c_g = split_projection(h, w_in)
    k = a_k.reshape(B, T, A_HEADS, HEAD_DIM)
    v = a_v.reshape(B, T, A_HEADS, HEAD_DIM)
    o_a = band_attention_sample(a_q.reshape(B, T, A_HEADS, HEAD_DIM), k, v, ca_k, ca_v, rel_bias)
    up = jnp.concatenate([c_conv, b_c * b_h], axis=1)
    o_b = b_b * causal_conv(up, conv_w, T)
    pos = past + jnp.arange(T)
    cq = partial_rope(c_q.reshape(B, T, C_HEADS, 2, C_QK_DIM), pos)
    ck = partial_rope(c_k.reshape(B, T, C_HEADS, 2, C_QK_DIM), pos)
    cv = c_v.reshape(B, T, C_HEADS, C_V_DIM)
    o = diff_attention_sample(cq, ck, cv, cc_k, cc_v, lam)
    o_c = (rmsnorm(o, subln_g, SUBLN_EPS) * (1.0 - lam_init)).reshape(B, T, C_WIDTH)
    y = x + merge_branches(o_a, a_g, o_b, b_g, o_c, c_g, w_out)
    return y, (k, v, up[:, -(CONV_WIDTH - 1):], ck, cv)


def setup_inputs(seed: int = 0) -> dict:
    key = jax.random.key(seed)
    ks = jax.random.split(key, 20)
    a_win = min(A_PREV_CHUNKS * CHUNK, PAST_LEN)

    def nrm(k, shape, scale=1.0):
        return scale * jax.random.normal(k, shape, dtype=jnp.float32)

    return {
        'x_prompt': nrm(ks[0], (BATCH, SEQ, D_MODEL)),
        'x_sample': nrm(ks[1], (DEC_BATCH, DEC_SEQ, D_MODEL)),
        'cache_a_k': nrm(ks[2], (DEPTH, DEC_BATCH, a_win, A_HEADS, HEAD_DIM)),
        'cache_a_v': nrm(ks[3], (DEPTH, DEC_BATCH, a_win, A_HEADS, HEAD_DIM)),
        'state_conv': nrm(ks[4], (DEPTH, DEC_BATCH, CONV_WIDTH - 1, B_WIDTH)),
        'cache_c_k': nrm(ks[5], (DEPTH, DEC_BATCH, PAST_LEN, C_HEADS, 2, C_QK_DIM)),
        'cache_c_v': nrm(ks[6], (DEPTH, DEC_BATCH, PAST_LEN, C_HEADS, C_V_DIM)),
        'norm_g': 1.0 + nrm(ks[7], (DEPTH, D_MODEL), 0.05),
        'w_in': nrm(ks[8], (DEPTH, D_MODEL, D_IN_PROJ), D_MODEL ** -0.5),
        'w_out': nrm(ks[9], (DEPTH, D_MIX, D_MODEL), D_MIX ** -0.5),
        'rel_bias': nrm(ks[10], (DEPTH, A_HEADS, 2 * REL_CLIP + 1), 0.2),
        'conv_w': nrm(ks[11], (DEPTH, CONV_WIDTH, B_WIDTH), CONV_WIDTH ** -0.5),
        'lam_q1': nrm(ks[12], (DEPTH, C_QK_DIM), 0.1),
        'lam_k1': nrm(ks[13], (DEPTH, C_QK_DIM), 0.1),
        'lam_q2': nrm(ks[14], (DEPTH, C_QK_DIM), 0.1),
        'lam_k2': nrm(ks[15], (DEPTH, C_QK_DIM), 0.1),
        'subln_g': 1.0 + nrm(ks[16], (DEPTH, C_V_DIM), 0.05),
        'final_g': 1.0 + nrm(ks[17], (D_MODEL,), 0.05),
    }


def reference(x_prompt, x_sample, cache_a_k, cache_a_v, state_conv, cache_c_k, cache_c_v,
              norm_g, w_in, w_out, rel_bias, conv_w, lam_q1, lam_k1, lam_q2, lam_k2, subln_g, final_g):
    xp, xs = x_prompt, x_sample
    p_ak, p_av, p_conv, p_ck, p_cv = [], [], [], [], []
    s_ak, s_av, s_conv, s_ck, s_cv = [], [], [], [], []
    for l in range(DEPTH):
        lam_init = 0.8 - 0.6 * math.exp(-0.3 * l)
        lam = diff_lambda(lam_q1[l], lam_k1[l], lam_q2[l], lam_k2[l], lam_init)
        xp, (ak, av, cs, ck, cv) = prompt_layer(xp, norm_g[l], w_in[l], w_out[l], rel_bias[l],
                                                conv_w[l], subln_g[l], lam, lam_init)
        p_ak.append(ak); p_av.append(av); p_conv.append(cs); p_ck.append(ck); p_cv.append(cv)
        xs, (ak, av, cs, ck, cv) = sample_layer(xs, cache_a_k[l], cache_a_v[l], state_conv[l],
                                                cache_c_k[l], cache_c_v[l], norm_g[l], w_in[l], w_out[l],
                                                rel_bias[l], conv_w[l], subln_g[l], lam, lam_init)
        s_ak.append(ak); s_av.append(av); s_conv.append(cs); s_ck.append(ck); s_cv.append(cv)
    y_prompt = rmsnorm(xp, final_g)
    y_sample = rmsnorm(xs, final_g)
    return (y_prompt, y_sample,
            jnp.stack(p_ak), jnp.stack(p_av), jnp.stack(p_conv), jnp.stack(p_ck), jnp.stack(p_cv),
            jnp.stack(s_ak), jnp.stack(s_av), jnp.stack(s_conv), jnp.stack(s_ck), jnp.stack(s_cv))
```

```cpp
#include <hip/hip_runtime.h>
#include <hip/hip_cooperative_groups.h>
#include <cstdio>
#include <cstdint>
namespace cg = cooperative_groups;
namespace pg8 {
#define PG8_LAS __attribute__((address_space(3)))
typedef unsigned short bf16_t;
typedef short bf16x8 __attribute__((ext_vector_type(8)));
typedef float f32x4 __attribute__((ext_vector_type(4)));
typedef unsigned u32x4 __attribute__((ext_vector_type(4)));
constexpr int BM = 256, BK = 64, HALF = 128, HTB = HALF * BK * 2  , STAGE_BYTES = 8 * HTB, NXCD = 8, WGM = 8;

__host__ __device__ __forceinline__ int lds_byte(int r, int c) { const int st = (r >> 4) * 2 + (c >> 5), rr = r & 15, cc = c & 31, ob = rr * 64 + cc * 2; return st * 1024 + (ob ^ (((ob >> 9) & 1) << 5)); }
__host__ __device__ __forceinline__ void stage_rc(int b, int& R, int& C) { const int st = b / 1024, sb = b % 1024, swz = sb ^ (((sb >> 9) & 1) << 5); R = (st >> 1) * 16 + swz / 64; C = (st & 1) * 32 + (swz % 64) / 2; }
__host__ __device__ __forceinline__ int perm32(int rho) { const int n = rho >> 4, i = rho & 15; return 8 * (i >> 2) + 4 * n + (i & 3); }

struct Unit { int pm, pn; };
struct Gemm { const bf16_t* A; const bf16_t* Bt; int M, N, K; };

struct StaticOrder {
    int nM, nN, nwg, G, c;
    __host__ __device__ void init(int M, int N, int G_, int c_) { nM = M / BM; nN = N / BM; nwg = nM * nN; G = G_; c = c_; }
    __host__ __device__ bool next(int i, Unit& u) const {
        const long L = (long)i * G + c; if (L >= nwg) return false;
        int wgid = (int)L; { const int q = nwg / NXCD, r = nwg % NXCD, xcd = wgid % NXCD, off = wgid / NXCD; wgid = (xcd < r ? xcd * (q + 1) : r * (q + 1) + (xcd - r) * q) + off; }
        const int nig = WGM * nN, gid = wgid / nig, fm = gid * WGM, gsz = (nM - fm) < WGM ? (nM - fm) : WGM;
        u.pm = fm + ((wgid % nig) % gsz); u.pn = (wgid % nig) / gsz; return true;
    }
    __device__ __forceinline__ void a_ready(const Unit&) const {}
    __device__ __forceinline__ void done(const Unit&) const {}
};

__device__ __forceinline__ unsigned cvt_pk_bf16(float lo, float hi) { unsigned r; asm volatile("v_cvt_pk_bf16_f32 %0, %1, %2" : "=v"(r) : "v"(lo), "v"(hi)); return r; }
typedef float f32x2 __attribute__((ext_vector_type(2)));
constexpr float LOG2E = 1.4426950408889634f;
constexpr float SC_QA = 0.125f * LOG2E;
constexpr float SC_QC = 0.17677669529663687f * LOG2E;
constexpr int ZLD = 4096, MROWS = 16640, NPROMPT = 16384;
constexpr size_t WSO_MiB = 1u << 20;
constexpr size_t WSO_CTL = 0, WSO_SSQ1 = 16384 * 4, WSO_SSQ2 = (16384 + 32768) * 4, WSO_SSQ0 = 1 * WSO_MiB, WSO_ROPE = 2 * WSO_MiB, WSO_WIN = 4 * WSO_MiB, WSO_WOUT = 20 * WSO_MiB, WSO_XB = 24 * WSO_MiB,
                 WSO_YMIX = 60 * WSO_MiB, WSO_X1 = 96 * WSO_MiB, WSO_Z = 164 * WSO_MiB, WSO_END = 296 * WSO_MiB;
constexpr size_t OO_Y = 0, OO_AKP = 17039360, OO_AVP = OO_AKP + 524288, OO_CONVP = OO_AVP + 524288, OO_CKP = OO_CONVP + 1024, OO_CVP = OO_CKP + 8388608,
                 OO_AKS = OO_CVP + 8388608, OO_AVS = OO_AKS + 262144, OO_CONVS = OO_AVS + 262144, OO_CKS = OO_CONVS + 16384, OO_CVS = OO_CKS + 131072, OO_END = OO_CVS + 131072;
__device__ __forceinline__ float silu_f(float x) { return x * __builtin_amdgcn_rcpf(1.0f + __builtin_amdgcn_exp2f(-x * LOG2E)); }
struct EpiIn {
    static constexpr bool PERM = true, AFTER_DRAIN = false;
    unsigned char* ws; float* out; int l;
    __device__ __forceinline__ void operator()(const f32x4 (&acc)[2][2][4][2], const Unit& u, int wr, int wc, int fr, int fq) const {
        const int pn = u.pn, pm = u.pm;
        bf16_t* Z = (bf16_t*)(ws + WSO_Z); const float* ssq = (const float*)(ws + (l == 0 ? WSO_SSQ0 : WSO_SSQ1)); const float* rope = (const float*)(ws + WSO_ROPE);
        float* o_ak_p = out + OO_AKP + (size_t)l * 262144; float* o_av_p = out + OO_AVP + (size_t)l * 262144; float* o_ak_s = out + OO_AKS + (size_t)l * 131072; float* o_av_s = out + OO_AVS + (size_t)l * 131072;
        float* o_ck_p = out + OO_CKP + (size_t)l * 4194304; float* o_cv_p = out + OO_CVP + (size_t)l * 4194304; float* o_ck_s = out + OO_CKS + (size_t)l * 65536; float* o_cv_s = out + OO_CVS + (size_t)l * 65536;
        const int rowl = wr * 64 + fr;
        const int colb = pn * BM + wc * 32 + 8 * fq;
        const bool rope_tile = (pn == 12 || pn == 13);
        const bool do_rope = rope_tile && fq == 0;
        const float sc = (pn < 2) ? SC_QA : (pn == 12 ? SC_QC : 1.f);
        const bool do_silu = (pn == 6 || pn == 7 || pn == 11 || pn == 15);
        float* ob = nullptr; int old = 0, ocol0 = 0;
        if (pn >= 2 && pn <= 5) { old = 512; ocol0 = (pn >= 4) ? 1024 : 512;
            if (pm == 64) ob = (pn >= 4) ? o_av_s : o_ak_s; else if (pm >= 62) ob = ((pn >= 4) ? o_av_p : o_ak_p) + (size_t)(pm - 62) * 256 * 512; }
        else if (pn == 13 || pn == 14) { old = 256; ocol0 = (pn == 13) ? 3328 : 3584;
            if (pm == 64) ob = (pn == 13) ? o_ck_s : o_cv_s; else ob = ((pn == 13) ? o_ck_p : o_cv_p) + (size_t)pm * 256 * 256; }
#pragma unroll
        for (int ai = 0; ai < 2; ++ai)
#pragma unroll
            for (int m = 0; m < 4; ++m) {
                const int rl = rowl + ai * HALF + m * 16, row = pm * BM + rl;
                const float rs = __builtin_amdgcn_rsqf(ssq[row] * (1.0f / 1024.0f) + 1e-6f);
                f32x4 rc = {1.f, 1.f, 1.f, 1.f}, rsn = {0.f, 0.f, 0.f, 0.f};
                if (do_rope) { rc = *(const f32x4*)(rope + (size_t)row * 8); rsn = *(const f32x4*)(rope + (size_t)row * 8 + 4); }
#pragma unroll
                for (int bj = 0; bj < 2; ++bj) {
                    f32x4 v0 = acc[ai][bj][m][0] * rs, v1 = acc[ai][bj][m][1] * rs;
                    const int col = colb + bj * HALF;
                    if (rope_tile) { const f32x4 a = v0 * rc - v1 * rsn, b = v1 * rc + v0 * rsn; v0 = a; v1 = b; }
                    if (ob) { float* op = ob + (size_t)rl * old + (col - ocol0); *(f32x4*)op = v0; *(f32x4*)(op + 4) = v1; }
                    if (do_silu) { v0 = (f32x4){silu_f(v0[0]), silu_f(v0[1]), silu_f(v0[2]), silu_f(v0[3])}; v1 = (f32x4){silu_f(v1[0]), silu_f(v1[1]), silu_f(v1[2]), silu_f(v1[3])}; }
                    v0 = v0 * sc; v1 = v1 * sc;
                    u32x4 w; w.x = cvt_pk_bf16(v0[0], v0[1]); w.y = cvt_pk_bf16(v0[2], v0[3]); w.z = cvt_pk_bf16(v1[0], v1[1]); w.w = cvt_pk_bf16(v1[2], v1[3]);
                    *(u32x4*)(Z + (size_t)row * ZLD + col) = w;
                }
                asm volatile("" ::: "memory");
            }
    }
};
struct EpiOut {
    static constexpr bool PERM = true, AFTER_DRAIN = false;
    unsigned char* ws; const float* x_p; const float* x_s; int l;
    __device__ __forceinline__ void operator()(const f32x4 (&acc)[2][2][4][2], const Unit& u, int wr, int wc, int fr, int fq) const {
        const int pm = u.pm; const int colb = u.pn * BM + wc * 32 + 8 * fq;
        float* X1 = (float*)(ws + WSO_X1) + (size_t)pm * BM * 1024; bf16_t* XB = (bf16_t*)(ws + WSO_XB) + (size_t)pm * BM * 1024; float* ssq = (float*)(ws + (l == 0 ? WSO_SSQ1 : WSO_SSQ2)) + pm * BM;
        const float* res = (l == 0) ? ((pm == 64) ? x_s : x_p + (size_t)pm * BM * 1024) : X1;
        const unsigned off0 = (unsigned)(wr * 64 + fr) * 1024u + (unsigned)colb;
#pragma unroll
        for (int ai = 0; ai < 2; ++ai)
#pragma unroll
            for (int m = 0; m < 4; ++m) {
                const unsigned offr = off0 + (unsigned)(ai * HALF + m * 16) * 1024u; float q = 0.f;
#pragma unroll
                for (int bj = 0; bj < 2; ++bj) { const unsigned off = offr + bj * HALF;
                    const f32x4 v0 = acc[ai][bj][m][0] + *(const f32x4*)(res + off), v1 = acc[ai][bj][m][1] + *(const f32x4*)(res + off + 4);
                    *(f32x4*)(X1 + off) = v0; *(f32x4*)(X1 + off + 4) = v1;
                    u32x4 w; w.x = cvt_pk_bf16(v0[0], v0[1]); w.y = cvt_pk_bf16(v0[2], v0[3]); w.z = cvt_pk_bf16(v1[0], v1[1]); w.w = cvt_pk_bf16(v1[2], v1[3]);
                    *(u32x4*)(XB + off) = w;
                    q += (v0[0] * v0[0] + v0[1] * v0[1]) + (v0[2] * v0[2] + v0[3] * v0[3]) + (v1[0] * v1[0] + v1[1] * v1[1]) + (v1[2] * v1[2] + v1[3] * v1[3]);
                    asm volatile("" ::: "memory"); }
                q += __shfl_xor(q, 16); q += __shfl_xor(q, 32);
                if (fq == 0) atomicAdd(ssq + (wr * 64 + fr + ai * HALF + m * 16), q);
                asm volatile("" ::: "memory");
            }
    }
};
template <class Epi, class Sched, bool ALIGN_EPI = false, bool SP2 = false>
__device__ __forceinline__ void gemm_phase(PG8_LAS unsigned char* lds, const Gemm g, const Sched& S, const Epi& E) {
    int tid_ = threadIdx.x; asm volatile("" : "+v"(tid_));
    const int tid = tid_, wid = __builtin_amdgcn_readfirstlane(tid >> 6), lane = tid & 63, wr = wid >> 2, wc = wid & 3, fr = lane & 15, fq = lane >> 4;
    const int K = g.K, nt = K / BK;
    unsigned voffA[2], voffB[2];
#pragma unroll
    for (int i = 0; i < 2; ++i) { int R, C; stage_rc(tid * 16 + i * 8192, R, C); const int Rb = Epi::PERM ? ((R & ~31) + perm32(R & 31)) : R;
        voffA[i] = (unsigned)(R * K + C) * 2u; voffB[i] = (unsigned)(Rb * K + C) * 2u; }
    const size_t kstep = (size_t)(BK * 2);
    const size_t hstep = (size_t)HALF * K * 2;
    const size_t tstep = 2 * hstep;
    const unsigned ldsw = (unsigned)wid * 1024u;
    const int aoff = lds_byte(wr * 64 + fr, fq * 8), boff = lds_byte(wc * 32 + fr, fq * 8);
#define PG8_SA(b, h) (((b) * 2 + (h)) * HTB)
#define PG8_SB(b, h) ((4 + (b) * 2 + (h)) * HTB)
#define PG8_STAGE(bufoff, gbase, voff) do { _Pragma("unroll") for (int _i = 0; _i < 2; ++_i) \
        __builtin_amdgcn_global_load_lds((const unsigned*)((const char*)(gbase) + (voff)[_i]), (PG8_LAS unsigned*)(lds + (bufoff) + ldsw + _i * 8192), 16, 0, 0); } while (0)
#define PG8_LDA(dst, b, h) do { _Pragma("unroll") for (int m = 0; m < 4; ++m) _Pragma("unroll") for (int k = 0; k < 2; ++k) dst[m][k] = *(const PG8_LAS bf16x8*)(lds + PG8_SA(b, h) + aoff + m * 2048 + k * 1024); } while (0)
#define PG8_LDB(dst, b, h) do { _Pragma("unroll") for (int n = 0; n < 2; ++n) _Pragma("unroll") for (int k = 0; k < 2; ++k) dst[n][k] = *(const PG8_LAS bf16x8*)(lds + PG8_SB(b, h) + boff + n * 2048 + k * 1024); } while (0)
#define PG8_MMA(ai, bj, At, Bt) do { __builtin_amdgcn_s_setprio(1); _Pragma("unroll") for (int m = 0; m < 4; ++m) _Pragma("unroll") for (int n = 0; n < 2; ++n) _Pragma("unroll") for (int k = 0; k < 2; ++k) \
        acc[ai][bj][m][n] = __builtin_amdgcn_mfma_f32_16x16x32_bf16(Bt[n][k], At[m][k], acc[ai][bj][m][n], 0, 0, 0); __builtin_amdgcn_s_setprio(0); } while (0)
#define PG8_WAIT_V(n) asm volatile("s_waitcnt vmcnt(" #n ")" ::: "memory")
#define PG8_WAIT_L(n) asm volatile("s_waitcnt lgkmcnt(" #n ")" ::: "memory")
#define PG8_BAR __builtin_amdgcn_s_barrier()
#define PG8_SCHED __builtin_amdgcn_sched_barrier(0)
    Unit cur, nxt; int ui = 0;
    if (!S.next(0, cur)) return;
    f32x4 acc[2][2][4][2];
#pragma unroll
    for (int a = 0; a < 2; ++a)
#pragma unroll
        for (int b = 0; b < 2; ++b)
#pragma unroll
            for (int m = 0; m < 4; ++m)
#pragma unroll
                for (int n = 0; n < 2; ++n) acc[a][b][m][n] = (f32x4){0.f, 0.f, 0.f, 0.f};
    bf16x8 At[4][2], B0[2][2], B1[2][2];
    const char* cA = (const char*)g.A + (size_t)cur.pm * tstep; const char* cB = (const char*)g.Bt + (size_t)cur.pn * tstep;
    S.a_ready(cur);
    if constexpr (SP2) {
        PG8_STAGE(PG8_SB(0, 0), cB, voffB); PG8_STAGE(PG8_SB(0, 1), cB + hstep, voffB); PG8_STAGE(PG8_SA(0, 0), cA, voffA); PG8_STAGE(PG8_SA(0, 1), cA + hstep, voffA);
        if (wr == 1) PG8_BAR;
        PG8_WAIT_V(2); PG8_BAR;
        PG8_STAGE(PG8_SB(1, 0), cB + kstep, voffB); PG8_STAGE(PG8_SA(1, 0), cA + kstep, voffA); PG8_STAGE(PG8_SB(1, 1), cB + hstep + kstep, voffB);
        PG8_WAIT_V(6); PG8_BAR;
    } else {
        PG8_STAGE(PG8_SB(0, 0), cB, voffB); PG8_STAGE(PG8_SA(0, 0), cA, voffA); PG8_STAGE(PG8_SB(0, 1), cB + hstep, voffB); PG8_STAGE(PG8_SA(0, 1), cA + hstep, voffA);
        if (wr == 1) PG8_BAR;
        PG8_WAIT_V(4); PG8_BAR;
        PG8_STAGE(PG8_SB(1, 0), cB + kstep, voffB); PG8_STAGE(PG8_SA(1, 0), cA + kstep, voffA); PG8_STAGE(PG8_SB(1, 1), cB + hstep + kstep, voffB);
        PG8_WAIT_V(6); PG8_BAR;
    }
    for (;;) {
        const bool has_next = S.next(ui + 1, nxt);
        const char* nA = has_next ? (const char*)g.A + (size_t)nxt.pm * tstep : cA; const char* nB = has_next ? (const char*)g.Bt + (size_t)nxt.pn * tstep : cB;
        for (int t = 0; t < nt; t += 2) {
            const bool last = (t == nt - 2);
            const char* a1 = cA + (size_t)(t + 1) * kstep;
            const char* a2 = last ? nA : cA + (size_t)(t + 2) * kstep; const char* b2 = last ? nB : cB + (size_t)(t + 2) * kstep;
            const char* a3 = a2 + kstep; const char* b3 = b2 + kstep;
            if (last && has_next) S.a_ready(nxt);
            if constexpr (SP2) {
            PG8_LDB(B0, 0, 0); PG8_LDB(B1, 0, 1); PG8_SCHED; PG8_LDA(At, 0, 0); PG8_STAGE(PG8_SA(1, 1), a1 + hstep, voffA);
            PG8_WAIT_V(8); PG8_WAIT_L(0); PG8_BAR; PG8_MMA(0, 0, At, B0); PG8_MMA(0, 1, At, B1); PG8_BAR; PG8_SCHED;
            PG8_LDA(At, 0, 1); PG8_STAGE(PG8_SB(0, 0), b2, voffB); PG8_STAGE(PG8_SB(0, 1), b2 + hstep, voffB); PG8_STAGE(PG8_SA(0, 0), a2, voffA);
            PG8_WAIT_V(8); PG8_WAIT_L(0); PG8_BAR; PG8_MMA(1, 0, At, B0); PG8_MMA(1, 1, At, B1); PG8_BAR; PG8_SCHED;
            PG8_LDB(B0, 1, 0); PG8_LDB(B1, 1, 1); PG8_SCHED; PG8_LDA(At, 1, 0); PG8_STAGE(PG8_SA(0, 1), a2 + hstep, voffA);
            PG8_WAIT_V(8); PG8_WAIT_L(0); PG8_BAR; PG8_MMA(0, 0, At, B0); PG8_MMA(0, 1, At, B1); PG8_BAR; PG8_SCHED;
            PG8_LDA(At, 1, 1); PG8_STAGE(PG8_SB(1, 0), b3, voffB); PG8_STAGE(PG8_SB(1, 1), b3 + hstep, voffB); PG8_STAGE(PG8_SA(1, 0), a3, voffA);
            PG8_WAIT_V(8); PG8_WAIT_L(0); PG8_BAR; PG8_MMA(1, 0, At, B0); PG8_MMA(1, 1, At, B1); PG8_BAR; PG8_SCHED;
            } else {
            PG8_LDB(B0, 0, 0); PG8_SCHED; PG8_LDA(At, 0, 0); PG8_STAGE(PG8_SA(1, 1), a1 + hstep, voffA);
            PG8_WAIT_L(8); PG8_BAR; PG8_WAIT_L(0); PG8_MMA(0, 0, At, B0); PG8_BAR; PG8_SCHED;
            PG8_LDB(B1, 0, 1); PG8_STAGE(PG8_SB(0, 0), b2, voffB);
            PG8_BAR; PG8_WAIT_L(0); PG8_MMA(0, 1, At, B1); PG8_BAR;
            PG8_LDA(At, 0, 1); PG8_STAGE(PG8_SA(0, 0), a2, voffA);
            PG8_BAR; PG8_WAIT_L(0); PG8_MMA(1, 0, At, B0); PG8_BAR; PG8_SCHED;
            PG8_STAGE(PG8_SB(0, 1), b2 + hstep, voffB);
            PG8_WAIT_V(6); PG8_BAR; PG8_MMA(1, 1, At, B1); PG8_BAR;
            PG8_LDB(B0, 1, 0); PG8_SCHED; PG8_LDA(At, 1, 0); PG8_STAGE(PG8_SA(0, 1), a2 + hstep, voffA);
            PG8_WAIT_L(8); PG8_BAR; PG8_WAIT_L(0); PG8_MMA(0, 0, At, B0); PG8_BAR; PG8_SCHED;
            PG8_LDB(B1, 1, 1); PG8_STAGE(PG8_SB(1, 0), b3, voffB);
            PG8_BAR; PG8_WAIT_L(0); PG8_MMA(0, 1, At, B1); PG8_BAR;
            PG8_LDA(At, 1, 1); PG8_STAGE(PG8_SA(1, 0), a3, voffA);
            PG8_BAR; PG8_WAIT_L(0); PG8_MMA(1, 0, At, B0); PG8_BAR; PG8_SCHED;
            PG8_STAGE(PG8_SB(1, 1), b3 + hstep, voffB);
            PG8_WAIT_V(6); PG8_BAR; PG8_MMA(1, 1, At, B1); PG8_BAR;
            }
        }
        if constexpr (ALIGN_EPI) { if (wr == 0) PG8_BAR; }
        if constexpr (!Epi::AFTER_DRAIN) { E(acc, cur, wr, wc, fr, fq); S.done(cur); }
        if (!has_next) break;
#pragma unroll
        for (int a = 0; a < 2; ++a)
#pragma unroll
            for (int b = 0; b < 2; ++b)
#pragma unroll
                for (int m = 0; m < 4; ++m)
#pragma unroll
                    for (int n = 0; n < 2; ++n) acc[a][b][m][n] = (f32x4){0.f, 0.f, 0.f, 0.f};
        cur = nxt; cA = nA; cB = nB; ++ui;
        if constexpr (ALIGN_EPI) { if (wr == 1) PG8_BAR; }
    }
    PG8_WAIT_V(0);
    if constexpr (!ALIGN_EPI) { if (wr == 0) PG8_BAR; }
    PG8_BAR;
    if constexpr (Epi::AFTER_DRAIN) { E.fused(acc, cur, wr, wc, fr, fq, lds, wid, lane); S.done(cur); }
#undef PG8_SA
#undef PG8_SB
#undef PG8_STAGE
#undef PG8_LDA
#undef PG8_LDB
#undef PG8_MMA
#undef PG8_WAIT_V
#undef PG8_WAIT_L
#undef PG8_BAR
#undef PG8_SCHED
}
}
#define LAS __attribute__((address_space(3)))
typedef unsigned short bf16_t;
typedef LAS unsigned char* ldsp;
typedef short bf16x8 __attribute__((ext_vector_type(8)));
typedef short s16x4 __attribute__((ext_vector_type(4)));
typedef float f32x16 __attribute__((ext_vector_type(16)));
typedef float f32x4 __attribute__((ext_vector_type(4)));
typedef float f32x2 __attribute__((ext_vector_type(2)));
typedef unsigned u32x4 __attribute__((ext_vector_type(4)));
typedef unsigned u32x2 __attribute__((ext_vector_type(2)));
typedef __bf16 bf16x2_t __attribute__((ext_vector_type(2)));
using pg8::ZLD; using pg8::MROWS; using pg8::NPROMPT; using pg8::LOG2E;
__device__ __forceinline__ int crow(int r, int hi) { return (r & 3) + 8 * (r >> 2) + 4 * hi; }
__device__ __forceinline__ unsigned cvtpk(float lo, float hi) { f32x2 v = {lo, hi}; bf16x2_t b = __builtin_convertvector(v, bf16x2_t); return __builtin_bit_cast(unsigned, b); }
__device__ __forceinline__ float bf_lo(unsigned w) { return __uint_as_float(w << 16); }
__device__ __forceinline__ float bf_hi(unsigned w) { return __uint_as_float(w & 0xffff0000u); }
__device__ __forceinline__ float xhalf_max(float m) { auto rr = __builtin_amdgcn_permlane32_swap(__float_as_uint(m), __float_as_uint(m), false, false); return fmaxf(__uint_as_float(rr[0]), __uint_as_float(rr[1])); }
__device__ __forceinline__ float xhalf_sum(float m) { auto rr = __builtin_amdgcn_permlane32_swap(__float_as_uint(m), __float_as_uint(m), false, false); return __uint_as_float(rr[0]) + __uint_as_float(rr[1]); }
__device__ __forceinline__ s16x4 vtr(ldsp p) { typedef short v4i16_t __attribute__((ext_vector_type(4))); return __builtin_bit_cast(s16x4, __builtin_amdgcn_ds_read_tr16_b64_v4i16((LAS v4i16_t*)p)); }
#define MFMA32(a, b, c) __builtin_amdgcn_mfma_f32_32x32x16_bf16((a), (b), (c), 0, 0, 0)

constexpr int KPITCH = 144, KT_BYTES = 64 * KPITCH, VT_BYTES = 8192, TILE_BYTES = KT_BYTES + VT_BYTES, BUF_BYTES = 2 * TILE_BYTES;
constexpr int COMB_OFF = 2 * BUF_BYTES, COMB_WAVE = 17408, TAB_OFF = COMB_OFF + 4 * COMB_WAVE, MISC_OFF = TAB_OFF + 1040, LDS_BYTES = 147456;
static_assert(MISC_OFF + 64 <= LDS_BYTES, "LDS map");
constexpr float NEG_BIG = -1.0e30f, THR = 8.0f;
struct AU {
    const bf16_t* q; int nq; int nt, ntc; const float* kc; const float* vc; int cp; const bf16_t* kz; const bf16_t* vz; int lastv; int nqg;
    int tlo0, thi0, tlo1, thi1; int qpos0, kpos0; const bf16_t* gate; bf16_t* y;
};
#ifndef ATTN_INL
#define ATTN_INL __forceinline__
#endif
template <int MODE  >
__device__ ATTN_INL void attn_unit(const AU& d, ldsp lds, float lam, float oml, const float* subg) {
    constexpr int NMAP = MODE == 0 ? 2 : 1, NSTEP = MODE == 0 ? 2 : 4;
    int tid_ = threadIdx.x; asm volatile("" : "+v"(tid_));
    const int tid = tid_, lane = tid & 63, wid = __builtin_amdgcn_readfirstlane(tid >> 6), qg = wid & 3, ks = wid >> 2, r32 = lane & 31, hi = lane >> 5;
    const int tlo = (qg >> 1) ? d.tlo1 : d.tlo0; int thi = (qg >> 1) ? d.thi1 : d.thi0; if (qg >= d.nqg) thi = -1;
    const LAS float* tab = (const LAS float*)(lds + TAB_OFF);
    bf16x8 qf[NMAP][NSTEP];
    { int qrow = 32 * qg + r32; if (qrow >= d.nq) qrow = d.nq - 1;
      const bf16_t* qp = d.q + (size_t)qrow * ZLD;
#pragma unroll
      for (int mp = 0; mp < NMAP; ++mp)
#pragma unroll
          for (int st = 0; st < NSTEP; ++st) qf[mp][st] = *(const bf16x8*)(qp + mp * 32 + st * 16 + hi * 8); }
    f32x16 O[NMAP][2]; float mref[NMAP], lsum[NMAP];
#pragma unroll
    for (int mp = 0; mp < NMAP; ++mp) { mref[mp] = NEG_BIG; lsum[mp] = 0.f;
#pragma unroll
        for (int db = 0; db < 2; ++db)
#pragma unroll
            for (int i = 0; i < 16; ++i) O[mp][db][i] = 0.f; }
    const int lrow = tid >> 3, lch = tid & 7;
    const int kwoff = lrow * KPITCH + lch * 16, vwoff = (lch >> 2) * 4096 + lrow * 64 + (lch & 3) * 16;
    const int kroff = r32 * KPITCH + hi * 16;
    const int vroff = (4 * hi + ((lane & 15) >> 2)) * 64 + ((lane >> 4) & 1) * 32 + (lane & 3) * 8;
    u32x4 stK[2], stV[2];
    const int nit = (d.nt + 1) >> 1;
#define AT_ISSUE(IT) do { _Pragma("unroll") for (int i_ = 0; i_ < 2; ++i_) { const int t_ = 2 * (IT) + i_; if (t_ < d.nt && t_ >= d.ntc) { int r_ = lrow; if (t_ == d.nt - 1 && r_ >= d.lastv) r_ = d.lastv - 1; \
        const size_t off_ = ((size_t)(t_ - d.ntc) * 64 + r_) * ZLD + lch * 8; stK[i_] = *(const u32x4*)(d.kz + off_); stV[i_] = *(const u32x4*)(d.vz + off_); } } } while (0)
#define AT_WRITE(IT, BUF) do { _Pragma("unroll") for (int i_ = 0; i_ < 2; ++i_) { const int t_ = 2 * (IT) + i_; if (t_ < d.nt) { u32x4 kk_, vv_; if (t_ >= d.ntc) { kk_ = stK[i_]; vv_ = stV[i_]; } else { \
        const size_t off_ = ((size_t)t_ * 64 + lrow) * d.cp + lch * 8; const f32x4 a_ = *(const f32x4*)(d.kc + off_), b_ = *(const f32x4*)(d.kc + off_ + 4), c_ = *(const f32x4*)(d.vc + off_), e_ = *(const f32x4*)(d.vc + off_ + 4); \
        kk_ = (u32x4){cvtpk(a_[0], a_[1]), cvtpk(a_[2], a_[3]), cvtpk(b_[0], b_[1]), cvtpk(b_[2], b_[3])}; vv_ = (u32x4){cvtpk(c_[0], c_[1]), cvtpk(c_[2], c_[3]), cvtpk(e_[0], e_[1]), cvtpk(e_[2], e_[3])}; } \
        *(LAS u32x4*)((BUF) + i_ * TILE_BYTES + kwoff) = kk_; *(LAS u32x4*)((BUF) + i_ * TILE_BYTES + KT_BYTES + vwoff) = vv_; } } } while (0)
    AT_ISSUE(0);
    for (int it = 0; it < nit; ++it) {
        const ldsp buf = lds + (it & 1) * BUF_BYTES;
        AT_WRITE(it, buf);
        __syncthreads();
        if (it + 1 < nit) AT_ISSUE(it + 1);
        const int t = 2 * it + ks;
        if (t >= tlo && t <= thi) {
            const ldsp Kt = buf + ks * TILE_BYTES, Vt = Kt + KT_BYTES;
            const int valid = (t == d.nt - 1) ? d.lastv : 64;
#pragma unroll
            for (int mp = 0; mp < NMAP; ++mp) {
                f32x16 s0, s1;
#pragma unroll
                for (int i = 0; i < 16; ++i) { s0[i] = 0.f; s1[i] = 0.f; }
#pragma unroll
                for (int st = 0; st < NSTEP; ++st) {
                    const bf16x8 a0 = *(const LAS bf16x8*)(Kt + kroff + (mp * 32 + st * 16) * 2);
                    const bf16x8 a1 = *(const LAS bf16x8*)(Kt + kroff + 32 * KPITCH + (mp * 32 + st * 16) * 2);
                    s0 = MFMA32(a0, qf[mp][st], s0); s1 = MFMA32(a1, qf[mp][st], s1);
                }
                if (MODE == 1) {
                    const int qpos = d.qpos0 + 32 * qg + r32, kp0 = d.kpos0 + 64 * t;
                    if (d.qpos0 + 32 * qg - (kp0 + 63) >= 128) { const float c = tab[256];
#pragma unroll
                        for (int i = 0; i < 16; ++i) { s0[i] += c; s1[i] += c; } }
                    else {
#pragma unroll
                        for (int i = 0; i < 16; ++i) { int dd = qpos - (kp0 + crow(i, hi)); int d0 = min(max(dd, -128), 128), d1 = min(max(dd - 32, -128), 128);
                            s0[i] += tab[d0 + 128]; s1[i] += tab[d1 + 128]; } }
                }
                if (valid < 64) {
#pragma unroll
                    for (int i = 0; i < 16; ++i) { const int k = crow(i, hi); if (k >= valid) s0[i] = NEG_BIG; if (k + 32 >= valid) s1[i] = NEG_BIG; } }
                float rm = fmaxf(s0[0], s1[0]);
#pragma unroll
                for (int i = 1; i < 16; ++i) rm = fmaxf(rm, fmaxf(s0[i], s1[i]));
                rm = xhalf_max(rm);
                if (__any(rm > mref[mp] + THR)) {
                    const float mn = fmaxf(mref[mp], rm), al = __builtin_amdgcn_exp2f(mref[mp] - mn);
                    mref[mp] = mn; lsum[mp] *= al;
#pragma unroll
                    for (int db = 0; db < 2; ++db)
#pragma unroll
                        for (int i = 0; i < 16; ++i) O[mp][db][i] *= al;
                }
                bf16x8 Pf[4];
                const float mr = mref[mp]; float sa = 0.f, sb = 0.f;
#pragma unroll
                for (int i = 0; i < 16; ++i) { s0[i] = __builtin_amdgcn_exp2f(s0[i] - mr); s1[i] = __builtin_amdgcn_exp2f(s1[i] - mr); sa += s0[i]; sb += s1[i]; }
                lsum[mp] += sa + sb;
#pragma unroll
                for (int s = 0; s < 2; ++s) {
                    u32x4 w0 = {cvtpk(s0[8 * s], s0[8 * s + 1]), cvtpk(s0[8 * s + 2], s0[8 * s + 3]), cvtpk(s0[8 * s + 4], s0[8 * s + 5]), cvtpk(s0[8 * s + 6], s0[8 * s + 7])};
                    u32x4 w1 = {cvtpk(s1[8 * s], s1[8 * s + 1]), cvtpk(s1[8 * s + 2], s1[8 * s + 3]), cvtpk(s1[8 * s + 4], s1[8 * s + 5]), cvtpk(s1[8 * s + 6], s1[8 * s + 7])};
                    Pf[s] = __builtin_bit_cast(bf16x8, w0); Pf[2 + s] = __builtin_bit_cast(bf16x8, w1);
                }
#pragma unroll
                for (int db = 0; db < 2; ++db)
#pragma unroll
                    for (int k4 = 0; k4 < 4; ++k4) {
                        const s16x4 lo = vtr(Vt + vroff + db * 4096 + k4 * 1024), hh = vtr(Vt + vroff + db * 4096 + k4 * 1024 + 512);
                        const bf16x8 vf = {lo[0], lo[1], lo[2], lo[3], hh[0], hh[1], hh[2], hh[3]};
                        O[mp][db] = MFMA32(vf, Pf[k4], O[mp][db]);
                    }
            }
        }
    }
#undef AT_ISSUE
#undef AT_WRITE
    __syncthreads();
    const ldsp cw = lds + COMB_OFF + qg * COMB_WAVE;
    if (ks == 1 && qg < d.nqg) {
#pragma unroll
        for (int mp = 0; mp < NMAP; ++mp) {
#pragma unroll
            for (int db = 0; db < 2; ++db)
#pragma unroll
                for (int i = 0; i < 16; ++i) *(LAS float*)(cw + ((mp * 2 + db) * 16 + i) * 256 + lane * 4) = O[mp][db][i];
            *(LAS float*)(cw + 16384 + (mp * 2) * 256 + lane * 4) = mref[mp]; *(LAS float*)(cw + 16384 + (mp * 2 + 1) * 256 + lane * 4) = lsum[mp];
        }
    }
    __syncthreads();
    if (ks == 0 && qg < d.nqg) {
        float linv[NMAP];
#pragma unroll
        for (int mp = 0; mp < NMAP; ++mp) {
            const float mb = *(const LAS float*)(cw + 16384 + (mp * 2) * 256 + lane * 4), lb = *(const LAS float*)(cw + 16384 + (mp * 2 + 1) * 256 + lane * 4);
            const float mt = fmaxf(mref[mp], mb), aa = __builtin_amdgcn_exp2f(mref[mp] - mt), ab = __builtin_amdgcn_exp2f(mb - mt);
            const float l = xhalf_sum(lsum[mp] * aa + lb * ab);
            linv[mp] = 1.0f / l;
#pragma unroll
            for (int db = 0; db < 2; ++db)
#pragma unroll
                for (int i = 0; i < 16; ++i) O[mp][db][i] = O[mp][db][i] * aa + *(const LAS float*)(cw + ((mp * 2 + db) * 16 + i) * 256 + lane * 4) * ab;
        }
        float fin = 1.f;
        if (MODE == 0) {
            const float i1 = linv[0], i2 = lam * linv[NMAP - 1]; float ss = 0.f;
#pragma unroll
            for (int db = 0; db < 2; ++db)
#pragma unroll
                for (int i = 0; i < 16; ++i) { const float o = O[0][db][i] * i1 - O[NMAP - 1][db][i] * i2; O[0][db][i] = o; ss += o * o; }
            ss = xhalf_sum(ss);
            fin = __builtin_amdgcn_rsqf(ss * (1.0f / 64.0f) + 1e-5f) * oml;
        } else fin = linv[0];
        const int row = 32 * qg + r32;
        if (row < d.nq) {
#pragma unroll
            for (int db = 0; db < 2; ++db)
#pragma unroll
                for (int g4 = 0; g4 < 4; ++g4) {
                    const int d0 = 32 * db + 8 * g4 + 4 * hi;
                    const u32x2 gw = *(const u32x2*)(d.gate + (size_t)row * ZLD + d0);
                    f32x4 sg = {1.f, 1.f, 1.f, 1.f}; if (MODE == 0) sg = *(const f32x4*)(subg + d0);
                    const float y0 = O[0][db][4 * g4] * fin * sg[0] * bf_lo(gw.x), y1 = O[0][db][4 * g4 + 1] * fin * sg[1] * bf_hi(gw.x);
                    const float y2 = O[0][db][4 * g4 + 2] * fin * sg[2] * bf_lo(gw.y), y3 = O[0][db][4 * g4 + 3] * fin * sg[3] * bf_hi(gw.y);
                    *(u32x2*)(d.y + (size_t)row * 1024 + d0) = (u32x2){cvtpk(y0, y1), cvtpk(y2, y3)};
                }
        }
    }
}
using namespace pg8;
constexpr size_t WS_CTL = WSO_CTL, CTL_BYTES = 1u << 20, WS_SSQ0 = WSO_SSQ0, WS_ROPE = WSO_ROPE, WS_WIN = WSO_WIN, WS_WOUT = WSO_WOUT, WS_XB = WSO_XB, WS_YMIX = WSO_YMIX, WS_X1 = WSO_X1, WS_Z = WSO_Z, WS_END = WSO_END;
static_assert((size_t)MROWS * 1024 * 2 <= 36u * (1u << 20) && (size_t)MROWS * 1024 * 4 <= 68u * (1u << 20) && (size_t)MROWS * 4096 * 2 <= 132u * (1u << 20), "ws map");
constexpr int CTL_Q0 = 0, CTL_SSQ1 = 16384, CTL_SSQ2 = 16384 + 32768;
static_assert((CTL_SSQ2 + MROWS) * 4 <= (int)CTL_BYTES, "ctl");
constexpr size_t O_Y = OO_Y, O_CONVP = OO_CONVP, O_CONVS = OO_CONVS, O_END = OO_END;
struct Args { const float* in[18]; float* out; unsigned char* ws; };

__device__ __forceinline__ float wave_sum(float v) {
#pragma unroll
    for (int o = 1; o < 64; o <<= 1) v += __shfl_xor(v, o);
    return v;
}
__device__ __forceinline__ unsigned f2bf(float f) { unsigned u = __builtin_bit_cast(unsigned, f); return (u + 0x7fffu + ((u >> 16) & 1u)) >> 16; }
__device__ __forceinline__ unsigned pk2(float lo, float hi) { return f2bf(lo) | (f2bf(hi) << 16); }
__device__ __forceinline__ void p0_transpose_item(const float* W, const float* g, int K, int N, bf16_t* WT, LAS float* scr, int item, int lane) {
    const int nblk = N / 32, kb = item / nblk, nb = item % nblk, k0 = 64 * kb, n0 = 32 * nb;
#pragma unroll 8
    for (int i = 0; i < 32; ++i) { const int kk = 2 * i + (lane >> 5); const float gs = g ? g[k0 + kk] : 1.f; scr[kk * 33 + (lane & 31)] = W[(size_t)(k0 + kk) * N + n0 + (lane & 31)] * gs; }
    asm volatile("s_waitcnt lgkmcnt(0)" ::: "memory");
    const int c = lane & 7;
#pragma unroll
    for (int j = 0; j < 4; ++j) { const int n = (lane >> 3) + 8 * j; const LAS float* s = scr + (8 * c) * 33 + n;
        u32x4 o; o.x = pk2(s[0 * 33], s[1 * 33]); o.y = pk2(s[2 * 33], s[3 * 33]); o.z = pk2(s[4 * 33], s[5 * 33]); o.w = pk2(s[6 * 33], s[7 * 33]);
        *(u32x4*)(WT + (size_t)(n0 + n) * K + k0 + 8 * c) = o; }
    asm volatile("s_waitcnt lgkmcnt(0)" ::: "memory");
}

__global__ void __launch_bounds__(512) fwd_megakernel(Args args) {
    extern __shared__ __attribute__((aligned(16))) unsigned char lds_raw[];
    cg::grid_group grid = cg::this_grid();
    const ldsp lds = (ldsp)lds_raw;
    const int tid = threadIdx.x, lane = tid & 63, wave = __builtin_amdgcn_readfirstlane(tid >> 6);
    const int G = gridDim.x, bx = blockIdx.x;
    unsigned char* ws = args.ws; float* out = args.out;
    unsigned* ctl = (unsigned*)(ws + WS_CTL);
    float* SSQ0 = (float*)(ws + WS_SSQ0); float* SSQ1 = (float*)ctl + CTL_SSQ1; float* SSQ2 = (float*)ctl + CTL_SSQ2;
    float* ROPE = (float*)(ws + WS_ROPE);
    bf16_t* WIN = (bf16_t*)(ws + WS_WIN); bf16_t* WOUT = (bf16_t*)(ws + WS_WOUT);
    bf16_t* XB = (bf16_t*)(ws + WS_XB); bf16_t* YMIX = (bf16_t*)(ws + WS_YMIX); float* X1 = (float*)(ws + WS_X1); bf16_t* Z = (bf16_t*)(ws + WS_Z);
    const float* x_p = args.in[0]; const float* x_s = args.in[1];

    {
        LAS float* scr = (LAS float*)(lds + wave * 16384);
        const int gw = bx * 8 + wave, NGW = G * 8;
        constexpr int I_IN = (1024 / 64) * (4096 / 32), I_OUT = (1024 / 64) * (1024 / 32), NITEMS = 2 * I_IN + 2 * I_OUT;
        for (int it = gw; it < NITEMS; it += NGW) {
            int r = it;
            if (r < 2 * I_IN) { const int l = r / I_IN; r -= l * I_IN; p0_transpose_item(args.in[8] + (size_t)l * 1024 * 4096, args.in[7] + l * 1024, 1024, 4096, WIN + (size_t)l * 4096 * 1024, scr, r, lane); }
            else { r -= 2 * I_IN; const int l = r / I_OUT; r -= l * I_OUT; p0_transpose_item(args.in[9] + (size_t)l * 1024 * 1024, nullptr, 1024, 1024, WOUT + (size_t)l * 1024 * 1024, scr, r, lane); }
        }
        for (int m = gw; m < MROWS; m += NGW) {
            const float* xr = (m < NPROMPT) ? x_p + (size_t)m * 1024 : x_s + (size_t)(m - NPROMPT) * 1024;
            f32x4 v[4]; float s = 0.f;
#pragma unroll
            for (int j = 0; j < 4; ++j) { v[j] = *((const f32x4*)xr + lane + 64 * j); s += (v[j][0] * v[j][0] + v[j][1] * v[j][1]) + (v[j][2] * v[j][2] + v[j][3] * v[j][3]); }
            s = wave_sum(s);
            if (lane == 0) SSQ0[m] = s;
#pragma unroll
            for (int j = 0; j < 4; ++j) *((u32x2*)(XB + (size_t)m * 1024) + lane + 64 * j) = (u32x2){cvtpk(v[j][0], v[j][1]), cvtpk(v[j][2], v[j][3])};
        }
        for (int e = bx * 512 + tid; e < MROWS * 4; e += G * 512) {
            const int row = e >> 2, i = e & 3; const int pos = (row < NPROMPT) ? row : 4096 + ((row - NPROMPT) & 15);
            const float invf = (i == 0) ? 1.0f : (i == 1 ? 0.037606030930863934f : (i == 2 ? 0.0014142135623730950f : 5.318295896944988e-05f));
            const float ang = (float)pos * invf;
            const double rev = (double)ang * 0.15915494309189535; const float fr = (float)(rev - __builtin_rint(rev));
            ROPE[(size_t)row * 8 + i] = __builtin_amdgcn_cosf(fr); ROPE[(size_t)row * 8 + 4 + i] = __builtin_amdgcn_sinf(fr);
        }
    }
    grid.sync();

    for (int l = 0; l < 2; ++l) {
        {
            pg8::Gemm g{XB, WIN + (size_t)l * 4096 * 1024, MROWS, 4096, 1024}; pg8::StaticOrder S; S.init(MROWS, 4096, G, bx);
            pg8::EpiIn E{ws, out, l};

#ifndef NO_GEMM1
            pg8::gemm_phase<pg8::EpiIn, pg8::StaticOrder, true, true>(lds, g, S, E);
#endif

        }
        grid.sync();
        {
            const float lam_init = (l == 0) ? 0.2f : 0.35550906759096927f;
            float d1 = 0.f, d2 = 0.f;
            for (int i = 0; i < 32; ++i) { d1 += args.in[12][l * 32 + i] * args.in[13][l * 32 + i]; d2 += args.in[14][l * 32 + i] * args.in[15][l * 32 + i]; }
            const float lam = __expf(d1) - __expf(d2) + lam_init, oml = 1.0f - lam_init;
            const float* subg = args.in[16] + l * 64;
            volatile LAS int* misc = (volatile LAS int*)(lds + MISC_OFF);
            constexpr int N_PC = 512, N_SC = 64, N_PA = 1024, N_SA = 128, N_CV = 130, N_TOT = N_PC + N_SC + N_PA + N_SA + N_CV;
            for (;;) {
                __syncthreads();
                if (tid == 0) misc[0] = (int)atomicAdd(ctl + CTL_Q0 + l, 1u);
                __syncthreads();
                int ui = misc[0]; ui = __builtin_amdgcn_readfirstlane(ui);
                if (ui >= N_TOT) break;
                AU d; d.kc = nullptr; d.vc = nullptr; d.cp = 0; d.ntc = 0; d.lastv = 64; d.nqg = 4; d.tlo1 = 0; d.thi1 = -1; d.qpos0 = 0; d.kpos0 = 0;
                int kind;
                int idx = ui;
                if (idx < 128) kind = 0; else if (idx < 192) { kind = 1; idx -= 128; } else if (idx < 576) { kind = 0; idx -= 64; } else if (idx < 1600) { kind = 2; idx -= 576; } else if (idx < 1728) { kind = 3; idx -= 1600; } else { kind = 4; idx -= 1728; }
                if (kind == 0) {
                    const int u = 127 - (idx >> 2), h = idx & 3; const size_t r0 = (size_t)128 * u;
                    d.q = Z + r0 * ZLD + 3072 + 64 * h; d.nq = 128; d.nt = 2 * u + 2; d.kz = Z + 3328 + 64 * h; d.vz = Z + 3584 + 64 * h;
                    d.tlo0 = 0; d.thi0 = d.nt - 2; d.tlo1 = 0; d.thi1 = d.nt - 1; d.gate = Z + r0 * ZLD + 3840 + 64 * h; d.y = YMIX + r0 * 1024 + 768 + 64 * h;

#ifndef NO_ATTN0
                    attn_unit<0>(d, lds, lam, oml, subg);
#endif

                } else if (kind == 1) {
                    const int b = idx >> 2, h = idx & 3; const size_t r0 = (size_t)NPROMPT + 16 * b;
                    d.q = Z + r0 * ZLD + 3072 + 64 * h; d.nq = 16; d.nt = 65; d.ntc = 64; d.cp = 256;
                    d.kc = args.in[5] + ((size_t)(l * 16 + b) * 4096) * 256 + 64 * h; d.vc = args.in[6] + ((size_t)(l * 16 + b) * 4096) * 256 + 64 * h;
                    d.kz = Z + r0 * ZLD + 3328 + 64 * h; d.vz = Z + r0 * ZLD + 3584 + 64 * h; d.lastv = 16; d.nqg = 1; d.tlo0 = 0; d.thi0 = 64;
                    d.gate = Z + r0 * ZLD + 3840 + 64 * h; d.y = YMIX + r0 * 1024 + 768 + 64 * h;

#ifndef NO_ATTN0
                    attn_unit<0>(d, lds, lam, oml, subg);
#endif

                } else if (kind == 2 || kind == 3) {
                    int h;
                    if (kind == 2) {
                        h = idx & 7; const int cp = idx >> 3, c0 = max(0, 2 * cp - 8); const size_t r0 = (size_t)128 * cp;
                        d.q = Z + r0 * ZLD + 64 * h; d.nq = 128; d.nt = 2 * cp + 2 - c0; d.kz = Z + (size_t)64 * c0 * ZLD + 512 + 64 * h; d.vz = Z + (size_t)64 * c0 * ZLD + 1024 + 64 * h;
                        d.tlo0 = 0; d.thi0 = 2 * cp - c0; d.tlo1 = max(0, 2 * cp + 1 - 8) - c0; d.thi1 = 2 * cp + 1 - c0; d.qpos0 = 128 * cp; d.kpos0 = 64 * c0;
                        d.gate = Z + r0 * ZLD + 1536 + 64 * h; d.y = YMIX + r0 * 1024 + 64 * h;
                    } else {
                        h = idx & 7; const int b = idx >> 3; const size_t r0 = (size_t)NPROMPT + 16 * b;
                        d.q = Z + r0 * ZLD + 64 * h; d.nq = 16; d.nt = 9; d.ntc = 8; d.cp = 512;
                        d.kc = args.in[2] + ((size_t)(l * 16 + b) * 512) * 512 + 64 * h; d.vc = args.in[3] + ((size_t)(l * 16 + b) * 512) * 512 + 64 * h;
                        d.kz = Z + r0 * ZLD + 512 + 64 * h; d.vz = Z + r0 * ZLD + 1024 + 64 * h; d.lastv = 16; d.nqg = 1; d.tlo0 = 0; d.thi0 = 8; d.qpos0 = 512; d.kpos0 = 0;
                        d.gate = Z + r0 * ZLD + 1536 + 64 * h; d.y = YMIX + r0 * 1024 + 64 * h;
                    }
                    if (tid < 257) ((LAS float*)(lds + TAB_OFF))[tid] = args.in[10][(size_t)(l * 8 + h) * 257 + tid] * LOG2E;

#ifndef NO_ATTN1
                    attn_unit<1>(d, lds, 0.f, 0.f, nullptr);
#endif

                } else {
                    int tq_ = threadIdx.x; asm volatile("" : "+v"(tq_));
                    const int c8 = (tq_ & 31) * 8, rr = tq_ >> 5;
                    const float* cw = args.in[11] + (size_t)l * 3 * 256 + c8;
                    float w0[8], w1[8], w2[8];
#pragma unroll
                    for (int j = 0; j < 8; ++j) { w0[j] = cw[j]; w1[j] = cw[256 + j]; w2[j] = cw[512 + j]; }
                    for (int g = 0; g < 8; ++g) {
                        const int row = 128 * idx + 16 * g + rr; const bool smp = row >= NPROMPT; const int t = smp ? ((row - NPROMPT) & 15) : row, b = (row - NPROMPT) >> 4;
                        const bf16_t* zr = Z + (size_t)row * ZLD;
                        float u0[8], u1[8], u2[8];
                        { const u32x4 c = *(const u32x4*)(zr + 2304 + c8), hh = *(const u32x4*)(zr + 2560 + c8);
#pragma unroll
                          for (int j = 0; j < 4; ++j) { u0[2 * j] = bf_lo(c[j]) * bf_lo(hh[j]); u0[2 * j + 1] = bf_hi(c[j]) * bf_hi(hh[j]); } }
                        if (t >= 1) { const u32x4 c = *(const u32x4*)(zr - ZLD + 2304 + c8), hh = *(const u32x4*)(zr - ZLD + 2560 + c8);
#pragma unroll
                          for (int j = 0; j < 4; ++j) { u1[2 * j] = bf_lo(c[j]) * bf_lo(hh[j]); u1[2 * j + 1] = bf_hi(c[j]) * bf_hi(hh[j]); } }
                        else if (smp) { const float* sp = args.in[4] + ((size_t)(l * 16 + b) * 2 + 1) * 256 + c8;
#pragma unroll
                          for (int j = 0; j < 8; ++j) u1[j] = sp[j]; }
                        else {
#pragma unroll
                          for (int j = 0; j < 8; ++j) u1[j] = 0.f; }
                        if (t >= 2) { const u32x4 c = *(const u32x4*)(zr - 2 * ZLD + 2304 + c8), hh = *(const u32x4*)(zr - 2 * ZLD + 2560 + c8);
#pragma unroll
                          for (int j = 0; j < 4; ++j) { u2[2 * j] = bf_lo(c[j]) * bf_lo(hh[j]); u2[2 * j + 1] = bf_hi(c[j]) * bf_hi(hh[j]); } }
                        else if (smp) { const float* sp = args.in[4] + ((size_t)(l * 16 + b) * 2 + t) * 256 + c8;
#pragma unroll
                          for (int j = 0; j < 8; ++j) u2[j] = sp[j]; }
                        else {
#pragma unroll
                          for (int j = 0; j < 8; ++j) u2[j] = 0.f; }
                        const u32x4 bb = *(const u32x4*)(zr + 2048 + c8), bg = *(const u32x4*)(zr + 2816 + c8);
                        float y[8];
#pragma unroll
                        for (int j = 0; j < 4; ++j) {
                            y[2 * j] = bf_lo(bb[j]) * (u2[2 * j] * w0[2 * j] + u1[2 * j] * w1[2 * j] + u0[2 * j] * w2[2 * j]) * bf_lo(bg[j]);
                            y[2 * j + 1] = bf_hi(bb[j]) * (u2[2 * j + 1] * w0[2 * j + 1] + u1[2 * j + 1] * w1[2 * j + 1] + u0[2 * j + 1] * w2[2 * j + 1]) * bf_hi(bg[j]); }
                        *(u32x4*)(YMIX + (size_t)row * 1024 + 512 + c8) = (u32x4){cvtpk(y[0], y[1]), cvtpk(y[2], y[3]), cvtpk(y[4], y[5]), cvtpk(y[6], y[7])};
                        float* so = nullptr;
                        if (!smp && row >= NPROMPT - 2) so = out + O_CONVP + (size_t)l * 512 + (size_t)(row - (NPROMPT - 2)) * 256 + c8;
                        if (smp && t >= 14) so = out + O_CONVS + (size_t)l * 8192 + (size_t)b * 512 + (size_t)(t - 14) * 256 + c8;
                        if (so) { *(f32x4*)so = (f32x4){u0[0], u0[1], u0[2], u0[3]}; *(f32x4*)(so + 4) = (f32x4){u0[4], u0[5], u0[6], u0[7]}; }
                    }
                }
            }
        }
        grid.sync();
        {
            pg8::Gemm g{YMIX, WOUT + (size_t)l * 1024 * 1024, MROWS, 1024, 1024}; pg8::StaticOrder S; S.init(MROWS, 1024, G, bx);
            pg8::EpiOut E{ws, x_p, x_s, l};

#ifndef NO_GEMM2
            pg8::gemm_phase<pg8::EpiOut, pg8::StaticOrder, true, true>(lds, g, S, E);
#endif

        }
        grid.sync();
    }
    {
        const int gw = bx * 8 + wave, NGW = G * 8;
        const float* fg = args.in[17];
        f32x4 gv[4];
#pragma unroll
        for (int j = 0; j < 4; ++j) gv[j] = *((const f32x4*)fg + lane + 64 * j);
        for (int m = gw; m < MROWS; m += NGW) {
            const float rs = __builtin_amdgcn_rsqf(SSQ2[m] * (1.0f / 1024.0f) + 1e-6f);
#pragma unroll
            for (int j = 0; j < 4; ++j) { const f32x4 v = *((const f32x4*)(X1 + (size_t)m * 1024) + lane + 64 * j); *((f32x4*)(out + O_Y + (size_t)m * 1024) + lane + 64 * j) = v * rs * gv[j]; }
        }
    }
}

extern "C" void kernel_launch(void* const* d_in, const int* in_sizes, int n_in, void* d_out, int out_size, void* d_ws, size_t ws_size, hipStream_t stream) {
    static int grid_blocks = 0;
    if (!grid_blocks) {
        if (n_in != 18 || (size_t)out_size != O_END || ws_size < WS_END) { fprintf(stderr, "kernel_launch: unexpected shapes n_in %d out %d ws %zu\n", n_in, out_size, ws_size); grid_blocks = -1; return; }
        int dev = 0, cus = 0, per_cu = 0;
        hipGetDevice(&dev); hipDeviceGetAttribute(&cus, hipDeviceAttributeMultiprocessorCount, dev);
        hipFuncSetAttribute((const void*)fwd_megakernel, hipFuncAttributeMaxDynamicSharedMemorySize, LDS_BYTES);
        hipOccupancyMaxActiveBlocksPerMultiprocessor(&per_cu, (const void*)fwd_megakernel, 512, LDS_BYTES);
        if (per_cu < 1) { fprintf(stderr, "kernel_launch: occupancy query says %d blocks per CU\n", per_cu); per_cu = 1; }
        if (per_cu > 1) per_cu = 1;
        grid_blocks = cus * per_cu;
    }
    if (grid_blocks < 0) return;
    hipMemsetAsync((char*)d_ws + WS_CTL, 0, CTL_BYTES, stream);
    Args a{};
    for (int i = 0; i < 18; ++i) a.in[i] = (const float*)d_in[i];
    a.out = (float*)d_out; a.ws = (unsigned char*)d_ws;
    void* kargs[] = {&a};
    hipError_t e = hipLaunchCooperativeKernel((const void*)fwd_megakernel, dim3(grid_blocks), dim3(512), kargs, LDS_BYTES, stream);
    if (e != hipSuccess) fprintf(stderr, "cooperative launch failed: %s (grid %d)\n", hipGetErrorString(e), grid_blocks);
}
```

```cpp
#include <hip/hip_runtime.h>
#include <hip/hip_cooperative_groups.h>
#include <cstdio>
#include <cstdint>
namespace cg = cooperative_groups;
namespace pg8 {
#define PG8_LAS __attribute__((address_space(3)))
typedef unsigned short bf16_t;
typedef short bf16x8 __attribute__((ext_vector_type(8)));
typedef float f32x4 __attribute__((ext_vector_type(4)));
typedef unsigned u32x4 __attribute__((ext_vector_type(4)));
constexpr int BM = 256, BK = 64, HALF = 128, HTB = HALF * BK * 2  , STAGE_BYTES = 8 * HTB, NXCD = 8, WGM = 8;

__host__ __device__ __forceinline__ int lds_byte(int r, int c) { const int st = (r >> 4) * 2 + (c >> 5), rr = r & 15, cc = c & 31, ob = rr * 64 + cc * 2; return st * 1024 + (ob ^ (((ob >> 9) & 1) << 5)); }
__host__ __device__ __forceinline__ void stage_rc(int b, int& R, int& C) { const int st = b / 1024, sb = b % 1024, swz = sb ^ (((sb >> 9) & 1) << 5); R = (st >> 1) * 16 + swz / 64; C = (st & 1) * 32 + (swz % 64) / 2; }
__host__ __device__ __forceinline__ int perm32(int rho) { const int n = rho >> 4, i = rho & 15; return 8 * (i >> 2) + 4 * n + (i & 3); }

struct Unit { int pm, pn; };
struct Gemm { const bf16_t* A; const bf16_t* Bt; int M, N, K; };

struct StaticOrder {
    int nM, nN, nwg, G, c;
    __host__ __device__ void init(int M, int N, int G_, int c_) { nM = M / BM; nN = N / BM; nwg = nM * nN; G = G_; c = c_; }
    __host__ __device__ bool next(int i, Unit& u) const {
        const long L = (long)i * G + c; if (L >= nwg) return false;
        int wgid = (int)L; { const int q = nwg / NXCD, r = nwg % NXCD, xcd = wgid % NXCD, off = wgid / NXCD; wgid = (xcd < r ? xcd * (q + 1) : r * (q + 1) + (xcd - r) * q) + off; }
        const int nig = WGM * nN, gid = wgid / nig, fm = gid * WGM, gsz = (nM - fm) < WGM ? (nM - fm) : WGM;
        u.pm = fm + ((wgid % nig) % gsz); u.pn = (wgid % nig) / gsz; return true;
    }
    __device__ __forceinline__ void a_ready(const Unit&) const {}
    __device__ __forceinline__ void done(const Unit&) const {}
};
struct OneUnit {
    int pm, pn;
    __host__ __device__ bool next(int i, Unit& u) const { if (i) return false; u.pm = pm; u.pn = pn; return true; }
    __device__ __forceinline__ void a_ready(const Unit&) const {}
    __device__ __forceinline__ void done(const Unit&) const {}
};
__device__ __forceinline__ unsigned cvt_pk_bf16(float lo, float hi) { unsigned r; asm volatile("v_cvt_pk_bf16_f32 %0, %1, %2" : "=v"(r) : "v"(lo), "v"(hi)); return r; }
typedef float f32x2 __attribute__((ext_vector_type(2)));
constexpr float LOG2E = 1.4426950408889634f;
constexpr float SC_QA = 0.125f * LOG2E;
constexpr float SC_QC = 0.17677669529663687f * LOG2E;
constexpr int ZLD = 4096, MROWS = 16640, NPROMPT = 16384;
constexpr size_t WSO_MiB = 1u << 20;
constexpr size_t WSO_CTL = 0, WSO_SSQ1 = 16384 * 4, WSO_SSQ2 = (16384 + 32768) * 4, WSO_SSQ0 = 1 * WSO_MiB, WSO_ROPE = 2 * WSO_MiB, WSO_WIN = 4 * WSO_MiB, WSO_WOUT = 20 * WSO_MiB, WSO_XB = 24 * WSO_MiB,
                 WSO_YMIX = 60 * WSO_MiB, WSO_X1 = 96 * WSO_MiB, WSO_Z = 164 * WSO_MiB, WSO_END = 296 * WSO_MiB;
constexpr size_t OO_Y = 0, OO_AKP = 17039360, OO_AVP = OO_AKP + 524288, OO_CONVP = OO_AVP + 524288, OO_CKP = OO_CONVP + 1024, OO_CVP = OO_CKP + 8388608,
                 OO_AKS = OO_CVP + 8388608, OO_AVS = OO_AKS + 262144, OO_CONVS = OO_AVS + 262144, OO_CKS = OO_CONVS + 16384, OO_CVS = OO_CKS + 131072, OO_END = OO_CVS + 131072;
__device__ __forceinline__ float silu_f(float x) { return x * __builtin_amdgcn_rcpf(1.0f + __builtin_amdgcn_exp2f(-x * LOG2E)); }
struct EpiIn {
    static constexpr bool PERM = true, AFTER_DRAIN = false;
    unsigned char* ws; float* out; int l;
    __device__ __forceinline__ void operator()(const f32x4 (&acc)[2][2][4][2], const Unit& u, int wr, int wc, int fr, int fq) const {
        const int pn = u.pn, pm = u.pm;
        bf16_t* Z = (bf16_t*)(ws + WSO_Z); const float* ssq = (const float*)(ws + (l == 0 ? WSO_SSQ0 : WSO_SSQ1)); const float* rope = (const float*)(ws + WSO_ROPE);
        float* o_ak_p = out + OO_AKP + (size_t)l * 262144; float* o_av_p = out + OO_AVP + (size_t)l * 262144; float* o_ak_s = out + OO_AKS + (size_t)l * 131072; float* o_av_s = out + OO_AVS + (size_t)l * 131072;
        float* o_ck_p = out + OO_CKP + (size_t)l * 4194304; float* o_cv_p = out + OO_CVP + (size_t)l * 4194304; float* o_ck_s = out + OO_CKS + (size_t)l * 65536; float* o_cv_s = out + OO_CVS + (size_t)l * 65536;
        const int rowl = wr * 64 + fr;
        const int colb = pn * BM + wc * 32 + 8 * fq;
        const bool rope_tile = (pn == 12 || pn == 13);
        const bool do_rope = rope_tile && fq == 0;
        const float sc = (pn < 2) ? SC_QA : (pn == 12 ? SC_QC : 1.f);
        const bool do_silu = (pn == 6 || pn == 7 || pn == 11 || pn == 15);
        float* ob = nullptr; int old = 0, ocol0 = 0;
        if (pn >= 2 && pn <= 5) { old = 512; ocol0 = (pn >= 4) ? 1024 : 512;
            if (pm == 64) ob = (pn >= 4) ? o_av_s : o_ak_s; else if (pm >= 62) ob = ((pn >= 4) ? o_av_p : o_ak_p) + (size_t)(pm - 62) * 256 * 512; }
        else if (pn == 13 || pn == 14) { old = 256; ocol0 = (pn == 13) ? 3328 : 3584;
            if (pm == 64) ob = (pn == 13) ? o_ck_s : o_cv_s; else ob = ((pn == 13) ? o_ck_p : o_cv_p) + (size_t)pm * 256 * 256; }
#pragma unroll
        for (int ai = 0; ai < 2; ++ai)
#pragma unroll
            for (int m = 0; m < 4; ++m) {
                const int rl = rowl + ai * HALF + m * 16, row = pm * BM + rl;
                const float rs = __builtin_amdgcn_rsqf(ssq[row] * (1.0f / 1024.0f) + 1e-6f);
                f32x4 rc = {1.f, 1.f, 1.f, 1.f}, rsn = {0.f, 0.f, 0.f, 0.f};
                if (do_rope) { rc = *(const f32x4*)(rope + (size_t)row * 8); rsn = *(const f32x4*)(rope + (size_t)row * 8 + 4); }
#pragma unroll
                for (int bj = 0; bj < 2; ++bj) {
                    f32x4 v0 = acc[ai][bj][m][0] * rs, v1 = acc[ai][bj][m][1] * rs;
                    const int col = colb + bj * HALF;
                    if (rope_tile) { const f32x4 a = v0 * rc - v1 * rsn, b = v1 * rc + v0 * rsn; v0 = a; v1 = b; }
                    if (ob) { float* op = ob + (size_t)rl * old + (col - ocol0); *(f32x4*)op = v0; *(f32x4*)(op + 4) = v1; }
                    if (do_silu) { v0 = (f32x4){silu_f(v0[0]), silu_f(v0[1]), silu_f(v0[2]), silu_f(v0[3])}; v1 = (f32x4){silu_f(v1[0]), silu_f(v1[1]), silu_f(v1[2]), silu_f(v1[3])}; }
                    v0 = v0 * sc; v1 = v1 * sc;
                    u32x4 w; w.x = cvt_pk_bf16(v0[0], v0[1]); w.y = cvt_pk_bf16(v0[2], v0[3]); w.z = cvt_pk_bf16(v1[0], v1[1]); w.w = cvt_pk_bf16(v1[2], v1[3]);
                    *(u32x4*)(Z + (size_t)row * ZLD + col) = w;
                }
                asm volatile("" ::: "memory");
            }
    }
};
struct EpiOut {
    static constexpr bool PERM = true, AFTER_DRAIN = false;
    unsigned char* ws; const float* x_p; const float* x_s; int l;
    __device__ __forceinline__ void operator()(const f32x4 (&acc)[2][2][4][2], const Unit& u, int wr, int wc, int fr, int fq) const {
        const int pm = u.pm; const int colb = u.pn * BM + wc * 32 + 8 * fq;
        float* X1 = (float*)(ws + WSO_X1) + (size_t)pm * BM * 1024; bf16_t* XB = (bf16_t*)(ws + WSO_XB) + (size_t)pm * BM * 1024; float* ssq = (float*)(ws + (l == 0 ? WSO_SSQ1 : WSO_SSQ2)) + pm * BM;
        const float* res = (l == 0) ? ((pm == 64) ? x_s : x_p + (size_t)pm * BM * 1024) : X1;
        const unsigned off0 = (unsigned)(wr * 64 + fr) * 1024u + (unsigned)colb;
#pragma unroll
        for (int ai = 0; ai < 2; ++ai)
#pragma unroll
            for (int m = 0; m < 4; ++m) {
                const unsigned offr = off0 + (unsigned)(ai * HALF + m * 16) * 1024u; float q = 0.f;
#pragma unroll
                for (int bj = 0; bj < 2; ++bj) { const unsigned off = offr + bj * HALF;
                    const f32x4 v0 = acc[ai][bj][m][0] + *(const f32x4*)(res + off), v1 = acc[ai][bj][m][1] + *(const f32x4*)(res + off + 4);
                    *(f32x4*)(X1 + off) = v0; *(f32x4*)(X1 + off + 4) = v1;
                    u32x4 w; w.x = cvt_pk_bf16(v0[0], v0[1]); w.y = cvt_pk_bf16(v0[2], v0[3]); w.z = cvt_pk_bf16(v1[0], v1[1]); w.w = cvt_pk_bf16(v1[2], v1[3]);
                    *(u32x4*)(XB + off) = w;
                    q += (v0[0] * v0[0] + v0[1] * v0[1]) + (v0[2] * v0[2] + v0[3] * v0[3]) + (v1[0] * v1[0] + v1[1] * v1[1]) + (v1[2] * v1[2] + v1[3] * v1[3]);
                    asm volatile("" ::: "memory"); }
                q += __shfl_xor(q, 16); q += __shfl_xor(q, 32);
                if (fq == 0) atomicAdd(ssq + (wr * 64 + fr + ai * HALF + m * 16), q);
                asm volatile("" ::: "memory");
            }
    }
};
template <class Epi, class Sched, bool ALIGN_EPI = false, bool SP2 = false>
__device__ __forceinline__ void gemm_phase(PG8_LAS unsigned char* lds, const Gemm g, const Sched& S, const Epi& E) {
    int tid_ = threadIdx.x; asm volatile("" : "+v"(tid_));
    const int tid = tid_, wid = __builtin_amdgcn_readfirstlane(tid >> 6), lane = tid & 63, wr = wid >> 2, wc = wid & 3, fr = lane & 15, fq = lane >> 4;
    const int K = g.K, nt = K / BK;
    unsigned voffA[2], voffB[2];
#pragma unroll
    for (int i = 0; i < 2; ++i) { int R, C; stage_rc(tid * 16 + i * 8192, R, C); const int Rb = Epi::PERM ? ((R & ~31) + perm32(R & 31)) : R;
        voffA[i] = (unsigned)(R * K + C) * 2u; voffB[i] = (unsigned)(Rb * K + C) * 2u; }
    const size_t kstep = (size_t)(BK * 2);
    const size_t hstep = (size_t)HALF * K * 2;
    const size_t tstep = 2 * hstep;
    const unsigned ldsw = (unsigned)wid * 1024u;
    const int aoff = lds_byte(wr * 64 + fr, fq * 8), boff = lds_byte(wc * 32 + fr, fq * 8);
#define PG8_SA(b, h) (((b) * 2 + (h)) * HTB)
#define PG8_SB(b, h) ((4 + (b) * 2 + (h)) * HTB)
#define PG8_STAGE(bufoff, gbase, voff) do { _Pragma("unroll") for (int _i = 0; _i < 2; ++_i) \
        __builtin_amdgcn_global_load_lds((const unsigned*)((const char*)(gbase) + (voff)[_i]), (PG8_LAS unsigned*)(lds + (bufoff) + ldsw + _i * 8192), 16, 0, 0); } while (0)
#define PG8_LDA(dst, b, h) do { _Pragma("unroll") for (int m = 0; m < 4; ++m) _Pragma("unroll") for (int k = 0; k < 2; ++k) dst[m][k] = *(const PG8_LAS bf16x8*)(lds + PG8_SA(b, h) + aoff + m * 2048 + k * 1024); } while (0)
#define PG8_LDB(dst, b, h) do { _Pragma("unroll") for (int n = 0; n < 2; ++n) _Pragma("unroll") for (int k = 0; k < 2; ++k) dst[n][k] = *(const PG8_LAS bf16x8*)(lds + PG8_SB(b, h) + boff + n * 2048 + k * 1024); } while (0)
#define PG8_MMA(ai, bj, At, Bt) do { __builtin_amdgcn_s_setprio(1); _Pragma("unroll") for (int m = 0; m < 4; ++m) _Pragma("unroll") for (int n = 0; n < 2; ++n) _Pragma("unroll") for (int k = 0; k < 2; ++k) \
        acc[ai][bj][m][n] = __builtin_amdgcn_mfma_f32_16x16x32_bf16(Bt[n][k], At[m][k], acc[ai][bj][m][n], 0, 0, 0); __builtin_amdgcn_s_setprio(0); } while (0)
#define PG8_WAIT_V(n) asm volatile("s_waitcnt vmcnt(" #n ")" ::: "memory")
#define PG8_WAIT_L(n) asm volatile("s_waitcnt lgkmcnt(" #n ")" ::: "memory")
#define PG8_BAR __builtin_amdgcn_s_barrier()
#define PG8_SCHED __builtin_amdgcn_sched_barrier(0)
    Unit cur, nxt; int ui = 0;
    if (!S.next(0, cur)) return;
    f32x4 acc[2][2][4][2];
#pragma unroll
    for (int a = 0; a < 2; ++a)
#pragma unroll
        for (int b = 0; b < 2; ++b)
#pragma unroll
            for (int m = 0; m < 4; ++m)
#pragma unroll
                for (int n = 0; n < 2; ++n) acc[a][b][m][n] = (f32x4){0.f, 0.f, 0.f, 0.f};
    bf16x8 At[4][2], B0[2][2], B1[2][2];
    const char* cA = (const char*)g.A + (size_t)cur.pm * tstep; const char* cB = (const char*)g.Bt + (size_t)cur.pn * tstep;
    S.a_ready(cur);
    if constexpr (SP2) {
        PG8_STAGE(PG8_SB(0, 0), cB, voffB); PG8_STAGE(PG8_SB(0, 1), cB + hstep, voffB); PG8_STAGE(PG8_SA(0, 0), cA, voffA); PG8_STAGE(PG8_SA(0, 1), cA + hstep, voffA);
        if (wr == 1) PG8_BAR;
        PG8_WAIT_V(2); PG8_BAR;
        PG8_STAGE(PG8_SB(1, 0), cB + kstep, voffB); PG8_STAGE(PG8_SA(1, 0), cA + kstep, voffA); PG8_STAGE(PG8_SB(1, 1), cB + hstep + kstep, voffB);
        PG8_WAIT_V(6); PG8_BAR;
    } else {
        PG8_STAGE(PG8_SB(0, 0), cB, voffB); PG8_STAGE(PG8_SA(0, 0), cA, voffA); PG8_STAGE(PG8_SB(0, 1), cB + hstep, voffB); PG8_STAGE(PG8_SA(0, 1), cA + hstep, voffA);
        if (wr == 1) PG8_BAR;
        PG8_WAIT_V(4); PG8_BAR;
        PG8_STAGE(PG8_SB(1, 0), cB + kstep, voffB); PG8_STAGE(PG8_SA(1, 0), cA + kstep, voffA); PG8_STAGE(PG8_SB(1, 1), cB + hstep + kstep, voffB);
        PG8_WAIT_V(6); PG8_BAR;
    }
    for (;;) {
        const bool has_next = S.next(ui + 1, nxt);
        const char* nA = has_next ? (const char*)g.A + (size_t)nxt.pm * tstep : cA; const char* nB = has_next ? (const char*)g.Bt + (size_t)nxt.pn * tstep : cB;
        for (int t = 0; t < nt; t += 2) {
            const bool last = (t == nt - 2);
            const char* a1 = cA + (size_t)(t + 1) * kstep;
            const char* a2 = last ? nA : cA + (size_t)(t + 2) * kstep; const char* b2 = last ? nB : cB + (size_t)(t + 2) * kstep;
            const char* a3 = a2 + kstep; const char* b3 = b2 + kstep;
            if (last && has_next) S.a_ready(nxt);
            if constexpr (SP2) {
            PG8_LDB(B0, 0, 0); PG8_LDB(B1, 0, 1); PG8_SCHED; PG8_LDA(At, 0, 0); PG8_STAGE(PG8_SA(1, 1), a1 + hstep, voffA);
            PG8_WAIT_V(8); PG8_WAIT_L(0); PG8_BAR; PG8_MMA(0, 0, At, B0); PG8_MMA(0, 1, At, B1); PG8_BAR; PG8_SCHED;
            PG8_LDA(At, 0, 1); PG8_STAGE(PG8_SB(0, 0), b2, voffB); PG8_STAGE(PG8_SB(0, 1), b2 + hstep, voffB); PG8_STAGE(PG8_SA(0, 0), a2, voffA);
            PG8_WAIT_V(8); PG8_WAIT_L(0); PG8_BAR; PG8_MMA(1, 0, At, B0); PG8_MMA(1, 1, At, B1); PG8_BAR; PG8_SCHED;
            PG8_LDB(B0, 1, 0); PG8_LDB(B1, 1, 1); PG8_SCHED; PG8_LDA(At, 1, 0); PG8_STAGE(PG8_SA(0, 1), a2 + hstep, voffA);
            PG8_WAIT_V(8); PG8_WAIT_L(0); PG8_BAR; PG8_MMA(0, 0, At, B0); PG8_MMA(0, 1, At, B1); PG8_BAR; PG8_SCHED;
            PG8_LDA(At, 1, 1); PG8_STAGE(PG8_SB(1, 0), b3, voffB); PG8_STAGE(PG8_SB(1, 1), b3 + hstep, voffB); PG8_STAGE(PG8_SA(1, 0), a3, voffA);
            PG8_WAIT_V(8); PG8_WAIT_L(0); PG8_BAR; PG8_MMA(1, 0, At, B0); PG8_MMA(1, 1, At, B1); PG8_BAR; PG8_SCHED;
            } else {
            PG8_LDB(B0, 0, 0); PG8_SCHED; PG8_LDA(At, 0, 0); PG8_STAGE(PG8_SA(1, 1), a1 + hstep, voffA);
            PG8_WAIT_L(8); PG8_BAR; PG8_WAIT_L(0); PG8_MMA(0, 0, At, B0); PG8_BAR; PG8_SCHED;
            PG8_LDB(B1, 0, 1); PG8_STAGE(PG8_SB(0, 0), b2, voffB);
            PG8_BAR; PG8_WAIT_L(0); PG8_MMA(0, 1, At, B1); PG8_BAR;
            PG8_LDA(At, 0, 1); PG8_STAGE(PG8_SA(0, 0), a2, voffA);
            PG8_BAR; PG8_WAIT_L(0); PG8_MMA(1, 0, At, B0); PG8_BAR; PG8_SCHED;
            PG8_STAGE(PG8_SB(0, 1), b2 + hstep, voffB);
            PG8_WAIT_V(6); PG8_BAR; PG8_MMA(1, 1, At, B1); PG8_BAR;
            PG8_LDB(B0, 1, 0); PG8_SCHED; PG8_LDA(At, 1, 0); PG8_STAGE(PG8_SA(0, 1), a2 + hstep, voffA);
            PG8_WAIT_L(8); PG8_BAR; PG8_WAIT_L(0); PG8_MMA(0, 0, At, B0); PG8_BAR; PG8_SCHED;
            PG8_LDB(B1, 1, 1); PG8_STAGE(PG8_SB(1, 0), b3, voffB);
            PG8_BAR; PG8_WAIT_L(0); PG8_MMA(0, 1, At, B1); PG8_BAR;
            PG8_LDA(At, 1, 1); PG8_STAGE(PG8_SA(1, 0), a3, voffA);
            PG8_BAR; PG8_WAIT_L(0); PG8_MMA(1, 0, At, B0); PG8_BAR; PG8_SCHED;
            PG8_STAGE(PG8_SB(1, 1), b3 + hstep, voffB);
            PG8_WAIT_V(6); PG8_BAR; PG8_MMA(1, 1, At, B1); PG8_BAR;
            }
        }
        if constexpr (ALIGN_EPI) { if (wr == 0) PG8_BAR; }
        if constexpr (!Epi::AFTER_DRAIN) { E(acc, cur, wr, wc, fr, fq); S.done(cur); }
        if (!has_next) break;
#pragma unroll
        for (int a = 0; a < 2; ++a)
#pragma unroll
            for (int b = 0; b < 2; ++b)
#pragma unroll
                for (int m = 0; m < 4; ++m)
#pragma unroll
                    for (int n = 0; n < 2; ++n) acc[a][b][m][n] = (f32x4){0.f, 0.f, 0.f, 0.f};
        cur = nxt; cA = nA; cB = nB; ++ui;
        if constexpr (ALIGN_EPI) { if (wr == 1) PG8_BAR; }
    }
    PG8_WAIT_V(0);
    if constexpr (!ALIGN_EPI) { if (wr == 0) PG8_BAR; }
    PG8_BAR;
    if constexpr (Epi::AFTER_DRAIN) { E.fused(acc, cur, wr, wc, fr, fq, lds, wid, lane); S.done(cur); }
#undef PG8_SA
#undef PG8_SB
#undef PG8_STAGE
#undef PG8_LDA
#undef PG8_LDB
#undef PG8_MMA
#undef PG8_WAIT_V
#undef PG8_WAIT_L
#undef PG8_BAR
#undef PG8_SCHED
}
}
#define LAS __attribute__((address_space(3)))
typedef unsigned short bf16_t;
typedef LAS unsigned char* ldsp;
typedef short bf16x8 __attribute__((ext_vector_type(8)));
typedef short s16x4 __attribute__((ext_vector_type(4)));
typedef float f32x16 __attribute__((ext_vector_type(16)));
typedef float f32x4 __attribute__((ext_vector_type(4)));
typedef float f32x2 __attribute__((ext_vector_type(2)));
typedef unsigned u32x4 __attribute__((ext_vector_type(4)));
typedef unsigned u32x2 __attribute__((ext_vector_type(2)));
typedef __bf16 bf16x2_t __attribute__((ext_vector_type(2)));
using pg8::ZLD; using pg8::MROWS; using pg8::NPROMPT; using pg8::LOG2E;
__device__ __forceinline__ int crow(int r, int hi) { return (r & 3) + 8 * (r >> 2) + 4 * hi; }
__device__ __forceinline__ unsigned cvtpk(float lo, float hi) { f32x2 v = {lo, hi}; bf16x2_t b = __builtin_convertvector(v, bf16x2_t); return __builtin_bit_cast(unsigned, b); }
__device__ __forceinline__ float bf_lo(unsigned w) { return __uint_as_float(w << 16); }
__device__ __forceinline__ float bf_hi(unsigned w) { return __uint_as_float(w & 0xffff0000u); }
__device__ __forceinline__ float xhalf_max(float m) { auto rr = __builtin_amdgcn_permlane32_swap(__float_as_uint(m), __float_as_uint(m), false, false); return fmaxf(__uint_as_float(rr[0]), __uint_as_float(rr[1])); }
__device__ __forceinline__ float xhalf_sum(float m) { auto rr = __builtin_amdgcn_permlane32_swap(__float_as_uint(m), __float_as_uint(m), false, false); return __uint_as_float(rr[0]) + __uint_as_float(rr[1]); }
__device__ __forceinline__ s16x4 vtr(ldsp p) { typedef short v4i16_t __attribute__((ext_vector_type(4))); return __builtin_bit_cast(s16x4, __builtin_amdgcn_ds_read_tr16_b64_v4i16((LAS v4i16_t*)p)); }
__device__ __forceinline__ float max3f(float a, float b, float c) { float r; asm("v_max3_f32 %0, %1, %2, %3" : "=v"(r) : "v"(a), "v"(b), "v"(c)); return r; }
__device__ __forceinline__ float max2f(float a, float b) { float r; asm("v_max_f32_e32 %0, %1, %2" : "=v"(r) : "v"(a), "v"(b)); return r; }
#define MFMA32(a, b, c) __builtin_amdgcn_mfma_f32_32x32x16_bf16((a), (b), (c), 0, 0, 0)

constexpr int KPITCH = 144, KT_BYTES = 64 * KPITCH, VT_BYTES = 8192, TILE_BYTES = KT_BYTES + VT_BYTES, BUF_BYTES = 2 * TILE_BYTES;
constexpr int COMB_OFF = 2 * BUF_BYTES, COMB_WAVE = 17408, TAB_OFF = COMB_OFF + 4 * COMB_WAVE, MISC_OFF = TAB_OFF + 1040, LDS_BYTES = 147456;
static_assert(MISC_OFF + 64 <= LDS_BYTES, "LDS map");
constexpr float NEG_BIG = -1.0e30f, THR = 8.0f;
struct AU {
    const bf16_t* q; int nq; int nt, ntc; const float* kc; const float* vc; int cp; const bf16_t* kz; const bf16_t* vz; int lastv; int nqg;
    int tlo0, thi0, tlo1, thi1; int qpos0, kpos0; const bf16_t* gate; bf16_t* y;
};
#ifndef ATTN_INL
#define ATTN_INL __forceinline__
#endif
template <int MODE  >
__device__ ATTN_INL void attn_unit(const AU& d, ldsp lds, float lam, float oml, const float* subg) {
    constexpr int NMAP = MODE == 0 ? 2 : 1, NSTEP = MODE == 0 ? 2 : 4;
    int tid_ = threadIdx.x; asm volatile("" : "+v"(tid_));
    const int tid = tid_, lane = tid & 63, wid = __builtin_amdgcn_readfirstlane(tid >> 6), qg = wid & 3, ks = wid >> 2, r32 = lane & 31, hi = lane >> 5;
    const int tlo = (qg >> 1) ? d.tlo1 : d.tlo0; int thi = (qg >> 1) ? d.thi1 : d.thi0; if (qg >= d.nqg) thi = -1;
    const LAS float* tab = (const LAS float*)(lds + TAB_OFF);
    bf16x8 qf[NMAP][NSTEP];
    { int qrow = 32 * qg + r32; if (qrow >= d.nq) qrow = d.nq - 1;
      const bf16_t* qp = d.q + (size_t)qrow * ZLD;
#pragma unroll
      for (int mp = 0; mp < NMAP; ++mp)
#pragma unroll
          for (int st = 0; st < NSTEP; ++st) qf[mp][st] = *(const bf16x8*)(qp + mp * 32 + st * 16 + hi * 8); }
    f32x16 O[NMAP][2]; float mref[NMAP], lsum[NMAP];
#pragma unroll
    for (int mp = 0; mp < NMAP; ++mp) { mref[mp] = 0.f; lsum[mp] = 0.f;
#pragma unroll
        for (int db = 0; db < 2; ++db)
#pragma unroll
            for (int i = 0; i < 16; ++i) O[mp][db][i] = 0.f; }
    const int lrow = tid >> 3, lch = tid & 7;
    const int kwoff = lrow * KPITCH + lch * 16, vwoff = (lch >> 2) * 4096 + lrow * 64 + (lch & 3) * 16;
    const int kroff = r32 * KPITCH + hi * 16;
    const int vroff = (4 * hi + ((lane & 15) >> 2)) * 64 + ((lane >> 4) & 1) * 32 + (lane & 3) * 8;
    u32x4 stK[2], stV[2];
    const int nit = (d.nt + 1) >> 1; bool started = false;
#define AT_ISSUE(IT) do { _Pragma("unroll") for (int i_ = 0; i_ < 2; ++i_) { const int t_ = 2 * (IT) + i_; if (t_ < d.nt && t_ >= d.ntc) { int r_ = lrow; if (t_ == d.nt - 1 && r_ >= d.lastv) r_ = d.lastv - 1; \
        const size_t off_ = ((size_t)(t_ - d.ntc) * 64 + r_) * ZLD + lch * 8; stK[i_] = *(const u32x4*)(d.kz + off_); stV[i_] = *(const u32x4*)(d.vz + off_); } } } while (0)
#define AT_WRITE(IT, BUF) do { _Pragma("unroll") for (int i_ = 0; i_ < 2; ++i_) { const int t_ = 2 * (IT) + i_; if (t_ < d.nt) { u32x4 kk_, vv_; if (t_ >= d.ntc) { kk_ = stK[i_]; vv_ = stV[i_]; } else { \
        const size_t off_ = ((size_t)t_ * 64 + lrow) * d.cp + lch * 8; const f32x4 a_ = *(const f32x4*)(d.kc + off_), b_ = *(const f32x4*)(d.kc + off_ + 4), c_ = *(const f32x4*)(d.vc + off_), e_ = *(const f32x4*)(d.vc + off_ + 4); \
        kk_ = (u32x4){cvtpk(a_[0], a_[1]), cvtpk(a_[2], a_[3]), cvtpk(b_[0], b_[1]), cvtpk(b_[2], b_[3])}; vv_ = (u32x4){cvtpk(c_[0], c_[1]), cvtpk(c_[2], c_[3]), cvtpk(e_[0], e_[1]), cvtpk(e_[2], e_[3])}; } \
        *(LAS u32x4*)((BUF) + i_ * TILE_BYTES + kwoff) = kk_; *(LAS u32x4*)((BUF) + i_ * TILE_BYTES + KT_BYTES + vwoff) = vv_; } } } while (0)
    AT_ISSUE(0);
    for (int it = 0; it < nit; ++it) {
        const ldsp buf = lds + (it & 1) * BUF_BYTES;
        AT_WRITE(it, buf);
        __builtin_amdgcn_s_waitcnt(0);
        __syncthreads();
        if (it + 1 < nit) AT_ISSUE(it + 1);
        const int t = 2 * it + ks;
        if (t >= tlo && t <= thi) {
            const ldsp Kt = buf + ks * TILE_BYTES, Vt = Kt + KT_BYTES;
            const int valid = (t == d.nt - 1) ? d.lastv : 64;
            f32x16 S0[NMAP], S1[NMAP];
#pragma unroll
            for (int mp = 0; mp < NMAP; ++mp) {
                f32x16 negm;
#pragma unroll
                for (int i = 0; i < 16; ++i) negm[i] = -mref[mp];
#pragma unroll
                for (int st = 0; st < NSTEP; ++st) {
                    const bf16x8 a0 = *(const LAS bf16x8*)(Kt + kroff + (mp * 32 + st * 16) * 2);
                    const bf16x8 a1 = *(const LAS bf16x8*)(Kt + kroff + 32 * KPITCH + (mp * 32 + st * 16) * 2);
                    if (st == 0) { S0[mp] = MFMA32(a0, qf[mp][st], negm); S1[mp] = MFMA32(a1, qf[mp][st], negm); }
                    else { S0[mp] = MFMA32(a0, qf[mp][st], S0[mp]); S1[mp] = MFMA32(a1, qf[mp][st], S1[mp]); }
                }
            }
#pragma unroll
            for (int mp = 0; mp < NMAP; ++mp) {
                f32x16& s0 = S0[mp]; f32x16& s1 = S1[mp];
                if (MODE == 1) {
                    const int qpos = d.qpos0 + 32 * qg + r32, kp0 = d.kpos0 + 64 * t;
                    if (d.qpos0 + 32 * qg - (kp0 + 63) >= 128) { const float c = tab[256];
#pragma unroll
                        for (int i = 0; i < 16; ++i) { s0[i] += c; s1[i] += c; } }
                    else {
#pragma unroll
                        for (int i = 0; i < 16; ++i) { int dd = qpos - (kp0 + crow(i, hi)); int d0 = min(max(dd, -128), 128), d1 = min(max(dd - 32, -128), 128);
                            s0[i] += tab[d0 + 128]; s1[i] += tab[d1 + 128]; } }
                }
                if (valid < 64) {
#pragma unroll
                    for (int i = 0; i < 16; ++i) { const int k = crow(i, hi); if (k >= valid) s0[i] = NEG_BIG; if (k + 32 >= valid) s1[i] = NEG_BIG; } }
                float ra = max3f(s0[0], s0[1], s1[0]), rb = max3f(s0[2], s0[3], s1[1]); ra = max3f(ra, s1[2], s1[3]);
#pragma unroll
                for (int i = 4; i < 16; i += 4) { ra = max3f(ra, s0[i], s0[i + 1]); rb = max3f(rb, s0[i + 2], s0[i + 3]); ra = max3f(ra, s1[i], s1[i + 1]); rb = max3f(rb, s1[i + 2], s1[i + 3]); }
                float rm = xhalf_max(max2f(ra, rb));
                if (!started || __any(rm > THR)) {
                    const float dl = started ? fmaxf(rm, 0.f) : rm, al = started ? __builtin_amdgcn_exp2f(-dl) : 1.f;
                    mref[mp] += dl; lsum[mp] *= al;
#pragma unroll
                    for (int i = 0; i < 16; ++i) { s0[i] -= dl; s1[i] -= dl; }
#pragma unroll
                    for (int db = 0; db < 2; ++db)
#pragma unroll
                        for (int i = 0; i < 16; ++i) O[mp][db][i] *= al;
                }
                bf16x8 Pf[4]; float sa = 0.f, sb = 0.f;
#pragma unroll
                for (int i = 0; i < 16; ++i) { s0[i] = __builtin_amdgcn_exp2f(s0[i]); s1[i] = __builtin_amdgcn_exp2f(s1[i]); sa += s0[i]; sb += s1[i]; }
                lsum[mp] += sa + sb;
#pragma unroll
                for (int s = 0; s < 2; ++s) {
                    u32x4 w0 = {cvtpk(s0[8 * s], s0[8 * s + 1]), cvtpk(s0[8 * s + 2], s0[8 * s + 3]), cvtpk(s0[8 * s + 4], s0[8 * s + 5]), cvtpk(s0[8 * s + 6], s0[8 * s + 7])};
                    u32x4 w1 = {cvtpk(s1[8 * s], s1[8 * s + 1]), cvtpk(s1[8 * s + 2], s1[8 * s + 3]), cvtpk(s1[8 * s + 4], s1[8 * s + 5]), cvtpk(s1[8 * s + 6], s1[8 * s + 7])};
                    Pf[s] = __builtin_bit_cast(bf16x8, w0); Pf[2 + s] = __builtin_bit_cast(bf16x8, w1);
                }
#pragma unroll
                for (int db = 0; db < 2; ++db)
#pragma unroll
                    for (int k4 = 0; k4 < 4; ++k4) {
                        const s16x4 lo = vtr(Vt + vroff + db * 4096 + k4 * 1024), hh = vtr(Vt + vroff + db * 4096 + k4 * 1024 + 512);
                        const bf16x8 vf = {lo[0], lo[1], lo[2], lo[3], hh[0], hh[1], hh[2], hh[3]};
                        O[mp][db] = MFMA32(vf, Pf[k4], O[mp][db]);
                    }
            }
            started = true;
        }
    }
#undef AT_ISSUE
#undef AT_WRITE
    __syncthreads();
    if (!started) {
#pragma unroll
        for (int mp = 0; mp < NMAP; ++mp) mref[mp] = NEG_BIG;
    }
    const ldsp cw = lds + COMB_OFF + qg * COMB_WAVE;
    if (ks == 1 && qg < d.nqg) {
#pragma unroll
        for (int mp = 0; mp < NMAP; ++mp) {
#pragma unroll
            for (int db = 0; db < 2; ++db)
#pragma unroll
                for (int i = 0; i < 16; ++i) *(LAS float*)(cw + ((mp * 2 + db) * 16 + i) * 256 + lane * 4) = O[mp][db][i];
            *(LAS float*)(cw + 16384 + (mp * 2) * 256 + lane * 4) = mref[mp]; *(LAS float*)(cw + 16384 + (mp * 2 + 1) * 256 + lane * 4) = lsum[mp];
        }
    }
    __syncthreads();
    if (ks == 0 && qg < d.nqg) {
        float linv[NMAP];
#pragma unroll
        for (int mp = 0; mp < NMAP; ++mp) {
            const float mb = *(const LAS float*)(cw + 16384 + (mp * 2) * 256 + lane * 4), lb = *(const LAS float*)(cw + 16384 + (mp * 2 + 1) * 256 + lane * 4);
            const float mt = fmaxf(mref[mp], mb), aa = __builtin_amdgcn_exp2f(mref[mp] - mt), ab = __builtin_amdgcn_exp2f(mb - mt);
            const float l = xhalf_sum(lsum[mp] * aa + lb * ab);
            linv[mp] = 1.0f / l;
#pragma unroll
            for (int db = 0; db < 2; ++db)
#pragma unroll
                for (int i = 0; i < 16; ++i) O[mp][db][i] = O[mp][db][i] * aa + *(const LAS float*)(cw + ((mp * 2 + db) * 16 + i) * 256 + lane * 4) * ab;
        }
        float fin = 1.f;
        if (MODE == 0) {
            const float i1 = linv[0], i2 = lam * linv[NMAP - 1]; float ss = 0.f;
#pragma unroll
            for (int db = 0; db < 2; ++db)
#pragma unroll
                for (int i = 0; i < 16; ++i) { const float o = O[0][db][i] * i1 - O[NMAP - 1][db][i] * i2; O[0][db][i] = o; ss += o * o; }
            ss = xhalf_sum(ss);
            fin = __builtin_amdgcn_rsqf(ss * (1.0f / 64.0f) + 1e-5f) * oml;
        } else fin = linv[0];
        const int row = 32 * qg + r32;
        if (row < d.nq) {
#pragma unroll
            for (int db = 0; db < 2; ++db)
#pragma unroll
                for (int g4 = 0; g4 < 4; ++g4) {
                    const int d0 = 32 * db + 8 * g4 + 4 * hi;
                    const u32x2 gw = *(const u32x2*)(d.gate + (size_t)row * ZLD + d0);
                    f32x4 sg = {1.f, 1.f, 1.f, 1.f}; if (MODE == 0) sg = *(const f32x4*)(subg + d0);
                    const float y0 = O[0][db][4 * g4] * fin * sg[0] * bf_lo(gw.x), y1 = O[0][db][4 * g4 + 1] * fin * sg[1] * bf_hi(gw.x);
                    const float y2 = O[0][db][4 * g4 + 2] * fin * sg[2] * bf_lo(gw.y), y3 = O[0][db][4 * g4 + 3] * fin * sg[3] * bf_hi(gw.y);
                    *(u32x2*)(d.y + (size_t)row * 1024 + d0) = (u32x2){cvtpk(y0, y1), cvtpk(y2, y3)};
                }
        }
    }
}
using namespace pg8;
constexpr size_t WS_CTL = WSO_CTL, CTL_BYTES = 1u << 20, WS_SSQ0 = WSO_SSQ0, WS_ROPE = WSO_ROPE, WS_WIN = WSO_WIN, WS_WOUT = WSO_WOUT, WS_XB = WSO_XB, WS_YMIX = WSO_YMIX, WS_X1 = WSO_X1, WS_Z = WSO_Z, WS_END = WSO_END;
static_assert((size_t)MROWS * 1024 * 2 <= 36u * (1u << 20) && (size_t)MROWS * 1024 * 4 <= 68u * (1u << 20) && (size_t)MROWS * 4096 * 2 <= 132u * (1u << 20), "ws map");
constexpr int CTL_Q0 = 0, CTL_SI = 64, CTL_SM = 128, CTL_SSQ1 = 16384, CTL_SSQ2 = 16384 + 32768;
static_assert((CTL_SSQ2 + MROWS) * 4 <= (int)CTL_BYTES, "ctl");
constexpr size_t O_Y = OO_Y, O_CONVP = OO_CONVP, O_CONVS = OO_CONVS, O_END = OO_END;
struct Args { const float* in[18]; float* out; unsigned char* ws; };

__device__ __forceinline__ float wave_sum(float v) {
#pragma unroll
    for (int o = 1; o < 64; o <<= 1) v += __shfl_xor(v, o);
    return v;
}
__device__ __forceinline__ unsigned f2bf(float f) { unsigned u = __builtin_bit_cast(unsigned, f); return (u + 0x7fffu + ((u >> 16) & 1u)) >> 16; }
__device__ __forceinline__ unsigned pk2(float lo, float hi) { return f2bf(lo) | (f2bf(hi) << 16); }
__device__ __forceinline__ void p0_transpose_item(const float* W, const float* g, int K, int N, bf16_t* WT, LAS float* scr, int item, int lane) {
    const int nblk = N / 32, kb = item / nblk, nb = item % nblk, k0 = 64 * kb, n0 = 32 * nb;
#pragma unroll 8
    for (int i = 0; i < 32; ++i) { const int kk = 2 * i + (lane >> 5); const float gs = g ? g[k0 + kk] : 1.f; scr[kk * 33 + (lane & 31)] = W[(size_t)(k0 + kk) * N + n0 + (lane & 31)] * gs; }
    asm volatile("s_waitcnt lgkmcnt(0)" ::: "memory");
    const int c = lane & 7;
#pragma unroll
    for (int j = 0; j < 4; ++j) { const int n = (lane >> 3) + 8 * j; const LAS float* s = scr + (8 * c) * 33 + n;
        u32x4 o; o.x = pk2(s[0 * 33], s[1 * 33]); o.y = pk2(s[2 * 33], s[3 * 33]); o.z = pk2(s[4 * 33], s[5 * 33]); o.w = pk2(s[6 * 33], s[7 * 33]);
        *(u32x4*)(WT + (size_t)(n0 + n) * K + k0 + 8 * c) = o; }
    asm volatile("s_waitcnt lgkmcnt(0)" ::: "memory");
}

__global__ void __launch_bounds__(512) fwd_megakernel(Args args) {
    extern __shared__ __attribute__((aligned(16))) unsigned char lds_raw[];
    cg::grid_group grid = cg::this_grid();
    const ldsp lds = (ldsp)lds_raw;
    const int tid = threadIdx.x, lane = tid & 63, wave = __builtin_amdgcn_readfirstlane(tid >> 6);
    const int G = gridDim.x, bx = blockIdx.x;
    unsigned char* ws = args.ws; float* out = args.out;
    unsigned* ctl = (unsigned*)(ws + WS_CTL);
    float* SSQ0 = (float*)(ws + WS_SSQ0); float* SSQ1 = (float*)ctl + CTL_SSQ1; float* SSQ2 = (float*)ctl + CTL_SSQ2;
    float* ROPE = (float*)(ws + WS_ROPE);
    bf16_t* WIN = (bf16_t*)(ws + WS_WIN); bf16_t* WOUT = (bf16_t*)(ws + WS_WOUT);
    bf16_t* XB = (bf16_t*)(ws + WS_XB); bf16_t* YMIX = (bf16_t*)(ws + WS_YMIX); float* X1 = (float*)(ws + WS_X1); bf16_t* Z = (bf16_t*)(ws + WS_Z);
    const float* x_p = args.in[0]; const float* x_s = args.in[1];

    {
        LAS float* scr = (LAS float*)(lds + wave * 16384);
        const int gw = bx * 8 + wave, NGW = G * 8;
        constexpr int I_IN = (1024 / 64) * (4096 / 32), I_OUT = (1024 / 64) * (1024 / 32), NITEMS = 2 * I_IN + 2 * I_OUT;
        for (int it = gw; it < NITEMS; it += NGW) {
            int r = it;
            if (r < 2 * I_IN) { const int l = r / I_IN; r -= l * I_IN; p0_transpose_item(args.in[8] + (size_t)l * 1024 * 4096, args.in[7] + l * 1024, 1024, 4096, WIN + (size_t)l * 4096 * 1024, scr, r, lane); }
            else { r -= 2 * I_IN; const int l = r / I_OUT; r -= l * I_OUT; p0_transpose_item(args.in[9] + (size_t)l * 1024 * 1024, nullptr, 1024, 1024, WOUT + (size_t)l * 1024 * 1024, scr, r, lane); }
        }
        for (int m = gw; m < MROWS; m += NGW) {
            const float* xr = (m < NPROMPT) ? x_p + (size_t)m * 1024 : x_s + (size_t)(m - NPROMPT) * 1024;
            f32x4 v[4]; float s = 0.f;
#pragma unroll
            for (int j = 0; j < 4; ++j) { v[j] = *((const f32x4*)xr + lane + 64 * j); s += (v[j][0] * v[j][0] + v[j][1] * v[j][1]) + (v[j][2] * v[j][2] + v[j][3] * v[j][3]); }
            s = wave_sum(s);
            if (lane == 0) SSQ0[m] = s;
#pragma unroll
            for (int j = 0; j < 4; ++j) *((u32x2*)(XB + (size_t)m * 1024) + lane + 64 * j) = (u32x2){cvtpk(v[j][0], v[j][1]), cvtpk(v[j][2], v[j][3])};
        }
        for (int e = bx * 512 + tid; e < MROWS * 4; e += G * 512) {
            const int row = e >> 2, i = e & 3; const int pos = (row < NPROMPT) ? row : 4096 + ((row - NPROMPT) & 15);
            const float invf = (i == 0) ? 1.0f : (i == 1 ? 0.037606030930863934f : (i == 2 ? 0.0014142135623730950f : 5.318295896944988e-05f));
            const float ang = (float)pos * invf;
            const double rev = (double)ang * 0.15915494309189535; const float fr = (float)(rev - __builtin_rint(rev));
            ROPE[(size_t)row * 8 + i] = __builtin_amdgcn_cosf(fr); ROPE[(size_t)row * 8 + 4 + i] = __builtin_amdgcn_sinf(fr);
        }
    }
    grid.sync();

    for (int l = 0; l < 2; ++l) {
        {
            pg8::Gemm g{XB, WIN + (size_t)l * 4096 * 1024, NPROMPT, 4096, 1024}; pg8::StaticOrder S; S.init(NPROMPT, 4096, G, bx);
            pg8::EpiIn E{ws, out, l};

#ifndef NO_GEMM1
            pg8::gemm_phase<pg8::EpiIn, pg8::StaticOrder, true, true>(lds, g, S, E);
#endif

        }
        grid.sync();
        {
            const float lam_init = (l == 0) ? 0.2f : 0.35550906759096927f;
            float d1 = 0.f, d2 = 0.f;
            for (int i = 0; i < 32; ++i) { d1 += args.in[12][l * 32 + i] * args.in[13][l * 32 + i]; d2 += args.in[14][l * 32 + i] * args.in[15][l * 32 + i]; }
            const float lam = __expf(d1) - __expf(d2) + lam_init, oml = 1.0f - lam_init;
            const float* subg = args.in[16] + l * 64;
            volatile LAS int* misc = (volatile LAS int*)(lds + MISC_OFF);
            constexpr int N_SI = 16, N_PC = 512, N_SC = 64, N_PA = 1024, N_SA = 128, N_CV = 130, N_SO = 4, N_TOT = N_SI + N_PC + N_SC + N_PA + N_SA + N_CV + N_SO;
            constexpr unsigned N_SMIX = N_SC + N_SA + 2;
#ifndef PROBE_P2X
#define PROBE_P2X 1
#endif
            for (int rep = 0; rep < ((l == 0) ? PROBE_P2X : 1); ++rep) {
            if (rep > 0) grid.sync();
            for (;;) {
                __syncthreads();
                if (tid == 0) misc[0] = (int)atomicAdd(ctl + CTL_Q0 + l + 2 * rep, 1u);
                __syncthreads();
                int ui = misc[0]; ui = __builtin_amdgcn_readfirstlane(ui);
                if (ui >= N_TOT) break;
                AU d; d.kc = nullptr; d.vc = nullptr; d.cp = 0; d.ntc = 0; d.lastv = 64; d.nqg = 4; d.tlo1 = 0; d.thi1 = -1; d.qpos0 = 0; d.kpos0 = 0;
                int kind;
                int idx = ui;
                if (idx < 16) kind = 5; else if (idx < 256) { kind = 0; idx -= 16; } else if (idx < 320) { kind = 1; idx -= 256; } else if (idx < 448) { kind = 3; idx -= 320; } else if (idx < 450) { kind = 4; idx = 128 + (idx - 448); }
                else if (idx < 454) { kind = 6; idx -= 450; } else if (idx < 726) { kind = 0; idx = 240 + (idx - 454); } else if (idx < 1750) { kind = 2; idx -= 726; } else { kind = 4; idx -= 1750; }
                const bool smp_unit = (kind == 1 || kind == 3 || (kind == 4 && idx >= 128));
                if (smp_unit || kind == 6) {
                    if (tid == 0) {
                        unsigned* cnt = ctl + (kind == 6 ? CTL_SM : CTL_SI) + l; const unsigned want = (kind == 6) ? N_SMIX : (unsigned)N_SI;
                        while (__hip_atomic_load(cnt, __ATOMIC_RELAXED, __HIP_MEMORY_SCOPE_AGENT) < want) __builtin_amdgcn_s_sleep(8);
                        __builtin_amdgcn_fence(__ATOMIC_ACQUIRE, "agent");
                        asm volatile("s_waitcnt vmcnt(0)" ::: "memory");
                    }
                    __syncthreads();
                }
                if (kind >= 5) {
                    if (kind == 5) { pg8::Gemm g{XB, WIN + (size_t)l * 4096 * 1024, MROWS, 4096, 1024}; pg8::OneUnit S{64, idx}; pg8::EpiIn E{ws, out, l};
                        pg8::gemm_phase<pg8::EpiIn, pg8::OneUnit, false, true>(lds, g, S, E); }
                    else { pg8::Gemm g{YMIX, WOUT + (size_t)l * 1024 * 1024, MROWS, 1024, 1024}; pg8::OneUnit S{64, idx}; pg8::EpiOut E{ws, x_p, x_s, l};
                        pg8::gemm_phase<pg8::EpiOut, pg8::OneUnit, false, true>(lds, g, S, E); }
                }
                else if (kind == 0) {
                    const int u = 127 - (idx >> 2), h = idx & 3; const size_t r0 = (size_t)128 * u;
                    d.q = Z + r0 * ZLD + 3072 + 64 * h; d.nq = 128; d.nt = 2 * u + 2; d.kz = Z + 3328 + 64 * h; d.vz = Z + 3584 + 64 * h;
                    d.tlo0 = 0; d.thi0 = d.nt - 2; d.tlo1 = 0; d.thi1 = d.nt - 1; d.gate = Z + r0 * ZLD + 3840 + 64 * h; d.y = YMIX + r0 * 1024 + 768 + 64 * h;

#ifndef NO_ATTN0
                    attn_unit<0>(d, lds, lam, oml, subg);
#endif

                } else if (kind == 1) {
                    const int b = idx >> 2, h = idx & 3; const size_t r0 = (size_t)NPROMPT + 16 * b;
                    d.q = Z + r0 * ZLD + 3072 + 64 * h; d.nq = 16; d.nt = 65; d.ntc = 64; d.cp = 256;
                    d.kc = args.in[5] + ((size_t)(l * 16 + b) * 4096) * 256 + 64 * h; d.vc = args.in[6] + ((size_t)(l * 16 + b) * 4096) * 256 + 64 * h;
                    d.kz = Z + r0 * ZLD + 3328 + 64 * h; d.vz = Z + r0 * ZLD + 3584 + 64 * h; d.lastv = 16; d.nqg = 1; d.tlo0 = 0; d.thi0 = 64;
                    d.gate = Z + r0 * ZLD + 3840 + 64 * h; d.y = YMIX + r0 * 1024 + 768 + 64 * h;

#ifndef NO_ATTN0
                    attn_unit<0>(d, lds, lam, oml, subg);
#endif

                } else if (kind == 2 || kind == 3) {
                    int h;
                    if (kind == 2) {
                        h = idx & 7; const int cp = idx >> 3, c0 = max(0, 2 * cp - 8); const size_t r0 = (size_t)128 * cp;
                        d.q = Z + r0 * ZLD + 64 * h; d.nq = 128; d.nt = 2 * cp + 2 - c0; d.kz = Z + (size_t)64 * c0 * ZLD + 512 + 64 * h; d.vz = Z + (size_t)64 * c0 * ZLD + 1024 + 64 * h;
                        d.tlo0 = 0; d.thi0 = 2 * cp - c0; d.tlo1 = max(0, 2 * cp + 1 - 8) - c0; d.thi1 = 2 * cp + 1 - c0; d.qpos0 = 128 * cp; d.kpos0 = 64 * c0;
                        d.gate = Z + r0 * ZLD + 1536 + 64 * h; d.y = YMIX + r0 * 1024 + 64 * h;
                    } else {
                        h = idx & 7; const int b = idx >> 3; const size_t r0 = (size_t)NPROMPT + 16 * b;
                        d.q = Z + r0 * ZLD + 64 * h; d.nq = 16; d.nt = 9; d.ntc = 8; d.cp = 512;
                        d.kc = args.in[2] + ((size_t)(l * 16 + b) * 512) * 512 + 64 * h; d.vc = args.in[3] + ((size_t)(l * 16 + b) * 512) * 512 + 64 * h;
                        d.kz = Z + r0 * ZLD + 512 + 64 * h; d.vz = Z + r0 * ZLD + 1024 + 64 * h; d.lastv = 16; d.nqg = 1; d.tlo0 = 0; d.thi0 = 8; d.qpos0 = 512; d.kpos0 = 0;
                        d.gate = Z + r0 * ZLD + 1536 + 64 * h; d.y = YMIX + r0 * 1024 + 64 * h;
                    }
                    if (tid < 257) ((LAS float*)(lds + TAB_OFF))[tid] = args.in[10][(size_t)(l * 8 + h) * 257 + tid] * LOG2E;

#ifndef NO_ATTN1
                    attn_unit<1>(d, lds, 0.f, 0.f, nullptr);
#endif

                } else {
                    int tq_ = threadIdx.x; asm volatile("" : "+v"(tq_));
                    const int c8 = (tq_ & 31) * 8, rr = tq_ >> 5;
                    const float* cw = args.in[11] + (size_t)l * 3 * 256 + c8;
                    float w0[8], w1[8], w2[8];
#pragma unroll
                    for (int j = 0; j < 8; ++j) { w0[j] = cw[j]; w1[j] = cw[256 + j]; w2[j] = cw[512 + j]; }
                    for (int g = 0; g < 8; ++g) {
                        const int row = 128 * idx + 16 * g + rr; const bool smp = row >= NPROMPT; const int t = smp ? ((row - NPROMPT) & 15) : row, b = (row - NPROMPT) >> 4;
                        const bf16_t* zr = Z + (size_t)row * ZLD;
                        float u0[8], u1[8], u2[8];
                        { const u32x4 c = *(const u32x4*)(zr + 2304 + c8), hh = *(const u32x4*)(zr + 2560 + c8);
#pragma unroll
                          for (int j = 0; j < 4; ++j) { u0[2 * j] = bf_lo(c[j]) * bf_lo(hh[j]); u0[2 * j + 1] = bf_hi(c[j]) * bf_hi(hh[j]); } }
                        if (t >= 1) { const u32x4 c = *(const u32x4*)(zr - ZLD + 2304 + c8), hh = *(const u32x4*)(zr - ZLD + 2560 + c8);
#pragma unroll
                          for (int j = 0; j < 4; ++j) { u1[2 * j] = bf_lo(c[j]) * bf_lo(hh[j]); u1[2 * j + 1] = bf_hi(c[j]) * bf_hi(hh[j]); } }
                        else if (smp) { const float* sp = args.in[4] + ((size_t)(l * 16 + b) * 2 + 1) * 256 + c8;
#pragma unroll
                          for (int j = 0; j < 8; ++j) u1[j] = sp[j]; }
                        else {
#pragma unroll
                          for (int j = 0; j < 8; ++j) u1[j] = 0.f; }
                        if (t >= 2) { const u32x4 c = *(const u32x4*)(zr - 2 * ZLD + 2304 + c8), hh = *(const u32x4*)(zr - 2 * ZLD + 2560 + c8);
#pragma unroll
                          for (int j = 0; j < 4; ++j) { u2[2 * j] = bf_lo(c[j]) * bf_lo(hh[j]); u2[2 * j + 1] = bf_hi(c[j]) * bf_hi(hh[j]); } }
                        else if (smp) { const float* sp = args.in[4] + ((size_t)(l * 16 + b) * 2 + t) * 256 + c8;
#pragma unroll
                          for (int j = 0; j < 8; ++j) u2[j] = sp[j]; }
                        else {
#pragma unroll
                          for (int j = 0; j < 8; ++j) u2[j] = 0.f; }
                        const u32x4 bb = *(const u32x4*)(zr + 2048 + c8), bg = *(const u32x4*)(zr + 2816 + c8);
                        float y[8];
#pragma unroll
                        for (int j = 0; j < 4; ++j) {
                            y[2 * j] = bf_lo(bb[j]) * (u2[2 * j] * w0[2 * j] + u1[2 * j] * w1[2 * j] + u0[2 * j] * w2[2 * j]) * bf_lo(bg[j]);
                            y[2 * j + 1] = bf_hi(bb[j]) * (u2[2 * j + 1] * w0[2 * j + 1] + u1[2 * j + 1] * w1[2 * j + 1] + u0[2 * j + 1] * w2[2 * j + 1]) * bf_hi(bg[j]); }
                        *(u32x4*)(YMIX + (size_t)row * 1024 + 512 + c8) = (u32x4){cvtpk(y[0], y[1]), cvtpk(y[2], y[3]), cvtpk(y[4], y[5]), cvtpk(y[6], y[7])};
                        float* so = nullptr;
                        if (!smp && row >= NPROMPT - 2) so = out + O_CONVP + (size_t)l * 512 + (size_t)(row - (NPROMPT - 2)) * 256 + c8;
                        if (smp && t >= 14) so = out + O_CONVS + (size_t)l * 8192 + (size_t)b * 512 + (size_t)(t - 14) * 256 + c8;
                        if (so) { *(f32x4*)so = (f32x4){u0[0], u0[1], u0[2], u0[3]}; *(f32x4*)(so + 4) = (f32x4){u0[4], u0[5], u0[6], u0[7]}; }
                    }
                }
                if (smp_unit || kind == 5) {
                    asm volatile("s_waitcnt vmcnt(0)" ::: "memory");
                    __syncthreads();
                    if (tid == 0) { __builtin_amdgcn_fence(__ATOMIC_RELEASE, "agent"); asm volatile("s_waitcnt vmcnt(0)" ::: "memory");
                        __hip_atomic_fetch_add(ctl + (kind == 5 ? CTL_SI : CTL_SM) + l, 1u, __ATOMIC_RELAXED, __HIP_MEMORY_SCOPE_AGENT); }
                }
            }
            }
        }
        grid.sync();
        {
            pg8::Gemm g{YMIX, WOUT + (size_t)l * 1024 * 1024, NPROMPT, 1024, 1024}; pg8::StaticOrder S; S.init(NPROMPT, 1024, G, bx);
            pg8::EpiOut E{ws, x_p, x_s, l};

#ifndef NO_GEMM2
            pg8::gemm_phase<pg8::EpiOut, pg8::StaticOrder, true, true>(lds, g, S, E);
#endif

        }
        grid.sync();
    }
    {
        const int gw = bx * 8 + wave, NGW = G * 8;
        const float* fg = args.in[17];
        f32x4 gv[4];
#pragma unroll
        for (int j = 0; j < 4; ++j) gv[j] = *((const f32x4*)fg + lane + 64 * j);
        for (int m = gw; m < MROWS; m += NGW) {
            const float rs = __builtin_amdgcn_rsqf(SSQ2[m] * (1.0f / 1024.0f) + 1e-6f);
#pragma unroll
            for (int j = 0; j < 4; ++j) { const f32x4 v = *((const f32x4*)(X1 + (size_t)m * 1024) + lane + 64 * j); *((f32x4*)(out + O_Y + (size_t)m * 1024) + lane + 64 * j) = v * rs * gv[j]; }
        }
    }
}

extern "C" void kernel_launch(void* const* d_in, const int* in_sizes, int n_in, void* d_out, int out_size, void* d_ws, size_t ws_size, hipStream_t stream) {
    static int grid_blocks = 0;
    if (!grid_blocks) {
        if (n_in != 18 || (size_t)out_size != O_END || ws_size < WS_END) { fprintf(stderr, "kernel_launch: unexpected shapes n_in %d out %d ws %zu\n", n_in, out_size, ws_size); grid_blocks = -1; return; }
        int dev = 0, cus = 0, per_cu = 0;
        hipGetDevice(&dev); hipDeviceGetAttribute(&cus, hipDeviceAttributeMultiprocessorCount, dev);
        hipFuncSetAttribute((const void*)fwd_megakernel, hipFuncAttributeMaxDynamicSharedMemorySize, LDS_BYTES);
        hipOccupancyMaxActiveBlocksPerMultiprocessor(&per_cu, (const void*)fwd_megakernel, 512, LDS_BYTES);
        if (per_cu < 1) { fprintf(stderr, "kernel_launch: occupancy query says %d blocks per CU\n", per_cu); per_cu = 1; }
        if (per_cu > 1) per_cu = 1;
        grid_blocks = cus * per_cu;
    }
    if (grid_blocks < 0) return;
    hipMemsetAsync((char*)d_ws + WS_CTL, 0, CTL_BYTES, stream);
    Args a{};
    for (int i = 0; i < 18; ++i) a.in[i] = (const float*)d_in[i];
    a.out = (float*)d_out; a.ws = (unsigned char*)d_ws;
    void* kargs[] = {&a};
    hipError_t e = hipLaunchCooperativeKernel((const void*)fwd_megakernel, dim3(grid_blocks), dim3(512), kargs, LDS_BYTES, stream);
    if (e != hipSuccess) fprintf(stderr, "cooperative launch failed: %s (grid %d)\n", hipGetErrorString(e), grid_blocks);
}
```

```cpp
#include <hip/hip_runtime.h>
#include <hip/hip_cooperative_groups.h>
#include <cstdio>
#include <cstdint>
namespace cg = cooperative_groups;
namespace pg8 {
#define PG8_LAS __attribute__((address_space(3)))
typedef unsigned short bf16_t;
typedef short bf16x8 __attribute__((ext_vector_type(8)));
typedef float f32x4 __attribute__((ext_vector_type(4)));
typedef unsigned u32x4 __attribute__((ext_vector_type(4)));
constexpr int BM = 256, BK = 64, HALF = 128, HTB = HALF * BK * 2  , STAGE_BYTES = 8 * HTB, NXCD = 8, WGM = 8;

__host__ __device__ __forceinline__ int lds_byte(int r, int c) { const int st = (r >> 4) * 2 + (c >> 5), rr = r & 15, cc = c & 31, ob = rr * 64 + cc * 2; return st * 1024 + (ob ^ (((ob >> 9) & 1) << 5)); }
__host__ __device__ __forceinline__ void stage_rc(int b, int& R, int& C) { const int st = b / 1024, sb = b % 1024, swz = sb ^ (((sb >> 9) & 1) << 5); R = (st >> 1) * 16 + swz / 64; C = (st & 1) * 32 + (swz % 64) / 2; }
__host__ __device__ __forceinline__ int perm32(int rho) { const int n = rho >> 4, i = rho & 15; return 8 * (i >> 2) + 4 * n + (i & 3); }

struct Unit { int pm, pn; };
struct Gemm { const bf16_t* A; const bf16_t* Bt; int M, N, K; };

struct StaticOrder {
    int nM, nN, nwg, G, c;
    __host__ __device__ void init(int M, int N, int G_, int c_) { nM = M / BM; nN = N / BM; nwg = nM * nN; G = G_; c = c_; }
    __host__ __device__ bool next(int i, Unit& u) const {
        const long L = (long)i * G + c; if (L >= nwg) return false;
        int wgid = (int)L; { const int q = nwg / NXCD, r = nwg % NXCD, xcd = wgid % NXCD, off = wgid / NXCD; wgid = (xcd < r ? xcd * (q + 1) : r * (q + 1) + (xcd - r) * q) + off; }
        const int nig = WGM * nN, gid = wgid / nig, fm = gid * WGM, gsz = (nM - fm) < WGM ? (nM - fm) : WGM;
        u.pm = fm + ((wgid % nig) % gsz); u.pn = (wgid % nig) / gsz; return true;
    }
    __device__ __forceinline__ void a_ready(const Unit&) const {}
    __device__ __forceinline__ void done(const Unit&) const {}
};
struct OneUnit {
    int pm, pn;
    __host__ __device__ bool next(int i, Unit& u) const { if (i) return false; u.pm = pm; u.pn = pn; return true; }
    __device__ __forceinline__ void a_ready(const Unit&) const {}
    __device__ __forceinline__ void done(const Unit&) const {}
};
__device__ __forceinline__ unsigned cvt_pk_bf16(float lo, float hi) { unsigned r; asm volatile("v_cvt_pk_bf16_f32 %0, %1, %2" : "=v"(r) : "v"(lo), "v"(hi)); return r; }
typedef float f32x2 __attribute__((ext_vector_type(2)));
constexpr float LOG2E = 1.4426950408889634f;
constexpr float SC_QA = 0.125f * LOG2E;
constexpr float SC_QC = 0.17677669529663687f * LOG2E;
constexpr int ZLD = 4096, MROWS = 16640, NPROMPT = 16384;
constexpr size_t WSO_MiB = 1u << 20;
constexpr size_t WSO_PANEL = 512 * 4  , WSO_CTL = 0, WSO_SSQ1 = 16384 * 4, WSO_SSQ2 = (16384 + 32768) * 4, WSO_SSQ0 = 1 * WSO_MiB, WSO_ROPE = 2 * WSO_MiB, WSO_WIN = 4 * WSO_MiB, WSO_WOUT = 20 * WSO_MiB, WSO_XB = 24 * WSO_MiB,
                 WSO_YMIX = 60 * WSO_MiB, WSO_X1 = 96 * WSO_MiB, WSO_Z = 164 * WSO_MiB, WSO_END = 296 * WSO_MiB;
constexpr size_t OO_Y = 0, OO_AKP = 17039360, OO_AVP = OO_AKP + 524288, OO_CONVP = OO_AVP + 524288, OO_CKP = OO_CONVP + 1024, OO_CVP = OO_CKP + 8388608,
                 OO_AKS = OO_CVP + 8388608, OO_AVS = OO_AKS + 262144, OO_CONVS = OO_AVS + 262144, OO_CKS = OO_CONVS + 16384, OO_CVS = OO_CKS + 131072, OO_END = OO_CVS + 131072;
__device__ __forceinline__ float silu_f(float x) { return x * __builtin_amdgcn_rcpf(1.0f + __builtin_amdgcn_exp2f(-x * LOG2E)); }
struct EpiIn {
    static constexpr bool PERM = true, AFTER_DRAIN = false;
    unsigned char* ws; float* out; int l;
    __device__ __forceinline__ void operator()(const f32x4 (&acc)[2][2][4][2], const Unit& u, int wr, int wc, int fr, int fq) const {
        const int pn = u.pn, pm = u.pm;
        bf16_t* Z = (bf16_t*)(ws + WSO_Z); const float* ssq = (const float*)(ws + (l == 0 ? WSO_SSQ0 : WSO_SSQ1)); const float* rope = (const float*)(ws + WSO_ROPE);
        float* o_ak_p = out + OO_AKP + (size_t)l * 262144; float* o_av_p = out + OO_AVP + (size_t)l * 262144; float* o_ak_s = out + OO_AKS + (size_t)l * 131072; float* o_av_s = out + OO_AVS + (size_t)l * 131072;
        float* o_ck_p = out + OO_CKP + (size_t)l * 4194304; float* o_cv_p = out + OO_CVP + (size_t)l * 4194304; float* o_ck_s = out + OO_CKS + (size_t)l * 65536; float* o_cv_s = out + OO_CVS + (size_t)l * 65536;
        const int rowl = wr * 64 + fr;
        const int colb = pn * BM + wc * 32 + 8 * fq;
        const bool rope_tile = (pn == 12 || pn == 13);
        const bool do_rope = rope_tile && fq == 0;
        const float sc = (pn < 2) ? SC_QA : (pn == 12 ? SC_QC : 1.f);
        const bool do_silu = (pn == 6 || pn == 7 || pn == 11 || pn == 15);
        float* ob = nullptr; int old = 0, ocol0 = 0;
        if (pn >= 2 && pn <= 5) { old = 512; ocol0 = (pn >= 4) ? 1024 : 512;
            if (pm == 64) ob = (pn >= 4) ? o_av_s : o_ak_s; else if (pm >= 62) ob = ((pn >= 4) ? o_av_p : o_ak_p) + (size_t)(pm - 62) * 256 * 512; }
        else if (pn == 13 || pn == 14) { old = 256; ocol0 = (pn == 13) ? 3328 : 3584;
            if (pm == 64) ob = (pn == 13) ? o_ck_s : o_cv_s; else ob = ((pn == 13) ? o_ck_p : o_cv_p) + (size_t)pm * 256 * 256; }
#pragma unroll
        for (int ai = 0; ai < 2; ++ai)
#pragma unroll
            for (int m = 0; m < 4; ++m) {
                const int rl = rowl + ai * HALF + m * 16, row = pm * BM + rl;
                const float rs = __builtin_amdgcn_rsqf(ssq[row] * (1.0f / 1024.0f) + 1e-6f);
                f32x4 rc = {1.f, 1.f, 1.f, 1.f}, rsn = {0.f, 0.f, 0.f, 0.f};
                if (do_rope) { rc = *(const f32x4*)(rope + (size_t)row * 8); rsn = *(const f32x4*)(rope + (size_t)row * 8 + 4); }
#pragma unroll
                for (int bj = 0; bj < 2; ++bj) {
                    f32x4 v0 = acc[ai][bj][m][0] * rs, v1 = acc[ai][bj][m][1] * rs;
                    const int col = colb + bj * HALF;
                    if (rope_tile) { const f32x4 a = v0 * rc - v1 * rsn, b = v1 * rc + v0 * rsn; v0 = a; v1 = b; }
                    if (ob) { float* op = ob + (size_t)rl * old + (col - ocol0); *(f32x4*)op = v0; *(f32x4*)(op + 4) = v1; }
                    if (do_silu) { v0 = (f32x4){silu_f(v0[0]), silu_f(v0[1]), silu_f(v0[2]), silu_f(v0[3])}; v1 = (f32x4){silu_f(v1[0]), silu_f(v1[1]), silu_f(v1[2]), silu_f(v1[3])}; }
                    v0 = v0 * sc; v1 = v1 * sc;
                    u32x4 w; w.x = cvt_pk_bf16(v0[0], v0[1]); w.y = cvt_pk_bf16(v0[2], v0[3]); w.z = cvt_pk_bf16(v1[0], v1[1]); w.w = cvt_pk_bf16(v1[2], v1[3]);
                    *(u32x4*)(Z + (size_t)row * ZLD + col) = w;
                }
                asm volatile("" ::: "memory");
            }
    }
};
struct EpiOut {
    static constexpr bool PERM = true, AFTER_DRAIN = false;
    unsigned char* ws; const float* x_p; const float* x_s; int l; const float* fg; float* yout;
    __device__ __forceinline__ void operator()(f32x4 (&acc)[2][2][4][2], const Unit& u, int wr, int wc, int fr, int fq) const {
        const int pm = u.pm; const int colb = u.pn * BM + wc * 32 + 8 * fq;
        float* X1 = (float*)(ws + WSO_X1) + (size_t)pm * BM * 1024; bf16_t* XB = (bf16_t*)(ws + WSO_XB) + (size_t)pm * BM * 1024; float* ssq = (float*)(ws + (l == 0 ? WSO_SSQ1 : WSO_SSQ2)) + pm * BM;
        const float* res = (l == 0) ? ((pm == 64) ? x_s : x_p + (size_t)pm * BM * 1024) : X1;
        const unsigned off0 = (unsigned)(wr * 64 + fr) * 1024u + (unsigned)colb;
        const bool fuse = (l == 1 && pm < 64);
#pragma unroll
        for (int ai = 0; ai < 2; ++ai)
#pragma unroll
            for (int m = 0; m < 4; ++m) {
                const unsigned offr = off0 + (unsigned)(ai * HALF + m * 16) * 1024u; float q = 0.f;
#pragma unroll
                for (int bj = 0; bj < 2; ++bj) { const unsigned off = offr + bj * HALF;
                    const f32x4 v0 = acc[ai][bj][m][0] + *(const f32x4*)(res + off), v1 = acc[ai][bj][m][1] + *(const f32x4*)(res + off + 4);
                    if (fuse) { acc[ai][bj][m][0] = v0; acc[ai][bj][m][1] = v1; }
                    else {
                        *(f32x4*)(X1 + off) = v0; *(f32x4*)(X1 + off + 4) = v1;
                        u32x4 w; w.x = cvt_pk_bf16(v0[0], v0[1]); w.y = cvt_pk_bf16(v0[2], v0[3]); w.z = cvt_pk_bf16(v1[0], v1[1]); w.w = cvt_pk_bf16(v1[2], v1[3]);
                        *(u32x4*)(XB + off) = w; }
                    q += (v0[0] * v0[0] + v0[1] * v0[1]) + (v0[2] * v0[2] + v0[3] * v0[3]) + (v1[0] * v1[0] + v1[1] * v1[1]) + (v1[2] * v1[2] + v1[3] * v1[3]);
                    asm volatile("" ::: "memory"); }
                q += __shfl_xor(q, 16); q += __shfl_xor(q, 32);
                if (fq == 0) atomicAdd(ssq + (wr * 64 + fr + ai * HALF + m * 16), q);
                asm volatile("" ::: "memory");
            }
        if (fuse) {
            unsigned* cnt = (unsigned*)(ws + WSO_PANEL) + 64 * pm;
            asm volatile("s_waitcnt vmcnt(0)" ::: "memory");
            if (__builtin_amdgcn_readfirstlane(fr + 16 * fq) == (fr + 16 * fq)) __hip_atomic_fetch_add(cnt, 1u, __ATOMIC_RELAXED, __HIP_MEMORY_SCOPE_AGENT);
            unsigned spins = 0;
            while (__hip_atomic_load(cnt, __ATOMIC_RELAXED, __HIP_MEMORY_SCOPE_AGENT) < 32u) { __builtin_amdgcn_s_sleep(2); if (++spins > (1u << 22)) break; }
            float* yo = yout + (size_t)pm * BM * 1024;
#pragma unroll
            for (int ai = 0; ai < 2; ++ai)
#pragma unroll
                for (int m = 0; m < 4; ++m) {
                    const int rl = wr * 64 + fr + ai * HALF + m * 16;
                    const float sq = __hip_atomic_load(ssq + rl, __ATOMIC_RELAXED, __HIP_MEMORY_SCOPE_AGENT);
                    const float rs = __builtin_amdgcn_rsqf(sq * (1.0f / 1024.0f) + 1e-6f);
                    const unsigned offr = off0 + (unsigned)(ai * HALF + m * 16) * 1024u;
#pragma unroll
                    for (int bj = 0; bj < 2; ++bj) {
                        const f32x4 g0 = *(const f32x4*)(fg + colb + bj * HALF), g1 = *(const f32x4*)(fg + colb + bj * HALF + 4);
                        *(f32x4*)(yo + offr + bj * HALF) = acc[ai][bj][m][0] * rs * g0; *(f32x4*)(yo + offr + bj * HALF + 4) = acc[ai][bj][m][1] * rs * g1;
                        asm volatile("" ::: "memory"); }
                }
        }
    }
};
template <class Epi, class Sched, bool ALIGN_EPI = false, bool SP2 = false>
__device__ __forceinline__ void gemm_phase(PG8_LAS unsigned char* lds, const Gemm g, const Sched& S, const Epi& E) {
    int tid_ = threadIdx.x; asm volatile("" : "+v"(tid_));
    const int tid = tid_, wid = __builtin_amdgcn_readfirstlane(tid >> 6), lane = tid & 63, wr = wid >> 2, wc = wid & 3, fr = lane & 15, fq = lane >> 4;
    const int K = g.K, nt = K / BK;
    unsigned voffA[2], voffB[2];
#pragma unroll
    for (int i = 0; i < 2; ++i) { int R, C; stage_rc(tid * 16 + i * 8192, R, C); const int Rb = Epi::PERM ? ((R & ~31) + perm32(R & 31)) : R;
        voffA[i] = (unsigned)(R * K + C) * 2u; voffB[i] = (unsigned)(Rb * K + C) * 2u; }
    const size_t kstep = (size_t)(BK * 2);
    const size_t hstep = (size_t)HALF * K * 2;
    const size_t tstep = 2 * hstep;
    const unsigned ldsw = (unsigned)wid * 1024u;
    const int aoff = lds_byte(wr * 64 + fr, fq * 8), boff = lds_byte(wc * 32 + fr, fq * 8);
#define PG8_SA(b, h) (((b) * 2 + (h)) * HTB)
#define PG8_SB(b, h) ((4 + (b) * 2 + (h)) * HTB)
#define PG8_STAGE(bufoff, gbase, voff) do { _Pragma("unroll") for (int _i = 0; _i < 2; ++_i) \
        __builtin_amdgcn_global_load_lds((const unsigned*)((const char*)(gbase) + (voff)[_i]), (PG8_LAS unsigned*)(lds + (bufoff) + ldsw + _i * 8192), 16, 0, 0); } while (0)
#define PG8_LDA(dst, b, h) do { _Pragma("unroll") for (int m = 0; m < 4; ++m) _Pragma("unroll") for (int k = 0; k < 2; ++k) dst[m][k] = *(const PG8_LAS bf16x8*)(lds + PG8_SA(b, h) + aoff + m * 2048 + k * 1024); } while (0)
#define PG8_LDB(dst, b, h) do { _Pragma("unroll") for (int n = 0; n < 2; ++n) _Pragma("unroll") for (int k = 0; k < 2; ++k) dst[n][k] = *(const PG8_LAS bf16x8*)(lds + PG8_SB(b, h) + boff + n * 2048 + k * 1024); } while (0)
#define PG8_MMA(ai, bj, At, Bt) do { __builtin_amdgcn_s_setprio(1); _Pragma("unroll") for (int m = 0; m < 4; ++m) _Pragma("unroll") for (int n = 0; n < 2; ++n) _Pragma("unroll") for (int k = 0; k < 2; ++k) \
        acc[ai][bj][m][n] = __builtin_amdgcn_mfma_f32_16x16x32_bf16(Bt[n][k], At[m][k], acc[ai][bj][m][n], 0, 0, 0); __builtin_amdgcn_s_setprio(0); } while (0)
#define PG8_WAIT_V(n) asm volatile("s_waitcnt vmcnt(" #n ")" ::: "memory")
#define PG8_WAIT_L(n) asm volatile("s_waitcnt lgkmcnt(" #n ")" ::: "memory")
#define PG8_BAR __builtin_amdgcn_s_barrier()
#define PG8_SCHED __builtin_amdgcn_sched_barrier(0)
    Unit cur, nxt; int ui = 0;
    if (!S.next(0, cur)) return;
    f32x4 acc[2][2][4][2];
#pragma unroll
    for (int a = 0; a < 2; ++a)
#pragma unroll
        for (int b = 0; b < 2; ++b)
#pragma unroll
            for (int m = 0; m < 4; ++m)
#pragma unroll
                for (int n = 0; n < 2; ++n) acc[a][b][m][n] = (f32x4){0.f, 0.f, 0.f, 0.f};
    bf16x8 At[4][2], B0[2][2], B1[2][2];
    const char* cA = (const char*)g.A + (size_t)cur.pm * tstep; const char* cB = (const char*)g.Bt + (size_t)cur.pn * tstep;
    S.a_ready(cur);
    if constexpr (SP2) {
        PG8_STAGE(PG8_SB(0, 0), cB, voffB); PG8_STAGE(PG8_SB(0, 1), cB + hstep, voffB); PG8_STAGE(PG8_SA(0, 0), cA, voffA); PG8_STAGE(PG8_SA(0, 1), cA + hstep, voffA);
        if (wr == 1) PG8_BAR;
        PG8_WAIT_V(2); PG8_BAR;
        PG8_STAGE(PG8_SB(1, 0), cB + kstep, voffB); PG8_STAGE(PG8_SA(1, 0), cA + kstep, voffA); PG8_STAGE(PG8_SB(1, 1), cB + hstep + kstep, voffB);
        PG8_WAIT_V(6); PG8_BAR;
    } else {
        PG8_STAGE(PG8_SB(0, 0), cB, voffB); PG8_STAGE(PG8_SA(0, 0), cA, voffA); PG8_STAGE(PG8_SB(0, 1), cB + hstep, voffB); PG8_STAGE(PG8_SA(0, 1), cA + hstep, voffA);
        if (wr == 1) PG8_BAR;
        PG8_WAIT_V(4); PG8_BAR;
        PG8_STAGE(PG8_SB(1, 0), cB + kstep, voffB); PG8_STAGE(PG8_SA(1, 0), cA + kstep, voffA); PG8_STAGE(PG8_SB(1, 1), cB + hstep + kstep, voffB);
        PG8_WAIT_V(6); PG8_BAR;
    }
    for (;;) {
        const bool has_next = S.next(ui + 1, nxt);
        const char* nA = has_next ? (const char*)g.A + (size_t)nxt.pm * tstep : cA; const char* nB = has_next ? (const char*)g.Bt + (size_t)nxt.pn * tstep : cB;
        for (int t = 0; t < nt; t += 2) {
            const bool last = (t == nt - 2);
            const char* a1 = cA + (size_t)(t + 1) * kstep;
            const char* a2 = last ? nA : cA + (size_t)(t + 2) * kstep; const char* b2 = last ? nB : cB + (size_t)(t + 2) * kstep;
            const char* a3 = a2 + kstep; const char* b3 = b2 + kstep;
            if (last && has_next) S.a_ready(nxt);
            if constexpr (SP2) {
            PG8_LDB(B0, 0, 0); PG8_LDB(B1, 0, 1); PG8_SCHED; PG8_LDA(At, 0, 0); PG8_STAGE(PG8_SA(1, 1), a1 + hstep, voffA);
            PG8_WAIT_V(8); PG8_WAIT_L(0); PG8_BAR; PG8_MMA(0, 0, At, B0); PG8_MMA(0, 1, At, B1); PG8_BAR; PG8_SCHED;
            PG8_LDA(At, 0, 1); PG8_STAGE(PG8_SB(0, 0), b2, voffB); PG8_STAGE(PG8_SB(0, 1), b2 + hstep, voffB); PG8_STAGE(PG8_SA(0, 0), a2, voffA);
            PG8_WAIT_V(8); PG8_WAIT_L(0); PG8_BAR; PG8_MMA(1, 0, At, B0); PG8_MMA(1, 1, At, B1); PG8_BAR; PG8_SCHED;
            PG8_LDB(B0, 1, 0); PG8_LDB(B1, 1, 1); PG8_SCHED; PG8_LDA(At, 1, 0); PG8_STAGE(PG8_SA(0, 1), a2 + hstep, voffA);
            PG8_WAIT_V(8); PG8_WAIT_L(0); PG8_BAR; PG8_MMA(0, 0, At, B0); PG8_MMA(0, 1, At, B1); PG8_BAR; PG8_SCHED;
            PG8_LDA(At, 1, 1); PG8_STAGE(PG8_SB(1, 0), b3, voffB); PG8_STAGE(PG8_SB(1, 1), b3 + hstep, voffB); PG8_STAGE(PG8_SA(1, 0), a3, voffA);
            PG8_WAIT_V(8); PG8_WAIT_L(0); PG8_BAR; PG8_MMA(1, 0, At, B0); PG8_MMA(1, 1, At, B1); PG8_BAR; PG8_SCHED;
            } else {
            PG8_LDB(B0, 0, 0); PG8_SCHED; PG8_LDA(At, 0, 0); PG8_STAGE(PG8_SA(1, 1), a1 + hstep, voffA);
            PG8_WAIT_L(8); PG8_BAR; PG8_WAIT_L(0); PG8_MMA(0, 0, At, B0); PG8_BAR; PG8_SCHED;
            PG8_LDB(B1, 0, 1); PG8_STAGE(PG8_SB(0, 0), b2, voffB);
            PG8_BAR; PG8_WAIT_L(0); PG8_MMA(0, 1, At, B1); PG8_BAR;
            PG8_LDA(At, 0, 1); PG8_STAGE(PG8_SA(0, 0), a2, voffA);
            PG8_BAR; PG8_WAIT_L(0); PG8_MMA(1, 0, At, B0); PG8_BAR; PG8_SCHED;
            PG8_STAGE(PG8_SB(0, 1), b2 + hstep, voffB);
            PG8_WAIT_V(6); PG8_BAR; PG8_MMA(1, 1, At, B1); PG8_BAR;
            PG8_LDB(B0, 1, 0); PG8_SCHED; PG8_LDA(At, 1, 0); PG8_STAGE(PG8_SA(0, 1), a2 + hstep, voffA);
            PG8_WAIT_L(8); PG8_BAR; PG8_WAIT_L(0); PG8_MMA(0, 0, At, B0); PG8_BAR; PG8_SCHED;
            PG8_LDB(B1, 1, 1); PG8_STAGE(PG8_SB(1, 0), b3, voffB);
            PG8_BAR; PG8_WAIT_L(0); PG8_MMA(0, 1, At, B1); PG8_BAR;
            PG8_LDA(At, 1, 1); PG8_STAGE(PG8_SA(1, 0), a3, voffA);
            PG8_BAR; PG8_WAIT_L(0); PG8_MMA(1, 0, At, B0); PG8_BAR; PG8_SCHED;
            PG8_STAGE(PG8_SB(1, 1), b3 + hstep, voffB);
            PG8_WAIT_V(6); PG8_BAR; PG8_MMA(1, 1, At, B1); PG8_BAR;
            }
        }
        if constexpr (ALIGN_EPI) { if (wr == 0) PG8_BAR; }
        if constexpr (!Epi::AFTER_DRAIN) { E(acc, cur, wr, wc, fr, fq); S.done(cur); }
        if (!has_next) break;
#pragma unroll
        for (int a = 0; a < 2; ++a)
#pragma unroll
            for (int b = 0; b < 2; ++b)
#pragma unroll
                for (int m = 0; m < 4; ++m)
#pragma unroll
                    for (int n = 0; n < 2; ++n) acc[a][b][m][n] = (f32x4){0.f, 0.f, 0.f, 0.f};
        cur = nxt; cA = nA; cB = nB; ++ui;
        if constexpr (ALIGN_EPI) { if (wr == 1) PG8_BAR; }
    }
    PG8_WAIT_V(0);
    if constexpr (!ALIGN_EPI) { if (wr == 0) PG8_BAR; }
    PG8_BAR;
    if constexpr (Epi::AFTER_DRAIN) { E.fused(acc, cur, wr, wc, fr, fq, lds, wid, lane); S.done(cur); }
#undef PG8_SA
#undef PG8_SB
#undef PG8_STAGE
#undef PG8_LDA
#undef PG8_LDB
#undef PG8_MMA
#undef PG8_WAIT_V
#undef PG8_WAIT_L
#undef PG8_BAR
#undef PG8_SCHED
}
}
#define LAS __attribute__((address_space(3)))
typedef unsigned short bf16_t;
typedef LAS unsigned char* ldsp;
typedef short bf16x8 __attribute__((ext_vector_type(8)));
typedef short s16x4 __attribute__((ext_vector_type(4)));
typedef float f32x16 __attribute__((ext_vector_type(16)));
typedef float f32x4 __attribute__((ext_vector_type(4)));
typedef float f32x2 __attribute__((ext_vector_type(2)));
typedef unsigned u32x4 __attribute__((ext_vector_type(4)));
typedef unsigned u32x2 __attribute__((ext_vector_type(2)));
typedef __bf16 bf16x2_t __attribute__((ext_vector_type(2)));
using pg8::ZLD; using pg8::MROWS; using pg8::NPROMPT; using pg8::LOG2E;
__device__ __forceinline__ int crow(int r, int hi) { return (r & 3) + 8 * (r >> 2) + 4 * hi; }
__device__ __forceinline__ unsigned cvtpk(float lo, float hi) { f32x2 v = {lo, hi}; bf16x2_t b = __builtin_convertvector(v, bf16x2_t); return __builtin_bit_cast(unsigned, b); }
__device__ __forceinline__ float bf_lo(unsigned w) { return __uint_as_float(w << 16); }
__device__ __forceinline__ float bf_hi(unsigned w) { return __uint_as_float(w & 0xffff0000u); }
__device__ __forceinline__ float xhalf_max(float m) { auto rr = __builtin_amdgcn_permlane32_swap(__float_as_uint(m), __float_as_uint(m), false, false); return fmaxf(__uint_as_float(rr[0]), __uint_as_float(rr[1])); }
__device__ __forceinline__ float xhalf_sum(float m) { auto rr = __builtin_amdgcn_permlane32_swap(__float_as_uint(m), __float_as_uint(m), false, false); return __uint_as_float(rr[0]) + __uint_as_float(rr[1]); }
__device__ __forceinline__ s16x4 vtr(ldsp p) { typedef short v4i16_t __attribute__((ext_vector_type(4))); return __builtin_bit_cast(s16x4, __builtin_amdgcn_ds_read_tr16_b64_v4i16((LAS v4i16_t*)p)); }
__device__ __forceinline__ float max3f(float a, float b, float c) { float r; asm("v_max3_f32 %0, %1, %2, %3" : "=v"(r) : "v"(a), "v"(b), "v"(c)); return r; }
__device__ __forceinline__ float max2f(float a, float b) { float r; asm("v_max_f32_e32 %0, %1, %2" : "=v"(r) : "v"(a), "v"(b)); return r; }
#define MFMA32(a, b, c) __builtin_amdgcn_mfma_f32_32x32x16_bf16((a), (b), (c), 0, 0, 0)

constexpr int KPITCH = 144, KT_BYTES = 64 * KPITCH, VT_BYTES = 8192, TILE_BYTES = KT_BYTES + VT_BYTES, BUF_BYTES = 2 * TILE_BYTES;
constexpr int COMB_OFF = 2 * BUF_BYTES, COMB_WAVE = 17408, TAB_OFF = COMB_OFF + 4 * COMB_WAVE, MISC_OFF = TAB_OFF + 1040, LDS_BYTES = 147456;
static_assert(MISC_OFF + 64 <= LDS_BYTES, "LDS map");
constexpr float NEG_BIG = -1.0e30f, THR = 8.0f;
struct AU {
    const bf16_t* q; int nq; int nt, ntc; const float* kc; const float* vc; int cp; const bf16_t* kz; const bf16_t* vz; int lastv; int nqg;
    int tlo0, thi0, tlo1, thi1; int qpos0, kpos0; const bf16_t* gate; bf16_t* y;
};
#ifndef ATTN_INL
#define ATTN_INL __forceinline__
#endif
template <int MODE  >
__device__ ATTN_INL void attn_unit(const AU& d, ldsp lds, float lam, float oml, const float* subg) {
    constexpr int NMAP = MODE == 0 ? 2 : 1, NSTEP = MODE == 0 ? 2 : 4;
    int tid_ = threadIdx.x; asm volatile("" : "+v"(tid_));
    const int tid = tid_, lane = tid & 63, wid = __builtin_amdgcn_readfirstlane(tid >> 6), qg = wid & 3, ks = wid >> 2, r32 = lane & 31, hi = lane >> 5;
    const int tlo = (qg >> 1) ? d.tlo1 : d.tlo0; int thi = (qg >> 1) ? d.thi1 : d.thi0; if (qg >= d.nqg) thi = -1;
    const LAS float* tab = (const LAS float*)(lds + TAB_OFF);
    bf16x8 qf[NMAP][NSTEP];
    { int qrow = 32 * qg + r32; if (qrow >= d.nq) qrow = d.nq - 1;
      const bf16_t* qp = d.q + (size_t)qrow * ZLD;
#pragma unroll
      for (int mp = 0; mp < NMAP; ++mp)
#pragma unroll
          for (int st = 0; st < NSTEP; ++st) qf[mp][st] = *(const bf16x8*)(qp + mp * 32 + st * 16 + hi * 8); }
    f32x16 O[NMAP][2]; float mref[NMAP], lsum[NMAP];
#pragma unroll
    for (int mp = 0; mp < NMAP; ++mp) { mref[mp] = 0.f; lsum[mp] = 0.f;
#pragma unroll
        for (int db = 0; db < 2; ++db)
#pragma unroll
            for (int i = 0; i < 16; ++i) O[mp][db][i] = 0.f; }
    const int lrow = tid >> 3, lch = tid & 7;
    const int kwoff = lrow * KPITCH + lch * 16, vwoff = (lch >> 2) * 4096 + lrow * 64 + (lch & 3) * 16;
    const int kroff = r32 * KPITCH + hi * 16;
    const int vroff = (4 * hi + ((lane & 15) >> 2)) * 64 + ((lane >> 4) & 1) * 32 + (lane & 3) * 8;
    u32x4 stK[2], stV[2];
    const int nit = (d.nt + 1) >> 1; bool started = false;
#define AT_ISSUE(IT) do { _Pragma("unroll") for (int i_ = 0; i_ < 2; ++i_) { const int t_ = 2 * (IT) + i_; if (t_ < d.nt && t_ >= d.ntc) { int r_ = lrow; if (t_ == d.nt - 1 && r_ >= d.lastv) r_ = d.lastv - 1; \
        const size_t off_ = ((size_t)(t_ - d.ntc) * 64 + r_) * ZLD + lch * 8; stK[i_] = *(const u32x4*)(d.kz + off_); stV[i_] = *(const u32x4*)(d.vz + off_); } } } while (0)
#define AT_WRITE(IT, BUF) do { _Pragma("unroll") for (int i_ = 0; i_ < 2; ++i_) { const int t_ = 2 * (IT) + i_; if (t_ < d.nt) { u32x4 kk_, vv_; if (t_ >= d.ntc) { kk_ = stK[i_]; vv_ = stV[i_]; } else { \
        const size_t off_ = ((size_t)t_ * 64 + lrow) * d.cp + lch * 8; const f32x4 a_ = *(const f32x4*)(d.kc + off_), b_ = *(const f32x4*)(d.kc + off_ + 4), c_ = *(const f32x4*)(d.vc + off_), e_ = *(const f32x4*)(d.vc + off_ + 4); \
        kk_ = (u32x4){cvtpk(a_[0], a_[1]), cvtpk(a_[2], a_[3]), cvtpk(b_[0], b_[1]), cvtpk(b_[2], b_[3])}; vv_ = (u32x4){cvtpk(c_[0], c_[1]), cvtpk(c_[2], c_[3]), cvtpk(e_[0], e_[1]), cvtpk(e_[2], e_[3])}; } \
        *(LAS u32x4*)((BUF) + i_ * TILE_BYTES + kwoff) = kk_; *(LAS u32x4*)((BUF) + i_ * TILE_BYTES + KT_BYTES + vwoff) = vv_; } } } while (0)
    AT_ISSUE(0);
    for (int it = 0; it < nit; ++it) {
        const ldsp buf = lds + (it & 1) * BUF_BYTES;
        AT_WRITE(it, buf);
        __builtin_amdgcn_s_waitcnt(0);
        __syncthreads();
        if (it + 1 < nit) AT_ISSUE(it + 1);
        const int t = 2 * it + ks;
        if (t >= tlo && t <= thi) {
            const ldsp Kt = buf + ks * TILE_BYTES, Vt = Kt + KT_BYTES;
            const int valid = (t == d.nt - 1) ? d.lastv : 64;
            f32x16 S0[NMAP], S1[NMAP];
#pragma unroll
            for (int mp = 0; mp < NMAP; ++mp) {
                f32x16 negm;
#pragma unroll
                for (int i = 0; i < 16; ++i) negm[i] = -mref[mp];
#pragma unroll
                for (int st = 0; st < NSTEP; ++st) {
                    const bf16x8 a0 = *(const LAS bf16x8*)(Kt + kroff + (mp * 32 + st * 16) * 2);
                    const bf16x8 a1 = *(const LAS bf16x8*)(Kt + kroff + 32 * KPITCH + (mp * 32 + st * 16) * 2);
                    if (st == 0) { S0[mp] = MFMA32(a0, qf[mp][st], negm); S1[mp] = MFMA32(a1, qf[mp][st], negm); }
                    else { S0[mp] = MFMA32(a0, qf[mp][st], S0[mp]); S1[mp] = MFMA32(a1, qf[mp][st], S1[mp]); }
                }
            }
#pragma unroll
            for (int mp = 0; mp < NMAP; ++mp) {
                f32x16& s0 = S0[mp]; f32x16& s1 = S1[mp];
                if (MODE == 1) {
                    const int qpos = d.qpos0 + 32 * qg + r32, kp0 = d.kpos0 + 64 * t;
                    if (d.qpos0 + 32 * qg - (kp0 + 63) >= 128) { const float c = tab[256];
#pragma unroll
                        for (int i = 0; i < 16; ++i) { s0[i] += c; s1[i] += c; } }
                    else {
#pragma unroll
                        for (int i = 0; i < 16; ++i) { int dd = qpos - (kp0 + crow(i, hi)); int d0 = min(max(dd, -128), 128), d1 = min(max(dd - 32, -128), 128);
                            s0[i] += tab[d0 + 128]; s1[i] += tab[d1 + 128]; } }
                }
                if (valid < 64) {
#pragma unroll
                    for (int i = 0; i < 16; ++i) { const int k = crow(i, hi); if (k >= valid) s0[i] = NEG_BIG; if (k + 32 >= valid) s1[i] = NEG_BIG; } }
                float ra = max3f(s0[0], s0[1], s1[0]), rb = max3f(s0[2], s0[3], s1[1]); ra = max3f(ra, s1[2], s1[3]);
#pragma unroll
                for (int i = 4; i < 16; i += 4) { ra = max3f(ra, s0[i], s0[i + 1]); rb = max3f(rb, s0[i + 2], s0[i + 3]); ra = max3f(ra, s1[i], s1[i + 1]); rb = max3f(rb, s1[i + 2], s1[i + 3]); }
                float rm = xhalf_max(max2f(ra, rb));
                if (!started || __any(rm > THR)) {
                    const float dl = started ? fmaxf(rm, 0.f) : rm, al = started ? __builtin_amdgcn_exp2f(-dl) : 1.f;
                    mref[mp] += dl; lsum[mp] *= al;
#pragma unroll
                    for (int i = 0; i < 16; ++i) { s0[i] -= dl; s1[i] -= dl; }
#pragma unroll
                    for (int db = 0; db < 2; ++db)
#pragma unroll
                        for (int i = 0; i < 16; ++i) O[mp][db][i] *= al;
                }
                s16x4 va[8], vb[8];
#pragma unroll
                for (int k4 = 0; k4 < 4; ++k4) { va[2 * k4] = vtr(Vt + vroff + k4 * 1024); va[2 * k4 + 1] = vtr(Vt + vroff + k4 * 1024 + 512); }
                __builtin_amdgcn_sched_barrier(0);
                bf16x8 Pf[4]; float sa = 0.f, sb = 0.f;
#pragma unroll
                for (int i = 0; i < 16; ++i) { s0[i] = __builtin_amdgcn_exp2f(s0[i]); s1[i] = __builtin_amdgcn_exp2f(s1[i]); sa += s0[i]; sb += s1[i]; }
                lsum[mp] += sa + sb;
#pragma unroll
                for (int s = 0; s < 2; ++s) {
                    u32x4 w0 = {cvtpk(s0[8 * s], s0[8 * s + 1]), cvtpk(s0[8 * s + 2], s0[8 * s + 3]), cvtpk(s0[8 * s + 4], s0[8 * s + 5]), cvtpk(s0[8 * s + 6], s0[8 * s + 7])};
                    u32x4 w1 = {cvtpk(s1[8 * s], s1[8 * s + 1]), cvtpk(s1[8 * s + 2], s1[8 * s + 3]), cvtpk(s1[8 * s + 4], s1[8 * s + 5]), cvtpk(s1[8 * s + 6], s1[8 * s + 7])};
                    Pf[s] = __builtin_bit_cast(bf16x8, w0); Pf[2 + s] = __builtin_bit_cast(bf16x8, w1);
                }
                __builtin_amdgcn_sched_barrier(0);
#pragma unroll
                for (int k4 = 0; k4 < 4; ++k4) { vb[2 * k4] = vtr(Vt + vroff + 4096 + k4 * 1024); vb[2 * k4 + 1] = vtr(Vt + vroff + 4096 + k4 * 1024 + 512); }
#pragma unroll
                for (int k4 = 0; k4 < 4; ++k4) {
                    const s16x4 lo = va[2 * k4], hh = va[2 * k4 + 1];
                    const bf16x8 vf = {lo[0], lo[1], lo[2], lo[3], hh[0], hh[1], hh[2], hh[3]};
                    O[mp][0] = MFMA32(vf, Pf[k4], O[mp][0]);
                }
                __builtin_amdgcn_sched_barrier(0);
#pragma unroll
                for (int k4 = 0; k4 < 4; ++k4) {
                    const s16x4 lo = vb[2 * k4], hh = vb[2 * k4 + 1];
                    const bf16x8 vf = {lo[0], lo[1], lo[2], lo[3], hh[0], hh[1], hh[2], hh[3]};
                    O[mp][1] = MFMA32(vf, Pf[k4], O[mp][1]);
                }
            }
            started = true;
        }
    }
#undef AT_ISSUE
#undef AT_WRITE
    __syncthreads();
    if (!started) {
#pragma unroll
        for (int mp = 0; mp < NMAP; ++mp) mref[mp] = NEG_BIG;
    }
    const ldsp cw = lds + COMB_OFF + qg * COMB_WAVE;
    if (ks == 1 && qg < d.nqg) {
#pragma unroll
        for (int mp = 0; mp < NMAP; ++mp) {
#pragma unroll
            for (int db = 0; db < 2; ++db)
#pragma unroll
                for (int i = 0; i < 16; ++i) *(LAS float*)(cw + ((mp * 2 + db) * 16 + i) * 256 + lane * 4) = O[mp][db][i];
            *(LAS float*)(cw + 16384 + (mp * 2) * 256 + lane * 4) = mref[mp]; *(LAS float*)(cw + 16384 + (mp * 2 + 1) * 256 + lane * 4) = lsum[mp];
        }
    }
    __syncthreads();
    if (ks == 0 && qg < d.nqg) {
        float linv[NMAP];
#pragma unroll
        for (int mp = 0; mp < NMAP; ++mp) {
            const float mb = *(const LAS float*)(cw + 16384 + (mp * 2) * 256 + lane * 4), lb = *(const LAS float*)(cw + 16384 + (mp * 2 + 1) * 256 + lane * 4);
            const float mt = fmaxf(mref[mp], mb), aa = __builtin_amdgcn_exp2f(mref[mp] - mt), ab = __builtin_amdgcn_exp2f(mb - mt);
            const float l = xhalf_sum(lsum[mp] * aa + lb * ab);
            linv[mp] = 1.0f / l;
#pragma unroll
            for (int db = 0; db < 2; ++db)
#pragma unroll
                for (int i = 0; i < 16; ++i) O[mp][db][i] = O[mp][db][i] * aa + *(const LAS float*)(cw + ((mp * 2 + db) * 16 + i) * 256 + lane * 4) * ab;
        }
        float fin = 1.f;
        if (MODE == 0) {
            const float i1 = linv[0], i2 = lam * linv[NMAP - 1]; float ss = 0.f;
#pragma unroll
            for (int db = 0; db < 2; ++db)
#pragma unroll
                for (int i = 0; i < 16; ++i) { const float o = O[0][db][i] * i1 - O[NMAP - 1][db][i] * i2; O[0][db][i] = o; ss += o * o; }
            ss = xhalf_sum(ss);
            fin = __builtin_amdgcn_rsqf(ss * (1.0f / 64.0f) + 1e-5f) * oml;
        } else fin = linv[0];
        const int row = 32 * qg + r32;
        if (row < d.nq) {
#pragma unroll
            for (int db = 0; db < 2; ++db)
#pragma unroll
                for (int g4 = 0; g4 < 4; ++g4) {
                    const int d0 = 32 * db + 8 * g4 + 4 * hi;
                    const u32x2 gw = *(const u32x2*)(d.gate + (size_t)row * ZLD + d0);
                    f32x4 sg = {1.f, 1.f, 1.f, 1.f}; if (MODE == 0) sg = *(const f32x4*)(subg + d0);
                    const float y0 = O[0][db][4 * g4] * fin * sg[0] * bf_lo(gw.x), y1 = O[0][db][4 * g4 + 1] * fin * sg[1] * bf_hi(gw.x);
                    const float y2 = O[0][db][4 * g4 + 2] * fin * sg[2] * bf_lo(gw.y), y3 = O[0][db][4 * g4 + 3] * fin * sg[3] * bf_hi(gw.y);
                    *(u32x2*)(d.y + (size_t)row * 1024 + d0) = (u32x2){cvtpk(y0, y1), cvtpk(y2, y3)};
                }
        }
    }
}
using namespace pg8;
constexpr size_t WS_CTL = WSO_CTL, CTL_BYTES = 1u << 20, WS_SSQ0 = WSO_SSQ0, WS_ROPE = WSO_ROPE, WS_WIN = WSO_WIN, WS_WOUT = WSO_WOUT, WS_XB = WSO_XB, WS_YMIX = WSO_YMIX, WS_X1 = WSO_X1, WS_Z = WSO_Z, WS_END = WSO_END;
static_assert((size_t)MROWS * 1024 * 2 <= 36u * (1u << 20) && (size_t)MROWS * 1024 * 4 <= 68u * (1u << 20) && (size_t)MROWS * 4096 * 2 <= 132u * (1u << 20), "ws map");
constexpr int CTL_Q0 = 0, CTL_SI = 64, CTL_SM = 128, CTL_SSQ1 = 16384, CTL_SSQ2 = 16384 + 32768;
static_assert((CTL_SSQ2 + MROWS) * 4 <= (int)CTL_BYTES, "ctl");
constexpr size_t O_Y = OO_Y, O_CONVP = OO_CONVP, O_CONVS = OO_CONVS, O_END = OO_END;
struct Args { const float* in[18]; float* out; unsigned char* ws; };

__device__ __forceinline__ float wave_sum(float v) {
#pragma unroll
    for (int o = 1; o < 64; o <<= 1) v += __shfl_xor(v, o);
    return v;
}
__device__ __forceinline__ unsigned f2bf(float f) { unsigned u = __builtin_bit_cast(unsigned, f); return (u + 0x7fffu + ((u >> 16) & 1u)) >> 16; }
__device__ __forceinline__ unsigned pk2(float lo, float hi) { return f2bf(lo) | (f2bf(hi) << 16); }
__device__ __forceinline__ void p0_transpose_item(const float* W, const float* g, int K, int N, bf16_t* WT, LAS float* scr, int item, int lane) {
    const int nblk = N / 32, kb = item / nblk, nb = item % nblk, k0 = 64 * kb, n0 = 32 * nb;
#pragma unroll 8
    for (int i = 0; i < 32; ++i) { const int kk = 2 * i + (lane >> 5); const float gs = g ? g[k0 + kk] : 1.f; scr[kk * 33 + (lane & 31)] = W[(size_t)(k0 + kk) * N + n0 + (lane & 31)] * gs; }
    asm volatile("s_waitcnt lgkmcnt(0)" ::: "memory");
    const int c = lane & 7;
#pragma unroll
    for (int j = 0; j < 4; ++j) { const int n = (lane >> 3) + 8 * j; const LAS float* s = scr + (8 * c) * 33 + n;
        u32x4 o; o.x = pk2(s[0 * 33], s[1 * 33]); o.y = pk2(s[2 * 33], s[3 * 33]); o.z = pk2(s[4 * 33], s[5 * 33]); o.w = pk2(s[6 * 33], s[7 * 33]);
        *(u32x4*)(WT + (size_t)(n0 + n) * K + k0 + 8 * c) = o; }
    asm volatile("s_waitcnt lgkmcnt(0)" ::: "memory");
}

__global__ void __launch_bounds__(512) fwd_megakernel(Args args) {
    extern __shared__ __attribute__((aligned(16))) unsigned char lds_raw[];
    cg::grid_group grid = cg::this_grid();
    const ldsp lds = (ldsp)lds_raw;
    const int tid = threadIdx.x, lane = tid & 63, wave = __builtin_amdgcn_readfirstlane(tid >> 6);
    const int G = gridDim.x, bx = blockIdx.x;
    unsigned char* ws = args.ws; float* out = args.out;
    unsigned* ctl = (unsigned*)(ws + WS_CTL);
    float* SSQ0 = (float*)(ws + WS_SSQ0); float* SSQ1 = (float*)ctl + CTL_SSQ1; float* SSQ2 = (float*)ctl + CTL_SSQ2;
    float* ROPE = (float*)(ws + WS_ROPE);
    bf16_t* WIN = (bf16_t*)(ws + WS_WIN); bf16_t* WOUT = (bf16_t*)(ws + WS_WOUT);
    bf16_t* XB = (bf16_t*)(ws + WS_XB); bf16_t* YMIX = (bf16_t*)(ws + WS_YMIX); float* X1 = (float*)(ws + WS_X1); bf16_t* Z = (bf16_t*)(ws + WS_Z);
    const float* x_p = args.in[0]; const float* x_s = args.in[1];

    {
        LAS float* scr = (LAS float*)(lds + wave * 16384);
        const int gw = bx * 8 + wave, NGW = G * 8;
        constexpr int I_IN = (1024 / 64) * (4096 / 32), I_OUT = (1024 / 64) * (1024 / 32), NITEMS = 2 * I_IN + 2 * I_OUT;
        for (int it = gw; it < NITEMS; it += NGW) {
            int r = it;
            if (r < 2 * I_IN) { const int l = r / I_IN; r -= l * I_IN; p0_transpose_item(args.in[8] + (size_t)l * 1024 * 4096, args.in[7] + l * 1024, 1024, 4096, WIN + (size_t)l * 4096 * 1024, scr, r, lane); }
            else { r -= 2 * I_IN; const int l = r / I_OUT; r -= l * I_OUT; p0_transpose_item(args.in[9] + (size_t)l * 1024 * 1024, nullptr, 1024, 1024, WOUT + (size_t)l * 1024 * 1024, scr, r, lane); }
        }
        for (int m = gw; m < MROWS; m += NGW) {
            const float* xr = (m < NPROMPT) ? x_p + (size_t)m * 1024 : x_s + (size_t)(m - NPROMPT) * 1024;
            f32x4 v[4]; float s = 0.f;
#pragma unroll
            for (int j = 0; j < 4; ++j) { v[j] = *((const f32x4*)xr + lane + 64 * j); s += (v[j][0] * v[j][0] + v[j][1] * v[j][1]) + (v[j][2] * v[j][2] + v[j][3] * v[j][3]); }
            s = wave_sum(s);
            if (lane == 0) SSQ0[m] = s;
#pragma unroll
            for (int j = 0; j < 4; ++j) *((u32x2*)(XB + (size_t)m * 1024) + lane + 64 * j) = (u32x2){cvtpk(v[j][0], v[j][1]), cvtpk(v[j][2], v[j][3])};
        }
        for (int e = bx * 512 + tid; e < MROWS * 4; e += G * 512) {
            const int row = e >> 2, i = e & 3; const int pos = (row < NPROMPT) ? row : 4096 + ((row - NPROMPT) & 15);
            const float invf = (i == 0) ? 1.0f : (i == 1 ? 0.037606030930863934f : (i == 2 ? 0.0014142135623730950f : 5.318295896944988e-05f));
            const float ang = (float)pos * invf;
            const double rev = (double)ang * 0.15915494309189535; const float fr = (float)(rev - __builtin_rint(rev));
            ROPE[(size_t)row * 8 + i] = __builtin_amdgcn_cosf(fr); ROPE[(size_t)row * 8 + 4 + i] = __builtin_amdgcn_sinf(fr);
        }
    }
    grid.sync();

    for (int l = 0; l < 2; ++l) {
        {
            pg8::Gemm g{XB, WIN + (size_t)l * 4096 * 1024, NPROMPT, 4096, 1024}; pg8::StaticOrder S; S.init(NPROMPT, 4096, G, bx);
            pg8::EpiIn E{ws, out, l};

#ifndef NO_GEMM1
            pg8::gemm_phase<pg8::EpiIn, pg8::StaticOrder, true, true>(lds, g, S, E);
#ifdef PROBE_P1X
            if (l == 0) { grid.sync(); pg8::gemm_phase<pg8::EpiIn, pg8::StaticOrder, true, true>(lds, g, S, E); }
#endif
#endif

        }
        grid.sync();
        {
            const float lam_init = (l == 0) ? 0.2f : 0.35550906759096927f;
            float d1 = 0.f, d2 = 0.f;
            for (int i = 0; i < 32; ++i) { d1 += args.in[12][l * 32 + i] * args.in[13][l * 32 + i]; d2 += args.in[14][l * 32 + i] * args.in[15][l * 32 + i]; }
            const float lam = __expf(d1) - __expf(d2) + lam_init, oml = 1.0f - lam_init;
            const float* subg = args.in[16] + l * 64;
            volatile LAS int* misc = (volatile LAS int*)(lds + MISC_OFF);
            constexpr int N_SI = 16, N_PC = 512, N_SC = 64, N_PA = 1024, N_SA = 128, N_CV = 130, N_SO = 4, N_TOT = N_SI + N_PC + N_SC + N_PA + N_SA + N_CV + N_SO;
            constexpr unsigned N_SMIX = N_SC + N_SA + 2;
#ifndef PROBE_P2X
#define PROBE_P2X 1
#endif
            for (int rep = 0; rep < ((l == 0) ? PROBE_P2X : 1); ++rep) {
            if (rep > 0) grid.sync();
            for (;;) {
                __syncthreads();
                if (tid == 0) misc[0] = (int)atomicAdd(ctl + CTL_Q0 + l + 2 * rep, 1u);
                __syncthreads();
                int ui = misc[0]; ui = __builtin_amdgcn_readfirstlane(ui);
                if (ui >= N_TOT) break;
                AU d; d.kc = nullptr; d.vc = nullptr; d.cp = 0; d.ntc = 0; d.lastv = 64; d.nqg = 4; d.tlo1 = 0; d.thi1 = -1; d.qpos0 = 0; d.kpos0 = 0;
                int kind;
                int idx = ui;
                if (idx < 16) kind = 5; else if (idx < 256) { kind = 0; idx -= 16; } else if (idx < 320) { kind = 1; idx -= 256; } else if (idx < 448) { kind = 3; idx -= 320; } else if (idx < 450) { kind = 4; idx = 128 + (idx - 448); }
                else if (idx < 454) { kind = 6; idx -= 450; } else if (idx < 726) { kind = 0; idx = 240 + (idx - 454); } else if (idx < 1750) { kind = 2; idx -= 726; } else { kind = 4; idx -= 1750; }
                const bool smp_unit = (kind == 1 || kind == 3 || (kind == 4 && idx >= 128));
                if (smp_unit || kind == 6) {
                    if (tid == 0) {
                        unsigned* cnt = ctl + (kind == 6 ? CTL_SM : CTL_SI) + l; const unsigned want = (kind == 6) ? N_SMIX : (unsigned)N_SI;
                        while (__hip_atomic_load(cnt, __ATOMIC_RELAXED, __HIP_MEMORY_SCOPE_AGENT) < want) __builtin_amdgcn_s_sleep(8);
                        __builtin_amdgcn_fence(__ATOMIC_ACQUIRE, "agent");
                        asm volatile("s_waitcnt vmcnt(0)" ::: "memory");
                    }
                    __syncthreads();
                }
                if (kind >= 5) {
                    if (kind == 5) { pg8::Gemm g{XB, WIN + (size_t)l * 4096 * 1024, MROWS, 4096, 1024}; pg8::OneUnit S{64, idx}; pg8::EpiIn E{ws, out, l};
                        pg8::gemm_phase<pg8::EpiIn, pg8::OneUnit, false, true>(lds, g, S, E); }
                    else { pg8::Gemm g{YMIX, WOUT + (size_t)l * 1024 * 1024, MROWS, 1024, 1024}; pg8::OneUnit S{64, idx}; pg8::EpiOut E{ws, x_p, x_s, l, args.in[17], out};
                        pg8::gemm_phase<pg8::EpiOut, pg8::OneUnit, false, true>(lds, g, S, E); }
                }
                else if (kind == 0) {
                    const int u = 127 - (idx >> 2), h = idx & 3; const size_t r0 = (size_t)128 * u;
                    d.q = Z + r0 * ZLD + 3072 + 64 * h; d.nq = 128; d.nt = 2 * u + 2; d.kz = Z + 3328 + 64 * h; d.vz = Z + 3584 + 64 * h;
                    d.tlo0 = 0; d.thi0 = d.nt - 2; d.tlo1 = 0; d.thi1 = d.nt - 1; d.gate = Z + r0 * ZLD + 3840 + 64 * h; d.y = YMIX + r0 * 1024 + 768 + 64 * h;

#ifndef NO_ATTN0
                    attn_unit<0>(d, lds, lam, oml, subg);
#endif

                } else if (kind == 1) {
                    const int b = idx >> 2, h = idx & 3; const size_t r0 = (size_t)NPROMPT + 16 * b;
                    d.q = Z + r0 * ZLD + 3072 + 64 * h; d.nq = 16; d.nt = 65; d.ntc = 64; d.cp = 256;
                    d.kc = args.in[5] + ((size_t)(l * 16 + b) * 4096) * 256 + 64 * h; d.vc = args.in[6] + ((size_t)(l * 16 + b) * 4096) * 256 + 64 * h;
                    d.kz = Z + r0 * ZLD + 3328 + 64 * h; d.vz = Z + r0 * ZLD + 3584 + 64 * h; d.lastv = 16; d.nqg = 1; d.tlo0 = 0; d.thi0 = 64;
                    d.gate = Z + r0 * ZLD + 3840 + 64 * h; d.y = YMIX + r0 * 1024 + 768 + 64 * h;

#ifndef NO_ATTN0
                    attn_unit<0>(d, lds, lam, oml, subg);
#endif

                } else if (kind == 2 || kind == 3) {
                    int h;
                    if (kind == 2) {
                        h = idx & 7; const int cp = idx >> 3, c0 = max(0, 2 * cp - 8); const size_t r0 = (size_t)128 * cp;
                        d.q = Z + r0 * ZLD + 64 * h; d.nq = 128; d.nt = 2 * cp + 2 - c0; d.kz = Z + (size_t)64 * c0 * ZLD + 512 + 64 * h; d.vz = Z + (size_t)64 * c0 * ZLD + 1024 + 64 * h;
                        d.tlo0 = 0; d.thi0 = 2 * cp - c0; d.tlo1 = max(0, 2 * cp + 1 - 8) - c0; d.thi1 = 2 * cp + 1 - c0; d.qpos0 = 128 * cp; d.kpos0 = 64 * c0;
                        d.gate = Z + r0 * ZLD + 1536 + 64 * h; d.y = YMIX + r0 * 1024 + 64 * h;
                    } else {
                        h = idx & 7; const int b = idx >> 3; const size_t r0 = (size_t)NPROMPT + 16 * b;
                        d.q = Z + r0 * ZLD + 64 * h; d.nq = 16; d.nt = 9; d.ntc = 8; d.cp = 512;
                        d.kc = args.in[2] + ((size_t)(l * 16 + b) * 512) * 512 + 64 * h; d.vc = args.in[3] + ((size_t)(l * 16 + b) * 512) * 512 + 64 * h;
                        d.kz = Z + r0 * ZLD + 512 + 64 * h; d.vz = Z + r0 * ZLD + 1024 + 64 * h; d.lastv = 16; d.nqg = 1; d.tlo0 = 0; d.thi0 = 8; d.qpos0 = 512; d.kpos0 = 0;
                        d.gate = Z + r0 * ZLD + 1536 + 64 * h; d.y = YMIX + r0 * 1024 + 64 * h;
                    }
                    if (tid < 257) ((LAS float*)(lds + TAB_OFF))[tid] = args.in[10][(size_t)(l * 8 + h) * 257 + tid] * LOG2E;

#ifndef NO_ATTN1
                    attn_unit<1>(d, lds, 0.f, 0.f, nullptr);
#endif

                } else {
                    int tq_ = threadIdx.x; asm volatile("" : "+v"(tq_));
                    const int c8 = (tq_ & 31) * 8, rr = tq_ >> 5;
                    const float* cw = args.in[11] + (size_t)l * 3 * 256 + c8;
                    float w0[8], w1[8], w2[8];
#pragma unroll
                    for (int j = 0; j < 8; ++j) { w0[j] = cw[j]; w1[j] = cw[256 + j]; w2[j] = cw[512 + j]; }
                    for (int g = 0; g < 8; ++g) {
                        const int row = 128 * idx + 16 * g + rr; const bool smp = row >= NPROMPT; const int t = smp ? ((row - NPROMPT) & 15) : row, b = (row - NPROMPT) >> 4;
                        const bf16_t* zr = Z + (size_t)row * ZLD;
                        float u0[8], u1[8], u2[8];
                        { const u32x4 c = *(const u32x4*)(zr + 2304 + c8), hh = *(const u32x4*)(zr + 2560 + c8);
#pragma unroll
                          for (int j = 0; j < 4; ++j) { u0[2 * j] = bf_lo(c[j]) * bf_lo(hh[j]); u0[2 * j + 1] = bf_hi(c[j]) * bf_hi(hh[j]); } }
                        if (t >= 1) { const u32x4 c = *(const u32x4*)(zr - ZLD + 2304 + c8), hh = *(const u32x4*)(zr - ZLD + 2560 + c8);
#pragma unroll
                          for (int j = 0; j < 4; ++j) { u1[2 * j] = bf_lo(c[j]) * bf_lo(hh[j]); u1[2 * j + 1] = bf_hi(c[j]) * bf_hi(hh[j]); } }
                        else if (smp) { const float* sp = args.in[4] + ((size_t)(l * 16 + b) * 2 + 1) * 256 + c8;
#pragma unroll
                          for (int j = 0; j < 8; ++j) u1[j] = sp[j]; }
                        else {
#pragma unroll
                          for (int j = 0; j < 8; ++j) u1[j] = 0.f; }
                        if (t >= 2) { const u32x4 c = *(const u32x4*)(zr - 2 * ZLD + 2304 + c8), hh = *(const u32x4*)(zr - 2 * ZLD + 2560 + c8);
#pragma unroll
                          for (int j = 0; j < 4; ++j) { u2[2 * j] = bf_lo(c[j]) * bf_lo(hh[j]); u2[2 * j + 1] = bf_hi(c[j]) * bf_hi(hh[j]); } }
                        else if (smp) { const float* sp = args.in[4] + ((size_t)(l * 16 + b) * 2 + t) * 256 + c8;
#pragma unroll
                          for (int j = 0; j < 8; ++j) u2[j] = sp[j]; }
                        else {
#pragma unroll
                          for (int j = 0; j < 8; ++j) u2[j] = 0.f; }
                        const u32x4 bb = *(const u32x4*)(zr + 2048 + c8), bg = *(const u32x4*)(zr + 2816 + c8);
                        float y[8];
#pragma unroll
                        for (int j = 0; j < 4; ++j) {
                            y[2 * j] = bf_lo(bb[j]) * (u2[2 * j] * w0[2 * j] + u1[2 * j] * w1[2 * j] + u0[2 * j] * w2[2 * j]) * bf_lo(bg[j]);
                            y[2 * j + 1] = bf_hi(bb[j]) * (u2[2 * j + 1] * w0[2 * j + 1] + u1[2 * j + 1] * w1[2 * j + 1] + u0[2 * j + 1] * w2[2 * j + 1]) * bf_hi(bg[j]); }
                        *(u32x4*)(YMIX + (size_t)row * 1024 + 512 + c8) = (u32x4){cvtpk(y[0], y[1]), cvtpk(y[2], y[3]), cvtpk(y[4], y[5]), cvtpk(y[6], y[7])};
                        float* so = nullptr;
                        if (!smp && row >= NPROMPT - 2) so = out + O_CONVP + (size_t)l * 512 + (size_t)(row - (NPROMPT - 2)) * 256 + c8;
                        if (smp && t >= 14) so = out + O_CONVS + (size_t)l * 8192 + (size_t)b * 512 + (size_t)(t - 14) * 256 + c8;
                        if (so) { *(f32x4*)so = (f32x4){u0[0], u0[1], u0[2], u0[3]}; *(f32x4*)(so + 4) = (f32x4){u0[4], u0[5], u0[6], u0[7]}; }
                    }
                }
                if (smp_unit || kind == 5) {
                    asm volatile("s_waitcnt vmcnt(0)" ::: "memory");
                    __syncthreads();
                    if (tid == 0) { __builtin_amdgcn_fence(__ATOMIC_RELEASE, "agent"); asm volatile("s_waitcnt vmcnt(0)" ::: "memory");
                        __hip_atomic_fetch_add(ctl + (kind == 5 ? CTL_SI : CTL_SM) + l, 1u, __ATOMIC_RELAXED, __HIP_MEMORY_SCOPE_AGENT); }
                }
            }
            }
        }
        grid.sync();
        {
            pg8::Gemm g{YMIX, WOUT + (size_t)l * 1024 * 1024, NPROMPT, 1024, 1024}; pg8::StaticOrder S; S.init(NPROMPT, 1024, G, bx);
            pg8::EpiOut E{ws, x_p, x_s, l, args.in[17], out};

#ifndef NO_GEMM2
            pg8::gemm_phase<pg8::EpiOut, pg8::StaticOrder, true, true>(lds, g, S, E);
#endif

            if (l == 1 && wave == 0 && bx < MROWS - NPROMPT) {
                int ln_ = threadIdx.x & 63; asm volatile("" : "+v"(ln_));
                const int lane = ln_;
                const int m = NPROMPT + bx; const float rs = __builtin_amdgcn_rsqf(SSQ2[m] * (1.0f / 1024.0f) + 1e-6f);
#pragma unroll
                for (int j = 0; j < 4; ++j) { const f32x4 v = *((const f32x4*)(X1 + (size_t)m * 1024) + lane + 64 * j); *((f32x4*)(out + O_Y + (size_t)m * 1024) + lane + 64 * j) = v * rs * *((const f32x4*)args.in[17] + lane + 64 * j); }
            }
        }
        if (l == 0) grid.sync();
    }
}

extern "C" void kernel_launch(void* const* d_in, const int* in_sizes, int n_in, void* d_out, int out_size, void* d_ws, size_t ws_size, hipStream_t stream) {
    static int grid_blocks = 0;
    if (!grid_blocks) {
        if (n_in != 18 || (size_t)out_size != O_END || ws_size < WS_END) { fprintf(stderr, "kernel_launch: unexpected shapes n_in %d out %d ws %zu\n", n_in, out_size, ws_size); grid_blocks = -1; return; }
        int dev = 0, cus = 0, per_cu = 0;
        hipGetDevice(&dev); hipDeviceGetAttribute(&cus, hipDeviceAttributeMultiprocessorCount, dev);
        hipFuncSetAttribute((const void*)fwd_megakernel, hipFuncAttributeMaxDynamicSharedMemorySize, LDS_BYTES);
        hipOccupancyMaxActiveBlocksPerMultiprocessor(&per_cu, (const void*)fwd_megakernel, 512, LDS_BYTES);
        if (per_cu < 1) { fprintf(stderr, "kernel_launch: occupancy query says %d blocks per CU\n", per_cu); per_cu = 1; }
        if (per_cu > 1) per_cu = 1;
        grid_blocks = cus * per_cu;
    }
    if (grid_blocks < 0) return;
    hipMemsetAsync((char*)d_ws + WS_CTL, 0, CTL_BYTES, stream);
    Args a{};
    for (int i = 0; i < 18; ++i) a.in[i] = (const float*)d_in[i];
    a.out = (float*)d_out; a.ws = (unsigned char*)d_ws;
    void* kargs[] = {&a};
    hipError_t e = hipLaunchCooperativeKernel((const void*)fwd_megakernel, dim3(grid_blocks), dim3(512), kargs, LDS_BYTES, stream);
    if (e != hipSuccess) fprintf(stderr, "cooperative launch failed: %s (grid %d)\n", hipGetErrorString(e), grid_blocks);
}
```

```cpp
#include <hip/hip_runtime.h>
#include <hip/hip_cooperative_groups.h>
#include <cstdio>
#include <cstdint>
namespace cg = cooperative_groups;
namespace pg8 {
#define PG8_LAS __attribute__((address_space(3)))
typedef unsigned short bf16_t;
typedef short bf16x8 __attribute__((ext_vector_type(8)));
typedef float f32x4 __attribute__((ext_vector_type(4)));
typedef unsigned u32x4 __attribute__((ext_vector_type(4)));
constexpr int BM = 256, BK = 64, HALF = 128, HTB = HALF * BK * 2  , STAGE_BYTES = 8 * HTB, NXCD = 8, WGM = 8;

__host__ __device__ __forceinline__ int lds_byte(int r, int c) { const int st = (r >> 4) * 2 + (c >> 5), rr = r & 15, cc = c & 31, ob = rr * 64 + cc * 2; return st * 1024 + (ob ^ (((ob >> 9) & 1) << 5)); }
__host__ __device__ __forceinline__ void stage_rc(int b, int& R, int& C) { const int st = b / 1024, sb = b % 1024, swz = sb ^ (((sb >> 9) & 1) << 5); R = (st >> 1) * 16 + swz / 64; C = (st & 1) * 32 + (swz % 64) / 2; }
__host__ __device__ __forceinline__ int perm32(int rho) { const int n = rho >> 4, i = rho & 15; return 8 * (i >> 2) + 4 * n + (i & 3); }

struct Unit { int pm, pn; };
struct Gemm { const bf16_t* A; const bf16_t* Bt; int M, N, K; };

struct StaticOrder {
    int nM, nN, nwg, G, c;
    __host__ __device__ void init(int M, int N, int G_, int c_) { nM = M / BM; nN = N / BM; nwg = nM * nN; G = G_; c = c_; }
    __host__ __device__ bool next(int i, Unit& u) const {
        const long L = (long)i * G + c; if (L >= nwg) return false;
        int wgid = (int)L; { const int q = nwg / NXCD, r = nwg % NXCD, xcd = wgid % NXCD, off = wgid / NXCD; wgid = (xcd < r ? xcd * (q + 1) : r * (q + 1) + (xcd - r) * q) + off; }
        const int nig = WGM * nN, gid = wgid / nig, fm = gid * WGM, gsz = (nM - fm) < WGM ? (nM - fm) : WGM;
        u.pm = fm + ((wgid % nig) % gsz); u.pn = (wgid % nig) / gsz; return true;
    }
    __device__ __forceinline__ void a_ready(const Unit&) const {}
    __device__ __forceinline__ void done(const Unit&) const {}
};
struct OneUnit {
    int pm, pn;
    __host__ __device__ bool next(int i, Unit& u) const { if (i) return false; u.pm = pm; u.pn = pn; return true; }
    __device__ __forceinline__ void a_ready(const Unit&) const {}
    __device__ __forceinline__ void done(const Unit&) const {}
};
__device__ __forceinline__ unsigned cvt_pk_bf16(float lo, float hi) { unsigned r; asm volatile("v_cvt_pk_bf16_f32 %0, %1, %2" : "=v"(r) : "v"(lo), "v"(hi)); return r; }
typedef float f32x2 __attribute__((ext_vector_type(2)));
constexpr float LOG2E = 1.4426950408889634f;
constexpr float SC_QA = 0.125f * LOG2E;
constexpr float SC_QC = 0.17677669529663687f * LOG2E;
constexpr int ZLD = 4096, MROWS = 16640, NPROMPT = 16384;
constexpr size_t WSO_MiB = 1u << 20;
constexpr size_t WSO_PANEL = 512 * 4  , WSO_CTL = 0, WSO_SSQ1 = 16384 * 4, WSO_SSQ2 = (16384 + 32768) * 4, WSO_SSQ0 = 1 * WSO_MiB, WSO_ROPE = 2 * WSO_MiB, WSO_WIN = 4 * WSO_MiB, WSO_WOUT = 20 * WSO_MiB, WSO_XB = 24 * WSO_MiB,
                 WSO_YMIX = 60 * WSO_MiB, WSO_X1 = 96 * WSO_MiB, WSO_Z = 164 * WSO_MiB, WSO_END = 296 * WSO_MiB;
constexpr size_t OO_Y = 0, OO_AKP = 17039360, OO_AVP = OO_AKP + 524288, OO_CONVP = OO_AVP + 524288, OO_CKP = OO_CONVP + 1024, OO_CVP = OO_CKP + 8388608,
                 OO_AKS = OO_CVP + 8388608, OO_AVS = OO_AKS + 262144, OO_CONVS = OO_AVS + 262144, OO_CKS = OO_CONVS + 16384, OO_CVS = OO_CKS + 131072, OO_END = OO_CVS + 131072;
__device__ __forceinline__ float silu_f(float x) { return x * __builtin_amdgcn_rcpf(1.0f + __builtin_amdgcn_exp2f(-x * LOG2E)); }
struct EpiIn {
    static constexpr bool PERM = true, AFTER_DRAIN = false;
    unsigned char* ws; float* out; int l;
    __device__ __forceinline__ void operator()(const f32x4 (&acc)[2][2][4][2], const Unit& u, int wr, int wc, int fr, int fq) const {
        const int pn = u.pn, pm = u.pm;
        bf16_t* Z = (bf16_t*)(ws + WSO_Z); const float* ssq = (const float*)(ws + (l == 0 ? WSO_SSQ0 : WSO_SSQ1)); const float* rope = (const float*)(ws + WSO_ROPE);
        float* o_ak_p = out + OO_AKP + (size_t)l * 262144; float* o_av_p = out + OO_AVP + (size_t)l * 262144; float* o_ak_s = out + OO_AKS + (size_t)l * 131072; float* o_av_s = out + OO_AVS + (size_t)l * 131072;
        float* o_ck_p = out + OO_CKP + (size_t)l * 4194304; float* o_cv_p = out + OO_CVP + (size_t)l * 4194304; float* o_ck_s = out + OO_CKS + (size_t)l * 65536; float* o_cv_s = out + OO_CVS + (size_t)l * 65536;
        const int rowl = wr * 64 + fr;
        const int colb = pn * BM + wc * 32 + 8 * fq;
        const bool rope_tile = (pn == 12 || pn == 13);
        const bool do_rope = rope_tile && fq == 0;
        const float sc = (pn < 2) ? SC_QA : (pn == 12 ? SC_QC : 1.f);
        const bool do_silu = (pn == 6 || pn == 7 || pn == 11 || pn == 15);
        float* ob = nullptr; int old = 0, ocol0 = 0;
        if (pn >= 2 && pn <= 5) { old = 512; ocol0 = (pn >= 4) ? 1024 : 512;
            if (pm == 64) ob = (pn >= 4) ? o_av_s : o_ak_s; else if (pm >= 62) ob = ((pn >= 4) ? o_av_p : o_ak_p) + (size_t)(pm - 62) * 256 * 512; }
        else if (pn == 13 || pn == 14) { old = 256; ocol0 = (pn == 13) ? 3328 : 3584;
            if (pm == 64) ob = (pn == 13) ? o_ck_s : o_cv_s; else ob = ((pn == 13) ? o_ck_p : o_cv_p) + (size_t)pm * 256 * 256; }
#pragma unroll
        for (int ai = 0; ai < 2; ++ai)
#pragma unroll
            for (int m = 0; m < 4; ++m) {
                const int rl = rowl + ai * HALF + m * 16, row = pm * BM + rl;
                const float rs = __builtin_amdgcn_rsqf(ssq[row] * (1.0f / 1024.0f) + 1e-6f);
                f32x4 rc = {1.f, 1.f, 1.f, 1.f}, rsn = {0.f, 0.f, 0.f, 0.f};
                if (do_rope) { rc = *(const f32x4*)(rope + (size_t)row * 8); rsn = *(const f32x4*)(rope + (size_t)row * 8 + 4); }
#pragma unroll
                for (int bj = 0; bj < 2; ++bj) {
                    f32x4 v0 = acc[ai][bj][m][0] * rs, v1 = acc[ai][bj][m][1] * rs;
                    const int col = colb + bj * HALF;
                    if (rope_tile) { const f32x4 a = v0 * rc - v1 * rsn, b = v1 * rc + v0 * rsn; v0 = a; v1 = b; }
                    if (ob) { float* op = ob + (size_t)rl * old + (col - ocol0); *(f32x4*)op = v0; *(f32x4*)(op + 4) = v1; }
                    if (do_silu) { v0 = (f32x4){silu_f(v0[0]), silu_f(v0[1]), silu_f(v0[2]), silu_f(v0[3])}; v1 = (f32x4){silu_f(v1[0]), silu_f(v1[1]), silu_f(v1[2]), silu_f(v1[3])}; }
                    v0 = v0 * sc; v1 = v1 * sc;
                    u32x4 w; w.x = cvt_pk_bf16(v0[0], v0[1]); w.y = cvt_pk_bf16(v0[2], v0[3]); w.z = cvt_pk_bf16(v1[0], v1[1]); w.w = cvt_pk_bf16(v1[2], v1[3]);
                    *(u32x4*)(Z + (size_t)row * ZLD + col) = w;
                }
                asm volatile("" ::: "memory");
            }
    }
};
struct EpiOut {
    static constexpr bool PERM = true, AFTER_DRAIN = false;
    unsigned char* ws; const float* x_p; const float* x_s; int l; const float* fg; float* yout;
    __device__ __forceinline__ void operator()(f32x4 (&acc)[2][2][4][2], const Unit& u, int wr, int wc, int fr, int fq) const {
        const int pm = u.pm; const int colb = u.pn * BM + wc * 32 + 8 * fq;
        float* X1 = (float*)(ws + WSO_X1) + (size_t)pm * BM * 1024; bf16_t* XB = (bf16_t*)(ws + WSO_XB) + (size_t)pm * BM * 1024; float* ssq = (float*)(ws + (l == 0 ? WSO_SSQ1 : WSO_SSQ2)) + pm * BM;
        const float* res = (l == 0) ? ((pm == 64) ? x_s : x_p + (size_t)pm * BM * 1024) : X1;
        const unsigned off0 = (unsigned)(wr * 64 + fr) * 1024u + (unsigned)colb;
        const bool fuse = (l == 1 && pm < 64);
#pragma unroll
        for (int ai = 0; ai < 2; ++ai)
#pragma unroll
            for (int m = 0; m < 4; ++m) {
                const unsigned offr = off0 + (unsigned)(ai * HALF + m * 16) * 1024u; float q = 0.f;
#pragma unroll
                for (int bj = 0; bj < 2; ++bj) { const unsigned off = offr + bj * HALF;
                    const f32x4 v0 = acc[ai][bj][m][0] + *(const f32x4*)(res + off), v1 = acc[ai][bj][m][1] + *(const f32x4*)(res + off + 4);
                    if (fuse) { acc[ai][bj][m][0] = v0; acc[ai][bj][m][1] = v1; }
                    else {
                        *(f32x4*)(X1 + off) = v0; *(f32x4*)(X1 + off + 4) = v1;
                        u32x4 w; w.x = cvt_pk_bf16(v0[0], v0[1]); w.y = cvt_pk_bf16(v0[2], v0[3]); w.z = cvt_pk_bf16(v1[0], v1[1]); w.w = cvt_pk_bf16(v1[2], v1[3]);
                        *(u32x4*)(XB + off) = w; }
                    q += (v0[0] * v0[0] + v0[1] * v0[1]) + (v0[2] * v0[2] + v0[3] * v0[3]) + (v1[0] * v1[0] + v1[1] * v1[1]) + (v1[2] * v1[2] + v1[3] * v1[3]);
                    asm volatile("" ::: "memory"); }
                q += __shfl_xor(q, 16); q += __shfl_xor(q, 32);
                if (fq == 0) atomicAdd(ssq + (wr * 64 + fr + ai * HALF + m * 16), q);
                asm volatile("" ::: "memory");
            }
        if (fuse) {
            unsigned* cnt = (unsigned*)(ws + WSO_PANEL) + 64 * pm;
            asm volatile("s_waitcnt vmcnt(0)" ::: "memory");
            if (__builtin_amdgcn_readfirstlane(fr + 16 * fq) == (fr + 16 * fq)) __hip_atomic_fetch_add(cnt, 1u, __ATOMIC_RELAXED, __HIP_MEMORY_SCOPE_AGENT);
            unsigned spins = 0;
            while (__hip_atomic_load(cnt, __ATOMIC_RELAXED, __HIP_MEMORY_SCOPE_AGENT) < 32u) { __builtin_amdgcn_s_sleep(2); if (++spins > (1u << 22)) break; }
            float* yo = yout + (size_t)pm * BM * 1024;
#pragma unroll
            for (int ai = 0; ai < 2; ++ai)
#pragma unroll
                for (int m = 0; m < 4; ++m) {
                    const int rl = wr * 64 + fr + ai * HALF + m * 16;
                    const float sq = __hip_atomic_load(ssq + rl, __ATOMIC_RELAXED, __HIP_MEMORY_SCOPE_AGENT);
                    const float rs = __builtin_amdgcn_rsqf(sq * (1.0f / 1024.0f) + 1e-6f);
                    const unsigned offr = off0 + (unsigned)(ai * HALF + m * 16) * 1024u;
#pragma unroll
                    for (int bj = 0; bj < 2; ++bj) {
                        const f32x4 g0 = *(const f32x4*)(fg + colb + bj * HALF), g1 = *(const f32x4*)(fg + colb + bj * HALF + 4);
                        *(f32x4*)(yo + offr + bj * HALF) = acc[ai][bj][m][0] * rs * g0; *(f32x4*)(yo + offr + bj * HALF + 4) = acc[ai][bj][m][1] * rs * g1;
                        asm volatile("" ::: "memory"); }
                }
        }
    }
};
template <class Epi, class Sched, bool ALIGN_EPI = false, bool SP2 = false>
__device__ __forceinline__ void gemm_phase(PG8_LAS unsigned char* lds, const Gemm g, const Sched& S, const Epi& E) {
    int tid_ = threadIdx.x; asm volatile("" : "+v"(tid_));
    const int tid = tid_, wid = __builtin_amdgcn_readfirstlane(tid >> 6), lane = tid & 63, wr = wid >> 2, wc = wid & 3, fr = lane & 15, fq = lane >> 4;
    const int K = g.K, nt = K / BK;
    unsigned voffA[2], voffB[2];
#pragma unroll
    for (int i = 0; i < 2; ++i) { int R, C; stage_rc(tid * 16 + i * 8192, R, C); const int Rb = Epi::PERM ? ((R & ~31) + perm32(R & 31)) : R;
        voffA[i] = (unsigned)(R * K + C) * 2u; voffB[i] = (unsigned)(Rb * K + C) * 2u; }
    const size_t kstep = (size_t)(BK * 2);
    const size_t hstep = (size_t)HALF * K * 2;
    const size_t tstep = 2 * hstep;
    const unsigned ldsw = (unsigned)wid * 1024u;
    const int aoff = lds_byte(wr * 64 + fr, fq * 8), boff = lds_byte(wc * 32 + fr, fq * 8);
#define PG8_SA(b, h) (((b) * 2 + (h)) * HTB)
#define PG8_SB(b, h) ((4 + (b) * 2 + (h)) * HTB)
#define PG8_STAGE(bufoff, gbase, voff) do { _Pragma("unroll") for (int _i = 0; _i < 2; ++_i) \
        __builtin_amdgcn_global_load_lds((const unsigned*)((const char*)(gbase) + (voff)[_i]), (PG8_LAS unsigned*)(lds + (bufoff) + ldsw + _i * 8192), 16, 0, 0); } while (0)
#define PG8_LDA(dst, b, h) do { _Pragma("unroll") for (int m = 0; m < 4; ++m) _Pragma("unroll") for (int k = 0; k < 2; ++k) dst[m][k] = *(const PG8_LAS bf16x8*)(lds + PG8_SA(b, h) + aoff + m * 2048 + k * 1024); } while (0)
#define PG8_LDB(dst, b, h) do { _Pragma("unroll") for (int n = 0; n < 2; ++n) _Pragma("unroll") for (int k = 0; k < 2; ++k) dst[n][k] = *(const PG8_LAS bf16x8*)(lds + PG8_SB(b, h) + boff + n * 2048 + k * 1024); } while (0)
#define PG8_MMA(ai, bj, At, Bt) do { __builtin_amdgcn_s_setprio(1); _Pragma("unroll") for (int m = 0; m < 4; ++m) _Pragma("unroll") for (int n = 0; n < 2; ++n) _Pragma("unroll") for (int k = 0; k < 2; ++k) \
        acc[ai][bj][m][n] = __builtin_amdgcn_mfma_f32_16x16x32_bf16(Bt[n][k], At[m][k], acc[ai][bj][m][n], 0, 0, 0); __builtin_amdgcn_s_setprio(0); } while (0)
#define PG8_WAIT_V(n) asm volatile("s_waitcnt vmcnt(" #n ")" ::: "memory")
#define PG8_WAIT_L(n) asm volatile("s_waitcnt lgkmcnt(" #n ")" ::: "memory")
#define PG8_BAR __builtin_amdgcn_s_barrier()
#define PG8_SCHED __builtin_amdgcn_sched_barrier(0)
    Unit cur, nxt; int ui = 0;
    if (!S.next(0, cur)) return;
    f32x4 acc[2][2][4][2];
#pragma unroll
    for (int a = 0; a < 2; ++a)
#pragma unroll
        for (int b = 0; b < 2; ++b)
#pragma unroll
            for (int m = 0; m < 4; ++m)
#pragma unroll
                for (int n = 0; n < 2; ++n) acc[a][b][m][n] = (f32x4){0.f, 0.f, 0.f, 0.f};
    bf16x8 At[4][2], B0[2][2], B1[2][2];
    const char* cA = (const char*)g.A + (size_t)cur.pm * tstep; const char* cB = (const char*)g.Bt + (size_t)cur.pn * tstep;
    S.a_ready(cur);
    if constexpr (SP2) {
        PG8_STAGE(PG8_SB(0, 0), cB, voffB); PG8_STAGE(PG8_SB(0, 1), cB + hstep, voffB); PG8_STAGE(PG8_SA(0, 0), cA, voffA); PG8_STAGE(PG8_SA(0, 1), cA + hstep, voffA);
        if (wr == 1) PG8_BAR;
        PG8_WAIT_V(2); PG8_BAR;
        PG8_STAGE(PG8_SB(1, 0), cB + kstep, voffB); PG8_STAGE(PG8_SA(1, 0), cA + kstep, voffA); PG8_STAGE(PG8_SB(1, 1), cB + hstep + kstep, voffB);
        PG8_WAIT_V(6); PG8_BAR;
    } else {
        PG8_STAGE(PG8_SB(0, 0), cB, voffB); PG8_STAGE(PG8_SA(0, 0), cA, voffA); PG8_STAGE(PG8_SB(0, 1), cB + hstep, voffB); PG8_STAGE(PG8_SA(0, 1), cA + hstep, voffA);
        if (wr == 1) PG8_BAR;
        PG8_WAIT_V(4); PG8_BAR;
        PG8_STAGE(PG8_SB(1, 0), cB + kstep, voffB); PG8_STAGE(PG8_SA(1, 0), cA + kstep, voffA); PG8_STAGE(PG8_SB(1, 1), cB + hstep + kstep, voffB);
        PG8_WAIT_V(6); PG8_BAR;
    }
    for (;;) {
        const bool has_next = S.next(ui + 1, nxt);
        const char* nA = has_next ? (const char*)g.A + (size_t)nxt.pm * tstep : cA; const char* nB = has_next ? (const char*)g.Bt + (size_t)nxt.pn * tstep : cB;
        for (int t = 0; t < nt; t += 2) {
            const bool last = (t == nt - 2);
            const char* a1 = cA + (size_t)(t + 1) * kstep;
            const char* a2 = last ? nA : cA + (size_t)(t + 2) * kstep; const char* b2 = last ? nB : cB + (size_t)(t + 2) * kstep;
            const char* a3 = a2 + kstep; const char* b3 = b2 + kstep;
            if (last && has_next) S.a_ready(nxt);
            if constexpr (SP2) {
            PG8_LDB(B0, 0, 0); PG8_LDB(B1, 0, 1); PG8_SCHED; PG8_LDA(At, 0, 0); PG8_STAGE(PG8_SA(1, 1), a1 + hstep, voffA);
            PG8_WAIT_V(8); PG8_WAIT_L(0); PG8_BAR; PG8_MMA(0, 0, At, B0); PG8_MMA(0, 1, At, B1); PG8_BAR; PG8_SCHED;
            PG8_LDA(At, 0, 1); PG8_STAGE(PG8_SB(0, 0), b2, voffB); PG8_STAGE(PG8_SB(0, 1), b2 + hstep, voffB); PG8_STAGE(PG8_SA(0, 0), a2, voffA);
            PG8_WAIT_V(8); PG8_WAIT_L(0); PG8_BAR; PG8_MMA(1, 0, At, B0); PG8_MMA(1, 1, At, B1); PG8_BAR; PG8_SCHED;
            PG8_LDB(B0, 1, 0); PG8_LDB(B1, 1, 1); PG8_SCHED; PG8_LDA(At, 1, 0); PG8_STAGE(PG8_SA(0, 1), a2 + hstep, voffA);
            PG8_WAIT_V(8); PG8_WAIT_L(0); PG8_BAR; PG8_MMA(0, 0, At, B0); PG8_MMA(0, 1, At, B1); PG8_BAR; PG8_SCHED;
            PG8_LDA(At, 1, 1); PG8_STAGE(PG8_SB(1, 0), b3, voffB); PG8_STAGE(PG8_SB(1, 1), b3 + hstep, voffB); PG8_STAGE(PG8_SA(1, 0), a3, voffA);
            PG8_WAIT_V(8); PG8_WAIT_L(0); PG8_BAR; PG8_MMA(1, 0, At, B0); PG8_MMA(1, 1, At, B1); PG8_BAR; PG8_SCHED;
            } else {
            PG8_LDB(B0, 0, 0); PG8_SCHED; PG8_LDA(At, 0, 0); PG8_STAGE(PG8_SA(1, 1), a1 + hstep, voffA);
            PG8_WAIT_L(8); PG8_BAR; PG8_WAIT_L(0); PG8_MMA(0, 0, At, B0); PG8_BAR; PG8_SCHED;
            PG8_LDB(B1, 0, 1); PG8_STAGE(PG8_SB(0, 0), b2, voffB);
            PG8_BAR; PG8_WAIT_L(0); PG8_MMA(0, 1, At, B1); PG8_BAR;
            PG8_LDA(At, 0, 1); PG8_STAGE(PG8_SA(0, 0), a2, voffA);
            PG8_BAR; PG8_WAIT_L(0); PG8_MMA(1, 0, At, B0); PG8_BAR; PG8_SCHED;
            PG8_STAGE(PG8_SB(0, 1), b2 + hstep, voffB);
            PG8_WAIT_V(6); PG8_BAR; PG8_MMA(1, 1, At, B1); PG8_BAR;
            PG8_LDB(B0, 1, 0); PG8_SCHED; PG8_LDA(At, 1, 0); PG8_STAGE(PG8_SA(0, 1), a2 + hstep, voffA);
            PG8_WAIT_L(8); PG8_BAR; PG8_WAIT_L(0); PG8_MMA(0, 0, At, B0); PG8_BAR; PG8_SCHED;
            PG8_LDB(B1, 1, 1); PG8_STAGE(PG8_SB(1, 0), b3, voffB);
            PG8_BAR; PG8_WAIT_L(0); PG8_MMA(0, 1, At, B1); PG8_BAR;
            PG8_LDA(At, 1, 1); PG8_STAGE(PG8_SA(1, 0), a3, voffA);
            PG8_BAR; PG8_WAIT_L(0); PG8_MMA(1, 0, At, B0); PG8_BAR; PG8_SCHED;
            PG8_STAGE(PG8_SB(1, 1), b3 + hstep, voffB);
            PG8_WAIT_V(6); PG8_BAR; PG8_MMA(1, 1, At, B1); PG8_BAR;
            }
        }
        if constexpr (ALIGN_EPI) { if (wr == 0) PG8_BAR; }
        if constexpr (!Epi::AFTER_DRAIN) { E(acc, cur, wr, wc, fr, fq); S.done(cur); }
        if (!has_next) break;
#pragma unroll
        for (int a = 0; a < 2; ++a)
#pragma unroll
            for (int b = 0; b < 2; ++b)
#pragma unroll
                for (int m = 0; m < 4; ++m)
#pragma unroll
                    for (int n = 0; n < 2; ++n) acc[a][b][m][n] = (f32x4){0.f, 0.f, 0.f, 0.f};
        cur = nxt; cA = nA; cB = nB; ++ui;
        if constexpr (ALIGN_EPI) { if (wr == 1) PG8_BAR; }
    }
    PG8_WAIT_V(0);
    if constexpr (!ALIGN_EPI) { if (wr == 0) PG8_BAR; }
    PG8_BAR;
    if constexpr (Epi::AFTER_DRAIN) { E.fused(acc, cur, wr, wc, fr, fq, lds, wid, lane); S.done(cur); }
#undef PG8_SA
#undef PG8_SB
#undef PG8_STAGE
#undef PG8_LDA
#undef PG8_LDB
#undef PG8_MMA
#undef PG8_WAIT_V
#undef PG8_WAIT_L
#undef PG8_BAR
#undef PG8_SCHED
}
}
#define LAS __attribute__((address_space(3)))
typedef unsigned short bf16_t;
typedef LAS unsigned char* ldsp;
typedef short bf16x8 __attribute__((ext_vector_type(8)));
typedef short s16x4 __attribute__((ext_vector_type(4)));
typedef float f32x16 __attribute__((ext_vector_type(16)));
typedef float f32x4 __attribute__((ext_vector_type(4)));
typedef float f32x2 __attribute__((ext_vector_type(2)));
typedef unsigned u32x4 __attribute__((ext_vector_type(4)));
typedef unsigned u32x2 __attribute__((ext_vector_type(2)));
typedef __bf16 bf16x2_t __attribute__((ext_vector_type(2)));
using pg8::ZLD; using pg8::MROWS; using pg8::NPROMPT; using pg8::LOG2E;
__device__ __forceinline__ int crow(int r, int hi) { return (r & 3) + 8 * (r >> 2) + 4 * hi; }
__device__ __forceinline__ unsigned cvtpk(float lo, float hi) { f32x2 v = {lo, hi}; bf16x2_t b = __builtin_convertvector(v, bf16x2_t); return __builtin_bit_cast(unsigned, b); }
__device__ __forceinline__ float bf_lo(unsigned w) { return __uint_as_float(w << 16); }
__device__ __forceinline__ float bf_hi(unsigned w) { return __uint_as_float(w & 0xffff0000u); }
__device__ __forceinline__ float xhalf_max(float m) { auto rr = __builtin_amdgcn_permlane32_swap(__float_as_uint(m), __float_as_uint(m), false, false); return fmaxf(__uint_as_float(rr[0]), __uint_as_float(rr[1])); }
__device__ __forceinline__ float xhalf_sum(float m) { auto rr = __builtin_amdgcn_permlane32_swap(__float_as_uint(m), __float_as_uint(m), false, false); return __uint_as_float(rr[0]) + __uint_as_float(rr[1]); }
__device__ __forceinline__ s16x4 vtr(ldsp p) { typedef short v4i16_t __attribute__((ext_vector_type(4))); return __builtin_bit_cast(s16x4, __builtin_amdgcn_ds_read_tr16_b64_v4i16((LAS v4i16_t*)p)); }
__device__ __forceinline__ float max3f(float a, float b, float c) { float r; asm("v_max3_f32 %0, %1, %2, %3" : "=v"(r) : "v"(a), "v"(b), "v"(c)); return r; }
__device__ __forceinline__ float max2f(float a, float b) { float r; asm("v_max_f32_e32 %0, %1, %2" : "=v"(r) : "v"(a), "v"(b)); return r; }
__device__ __forceinline__ float sum8_s(float acc, float a, float b, float c, float d, float e, float f, float g, float h) {
    asm("s_nop 0\n\tv_add_f32_e32 %0, %0, %1\n\tv_add_f32_e32 %0, %0, %2\n\tv_add_f32_e32 %0, %0, %3\n\tv_add_f32_e32 %0, %0, %4\n\tv_add_f32_e32 %0, %0, %5\n\tv_add_f32_e32 %0, %0, %6\n\tv_add_f32_e32 %0, %0, %7\n\tv_add_f32_e32 %0, %0, %8"
        : "+v"(acc) : "v"(a), "v"(b), "v"(c), "v"(d), "v"(e), "v"(f), "v"(g), "v"(h));
    return acc; }
__device__ __forceinline__ float fadd_s(float a, float b) { float r; asm("v_add_f32_e32 %0, %1, %2" : "=v"(r) : "v"(a), "v"(b)); return r; }
#define MFMA32(a, b, c) __builtin_amdgcn_mfma_f32_32x32x16_bf16((a), (b), (c), 0, 0, 0)

constexpr int KPITCH = 144, KT_BYTES = 64 * KPITCH, VT_BYTES = 8192, TILE_BYTES = KT_BYTES + VT_BYTES, BUF_BYTES = 2 * TILE_BYTES;
constexpr int COMB_OFF = 2 * BUF_BYTES, COMB_WAVE = 17408, TAB_OFF = COMB_OFF + 4 * COMB_WAVE, MISC_OFF = TAB_OFF + 1040, LDS_BYTES = 147456;
static_assert(MISC_OFF + 64 <= LDS_BYTES, "LDS map");
constexpr float NEG_BIG = -1.0e30f, THR = 8.0f;
struct AU {
    const bf16_t* q; int nq; int nt, ntc; const float* kc; const float* vc; int cp; const bf16_t* kz; const bf16_t* vz; int lastv; int nqg;
    int tlo0, thi0, tlo1, thi1; int qpos0, kpos0; const bf16_t* gate; bf16_t* y;
};
#ifndef ATTN_INL
#define ATTN_INL __forceinline__
#endif
template <int MODE  >
__device__ ATTN_INL void attn_unit(const AU& d, ldsp lds, float lam, float oml, const float* subg) {
    constexpr int NMAP = MODE == 0 ? 2 : 1, NSTEP = MODE == 0 ? 2 : 4;
    int tid_ = threadIdx.x; asm volatile("" : "+v"(tid_));
    const int tid = tid_, lane = tid & 63, wid = __builtin_amdgcn_readfirstlane(tid >> 6), qg = wid & 3, ks = wid >> 2, r32 = lane & 31, hi = lane >> 5;
    const int tlo = (qg >> 1) ? d.tlo1 : d.tlo0; int thi = (qg >> 1) ? d.thi1 : d.thi0; if (qg >= d.nqg) thi = -1;
    const LAS float* tab = (const LAS float*)(lds + TAB_OFF);
    bf16x8 qf[NMAP][NSTEP];
    { int qrow = 32 * qg + r32; if (qrow >= d.nq) qrow = d.nq - 1;
      const bf16_t* qp = d.q + (size_t)qrow * ZLD;
#pragma unroll
      for (int mp = 0; mp < NMAP; ++mp)
#pragma unroll
          for (int st = 0; st < NSTEP; ++st) qf[mp][st] = *(const bf16x8*)(qp + mp * 32 + st * 16 + hi * 8); }
    f32x16 O[NMAP][2]; float mref[NMAP], lsum[NMAP];
#pragma unroll
    for (int mp = 0; mp < NMAP; ++mp) { mref[mp] = 0.f; lsum[mp] = 0.f;
#pragma unroll
        for (int db = 0; db < 2; ++db)
#pragma unroll
            for (int i = 0; i < 16; ++i) O[mp][db][i] = 0.f; }
    const int lrow = tid >> 3, lch = tid & 7;
    const int kwoff = lrow * KPITCH + lch * 16, vwoff = (lch >> 2) * 4096 + lrow * 64 + (lch & 3) * 16;
    const int kroff = r32 * KPITCH + hi * 16;
    const int vroff = (4 * hi + ((lane & 15) >> 2)) * 64 + ((lane >> 4) & 1) * 32 + (lane & 3) * 8;
    u32x4 stK[2], stV[2];
    const int nit = (d.nt + 1) >> 1; bool started = false;
#define AT_ISSUE(IT) do { _Pragma("unroll") for (int i_ = 0; i_ < 2; ++i_) { const int t_ = 2 * (IT) + i_; if (t_ < d.nt && t_ >= d.ntc) { int r_ = lrow; if (t_ == d.nt - 1 && r_ >= d.lastv) r_ = d.lastv - 1; \
        const size_t off_ = ((size_t)(t_ - d.ntc) * 64 + r_) * ZLD + lch * 8; stK[i_] = *(const u32x4*)(d.kz + off_); stV[i_] = *(const u32x4*)(d.vz + off_); } } } while (0)
#define AT_WRITE(IT, BUF) do { _Pragma("unroll") for (int i_ = 0; i_ < 2; ++i_) { const int t_ = 2 * (IT) + i_; if (t_ < d.nt) { u32x4 kk_, vv_; if (t_ >= d.ntc) { kk_ = stK[i_]; vv_ = stV[i_]; } else { \
        const size_t off_ = ((size_t)t_ * 64 + lrow) * d.cp + lch * 8; const f32x4 a_ = *(const f32x4*)(d.kc + off_), b_ = *(const f32x4*)(d.kc + off_ + 4), c_ = *(const f32x4*)(d.vc + off_), e_ = *(const f32x4*)(d.vc + off_ + 4); \
        kk_ = (u32x4){cvtpk(a_[0], a_[1]), cvtpk(a_[2], a_[3]), cvtpk(b_[0], b_[1]), cvtpk(b_[2], b_[3])}; vv_ = (u32x4){cvtpk(c_[0], c_[1]), cvtpk(c_[2], c_[3]), cvtpk(e_[0], e_[1]), cvtpk(e_[2], e_[3])}; } \
        *(LAS u32x4*)((BUF) + i_ * TILE_BYTES + kwoff) = kk_; *(LAS u32x4*)((BUF) + i_ * TILE_BYTES + KT_BYTES + vwoff) = vv_; } } } while (0)
    AT_ISSUE(0);
    for (int it = 0; it < nit; ++it) {
        const ldsp buf = lds + (it & 1) * BUF_BYTES;
        AT_WRITE(it, buf);
        __builtin_amdgcn_s_waitcnt(0);
        __syncthreads();
        if (it + 1 < nit) AT_ISSUE(it + 1);
        const int t = 2 * it + ks;
        if (t >= tlo && t <= thi) {
            const ldsp Kt = buf + ks * TILE_BYTES, Vt = Kt + KT_BYTES;
            const int valid = (t == d.nt - 1) ? d.lastv : 64;
            f32x16 S0[NMAP], S1[NMAP];
#define AT_QK(MP) do { f32x16 negm_; _Pragma("unroll") for (int i = 0; i < 16; ++i) negm_[i] = -mref[MP]; \
                _Pragma("unroll") for (int st = 0; st < NSTEP; ++st) { \
                    const bf16x8 a0_ = *(const LAS bf16x8*)(Kt + kroff + ((MP) * 32 + st * 16) * 2); \
                    const bf16x8 a1_ = *(const LAS bf16x8*)(Kt + kroff + 32 * KPITCH + ((MP) * 32 + st * 16) * 2); \
                    if (st == 0) { S0[MP] = MFMA32(a0_, qf[MP][st], negm_); S1[MP] = MFMA32(a1_, qf[MP][st], negm_); } \
                    else { S0[MP] = MFMA32(a0_, qf[MP][st], S0[MP]); S1[MP] = MFMA32(a1_, qf[MP][st], S1[MP]); } } \
                if (MODE == 1) { const int qpos = d.qpos0 + 32 * qg + r32, kp0 = d.kpos0 + 64 * t; \
                    if (d.qpos0 + 32 * qg - (kp0 + 63) >= 128) { const float c = tab[256]; _Pragma("unroll") for (int i = 0; i < 16; ++i) { S0[MP][i] += c; S1[MP][i] += c; } } \
                    else { _Pragma("unroll") for (int i = 0; i < 16; ++i) { int dd = qpos - (kp0 + crow(i, hi)); int d0 = min(max(dd, -128), 128), d1 = min(max(dd - 32, -128), 128); S0[MP][i] += tab[d0 + 128]; S1[MP][i] += tab[d1 + 128]; } } } \
                if (valid < 64) { _Pragma("unroll") for (int i = 0; i < 16; ++i) { const int k = crow(i, hi); if (k >= valid) S0[MP][i] = NEG_BIG; if (k + 32 >= valid) S1[MP][i] = NEG_BIG; } } } while (0)
            AT_QK(0);
            if (NMAP == 2) AT_QK(NMAP - 1);
#pragma unroll
            for (int mp = 0; mp < NMAP; ++mp) {
                f32x16& s0 = S0[mp]; f32x16& s1 = S1[mp];
                float sa, sb;
#pragma nounroll
                for (int pass = 0;; ++pass) {
                    const bool do_max = !started || pass == 1;
                    if (pass == 1) AT_QK(mp);
                    if (do_max) {
                        asm volatile("s_nop 15\n\ts_nop 7" : "+v"(s0), "+v"(s1));
                        float ra = max3f(s0[0], s0[1], s1[0]), rb = max3f(s0[2], s0[3], s1[1]); ra = max3f(ra, s1[2], s1[3]);
#pragma unroll
                        for (int i = 4; i < 16; i += 4) { ra = max3f(ra, s0[i], s0[i + 1]); rb = max3f(rb, s0[i + 2], s0[i + 3]); ra = max3f(ra, s1[i], s1[i + 1]); rb = max3f(rb, s1[i + 2], s1[i + 3]); }
                        const float rm = xhalf_max(max2f(ra, rb));
                        const float dl = started ? fmaxf(rm, 0.f) : rm, al = started ? __builtin_amdgcn_exp2f(-dl) : 1.f;
                        mref[mp] += dl; lsum[mp] *= al;
#pragma unroll
                        for (int i = 0; i < 16; ++i) { s0[i] -= dl; s1[i] -= dl; }
#pragma unroll
                        for (int db = 0; db < 2; ++db)
#pragma unroll
                            for (int i = 0; i < 16; ++i) O[mp][db][i] *= al;
                    }
                    sa = 0.f; sb = 0.f;
#pragma unroll
                    for (int i = 0; i < 16; ++i) { s0[i] = __builtin_amdgcn_exp2f(s0[i]); s1[i] = __builtin_amdgcn_exp2f(s1[i]); }
#pragma unroll
                    for (int i = 0; i < 16; i += 8) { sa = sum8_s(sa, s0[i], s0[i + 1], s0[i + 2], s0[i + 3], s0[i + 4], s0[i + 5], s0[i + 6], s0[i + 7]); sb = sum8_s(sb, s1[i], s1[i + 1], s1[i + 2], s1[i + 3], s1[i + 4], s1[i + 5], s1[i + 6], s1[i + 7]); }
                    if (do_max || !__any(!(sa + sb <= 256.0f))) break;
                }
                lsum[mp] += sa + sb;
                s16x4 va[8], vb[8];
#pragma unroll
                for (int k4 = 0; k4 < 4; ++k4) { va[2 * k4] = vtr(Vt + vroff + k4 * 1024); va[2 * k4 + 1] = vtr(Vt + vroff + k4 * 1024 + 512); }
                __builtin_amdgcn_sched_barrier(0);
                bf16x8 Pf[4];
#pragma unroll
                for (int s = 0; s < 2; ++s) {
                    u32x4 w0 = {cvtpk(s0[8 * s], s0[8 * s + 1]), cvtpk(s0[8 * s + 2], s0[8 * s + 3]), cvtpk(s0[8 * s + 4], s0[8 * s + 5]), cvtpk(s0[8 * s + 6], s0[8 * s + 7])};
                    u32x4 w1 = {cvtpk(s1[8 * s], s1[8 * s + 1]), cvtpk(s1[8 * s + 2], s1[8 * s + 3]), cvtpk(s1[8 * s + 4], s1[8 * s + 5]), cvtpk(s1[8 * s + 6], s1[8 * s + 7])};
                    Pf[s] = __builtin_bit_cast(bf16x8, w0); Pf[2 + s] = __builtin_bit_cast(bf16x8, w1);
                }
                __builtin_amdgcn_sched_barrier(0);
#pragma unroll
                for (int k4 = 0; k4 < 4; ++k4) { vb[2 * k4] = vtr(Vt + vroff + 4096 + k4 * 1024); vb[2 * k4 + 1] = vtr(Vt + vroff + 4096 + k4 * 1024 + 512); }
#pragma unroll
                for (int k4 = 0; k4 < 4; ++k4) {
                    const s16x4 lo = va[2 * k4], hh = va[2 * k4 + 1];
                    const bf16x8 vf = {lo[0], lo[1], lo[2], lo[3], hh[0], hh[1], hh[2], hh[3]};
                    O[mp][0] = MFMA32(vf, Pf[k4], O[mp][0]);
                }
                __builtin_amdgcn_sched_barrier(0);
#pragma unroll
                for (int k4 = 0; k4 < 4; ++k4) {
                    const s16x4 lo = vb[2 * k4], hh = vb[2 * k4 + 1];
                    const bf16x8 vf = {lo[0], lo[1], lo[2], lo[3], hh[0], hh[1], hh[2], hh[3]};
                    O[mp][1] = MFMA32(vf, Pf[k4], O[mp][1]);
                }
            }
            started = true;
#undef AT_QK
        }
    }
#undef AT_ISSUE
#undef AT_WRITE
    __syncthreads();
    if (!started) {
#pragma unroll
        for (int mp = 0; mp < NMAP; ++mp) mref[mp] = NEG_BIG;
    }
    const ldsp cw = lds + COMB_OFF + qg * COMB_WAVE;
    if (ks == 1 && qg < d.nqg) {
#pragma unroll
        for (int mp = 0; mp < NMAP; ++mp) {
#pragma unroll
            for (int db = 0; db < 2; ++db)
#pragma unroll
                for (int i = 0; i < 16; ++i) *(LAS float*)(cw + ((mp * 2 + db) * 16 + i) * 256 + lane * 4) = O[mp][db][i];
            *(LAS float*)(cw + 16384 + (mp * 2) * 256 + lane * 4) = mref[mp]; *(LAS float*)(cw + 16384 + (mp * 2 + 1) * 256 + lane * 4) = lsum[mp];
        }
    }
    __syncthreads();
    if (ks == 0 && qg < d.nqg) {
        float linv[NMAP];
#pragma unroll
        for (int mp = 0; mp < NMAP; ++mp) {
            const float mb = *(const LAS float*)(cw + 16384 + (mp * 2) * 256 + lane * 4), lb = *(const LAS float*)(cw + 16384 + (mp * 2 + 1) * 256 + lane * 4);
            const float mt = fmaxf(mref[mp], mb), aa = __builtin_amdgcn_exp2f(mref[mp] - mt), ab = __builtin_amdgcn_exp2f(mb - mt);
            const float l = xhalf_sum(lsum[mp] * aa + lb * ab);
            linv[mp] = 1.0f / l;
#pragma unroll
            for (int db = 0; db < 2; ++db)
#pragma unroll
                for (int i = 0; i < 16; ++i) O[mp][db][i] = O[mp][db][i] * aa + *(const LAS float*)(cw + ((mp * 2 + db) * 16 + i) * 256 + lane * 4) * ab;
        }
        float fin = 1.f;
        if (MODE == 0) {
            const float i1 = linv[0], i2 = lam * linv[NMAP - 1]; float ss = 0.f;
#pragma unroll
            for (int db = 0; db < 2; ++db)
#pragma unroll
                for (int i = 0; i < 16; ++i) { const float o = O[0][db][i] * i1 - O[NMAP - 1][db][i] * i2; O[0][db][i] = o; ss += o * o; }
            ss = xhalf_sum(ss);
            fin = __builtin_amdgcn_rsqf(ss * (1.0f / 64.0f) + 1e-5f) * oml;
        } else fin = linv[0];
        const int row = 32 * qg + r32;
        if (row < d.nq) {
#pragma unroll
            for (int db = 0; db < 2; ++db)
#pragma unroll
                for (int g4 = 0; g4 < 4; ++g4) {
                    const int d0 = 32 * db + 8 * g4 + 4 * hi;
                    const u32x2 gw = *(const u32x2*)(d.gate + (size_t)row * ZLD + d0);
                    f32x4 sg = {1.f, 1.f, 1.f, 1.f}; if (MODE == 0) sg = *(const f32x4*)(subg + d0);
                    const float y0 = O[0][db][4 * g4] * fin * sg[0] * bf_lo(gw.x), y1 = O[0][db][4 * g4 + 1] * fin * sg[1] * bf_hi(gw.x);
                    const float y2 = O[0][db][4 * g4 + 2] * fin * sg[2] * bf_lo(gw.y), y3 = O[0][db][4 * g4 + 3] * fin * sg[3] * bf_hi(gw.y);
                    *(u32x2*)(d.y + (size_t)row * 1024 + d0) = (u32x2){cvtpk(y0, y1), cvtpk(y2, y3)};
                }
        }
    }
}
using namespace pg8;
constexpr size_t WS_CTL = WSO_CTL, CTL_BYTES = 1u << 20, WS_SSQ0 = WSO_SSQ0, WS_ROPE = WSO_ROPE, WS_WIN = WSO_WIN, WS_WOUT = WSO_WOUT, WS_XB = WSO_XB, WS_YMIX = WSO_YMIX, WS_X1 = WSO_X1, WS_Z = WSO_Z, WS_END = WSO_END;
static_assert((size_t)MROWS * 1024 * 2 <= 36u * (1u << 20) && (size_t)MROWS * 1024 * 4 <= 68u * (1u << 20) && (size_t)MROWS * 4096 * 2 <= 132u * (1u << 20), "ws map");
constexpr int CTL_Q0 = 0, CTL_SI = 64, CTL_SM = 128, CTL_SSQ1 = 16384, CTL_SSQ2 = 16384 + 32768;
static_assert((CTL_SSQ2 + MROWS) * 4 <= (int)CTL_BYTES, "ctl");
constexpr size_t O_Y = OO_Y, O_CONVP = OO_CONVP, O_CONVS = OO_CONVS, O_END = OO_END;
struct Args { const float* in[18]; float* out; unsigned char* ws; };

__device__ __forceinline__ float wave_sum(float v) {
#pragma unroll
    for (int o = 1; o < 64; o <<= 1) v += __shfl_xor(v, o);
    return v;
}
__device__ __forceinline__ unsigned f2bf(float f) { unsigned u = __builtin_bit_cast(unsigned, f); return (u + 0x7fffu + ((u >> 16) & 1u)) >> 16; }
__device__ __forceinline__ unsigned pk2(float lo, float hi) { return f2bf(lo) | (f2bf(hi) << 16); }
__device__ __forceinline__ void p0_transpose_item(const float* W, const float* g, int K, int N, bf16_t* WT, LAS float* scr, int item, int lane) {
    const int nblk = N / 32, kb = item / nblk, nb = item % nblk, k0 = 64 * kb, n0 = 32 * nb;
#pragma unroll 8
    for (int i = 0; i < 32; ++i) { const int kk = 2 * i + (lane >> 5); const float gs = g ? g[k0 + kk] : 1.f; scr[kk * 33 + (lane & 31)] = W[(size_t)(k0 + kk) * N + n0 + (lane & 31)] * gs; }
    asm volatile("s_waitcnt lgkmcnt(0)" ::: "memory");
    const int c = lane & 7;
#pragma unroll
    for (int j = 0; j < 4; ++j) { const int n = (lane >> 3) + 8 * j; const LAS float* s = scr + (8 * c) * 33 + n;
        u32x4 o; o.x = pk2(s[0 * 33], s[1 * 33]); o.y = pk2(s[2 * 33], s[3 * 33]); o.z = pk2(s[4 * 33], s[5 * 33]); o.w = pk2(s[6 * 33], s[7 * 33]);
        *(u32x4*)(WT + (size_t)(n0 + n) * K + k0 + 8 * c) = o; }
    asm volatile("s_waitcnt lgkmcnt(0)" ::: "memory");
}

__global__ void __launch_bounds__(512) fwd_megakernel(Args args) {
    extern __shared__ __attribute__((aligned(16))) unsigned char lds_raw[];
    cg::grid_group grid = cg::this_grid();
    const ldsp lds = (ldsp)lds_raw;
    const int tid = threadIdx.x, lane = tid & 63, wave = __builtin_amdgcn_readfirstlane(tid >> 6);
    const int G = gridDim.x, bx = blockIdx.x;
    unsigned char* ws = args.ws; float* out = args.out;
    unsigned* ctl = (unsigned*)(ws + WS_CTL);
    float* SSQ0 = (float*)(ws + WS_SSQ0); float* SSQ1 = (float*)ctl + CTL_SSQ1; float* SSQ2 = (float*)ctl + CTL_SSQ2;
    float* ROPE = (float*)(ws + WS_ROPE);
    bf16_t* WIN = (bf16_t*)(ws + WS_WIN); bf16_t* WOUT = (bf16_t*)(ws + WS_WOUT);
    bf16_t* XB = (bf16_t*)(ws + WS_XB); bf16_t* YMIX = (bf16_t*)(ws + WS_YMIX); float* X1 = (float*)(ws + WS_X1); bf16_t* Z = (bf16_t*)(ws + WS_Z);
    const float* x_p = args.in[0]; const float* x_s = args.in[1];

    {
        LAS float* scr = (LAS float*)(lds + wave * 16384);
        const int gw = bx * 8 + wave, NGW = G * 8;
        constexpr int I_IN = (1024 / 64) * (4096 / 32), I_OUT = (1024 / 64) * (1024 / 32), NITEMS = 2 * I_IN + 2 * I_OUT;
        for (int it = gw; it < NITEMS; it += NGW) {
            int r = it;
            if (r < 2 * I_IN) { const int l = r / I_IN; r -= l * I_IN; p0_transpose_item(args.in[8] + (size_t)l * 1024 * 4096, args.in[7] + l * 1024, 1024, 4096, WIN + (size_t)l * 4096 * 1024, scr, r, lane); }
            else { r -= 2 * I_IN; const int l = r / I_OUT; r -= l * I_OUT; p0_transpose_item(args.in[9] + (size_t)l * 1024 * 1024, nullptr, 1024, 1024, WOUT + (size_t)l * 1024 * 1024, scr, r, lane); }
        }
        for (int m = gw; m < MROWS; m += NGW) {
            const float* xr = (m < NPROMPT) ? x_p + (size_t)m * 1024 : x_s + (size_t)(m - NPROMPT) * 1024;
            f32x4 v[4]; float s = 0.f;
#pragma unroll
            for (int j = 0; j < 4; ++j) { v[j] = *((const f32x4*)xr + lane + 64 * j); s += (v[j][0] * v[j][0] + v[j][1] * v[j][1]) + (v[j][2] * v[j][2] + v[j][3] * v[j][3]); }
            s = wave_sum(s);
            if (lane == 0) SSQ0[m] = s;
#pragma unroll
            for (int j = 0; j < 4; ++j) *((u32x2*)(XB + (size_t)m * 1024) + lane + 64 * j) = (u32x2){cvtpk(v[j][0], v[j][1]), cvtpk(v[j][2], v[j][3])};
        }
        for (int e = bx * 512 + tid; e < MROWS * 4; e += G * 512) {
            const int row = e >> 2, i = e & 3; const int pos = (row < NPROMPT) ? row : 4096 + ((row - NPROMPT) & 15);
            const float invf = (i == 0) ? 1.0f : (i == 1 ? 0.037606030930863934f : (i == 2 ? 0.0014142135623730950f : 5.318295896944988e-05f));
            const float ang = (float)pos * invf;
            const double rev = (double)ang * 0.15915494309189535; const float fr = (float)(rev - __builtin_rint(rev));
            ROPE[(size_t)row * 8 + i] = __builtin_amdgcn_cosf(fr); ROPE[(size_t)row * 8 + 4 + i] = __builtin_amdgcn_sinf(fr);
        }
    }
    grid.sync();

    for (int l = 0; l < 2; ++l) {
        {
            pg8::Gemm g{XB, WIN + (size_t)l * 4096 * 1024, NPROMPT, 4096, 1024}; pg8::StaticOrder S; S.init(NPROMPT, 4096, G, bx);
            pg8::EpiIn E{ws, out, l};

#ifndef NO_GEMM1
            pg8::gemm_phase<pg8::EpiIn, pg8::StaticOrder, true, true>(lds, g, S, E);
#ifdef PROBE_P1X
            if (l == 0) { grid.sync(); pg8::gemm_phase<pg8::EpiIn, pg8::StaticOrder, true, true>(lds, g, S, E); }
#endif
#endif

        }
        grid.sync();
        {
            const float lam_init = (l == 0) ? 0.2f : 0.35550906759096927f;
            float d1 = 0.f, d2 = 0.f;
            for (int i = 0; i < 32; ++i) { d1 += args.in[12][l * 32 + i] * args.in[13][l * 32 + i]; d2 += args.in[14][l * 32 + i] * args.in[15][l * 32 + i]; }
            const float lam = __expf(d1) - __expf(d2) + lam_init, oml = 1.0f - lam_init;
            const float* subg = args.in[16] + l * 64;
            volatile LAS int* misc = (volatile LAS int*)(lds + MISC_OFF);
            constexpr int N_SI = 16, N_PC = 512, N_SC = 64, N_PA = 1024, N_SA = 128, N_CV = 130, N_SO = 4, N_TOT = N_SI + N_PC + N_SC + N_PA + N_SA + N_CV + N_SO;
            constexpr unsigned N_SMIX = N_SC + N_SA + 2;
#ifndef PROBE_P2X
#define PROBE_P2X 1
#endif
            for (int rep = 0; rep < ((l == 0) ? PROBE_P2X : 1); ++rep) {
            if (rep > 0) grid.sync();
            for (;;) {
                __syncthreads();
                if (tid == 0) misc[0] = (int)atomicAdd(ctl + CTL_Q0 + l + 2 * rep, 1u);
                __syncthreads();
                int ui = misc[0]; ui = __builtin_amdgcn_readfirstlane(ui);
                if (ui >= N_TOT) break;
                AU d; d.kc = nullptr; d.vc = nullptr; d.cp = 0; d.ntc = 0; d.lastv = 64; d.nqg = 4; d.tlo1 = 0; d.thi1 = -1; d.qpos0 = 0; d.kpos0 = 0;
                int kind;
                int idx = ui;
                if (idx < 16) kind = 5; else if (idx < 256) { kind = 0; idx -= 16; } else if (idx < 320) { kind = 1; idx -= 256; } else if (idx < 448) { kind = 3; idx -= 320; } else if (idx < 450) { kind = 4; idx = 128 + (idx - 448); }
                else if (idx < 454) { kind = 6; idx -= 450; } else if (idx < 726) { kind = 0; idx = 240 + (idx - 454); } else if (idx < 1750) { kind = 2; idx -= 726; } else { kind = 4; idx -= 1750; }
                const bool smp_unit = (kind == 1 || kind == 3 || (kind == 4 && idx >= 128));
                if (smp_unit || kind == 6) {
                    if (tid == 0) {
                        unsigned* cnt = ctl + (kind == 6 ? CTL_SM : CTL_SI) + l; const unsigned want = (kind == 6) ? N_SMIX : (unsigned)N_SI;
                        while (__hip_atomic_load(cnt, __ATOMIC_RELAXED, __HIP_MEMORY_SCOPE_AGENT) < want) __builtin_amdgcn_s_sleep(8);
                        __builtin_amdgcn_fence(__ATOMIC_ACQUIRE, "agent");
                        asm volatile("s_waitcnt vmcnt(0)" ::: "memory");
                    }
                    __syncthreads();
                }
                if (kind >= 5) {
                    if (kind == 5) { pg8::Gemm g{XB, WIN + (size_t)l * 4096 * 1024, MROWS, 4096, 1024}; pg8::OneUnit S{64, idx}; pg8::EpiIn E{ws, out, l};
                        pg8::gemm_phase<pg8::EpiIn, pg8::OneUnit, false, true>(lds, g, S, E); }
                    else { pg8::Gemm g{YMIX, WOUT + (size_t)l * 1024 * 1024, MROWS, 1024, 1024}; pg8::OneUnit S{64, idx}; pg8::EpiOut E{ws, x_p, x_s, l, args.in[17], out};
                        pg8::gemm_phase<pg8::EpiOut, pg8::OneUnit, false, true>(lds, g, S, E); }
                }
                else if (kind == 0) {
                    const int u = 127 - (idx >> 2), h = idx & 3; const size_t r0 = (size_t)128 * u;
                    d.q = Z + r0 * ZLD + 3072 + 64 * h; d.nq = 128; d.nt = 2 * u + 2; d.kz = Z + 3328 + 64 * h; d.vz = Z + 3584 + 64 * h;
                    d.tlo0 = 0; d.thi0 = d.nt - 2; d.tlo1 = 0; d.thi1 = d.nt - 1; d.gate = Z + r0 * ZLD + 3840 + 64 * h; d.y = YMIX + r0 * 1024 + 768 + 64 * h;

#ifndef NO_ATTN0
                    attn_unit<0>(d, lds, lam, oml, subg);
#endif

                } else if (kind == 1) {
                    const int b = idx >> 2, h = idx & 3; const size_t r0 = (size_t)NPROMPT + 16 * b;
                    d.q = Z + r0 * ZLD + 3072 + 64 * h; d.nq = 16; d.nt = 65; d.ntc = 64; d.cp = 256;
                    d.kc = args.in[5] + ((size_t)(l * 16 + b) * 4096) * 256 + 64 * h; d.vc = args.in[6] + ((size_t)(l * 16 + b) * 4096) * 256 + 64 * h;
                    d.kz = Z + r0 * ZLD + 3328 + 64 * h; d.vz = Z + r0 * ZLD + 3584 + 64 * h; d.lastv = 16; d.nqg = 1; d.tlo0 = 0; d.thi0 = 64;
                    d.gate = Z + r0 * ZLD + 3840 + 64 * h; d.y = YMIX + r0 * 1024 + 768 + 64 * h;

#ifndef NO_ATTN0
                    attn_unit<0>(d, lds, lam, oml, subg);
#endif

                } else if (kind == 2 || kind == 3) {
                    int h;
                    if (kind == 2) {
                        h = idx & 7; const int cp = idx >> 3, c0 = max(0, 2 * cp - 8); const size_t r0 = (size_t)128 * cp;
                        d.q = Z + r0 * ZLD + 64 * h; d.nq = 128; d.nt = 2 * cp + 2 - c0; d.kz = Z + (size_t)64 * c0 * ZLD + 512 + 64 * h; d.vz = Z + (size_t)64 * c0 * ZLD + 1024 + 64 * h;
                        d.tlo0 = 0; d.thi0 = 2 * cp - c0; d.tlo1 = max(0, 2 * cp + 1 - 8) - c0; d.thi1 = 2 * cp + 1 - c0; d.qpos0 = 128 * cp; d.kpos0 = 64 * c0;
                        d.gate = Z + r0 * ZLD + 1536 + 64 * h; d.y = YMIX + r0 * 1024 + 64 * h;
                    } else {
                        h = idx & 7; const int b = idx >> 3; const size_t r0 = (size_t)NPROMPT + 16 * b;
                        d.q = Z + r0 * ZLD + 64 * h; d.nq = 16; d.nt = 9; d.ntc = 8; d.cp = 512;
                        d.kc = args.in[2] + ((size_t)(l * 16 + b) * 512) * 512 + 64 * h; d.vc = args.in[3] + ((size_t)(l * 16 + b) * 512) * 512 + 64 * h;
                        d.kz = Z + r0 * ZLD + 512 + 64 * h; d.vz = Z + r0 * ZLD + 1024 + 64 * h; d.lastv = 16; d.nqg = 1; d.tlo0 = 0; d.thi0 = 8; d.qpos0 = 512; d.kpos0 = 0;
                        d.gate = Z + r0 * ZLD + 1536 + 64 * h; d.y = YMIX + r0 * 1024 + 64 * h;
                    }
                    if (tid < 257) ((LAS float*)(lds + TAB_OFF))[tid] = args.in[10][(size_t)(l * 8 + h) * 257 + tid] * LOG2E;

#ifndef NO_ATTN1
                    attn_unit<1>(d, lds, 0.f, 0.f, nullptr);
#endif

                } else {
                    int tq_ = threadIdx.x; asm volatile("" : "+v"(tq_));
                    const int c8 = (tq_ & 31) * 8, rr = tq_ >> 5;
                    const float* cw = args.in[11] + (size_t)l * 3 * 256 + c8;
                    float w0[8], w1[8], w2[8];
#pragma unroll
                    for (int j = 0; j < 8; ++j) { w0[j] = cw[j]; w1[j] = cw[256 + j]; w2[j] = cw[512 + j]; }
                    for (int g = 0; g < 8; ++g) {
                        const int row = 128 * idx + 16 * g + rr; const bool smp = row >= NPROMPT; const int t = smp ? ((row - NPROMPT) & 15) : row, b = (row - NPROMPT) >> 4;
                        const bf16_t* zr = Z + (size_t)row * ZLD;
                        float u0[8], u1[8], u2[8];
                        { const u32x4 c = *(const u32x4*)(zr + 2304 + c8), hh = *(const u32x4*)(zr + 2560 + c8);
#pragma unroll
                          for (int j = 0; j < 4; ++j) { u0[2 * j] = bf_lo(c[j]) * bf_lo(hh[j]); u0[2 * j + 1] = bf_hi(c[j]) * bf_hi(hh[j]); } }
                        if (t >= 1) { const u32x4 c = *(const u32x4*)(zr - ZLD + 2304 + c8), hh = *(const u32x4*)(zr - ZLD + 2560 + c8);
#pragma unroll
                          for (int j = 0; j < 4; ++j) { u1[2 * j] = bf_lo(c[j]) * bf_lo(hh[j]); u1[2 * j + 1] = bf_hi(c[j]) * bf_hi(hh[j]); } }
                        else if (smp) { const float* sp = args.in[4] + ((size_t)(l * 16 + b) * 2 + 1) * 256 + c8;
#pragma unroll
                          for (int j = 0; j < 8; ++j) u1[j] = sp[j]; }
                        else {
#pragma unroll
                          for (int j = 0; j < 8; ++j) u1[j] = 0.f; }
                        if (t >= 2) { const u32x4 c = *(const u32x4*)(zr - 2 * ZLD + 2304 + c8), hh = *(const u32x4*)(zr - 2 * ZLD + 2560 + c8);
#pragma unroll
                          for (int j = 0; j < 4; ++j) { u2[2 * j] = bf_lo(c[j]) * bf_lo(hh[j]); u2[2 * j + 1] = bf_hi(c[j]) * bf_hi(hh[j]); } }
                        else if (smp) { const float* sp = args.in[4] + ((size_t)(l * 16 + b) * 2 + t) * 256 + c8;
#pragma unroll
                          for (int j = 0; j < 8; ++j) u2[j] = sp[j]; }
                        else {
#pragma unroll
                          for (int j = 0; j < 8; ++j) u2[j] = 0.f; }
                        const u32x4 bb = *(const u32x4*)(zr + 2048 + c8), bg = *(const u32x4*)(zr + 2816 + c8);
                        float y[8];
#pragma unroll
                        for (int j = 0; j < 4; ++j) {
                            y[2 * j] = bf_lo(bb[j]) * (u2[2 * j] * w0[2 * j] + u1[2 * j] * w1[2 * j] + u0[2 * j] * w2[2 * j]) * bf_lo(bg[j]);
                            y[2 * j + 1] = bf_hi(bb[j]) * (u2[2 * j + 1] * w0[2 * j + 1] + u1[2 * j + 1] * w1[2 * j + 1] + u0[2 * j + 1] * w2[2 * j + 1]) * bf_hi(bg[j]); }
                        *(u32x4*)(YMIX + (size_t)row * 1024 + 512 + c8) = (u32x4){cvtpk(y[0], y[1]), cvtpk(y[2], y[3]), cvtpk(y[4], y[5]), cvtpk(y[6], y[7])};
                        float* so = nullptr;
                        if (!smp && row >= NPROMPT - 2) so = out + O_CONVP + (size_t)l * 512 + (size_t)(row - (NPROMPT - 2)) * 256 + c8;
                        if (smp && t >= 14) so = out + O_CONVS + (size_t)l * 8192 + (size_t)b * 512 + (size_t)(t - 14) * 256 + c8;
                        if (so) { *(f32x4*)so = (f32x4){u0[0], u0[1], u0[2], u0[3]}; *(f32x4*)(so + 4) = (f32x4){u0[4], u0[5], u0[6], u0[7]}; }
                    }
                }
                if (smp_unit || kind == 5) {
                    asm volatile("s_waitcnt vmcnt(0)" ::: "memory");
                    __syncthreads();
                    if (tid == 0) { __builtin_amdgcn_fence(__ATOMIC_RELEASE, "agent"); asm volatile("s_waitcnt vmcnt(0)" ::: "memory");
                        __hip_atomic_fetch_add(ctl + (kind == 5 ? CTL_SI : CTL_SM) + l, 1u, __ATOMIC_RELAXED, __HIP_MEMORY_SCOPE_AGENT); }
                }
            }
            }
        }
        grid.sync();
        {
            pg8::Gemm g{YMIX, WOUT + (size_t)l * 1024 * 1024, NPROMPT, 1024, 1024}; pg8::StaticOrder S; S.init(NPROMPT, 1024, G, bx);
            pg8::EpiOut E{ws, x_p, x_s, l, args.in[17], out};

#ifndef NO_GEMM2
            pg8::gemm_phase<pg8::EpiOut, pg8::StaticOrder, true, true>(lds, g, S, E);
#endif

            if (l == 1 && wave == 0 && bx < MROWS - NPROMPT) {
                int ln_ = threadIdx.x & 63; asm volatile("" : "+v"(ln_));
                const int lane = ln_;
                const int m = NPROMPT + bx; const float rs = __builtin_amdgcn_rsqf(SSQ2[m] * (1.0f / 1024.0f) + 1e-6f);
#pragma unroll
                for (int j = 0; j < 4; ++j) { const f32x4 v = *((const f32x4*)(X1 + (size_t)m * 1024) + lane + 64 * j); *((f32x4*)(out + O_Y + (size_t)m * 1024) + lane + 64 * j) = v * rs * *((const f32x4*)args.in[17] + lane + 64 * j); }
            }
        }
        if (l == 0) grid.sync();
    }
}

extern "C" void kernel_launch(void* const* d_in, const int* in_sizes, int n_in, void* d_out, int out_size, void* d_ws, size_t ws_size, hipStream_t stream) {
    static int grid_blocks = 0;
    if (!grid_blocks) {
        if (n_in != 18 || (size_t)out_size != O_END || ws_size < WS_END) { fprintf(stderr, "kernel_launch: unexpected shapes n_in %d out %d ws %zu\n", n_in, out_size, ws_size); grid_blocks = -1; return; }
        int dev = 0, cus = 0, per_cu = 0;
        hipGetDevice(&dev); hipDeviceGetAttribute(&cus, hipDeviceAttributeMultiprocessorCount, dev);
        hipFuncSetAttribute((const void*)fwd_megakernel, hipFuncAttributeMaxDynamicSharedMemorySize, LDS_BYTES);
        hipOccupancyMaxActiveBlocksPerMultiprocessor(&per_cu, (const void*)fwd_megakernel, 512, LDS_BYTES);
        if (per_cu < 1) { fprintf(stderr, "kernel_launch: occupancy query says %d blocks per CU\n", per_cu); per_cu = 1; }
        if (per_cu > 1) per_cu = 1;
        grid_blocks = cus * per_cu;
    }
    if (grid_blocks < 0) return;
    hipMemsetAsync((char*)d_ws + WS_CTL, 0, CTL_BYTES, stream);
    Args a{};
    for (int i = 0; i < 18; ++i) a.in[i] = (const float*)d_in[i];
    a.out = (float*)d_out; a.ws = (unsigned char*)d_ws;
    void* kargs[] = {&a};
    hipError_t e = hipLaunchCooperativeKernel((const void*)fwd_megakernel, dim3(grid_blocks), dim3(512), kargs, LDS_BYTES, stream);
    if (e != hipSuccess) fprintf(stderr, "cooperative launch failed: %s (grid %d)\n", hipGetErrorString(e), grid_blocks);
}
```

```cpp
#include <hip/hip_runtime.h>
#include <hip/hip_cooperative_groups.h>
#include <cstdio>
#include <cstdint>
namespace cg = cooperative_groups;
namespace pg8 {
#define PG8_LAS __attribute__((address_space(3)))
typedef unsigned short bf16_t;
typedef short bf16x8 __attribute__((ext_vector_type(8)));
typedef float f32x4 __attribute__((ext_vector_type(4)));
typedef unsigned u32x4 __attribute__((ext_vector_type(4)));
constexpr int BM = 256, BK = 64, HALF = 128, HTB = HALF * BK * 2  , STAGE_BYTES = 8 * HTB, NXCD = 8, WGM = 8;

__host__ __device__ __forceinline__ int lds_byte(int r, int c) { const int st = (r >> 4) * 2 + (c >> 5), rr = r & 15, cc = c & 31, ob = rr * 64 + cc * 2; return st * 1024 + (ob ^ (((ob >> 9) & 1) << 5)); }
__host__ __device__ __forceinline__ void stage_rc(int b, int& R, int& C) { const int st = b / 1024, sb = b % 1024, swz = sb ^ (((sb >> 9) & 1) << 5); R = (st >> 1) * 16 + swz / 64; C = (st & 1) * 32 + (swz % 64) / 2; }
__host__ __device__ __forceinline__ int perm32(int rho) { const int n = rho >> 4, i = rho & 15; return 8 * (i >> 2) + 4 * n + (i & 3); }

struct Unit { int pm, pn; };
struct Gemm { const bf16_t* A; const bf16_t* Bt; int M, N, K; };

struct StaticOrder {
    int nM, nN, nwg, G, c;
    __host__ __device__ void init(int M, int N, int G_, int c_) { nM = M / BM; nN = N / BM; nwg = nM * nN; G = G_; c = c_; }
    __host__ __device__ bool next(int i, Unit& u) const {
        const long L = (long)i * G + c; if (L >= nwg) return false;
        int wgid = (int)L; { const int q = nwg / NXCD, r = nwg % NXCD, xcd = wgid % NXCD, off = wgid / NXCD; wgid = (xcd < r ? xcd * (q + 1) : r * (q + 1) + (xcd - r) * q) + off; }
        const int nig = WGM * nN, gid = wgid / nig, fm = gid * WGM, gsz = (nM - fm) < WGM ? (nM - fm) : WGM;
        u.pm = fm + ((wgid % nig) % gsz); u.pn = (wgid % nig) / gsz; return true;
    }
    __device__ __forceinline__ void a_ready(const Unit&) const {}
    __device__ __forceinline__ void done(const Unit&) const {}
};
struct OneUnit {
    int pm, pn;
    __host__ __device__ bool next(int i, Unit& u) const { if (i) return false; u.pm = pm; u.pn = pn; return true; }
    __device__ __forceinline__ void a_ready(const Unit&) const {}
    __device__ __forceinline__ void done(const Unit&) const {}
};
__device__ __forceinline__ unsigned cvt_pk_bf16(float lo, float hi) { unsigned r; asm volatile("v_cvt_pk_bf16_f32 %0, %1, %2" : "=v"(r) : "v"(lo), "v"(hi)); return r; }
typedef float f32x2 __attribute__((ext_vector_type(2)));
constexpr float LOG2E = 1.4426950408889634f;
constexpr float SC_QA = 0.125f * LOG2E;
constexpr float SC_QC = 0.17677669529663687f * LOG2E;
constexpr int ZLD = 4096, MROWS = 16640, NPROMPT = 16384;
constexpr size_t WSO_MiB = 1u << 20;
constexpr size_t WSO_PANEL = 512 * 4  , WSO_CTL = 0, WSO_SSQ1 = 16384 * 4, WSO_SSQ2 = (16384 + 32768) * 4, WSO_SSQ0 = 1 * WSO_MiB, WSO_ROPE = 2 * WSO_MiB, WSO_WIN = 4 * WSO_MiB, WSO_WOUT = 20 * WSO_MiB, WSO_XB = 24 * WSO_MiB,
                 WSO_YMIX = 60 * WSO_MiB, WSO_X1 = 96 * WSO_MiB, WSO_Z = 164 * WSO_MiB, WSO_END = 296 * WSO_MiB;
constexpr size_t OO_Y = 0, OO_AKP = 17039360, OO_AVP = OO_AKP + 524288, OO_CONVP = OO_AVP + 524288, OO_CKP = OO_CONVP + 1024, OO_CVP = OO_CKP + 8388608,
                 OO_AKS = OO_CVP + 8388608, OO_AVS = OO_AKS + 262144, OO_CONVS = OO_AVS + 262144, OO_CKS = OO_CONVS + 16384, OO_CVS = OO_CKS + 131072, OO_END = OO_CVS + 131072;
__device__ __forceinline__ float silu_f(float x) { return x * __builtin_amdgcn_rcpf(1.0f + __builtin_amdgcn_exp2f(-x * LOG2E)); }
struct EpiIn {
    static constexpr bool PERM = true, AFTER_DRAIN = false;
    unsigned char* ws; float* out; int l;
    __device__ __forceinline__ void operator()(const f32x4 (&acc)[2][2][4][2], const Unit& u, int wr, int wc, int fr, int fq) const {
        const int pn = u.pn, pm = u.pm;
        bf16_t* Z = (bf16_t*)(ws + WSO_Z); const float* ssq = (const float*)(ws + (l == 0 ? WSO_SSQ0 : WSO_SSQ1)); const float* rope = (const float*)(ws + WSO_ROPE);
        float* o_ak_p = out + OO_AKP + (size_t)l * 262144; float* o_av_p = out + OO_AVP + (size_t)l * 262144; float* o_ak_s = out + OO_AKS + (size_t)l * 131072; float* o_av_s = out + OO_AVS + (size_t)l * 131072;
        float* o_ck_p = out + OO_CKP + (size_t)l * 4194304; float* o_cv_p = out + OO_CVP + (size_t)l * 4194304; float* o_ck_s = out + OO_CKS + (size_t)l * 65536; float* o_cv_s = out + OO_CVS + (size_t)l * 65536;
        const int rowl = wr * 64 + fr;
        const int colb = pn * BM + wc * 32 + 8 * fq;
        const bool rope_tile = (pn == 12 || pn == 13);
        const bool do_rope = rope_tile && fq == 0;
        const float sc = (pn < 2) ? SC_QA : (pn == 12 ? SC_QC : 1.f);
        const bool do_silu = (pn == 6 || pn == 7 || pn == 11 || pn == 15);
        float* ob = nullptr; int old = 0, ocol0 = 0;
        if (pn >= 2 && pn <= 5) { old = 512; ocol0 = (pn >= 4) ? 1024 : 512;
            if (pm == 64) ob = (pn >= 4) ? o_av_s : o_ak_s; else if (pm >= 62) ob = ((pn >= 4) ? o_av_p : o_ak_p) + (size_t)(pm - 62) * 256 * 512; }
        else if (pn == 13 || pn == 14) { old = 256; ocol0 = (pn == 13) ? 3328 : 3584;
            if (pm == 64) ob = (pn == 13) ? o_ck_s : o_cv_s; else ob = ((pn == 13) ? o_ck_p : o_cv_p) + (size_t)pm * 256 * 256; }
#pragma unroll
        for (int ai = 0; ai < 2; ++ai)
#pragma unroll
            for (int m = 0; m < 4; ++m) {
                const int rl = rowl + ai * HALF + m * 16, row = pm * BM + rl;
                const float rs = __builtin_amdgcn_rsqf(ssq[row] * (1.0f / 1024.0f) + 1e-6f);
                f32x4 rc = {1.f, 1.f, 1.f, 1.f}, rsn = {0.f, 0.f, 0.f, 0.f};
                if (do_rope) { rc = *(const f32x4*)(rope + (size_t)row * 8); rsn = *(const f32x4*)(rope + (size_t)row * 8 + 4); }
#pragma unroll
                for (int bj = 0; bj < 2; ++bj) {
                    f32x4 v0 = acc[ai][bj][m][0] * rs, v1 = acc[ai][bj][m][1] * rs;
                    const int col = colb + bj * HALF;
                    if (rope_tile) { const f32x4 a = v0 * rc - v1 * rsn, b = v1 * rc + v0 * rsn; v0 = a; v1 = b; }
                    if (ob) { float* op = ob + (size_t)rl * old + (col - ocol0); *(f32x4*)op = v0; *(f32x4*)(op + 4) = v1; }
                    if (do_silu) { v0 = (f32x4){silu_f(v0[0]), silu_f(v0[1]), silu_f(v0[2]), silu_f(v0[3])}; v1 = (f32x4){silu_f(v1[0]), silu_f(v1[1]), silu_f(v1[2]), silu_f(v1[3])}; }
                    v0 = v0 * sc; v1 = v1 * sc;
                    u32x4 w; w.x = cvt_pk_bf16(v0[0], v0[1]); w.y = cvt_pk_bf16(v0[2], v0[3]); w.z = cvt_pk_bf16(v1[0], v1[1]); w.w = cvt_pk_bf16(v1[2], v1[3]);
                    *(u32x4*)(Z + (size_t)row * ZLD + col) = w;
                }
                asm volatile("" ::: "memory");
            }
    }
};
struct EpiOut {
    static constexpr bool PERM = true, AFTER_DRAIN = false;
    unsigned char* ws; const float* x_p; const float* x_s; int l; const float* fg; float* yout;
    __device__ __forceinline__ void operator()(f32x4 (&acc)[2][2][4][2], const Unit& u, int wr, int wc, int fr, int fq) const {
        const int pm = u.pm; const int colb = u.pn * BM + wc * 32 + 8 * fq;
        float* X1 = (float*)(ws + WSO_X1) + (size_t)pm * BM * 1024; bf16_t* XB = (bf16_t*)(ws + WSO_XB) + (size_t)pm * BM * 1024; float* ssq = (float*)(ws + (l == 0 ? WSO_SSQ1 : WSO_SSQ2)) + pm * BM;
        const float* res = (l == 0) ? ((pm == 64) ? x_s : x_p + (size_t)pm * BM * 1024) : X1;
        const unsigned off0 = (unsigned)(wr * 64 + fr) * 1024u + (unsigned)colb;
        const bool fuse = (l == 1 && pm < 64);
#pragma unroll
        for (int ai = 0; ai < 2; ++ai)
#pragma unroll
            for (int m = 0; m < 4; ++m) {
                const unsigned offr = off0 + (unsigned)(ai * HALF + m * 16) * 1024u; float q = 0.f;
#pragma unroll
                for (int bj = 0; bj < 2; ++bj) { const unsigned off = offr + bj * HALF;
                    const f32x4 v0 = acc[ai][bj][m][0] + *(const f32x4*)(res + off), v1 = acc[ai][bj][m][1] + *(const f32x4*)(res + off + 4);
                    if (fuse) { acc[ai][bj][m][0] = v0; acc[ai][bj][m][1] = v1; }
                    else {
                        *(f32x4*)(X1 + off) = v0; *(f32x4*)(X1 + off + 4) = v1;
                        u32x4 w; w.x = cvt_pk_bf16(v0[0], v0[1]); w.y = cvt_pk_bf16(v0[2], v0[3]); w.z = cvt_pk_bf16(v1[0], v1[1]); w.w = cvt_pk_bf16(v1[2], v1[3]);
                        *(u32x4*)(XB + off) = w; }
                    q += (v0[0] * v0[0] + v0[1] * v0[1]) + (v0[2] * v0[2] + v0[3] * v0[3]) + (v1[0] * v1[0] + v1[1] * v1[1]) + (v1[2] * v1[2] + v1[3] * v1[3]);
                    asm volatile("" ::: "memory"); }
                q += __shfl_xor(q, 16); q += __shfl_xor(q, 32);
                if (fq == 0) atomicAdd(ssq + (wr * 64 + fr + ai * HALF + m * 16), q);
                asm volatile("" ::: "memory");
            }
        if (fuse) {
            unsigned* cnt = (unsigned*)(ws + WSO_PANEL) + 64 * pm;
            asm volatile("s_waitcnt vmcnt(0)" ::: "memory");
            if (__builtin_amdgcn_readfirstlane(fr + 16 * fq) == (fr + 16 * fq)) __hip_atomic_fetch_add(cnt, 1u, __ATOMIC_RELAXED, __HIP_MEMORY_SCOPE_AGENT);
            unsigned spins = 0;
            while (__hip_atomic_load(cnt, __ATOMIC_RELAXED, __HIP_MEMORY_SCOPE_AGENT) < 32u) { __builtin_amdgcn_s_sleep(2); if (++spins > (1u << 22)) break; }
            float* yo = yout + (size_t)pm * BM * 1024;
#pragma unroll
            for (int ai = 0; ai < 2; ++ai)
#pragma unroll
                for (int m = 0; m < 4; ++m) {
                    const int rl = wr * 64 + fr + ai * HALF + m * 16;
                    const float sq = __hip_atomic_load(ssq + rl, __ATOMIC_RELAXED, __HIP_MEMORY_SCOPE_AGENT);
                    const float rs = __builtin_amdgcn_rsqf(sq * (1.0f / 1024.0f) + 1e-6f);
                    const unsigned offr = off0 + (unsigned)(ai * HALF + m * 16) * 1024u;
#pragma unroll
                    for (int bj = 0; bj < 2; ++bj) {
                        const f32x4 g0 = *(const f32x4*)(fg + colb + bj * HALF), g1 = *(const f32x4*)(fg + colb + bj * HALF + 4);
                        *(f32x4*)(yo + offr + bj * HALF) = acc[ai][bj][m][0] * rs * g0; *(f32x4*)(yo + offr + bj * HALF + 4) = acc[ai][bj][m][1] * rs * g1;
                        asm volatile("" ::: "memory"); }
                }
        }
    }
};
template <class Epi, class Sched, bool ALIGN_EPI = false, bool SP2 = false>
__device__ __forceinline__ void gemm_phase(PG8_LAS unsigned char* lds, const Gemm g, const Sched& S, const Epi& E) {
    int tid_ = threadIdx.x; asm volatile("" : "+v"(tid_));
    const int tid = tid_, wid = __builtin_amdgcn_readfirstlane(tid >> 6), lane = tid & 63, wr = wid >> 2, wc = wid & 3, fr = lane & 15, fq = lane >> 4;
    const int K = g.K, nt = K / BK;
    unsigned voffA[2], voffB[2];
#pragma unroll
    for (int i = 0; i < 2; ++i) { int R, C; stage_rc(tid * 16 + i * 8192, R, C); const int Rb = Epi::PERM ? ((R & ~31) + perm32(R & 31)) : R;
        voffA[i] = (unsigned)(R * K + C) * 2u; voffB[i] = (unsigned)(Rb * K + C) * 2u; }
    const size_t kstep = (size_t)(BK * 2);
    const size_t hstep = (size_t)HALF * K * 2;
    const size_t tstep = 2 * hstep;
    const unsigned ldsw = (unsigned)wid * 1024u;
    const int aoff = lds_byte(wr * 64 + fr, fq * 8), boff = lds_byte(wc * 32 + fr, fq * 8);
#define PG8_SA(b, h) (((b) * 2 + (h)) * HTB)
#define PG8_SB(b, h) ((4 + (b) * 2 + (h)) * HTB)
#define PG8_STAGE(bufoff, gbase, voff) do { _Pragma("unroll") for (int _i = 0; _i < 2; ++_i) \
        __builtin_amdgcn_global_load_lds((const unsigned*)((const char*)(gbase) + (voff)[_i]), (PG8_LAS unsigned*)(lds + (bufoff) + ldsw + _i * 8192), 16, 0, 0); } while (0)
#define PG8_LDA(dst, b, h) do { _Pragma("unroll") for (int m = 0; m < 4; ++m) _Pragma("unroll") for (int k = 0; k < 2; ++k) dst[m][k] = *(const PG8_LAS bf16x8*)(lds + PG8_SA(b, h) + aoff + m * 2048 + k * 1024); } while (0)
#define PG8_LDB(dst, b, h) do { _Pragma("unroll") for (int n = 0; n < 2; ++n) _Pragma("unroll") for (int k = 0; k < 2; ++k) dst[n][k] = *(const PG8_LAS bf16x8*)(lds + PG8_SB(b, h) + boff + n * 2048 + k * 1024); } while (0)
#define PG8_MMA(ai, bj, At, Bt) do { __builtin_amdgcn_s_setprio(1); _Pragma("unroll") for (int m = 0; m < 4; ++m) _Pragma("unroll") for (int n = 0; n < 2; ++n) _Pragma("unroll") for (int k = 0; k < 2; ++k) \
        acc[ai][bj][m][n] = __builtin_amdgcn_mfma_f32_16x16x32_bf16(Bt[n][k], At[m][k], acc[ai][bj][m][n], 0, 0, 0); __builtin_amdgcn_s_setprio(0); } while (0)
#define PG8_WAIT_V(n) asm volatile("s_waitcnt vmcnt(" #n ")" ::: "memory")
#define PG8_WAIT_L(n) asm volatile("s_waitcnt lgkmcnt(" #n ")" ::: "memory")
#define PG8_BAR __builtin_amdgcn_s_barrier()
#define PG8_SCHED __builtin_amdgcn_sched_barrier(0)
    Unit cur, nxt; int ui = 0;
    if (!S.next(0, cur)) return;
    f32x4 acc[2][2][4][2];
#pragma unroll
    for (int a = 0; a < 2; ++a)
#pragma unroll
        for (int b = 0; b < 2; ++b)
#pragma unroll
            for (int m = 0; m < 4; ++m)
#pragma unroll
                for (int n = 0; n < 2; ++n) acc[a][b][m][n] = (f32x4){0.f, 0.f, 0.f, 0.f};
    bf16x8 At[4][2], B0[2][2], B1[2][2];
    const char* cA = (const char*)g.A + (size_t)cur.pm * tstep; const char* cB = (const char*)g.Bt + (size_t)cur.pn * tstep;
    S.a_ready(cur);
    if constexpr (SP2) {
        PG8_STAGE(PG8_SB(0, 0), cB, voffB); PG8_STAGE(PG8_SB(0, 1), cB + hstep, voffB); PG8_STAGE(PG8_SA(0, 0), cA, voffA); PG8_STAGE(PG8_SA(0, 1), cA + hstep, voffA);
        if (wr == 1) PG8_BAR;
        PG8_WAIT_V(2); PG8_BAR;
        PG8_STAGE(PG8_SB(1, 0), cB + kstep, voffB); PG8_STAGE(PG8_SA(1, 0), cA + kstep, voffA); PG8_STAGE(PG8_SB(1, 1), cB + hstep + kstep, voffB);
        PG8_WAIT_V(6); PG8_BAR;
    } else {
        PG8_STAGE(PG8_SB(0, 0), cB, voffB); PG8_STAGE(PG8_SA(0, 0), cA, voffA); PG8_STAGE(PG8_SB(0, 1), cB + hstep, voffB); PG8_STAGE(PG8_SA(0, 1), cA + hstep, voffA);
        if (wr == 1) PG8_BAR;
        PG8_WAIT_V(4); PG8_BAR;
        PG8_STAGE(PG8_SB(1, 0), cB + kstep, voffB); PG8_STAGE(PG8_SA(1, 0), cA + kstep, voffA); PG8_STAGE(PG8_SB(1, 1), cB + hstep + kstep, voffB);
        PG8_WAIT_V(6); PG8_BAR;
    }
    for (;;) {
        const bool has_next = S.next(ui + 1, nxt);
        const char* nA = has_next ? (const char*)g.A + (size_t)nxt.pm * tstep : cA; const char* nB = has_next ? (const char*)g.Bt + (size_t)nxt.pn * tstep : cB;
        for (int t = 0; t < nt; t += 2) {
            const bool last = (t == nt - 2);
            const char* a1 = cA + (size_t)(t + 1) * kstep;
            const char* a2 = last ? nA : cA + (size_t)(t + 2) * kstep; const char* b2 = last ? nB : cB + (size_t)(t + 2) * kstep;
            const char* a3 = a2 + kstep; const char* b3 = b2 + kstep;
            if (last && has_next) S.a_ready(nxt);
            if constexpr (SP2) {
            PG8_LDB(B0, 0, 0); PG8_LDB(B1, 0, 1); PG8_SCHED; PG8_LDA(At, 0, 0); PG8_STAGE(PG8_SA(1, 1), a1 + hstep, voffA);
            PG8_WAIT_V(8); PG8_WAIT_L(0); PG8_BAR; PG8_MMA(0, 0, At, B0); PG8_MMA(0, 1, At, B1); PG8_BAR; PG8_SCHED;
            PG8_LDA(At, 0, 1); PG8_STAGE(PG8_SB(0, 0), b2, voffB); PG8_STAGE(PG8_SB(0, 1), b2 + hstep, voffB); PG8_STAGE(PG8_SA(0, 0), a2, voffA);
            PG8_WAIT_V(8); PG8_WAIT_L(0); PG8_BAR; PG8_MMA(1, 0, At, B0); PG8_MMA(1, 1, At, B1); PG8_BAR; PG8_SCHED;
            PG8_LDB(B0, 1, 0); PG8_LDB(B1, 1, 1); PG8_SCHED; PG8_LDA(At, 1, 0); PG8_STAGE(PG8_SA(0, 1), a2 + hstep, voffA);
            PG8_WAIT_V(8); PG8_WAIT_L(0); PG8_BAR; PG8_MMA(0, 0, At, B0); PG8_MMA(0, 1, At, B1); PG8_BAR; PG8_SCHED;
            PG8_LDA(At, 1, 1); PG8_STAGE(PG8_SB(1, 0), b3, voffB); PG8_STAGE(PG8_SB(1, 1), b3 + hstep, voffB); PG8_STAGE(PG8_SA(1, 0), a3, voffA);
            PG8_WAIT_V(8); PG8_WAIT_L(0); PG8_BAR; PG8_MMA(1, 0, At, B0); PG8_MMA(1, 1, At, B1); PG8_BAR; PG8_SCHED;
            } else {
            PG8_LDB(B0, 0, 0); PG8_SCHED; PG8_LDA(At, 0, 0); PG8_STAGE(PG8_SA(1, 1), a1 + hstep, voffA);
            PG8_WAIT_L(8); PG8_BAR; PG8_WAIT_L(0); PG8_MMA(0, 0, At, B0); PG8_BAR; PG8_SCHED;
            PG8_LDB(B1, 0, 1); PG8_STAGE(PG8_SB(0, 0), b2, voffB);
            PG8_BAR; PG8_WAIT_L(0); PG8_MMA(0, 1, At, B1); PG8_BAR;
            PG8_LDA(At, 0, 1); PG8_STAGE(PG8_SA(0, 0), a2, voffA);
            PG8_BAR; PG8_WAIT_L(0); PG8_MMA(1, 0, At, B0); PG8_BAR; PG8_SCHED;
            PG8_STAGE(PG8_SB(0, 1), b2 + hstep, voffB);
            PG8_WAIT_V(6); PG8_BAR; PG8_MMA(1, 1, At, B1); PG8_BAR;
            PG8_LDB(B0, 1, 0); PG8_SCHED; PG8_LDA(At, 1, 0); PG8_STAGE(PG8_SA(0, 1), a2 + hstep, voffA);
            PG8_WAIT_L(8); PG8_BAR; PG8_WAIT_L(0); PG8_MMA(0, 0, At, B0); PG8_BAR; PG8_SCHED;
            PG8_LDB(B1, 1, 1); PG8_STAGE(PG8_SB(1, 0), b3, voffB);
            PG8_BAR; PG8_WAIT_L(0); PG8_MMA(0, 1, At, B1); PG8_BAR;
            PG8_LDA(At, 1, 1); PG8_STAGE(PG8_SA(1, 0), a3, voffA);
            PG8_BAR; PG8_WAIT_L(0); PG8_MMA(1, 0, At, B0); PG8_BAR; PG8_SCHED;
            PG8_STAGE(PG8_SB(1, 1), b3 + hstep, voffB);
            PG8_WAIT_V(6); PG8_BAR; PG8_MMA(1, 1, At, B1); PG8_BAR;
            }
        }
        if constexpr (ALIGN_EPI) { if (wr == 0) PG8_BAR; }
        if constexpr (!Epi::AFTER_DRAIN) { E(acc, cur, wr, wc, fr, fq); S.done(cur); }
        if (!has_next) break;
#pragma unroll
        for (int a = 0; a < 2; ++a)
#pragma unroll
            for (int b = 0; b < 2; ++b)
#pragma unroll
                for (int m = 0; m < 4; ++m)
#pragma unroll
                    for (int n = 0; n < 2; ++n) acc[a][b][m][n] = (f32x4){0.f, 0.f, 0.f, 0.f};
        cur = nxt; cA = nA; cB = nB; ++ui;
        if constexpr (ALIGN_EPI) { if (wr == 1) PG8_BAR; }
    }
    PG8_WAIT_V(0);
    if constexpr (!ALIGN_EPI) { if (wr == 0) PG8_BAR; }
    PG8_BAR;
    if constexpr (Epi::AFTER_DRAIN) { E.fused(acc, cur, wr, wc, fr, fq, lds, wid, lane); S.done(cur); }
#undef PG8_SA
#undef PG8_SB
#undef PG8_STAGE
#undef PG8_LDA
#undef PG8_LDB
#undef PG8_MMA
#undef PG8_WAIT_V
#undef PG8_WAIT_L
#undef PG8_BAR
#undef PG8_SCHED
}
}
#define LAS __attribute__((address_space(3)))
typedef unsigned short bf16_t;
typedef LAS unsigned char* ldsp;
typedef short bf16x8 __attribute__((ext_vector_type(8)));
typedef short s16x4 __attribute__((ext_vector_type(4)));
typedef float f32x16 __attribute__((ext_vector_type(16)));
typedef float f32x4 __attribute__((ext_vector_type(4)));
typedef float f32x2 __attribute__((ext_vector_type(2)));
typedef unsigned u32x4 __attribute__((ext_vector_type(4)));
typedef unsigned u32x2 __attribute__((ext_vector_type(2)));
typedef __bf16 bf16x2_t __attribute__((ext_vector_type(2)));
using pg8::ZLD; using pg8::MROWS; using pg8::NPROMPT; using pg8::LOG2E;
__device__ __forceinline__ int crow(int r, int hi) { return (r & 3) + 8 * (r >> 2) + 4 * hi; }
__device__ __forceinline__ unsigned cvtpk(float lo, float hi) { f32x2 v = {lo, hi}; bf16x2_t b = __builtin_convertvector(v, bf16x2_t); return __builtin_bit_cast(unsigned, b); }
__device__ __forceinline__ float bf_lo(unsigned w) { return __uint_as_float(w << 16); }
__device__ __forceinline__ float bf_hi(unsigned w) { return __uint_as_float(w & 0xffff0000u); }
__device__ __forceinline__ float xhalf_max(float m) { auto rr = __builtin_amdgcn_permlane32_swap(__float_as_uint(m), __float_as_uint(m), false, false); return fmaxf(__uint_as_float(rr[0]), __uint_as_float(rr[1])); }
__device__ __forceinline__ float xhalf_sum(float m) { auto rr = __builtin_amdgcn_permlane32_swap(__float_as_uint(m), __float_as_uint(m), false, false); return __uint_as_float(rr[0]) + __uint_as_float(rr[1]); }
__device__ __forceinline__ s16x4 vtr(ldsp p) { typedef short v4i16_t __attribute__((ext_vector_type(4))); return __builtin_bit_cast(s16x4, __builtin_amdgcn_ds_read_tr16_b64_v4i16((LAS v4i16_t*)p)); }
__device__ __forceinline__ float max3f(float a, float b, float c) { float r; asm("v_max3_f32 %0, %1, %2, %3" : "=v"(r) : "v"(a), "v"(b), "v"(c)); return r; }
__device__ __forceinline__ float max2f(float a, float b) { float r; asm("v_max_f32_e32 %0, %1, %2" : "=v"(r) : "v"(a), "v"(b)); return r; }
__device__ __forceinline__ float sum8_s(float acc, float a, float b, float c, float d, float e, float f, float g, float h) {
    asm("s_nop 0\n\tv_add_f32_e32 %0, %0, %1\n\tv_add_f32_e32 %0, %0, %2\n\tv_add_f32_e32 %0, %0, %3\n\tv_add_f32_e32 %0, %0, %4\n\tv_add_f32_e32 %0, %0, %5\n\tv_add_f32_e32 %0, %0, %6\n\tv_add_f32_e32 %0, %0, %7\n\tv_add_f32_e32 %0, %0, %8"
        : "+v"(acc) : "v"(a), "v"(b), "v"(c), "v"(d), "v"(e), "v"(f), "v"(g), "v"(h));
    return acc; }
__device__ __forceinline__ float sum4_s(float acc, float a, float b, float c, float d) {
    asm("s_nop 0\n\tv_add_f32_e32 %0, %0, %1\n\tv_add_f32_e32 %0, %0, %2\n\tv_add_f32_e32 %0, %0, %3\n\tv_add_f32_e32 %0, %0, %4" : "+v"(acc) : "v"(a), "v"(b), "v"(c), "v"(d));
    return acc; }
__device__ __forceinline__ float fadd_s(float a, float b) { float r; asm("v_add_f32_e32 %0, %1, %2" : "=v"(r) : "v"(a), "v"(b)); return r; }
#define MFMA32(a, b, c) __builtin_amdgcn_mfma_f32_32x32x16_bf16((a), (b), (c), 0, 0, 0)

constexpr int KPITCH = 144, KT_BYTES = 64 * KPITCH, VT_BYTES = 8192, TILE_BYTES = KT_BYTES + VT_BYTES, BUF_BYTES = 2 * TILE_BYTES;
constexpr int COMB_OFF = 2 * BUF_BYTES, COMB_WAVE = 17408, TAB_OFF = COMB_OFF + 4 * COMB_WAVE, MISC_OFF = TAB_OFF + 1040, LDS_BYTES = 147456;
static_assert(MISC_OFF + 64 <= LDS_BYTES, "LDS map");
constexpr float NEG_BIG = -1.0e30f, THR = 8.0f;
struct AU {
    const bf16_t* q; int nq; int nt, ntc; const float* kc; const float* vc; int cp; const bf16_t* kz; const bf16_t* vz; int lastv; int nqg;
    int tlo0, thi0, tlo1, thi1; int qpos0, kpos0; const bf16_t* gate; bf16_t* y;
};
#ifndef ATTN_INL
#define ATTN_INL __forceinline__
#endif
template <int MODE  >
__device__ ATTN_INL void attn_unit(const AU& d, ldsp lds, float lam, float oml, const float* subg) {
    constexpr int NMAP = MODE == 0 ? 2 : 1, NSTEP = MODE == 0 ? 2 : 4;
    int tid_ = threadIdx.x; asm volatile("" : "+v"(tid_));
    const int tid = tid_, lane = tid & 63, wid = __builtin_amdgcn_readfirstlane(tid >> 6), qg = wid & 3, ks = wid >> 2, r32 = lane & 31, hi = lane >> 5;
    const int tlo = (qg >> 1) ? d.tlo1 : d.tlo0; int thi = (qg >> 1) ? d.thi1 : d.thi0; if (qg >= d.nqg) thi = -1;
    const LAS float* tab = (const LAS float*)(lds + TAB_OFF);
    bf16x8 qf[NMAP][NSTEP];
    { int qrow = 32 * qg + r32; if (qrow >= d.nq) qrow = d.nq - 1;
      const bf16_t* qp = d.q + (size_t)qrow * ZLD;
#pragma unroll
      for (int mp = 0; mp < NMAP; ++mp)
#pragma unroll
          for (int st = 0; st < NSTEP; ++st) qf[mp][st] = *(const bf16x8*)(qp + mp * 32 + st * 16 + hi * 8); }
    f32x16 O[NMAP][2]; float mref[NMAP], lsum[NMAP];
#pragma unroll
    for (int mp = 0; mp < NMAP; ++mp) { mref[mp] = 0.f; lsum[mp] = 0.f;
#pragma unroll
        for (int db = 0; db < 2; ++db)
#pragma unroll
            for (int i = 0; i < 16; ++i) O[mp][db][i] = 0.f; }
    const int lrow = tid >> 3, lch = tid & 7;
    const int kwoff = lrow * KPITCH + lch * 16, vwoff = (lch >> 2) * 4096 + lrow * 64 + (lch & 3) * 16;
    const int kroff = r32 * KPITCH + hi * 16;
    const int vroff = (4 * hi + ((lane & 15) >> 2)) * 64 + ((lane >> 4) & 1) * 32 + (lane & 3) * 8;
    u32x4 stK[2], stV[2];
    const int nit = (d.nt + 1) >> 1; bool started = false;
#define AT_ISSUE(IT) do { _Pragma("unroll") for (int i_ = 0; i_ < 2; ++i_) { const int t_ = 2 * (IT) + i_; if (t_ < d.nt && t_ >= d.ntc) { int r_ = lrow; if (t_ == d.nt - 1 && r_ >= d.lastv) r_ = d.lastv - 1; \
        const size_t off_ = ((size_t)(t_ - d.ntc) * 64 + r_) * ZLD + lch * 8; stK[i_] = *(const u32x4*)(d.kz + off_); stV[i_] = *(const u32x4*)(d.vz + off_); } } } while (0)
#define AT_WRITE(IT, BUF) do { _Pragma("unroll") for (int i_ = 0; i_ < 2; ++i_) { const int t_ = 2 * (IT) + i_; if (t_ < d.nt) { u32x4 kk_, vv_; if (t_ >= d.ntc) { kk_ = stK[i_]; vv_ = stV[i_]; } else { \
        const size_t off_ = ((size_t)t_ * 64 + lrow) * d.cp + lch * 8; const f32x4 a_ = *(const f32x4*)(d.kc + off_), b_ = *(const f32x4*)(d.kc + off_ + 4), c_ = *(const f32x4*)(d.vc + off_), e_ = *(const f32x4*)(d.vc + off_ + 4); \
        kk_ = (u32x4){cvtpk(a_[0], a_[1]), cvtpk(a_[2], a_[3]), cvtpk(b_[0], b_[1]), cvtpk(b_[2], b_[3])}; vv_ = (u32x4){cvtpk(c_[0], c_[1]), cvtpk(c_[2], c_[3]), cvtpk(e_[0], e_[1]), cvtpk(e_[2], e_[3])}; } \
        *(LAS u32x4*)((BUF) + i_ * TILE_BYTES + kwoff) = kk_; *(LAS u32x4*)((BUF) + i_ * TILE_BYTES + KT_BYTES + vwoff) = vv_; } } } while (0)
    AT_ISSUE(0);
    for (int it = 0; it < nit; ++it) {
        const ldsp buf = lds + (it & 1) * BUF_BYTES;
        AT_WRITE(it, buf);
        __builtin_amdgcn_s_waitcnt(0);
        __syncthreads();
        if (it + 1 < nit) AT_ISSUE(it + 1);
        const int t = 2 * it + ks;
        if (t >= tlo && t <= thi) {
            const ldsp Kt = buf + ks * TILE_BYTES, Vt = Kt + KT_BYTES;
            const int valid = (t == d.nt - 1) ? d.lastv : 64;
            f32x16 S0[NMAP], S1[NMAP];
#define AT_QK(MP) do { f32x16 negm_; _Pragma("unroll") for (int i = 0; i < 16; ++i) negm_[i] = -mref[MP]; \
                _Pragma("unroll") for (int st = 0; st < NSTEP; ++st) { \
                    const bf16x8 a0_ = *(const LAS bf16x8*)(Kt + kroff + ((MP) * 32 + st * 16) * 2); \
                    const bf16x8 a1_ = *(const LAS bf16x8*)(Kt + kroff + 32 * KPITCH + ((MP) * 32 + st * 16) * 2); \
                    if (st == 0) { S0[MP] = MFMA32(a0_, qf[MP][st], negm_); S1[MP] = MFMA32(a1_, qf[MP][st], negm_); } \
                    else { S0[MP] = MFMA32(a0_, qf[MP][st], S0[MP]); S1[MP] = MFMA32(a1_, qf[MP][st], S1[MP]); } } \
                if (MODE == 1) { const int qpos = d.qpos0 + 32 * qg + r32, kp0 = d.kpos0 + 64 * t; \
                    if (d.qpos0 + 32 * qg - (kp0 + 63) >= 128) { const float c = tab[256]; _Pragma("unroll") for (int i = 0; i < 16; ++i) { S0[MP][i] += c; S1[MP][i] += c; } } \
                    else { _Pragma("unroll") for (int i = 0; i < 16; ++i) { int dd = qpos - (kp0 + crow(i, hi)); int d0 = min(max(dd, -128), 128), d1 = min(max(dd - 32, -128), 128); S0[MP][i] += tab[d0 + 128]; S1[MP][i] += tab[d1 + 128]; } } } \
                if (valid < 64) { _Pragma("unroll") for (int i = 0; i < 16; ++i) { const int k = crow(i, hi); if (k >= valid) S0[MP][i] = NEG_BIG; if (k + 32 >= valid) S1[MP][i] = NEG_BIG; } } } while (0)
#define AT_SLOW(MP) do { asm volatile("s_nop 15\n\ts_nop 7" : "+v"(S0[MP]), "+v"(S1[MP])); \
                float ra_ = max3f(S0[MP][0], S0[MP][1], S1[MP][0]), rb_ = max3f(S0[MP][2], S0[MP][3], S1[MP][1]); ra_ = max3f(ra_, S1[MP][2], S1[MP][3]); \
                _Pragma("unroll") for (int i = 4; i < 16; i += 4) { ra_ = max3f(ra_, S0[MP][i], S0[MP][i + 1]); rb_ = max3f(rb_, S0[MP][i + 2], S0[MP][i + 3]); ra_ = max3f(ra_, S1[MP][i], S1[MP][i + 1]); rb_ = max3f(rb_, S1[MP][i + 2], S1[MP][i + 3]); } \
                const float rm_ = xhalf_max(max2f(ra_, rb_)); \
                const float dl_ = started ? fmaxf(rm_, 0.f) : rm_, al_ = started ? __builtin_amdgcn_exp2f(-dl_) : 1.f; \
                mref[MP] += dl_; lsum[MP] *= al_; \
                _Pragma("unroll") for (int i = 0; i < 16; ++i) { S0[MP][i] -= dl_; S1[MP][i] -= dl_; } \
                _Pragma("unroll") for (int db = 0; db < 2; ++db) _Pragma("unroll") for (int i = 0; i < 16; ++i) O[MP][db][i] *= al_; } while (0)
#define AT_EXPSUM(MP) do { sa = 0.f; sb = 0.f; \
                _Pragma("unroll") for (int i = 0; i < 16; ++i) { S0[MP][i] = __builtin_amdgcn_exp2f(S0[MP][i]); S1[MP][i] = __builtin_amdgcn_exp2f(S1[MP][i]); } \
                _Pragma("unroll") for (int i = 0; i < 16; i += 8) { sa = sum8_s(sa, S0[MP][i], S0[MP][i + 1], S0[MP][i + 2], S0[MP][i + 3], S0[MP][i + 4], S0[MP][i + 5], S0[MP][i + 6], S0[MP][i + 7]); \
                    sb = sum8_s(sb, S1[MP][i], S1[MP][i + 1], S1[MP][i + 2], S1[MP][i + 3], S1[MP][i + 4], S1[MP][i + 5], S1[MP][i + 6], S1[MP][i + 7]); } } while (0)
#define AT_CVT(MP) do { _Pragma("unroll") for (int s_ = 0; s_ < 2; ++s_) { \
                u32x4 w0_ = {cvtpk(S0[MP][8 * s_], S0[MP][8 * s_ + 1]), cvtpk(S0[MP][8 * s_ + 2], S0[MP][8 * s_ + 3]), cvtpk(S0[MP][8 * s_ + 4], S0[MP][8 * s_ + 5]), cvtpk(S0[MP][8 * s_ + 6], S0[MP][8 * s_ + 7])}; \
                u32x4 w1_ = {cvtpk(S1[MP][8 * s_], S1[MP][8 * s_ + 1]), cvtpk(S1[MP][8 * s_ + 2], S1[MP][8 * s_ + 3]), cvtpk(S1[MP][8 * s_ + 4], S1[MP][8 * s_ + 5]), cvtpk(S1[MP][8 * s_ + 6], S1[MP][8 * s_ + 7])}; \
                Pf[s_] = __builtin_bit_cast(bf16x8, w0_); Pf[2 + s_] = __builtin_bit_cast(bf16x8, w1_); } } while (0)
#define AT_VF(J) ({ const s16x4 lo_ = vfr[2 * (J)], hh_ = vfr[2 * (J) + 1]; (bf16x8){lo_[0], lo_[1], lo_[2], lo_[3], hh_[0], hh_[1], hh_[2], hh_[3]}; })
#define AT_VLOAD() do { _Pragma("unroll") for (int j_ = 0; j_ < 8; ++j_) { vfr[2 * j_] = vtr(Vt + vroff + (j_ & 1) * 4096 + (j_ >> 1) * 1024); vfr[2 * j_ + 1] = vtr(Vt + vroff + (j_ & 1) * 4096 + (j_ >> 1) * 1024 + 512); } } while (0)
#define SBAR() __builtin_amdgcn_sched_barrier(0)
            float sa, sb; bf16x8 Pf[4]; s16x4 vfr[16];
            AT_QK(0);
            if (!started) AT_SLOW(0);
            if (NMAP == 2) {
                constexpr int M1 = NMAP - 1;
                bf16x8 kf1[4]; f32x16 negm1;
#pragma unroll
                for (int st = 0; st < 2; ++st) { kf1[2 * st] = *(const LAS bf16x8*)(Kt + kroff + (32 + st * 16) * 2); kf1[2 * st + 1] = *(const LAS bf16x8*)(Kt + kroff + 32 * KPITCH + (32 + st * 16) * 2); }
#pragma unroll
                for (int i = 0; i < 16; ++i) negm1[i] = -mref[M1];
                sa = 0.f; sb = 0.f;
                SBAR();
#pragma unroll
                for (int g = 0; g < 4; ++g) {
                    if (g == 0) S0[M1] = MFMA32(kf1[0], qf[M1][0], negm1); else if (g == 1) S1[M1] = MFMA32(kf1[1], qf[M1][0], negm1);
                    else if (g == 2) S0[M1] = MFMA32(kf1[2], qf[M1][1], S0[M1]); else S1[M1] = MFMA32(kf1[3], qf[M1][1], S1[M1]);
                    SBAR();
#pragma unroll
                    for (int i = 4 * g; i < 4 * g + 4; ++i) { S0[0][i] = __builtin_amdgcn_exp2f(S0[0][i]); S1[0][i] = __builtin_amdgcn_exp2f(S1[0][i]); }
                    if (g & 1) sb = sum8_s(sb, S0[0][4 * g], S0[0][4 * g + 1], S0[0][4 * g + 2], S0[0][4 * g + 3], S1[0][4 * g], S1[0][4 * g + 1], S1[0][4 * g + 2], S1[0][4 * g + 3]);
                    else sa = sum8_s(sa, S0[0][4 * g], S0[0][4 * g + 1], S0[0][4 * g + 2], S0[0][4 * g + 3], S1[0][4 * g], S1[0][4 * g + 1], S1[0][4 * g + 2], S1[0][4 * g + 3]);
                    SBAR();
                }
                if (valid < 64) {
#pragma unroll
                    for (int i = 0; i < 16; ++i) { const int k = crow(i, hi); if (k >= valid) S0[M1][i] = NEG_BIG; if (k + 32 >= valid) S1[M1][i] = NEG_BIG; } }
            } else AT_EXPSUM(0);
            if (started && __any(!(sa + sb <= 256.0f))) { AT_QK(0); AT_SLOW(0); AT_EXPSUM(0); }
            lsum[0] += sa + sb;
            AT_VLOAD();
            AT_CVT(0);
            if (NMAP == 2) {
                constexpr int M1 = NMAP - 1;
                if (!started) AT_SLOW(M1);
                sa = 0.f; sb = 0.f;
                SBAR();
#pragma unroll
                for (int j = 0; j < 8; ++j) {
                    O[0][j & 1] = MFMA32(AT_VF(j), Pf[j >> 1], O[0][j & 1]);
                    SBAR();
                    S0[M1][2 * j] = __builtin_amdgcn_exp2f(S0[M1][2 * j]); S0[M1][2 * j + 1] = __builtin_amdgcn_exp2f(S0[M1][2 * j + 1]);
                    S1[M1][2 * j] = __builtin_amdgcn_exp2f(S1[M1][2 * j]); S1[M1][2 * j + 1] = __builtin_amdgcn_exp2f(S1[M1][2 * j + 1]);
                    if (j & 1) sb = sum4_s(sb, S0[M1][2 * j], S0[M1][2 * j + 1], S1[M1][2 * j], S1[M1][2 * j + 1]); else sa = sum4_s(sa, S0[M1][2 * j], S0[M1][2 * j + 1], S1[M1][2 * j], S1[M1][2 * j + 1]);
                    SBAR();
                }
                if (started && __any(!(sa + sb <= 256.0f))) { AT_QK(M1); AT_SLOW(M1); AT_EXPSUM(M1); }
                lsum[M1] += sa + sb;
                AT_CVT(M1);
                SBAR();
#pragma unroll
                for (int j = 0; j < 8; ++j) O[M1][j & 1] = MFMA32(AT_VF(j), Pf[j >> 1], O[M1][j & 1]);
            } else {
#pragma unroll
                for (int j = 0; j < 8; ++j) O[0][j & 1] = MFMA32(AT_VF(j), Pf[j >> 1], O[0][j & 1]);
            }
#undef AT_SLOW
#undef AT_EXPSUM
#undef AT_CVT
#undef AT_VF
#undef AT_VLOAD
#undef SBAR
            started = true;
#undef AT_QK
        }
    }
#undef AT_ISSUE
#undef AT_WRITE
    __syncthreads();
    if (!started) {
#pragma unroll
        for (int mp = 0; mp < NMAP; ++mp) mref[mp] = NEG_BIG;
    }
    const ldsp cw = lds + COMB_OFF + qg * COMB_WAVE;
    if (ks == 1 && qg < d.nqg) {
#pragma unroll
        for (int mp = 0; mp < NMAP; ++mp) {
#pragma unroll
            for (int db = 0; db < 2; ++db)
#pragma unroll
                for (int i = 0; i < 16; ++i) *(LAS float*)(cw + ((mp * 2 + db) * 16 + i) * 256 + lane * 4) = O[mp][db][i];
            *(LAS float*)(cw + 16384 + (mp * 2) * 256 + lane * 4) = mref[mp]; *(LAS float*)(cw + 16384 + (mp * 2 + 1) * 256 + lane * 4) = lsum[mp];
        }
    }
    __syncthreads();
    if (ks == 0 && qg < d.nqg) {
        float linv[NMAP];
#pragma unroll
        for (int mp = 0; mp < NMAP; ++mp) {
            const float mb = *(const LAS float*)(cw + 16384 + (mp * 2) * 256 + lane * 4), lb = *(const LAS float*)(cw + 16384 + (mp * 2 + 1) * 256 + lane * 4);
            const float mt = fmaxf(mref[mp], mb), aa = __builtin_amdgcn_exp2f(mref[mp] - mt), ab = __builtin_amdgcn_exp2f(mb - mt);
            const float l = xhalf_sum(lsum[mp] * aa + lb * ab);
            linv[mp] = 1.0f / l;
#pragma unroll
            for (int db = 0; db < 2; ++db)
#pragma unroll
                for (int i = 0; i < 16; ++i) O[mp][db][i] = O[mp][db][i] * aa + *(const LAS float*)(cw + ((mp * 2 + db) * 16 + i) * 256 + lane * 4) * ab;
        }
        float fin = 1.f;
        if (MODE == 0) {
            const float i1 = linv[0], i2 = lam * linv[NMAP - 1]; float ss = 0.f;
#pragma unroll
            for (int db = 0; db < 2; ++db)
#pragma unroll
                for (int i = 0; i < 16; ++i) { const float o = O[0][db][i] * i1 - O[NMAP - 1][db][i] * i2; O[0][db][i] = o; ss += o * o; }
            ss = xhalf_sum(ss);
            fin = __builtin_amdgcn_rsqf(ss * (1.0f / 64.0f) + 1e-5f) * oml;
        } else fin = linv[0];
        const int row = 32 * qg + r32;
        if (row < d.nq) {
#pragma unroll
            for (int db = 0; db < 2; ++db)
#pragma unroll
                for (int g4 = 0; g4 < 4; ++g4) {
                    const int d0 = 32 * db + 8 * g4 + 4 * hi;
                    const u32x2 gw = *(const u32x2*)(d.gate + (size_t)row * ZLD + d0);
                    f32x4 sg = {1.f, 1.f, 1.f, 1.f}; if (MODE == 0) sg = *(const f32x4*)(subg + d0);
                    const float y0 = O[0][db][4 * g4] * fin * sg[0] * bf_lo(gw.x), y1 = O[0][db][4 * g4 + 1] * fin * sg[1] * bf_hi(gw.x);
                    const float y2 = O[0][db][4 * g4 + 2] * fin * sg[2] * bf_lo(gw.y), y3 = O[0][db][4 * g4 + 3] * fin * sg[3] * bf_hi(gw.y);
                    *(u32x2*)(d.y + (size_t)row * 1024 + d0) = (u32x2){cvtpk(y0, y1), cvtpk(y2, y3)};
                }
        }
    }
}
using namespace pg8;
constexpr size_t WS_CTL = WSO_CTL, CTL_BYTES = 1u << 20, WS_SSQ0 = WSO_SSQ0, WS_ROPE = WSO_ROPE, WS_WIN = WSO_WIN, WS_WOUT = WSO_WOUT, WS_XB = WSO_XB, WS_YMIX = WSO_YMIX, WS_X1 = WSO_X1, WS_Z = WSO_Z, WS_END = WSO_END;
static_assert((size_t)MROWS * 1024 * 2 <= 36u * (1u << 20) && (size_t)MROWS * 1024 * 4 <= 68u * (1u << 20) && (size_t)MROWS * 4096 * 2 <= 132u * (1u << 20), "ws map");
constexpr int CTL_Q0 = 0, CTL_SI = 64, CTL_SM = 128, CTL_SSQ1 = 16384, CTL_SSQ2 = 16384 + 32768;
static_assert((CTL_SSQ2 + MROWS) * 4 <= (int)CTL_BYTES, "ctl");
constexpr size_t O_Y = OO_Y, O_CONVP = OO_CONVP, O_CONVS = OO_CONVS, O_END = OO_END;
struct Args { const float* in[18]; float* out; unsigned char* ws; };

__device__ __forceinline__ float wave_sum(float v) {
#pragma unroll
    for (int o = 1; o < 64; o <<= 1) v += __shfl_xor(v, o);
    return v;
}
__device__ __forceinline__ unsigned f2bf(float f) { unsigned u = __builtin_bit_cast(unsigned, f); return (u + 0x7fffu + ((u >> 16) & 1u)) >> 16; }
__device__ __forceinline__ unsigned pk2(float lo, float hi) { return f2bf(lo) | (f2bf(hi) << 16); }
__device__ __forceinline__ void p0_transpose_item(const float* W, const float* g, int K, int N, bf16_t* WT, LAS float* scr, int item, int lane) {
    const int nblk = N / 32, kb = item / nblk, nb = item % nblk, k0 = 64 * kb, n0 = 32 * nb;
#pragma unroll 8
    for (int i = 0; i < 32; ++i) { const int kk = 2 * i + (lane >> 5); const float gs = g ? g[k0 + kk] : 1.f; scr[kk * 33 + (lane & 31)] = W[(size_t)(k0 + kk) * N + n0 + (lane & 31)] * gs; }
    asm volatile("s_waitcnt lgkmcnt(0)" ::: "memory");
    const int c = lane & 7;
#pragma unroll
    for (int j = 0; j < 4; ++j) { const int n = (lane >> 3) + 8 * j; const LAS float* s = scr + (8 * c) * 33 + n;
        u32x4 o; o.x = pk2(s[0 * 33], s[1 * 33]); o.y = pk2(s[2 * 33], s[3 * 33]); o.z = pk2(s[4 * 33], s[5 * 33]); o.w = pk2(s[6 * 33], s[7 * 33]);
        *(u32x4*)(WT + (size_t)(n0 + n) * K + k0 + 8 * c) = o; }
    asm volatile("s_waitcnt lgkmcnt(0)" ::: "memory");
}

__global__ void __launch_bounds__(512) fwd_megakernel(Args args) {
    extern __shared__ __attribute__((aligned(16))) unsigned char lds_raw[];
    cg::grid_group grid = cg::this_grid();
    const ldsp lds = (ldsp)lds_raw;
    const int tid = threadIdx.x, lane = tid & 63, wave = __builtin_amdgcn_readfirstlane(tid >> 6);
    const int G = gridDim.x, bx = blockIdx.x;
    unsigned char* ws = args.ws; float* out = args.out;
    unsigned* ctl = (unsigned*)(ws + WS_CTL);
    float* SSQ0 = (float*)(ws + WS_SSQ0); float* SSQ1 = (float*)ctl + CTL_SSQ1; float* SSQ2 = (float*)ctl + CTL_SSQ2;
    float* ROPE = (float*)(ws + WS_ROPE);
    bf16_t* WIN = (bf16_t*)(ws + WS_WIN); bf16_t* WOUT = (bf16_t*)(ws + WS_WOUT);
    bf16_t* XB = (bf16_t*)(ws + WS_XB); bf16_t* YMIX = (bf16_t*)(ws + WS_YMIX); float* X1 = (float*)(ws + WS_X1); bf16_t* Z = (bf16_t*)(ws + WS_Z);
    const float* x_p = args.in[0]; const float* x_s = args.in[1];

    {
        LAS float* scr = (LAS float*)(lds + wave * 16384);
        const int gw = bx * 8 + wave, NGW = G * 8;
        constexpr int I_IN = (1024 / 64) * (4096 / 32), I_OUT = (1024 / 64) * (1024 / 32), NITEMS = 2 * I_IN + 2 * I_OUT;
        for (int it = gw; it < NITEMS; it += NGW) {
            int r = it;
            if (r < 2 * I_IN) { const int l = r / I_IN; r -= l * I_IN; p0_transpose_item(args.in[8] + (size_t)l * 1024 * 4096, args.in[7] + l * 1024, 1024, 4096, WIN + (size_t)l * 4096 * 1024, scr, r, lane); }
            else { r -= 2 * I_IN; const int l = r / I_OUT; r -= l * I_OUT; p0_transpose_item(args.in[9] + (size_t)l * 1024 * 1024, nullptr, 1024, 1024, WOUT + (size_t)l * 1024 * 1024, scr, r, lane); }
        }
        for (int m = gw; m < MROWS; m += NGW) {
            const float* xr = (m < NPROMPT) ? x_p + (size_t)m * 1024 : x_s + (size_t)(m - NPROMPT) * 1024;
            f32x4 v[4]; float s = 0.f;
#pragma unroll
            for (int j = 0; j < 4; ++j) { v[j] = *((const f32x4*)xr + lane + 64 * j); s += (v[j][0] * v[j][0] + v[j][1] * v[j][1]) + (v[j][2] * v[j][2] + v[j][3] * v[j][3]); }
            s = wave_sum(s);
            if (lane == 0) SSQ0[m] = s;
#pragma unroll
            for (int j = 0; j < 4; ++j) *((u32x2*)(XB + (size_t)m * 1024) + lane + 64 * j) = (u32x2){cvtpk(v[j][0], v[j][1]), cvtpk(v[j][2], v[j][3])};
        }
        for (int e = bx * 512 + tid; e < MROWS * 4; e += G * 512) {
            const int row = e >> 2, i = e & 3; const int pos = (row < NPROMPT) ? row : 4096 + ((row - NPROMPT) & 15);
            const float invf = (i == 0) ? 1.0f : (i == 1 ? 0.037606030930863934f : (i == 2 ? 0.0014142135623730950f : 5.318295896944988e-05f));
            const float ang = (float)pos * invf;
            const double rev = (double)ang * 0.15915494309189535; const float fr = (float)(rev - __builtin_rint(rev));
            ROPE[(size_t)row * 8 + i] = __builtin_amdgcn_cosf(fr); ROPE[(size_t)row * 8 + 4 + i] = __builtin_amdgcn_sinf(fr);
        }
    }
    grid.sync();

    for (int l = 0; l < 2; ++l) {
        {
            pg8::Gemm g{XB, WIN + (size_t)l * 4096 * 1024, NPROMPT, 4096, 1024}; pg8::StaticOrder S; S.init(NPROMPT, 4096, G, bx);
            pg8::EpiIn E{ws, out, l};

#ifndef NO_GEMM1
            pg8::gemm_phase<pg8::EpiIn, pg8::StaticOrder, true, true>(lds, g, S, E);
#ifdef PROBE_P1X
            if (l == 0) { grid.sync(); pg8::gemm_phase<pg8::EpiIn, pg8::StaticOrder, true, true>(lds, g, S, E); }
#endif
#endif

        }
        grid.sync();
        {
            const float lam_init = (l == 0) ? 0.2f : 0.35550906759096927f;
            float d1 = 0.f, d2 = 0.f;
            for (int i = 0; i < 32; ++i) { d1 += args.in[12][l * 32 + i] * args.in[13][l * 32 + i]; d2 += args.in[14][l * 32 + i] * args.in[15][l * 32 + i]; }
            const float lam = __expf(d1) - __expf(d2) + lam_init, oml = 1.0f - lam_init;
            const float* subg = args.in[16] + l * 64;
            volatile LAS int* misc = (volatile LAS int*)(lds + MISC_OFF);
            constexpr int N_SI = 16, N_PC = 512, N_SC = 64, N_PA = 1024, N_SA = 128, N_CV = 130, N_SO = 4, N_TOT = N_SI + N_PC + N_SC + N_PA + N_SA + N_CV + N_SO;
            constexpr unsigned N_SMIX = N_SC + N_SA + 2;
#ifndef PROBE_P2X
#define PROBE_P2X 1
#endif
            for (int rep = 0; rep < ((l == 0) ? PROBE_P2X : 1); ++rep) {
            if (rep > 0) grid.sync();
            for (;;) {
                __syncthreads();
                if (tid == 0) misc[0] = (int)atomicAdd(ctl + CTL_Q0 + l + 2 * rep, 1u);
                __syncthreads();
                int ui = misc[0]; ui = __builtin_amdgcn_readfirstlane(ui);
                if (ui >= N_TOT) break;
                AU d; d.kc = nullptr; d.vc = nullptr; d.cp = 0; d.ntc = 0; d.lastv = 64; d.nqg = 4; d.tlo1 = 0; d.thi1 = -1; d.qpos0 = 0; d.kpos0 = 0;
                int kind;
                int idx = ui;
                if (idx < 16) kind = 5; else if (idx < 256) { kind = 0; idx -= 16; } else if (idx < 320) { kind = 1; idx -= 256; } else if (idx < 448) { kind = 3; idx -= 320; } else if (idx < 450) { kind = 4; idx = 128 + (idx - 448); }
                else if (idx < 454) { kind = 6; idx -= 450; } else if (idx < 726) { kind = 0; idx = 240 + (idx - 454); } else if (idx < 1750) { kind = 2; idx -= 726; } else { kind = 4; idx -= 1750; }
#ifdef PROBE_ONLY_KIND
                if (rep > 0 && kind != PROBE_ONLY_KIND) continue;
#endif
                if (rep > 0 && kind >= 5) continue;
                const bool smp_unit = (kind == 1 || kind == 3 || (kind == 4 && idx >= 128));
                if (smp_unit || kind == 6) {
                    if (tid == 0) {
                        unsigned* cnt = ctl + (kind == 6 ? CTL_SM : CTL_SI) + l; const unsigned want = (kind == 6) ? N_SMIX : (unsigned)N_SI;
                        while (__hip_atomic_load(cnt, __ATOMIC_RELAXED, __HIP_MEMORY_SCOPE_AGENT) < want) __builtin_amdgcn_s_sleep(8);
                        __builtin_amdgcn_fence(__ATOMIC_ACQUIRE, "agent");
                        asm volatile("s_waitcnt vmcnt(0)" ::: "memory");
                    }
                    __syncthreads();
                }
                if (kind >= 5) {
                    if (kind == 5) { pg8::Gemm g{XB, WIN + (size_t)l * 4096 * 1024, MROWS, 4096, 1024}; pg8::OneUnit S{64, idx}; pg8::EpiIn E{ws, out, l};
                        pg8::gemm_phase<pg8::EpiIn, pg8::OneUnit, false, true>(lds, g, S, E); }
                    else { pg8::Gemm g{YMIX, WOUT + (size_t)l * 1024 * 1024, MROWS, 1024, 1024}; pg8::OneUnit S{64, idx}; pg8::EpiOut E{ws, x_p, x_s, l, args.in[17], out};
                        pg8::gemm_phase<pg8::EpiOut, pg8::OneUnit, false, true>(lds, g, S, E); }
                }
                else if (kind == 0) {
                    const int u = 127 - (idx >> 2), h = idx & 3; const size_t r0 = (size_t)128 * u;
                    d.q = Z + r0 * ZLD + 3072 + 64 * h; d.nq = 128; d.nt = 2 * u + 2; d.kz = Z + 3328 + 64 * h; d.vz = Z + 3584 + 64 * h;
                    d.tlo0 = 0; d.thi0 = d.nt - 2; d.tlo1 = 0; d.thi1 = d.nt - 1; d.gate = Z + r0 * ZLD + 3840 + 64 * h; d.y = YMIX + r0 * 1024 + 768 + 64 * h;

#ifndef NO_ATTN0
                    attn_unit<0>(d, lds, lam, oml, subg);
#endif

                } else if (kind == 1) {
                    const int b = idx >> 2, h = idx & 3; const size_t r0 = (size_t)NPROMPT + 16 * b;
                    d.q = Z + r0 * ZLD + 3072 + 64 * h; d.nq = 16; d.nt = 65; d.ntc = 64; d.cp = 256;
                    d.kc = args.in[5] + ((size_t)(l * 16 + b) * 4096) * 256 + 64 * h; d.vc = args.in[6] + ((size_t)(l * 16 + b) * 4096) * 256 + 64 * h;
                    d.kz = Z + r0 * ZLD + 3328 + 64 * h; d.vz = Z + r0 * ZLD + 3584 + 64 * h; d.lastv = 16; d.nqg = 1; d.tlo0 = 0; d.thi0 = 64;
                    d.gate = Z + r0 * ZLD + 3840 + 64 * h; d.y = YMIX + r0 * 1024 + 768 + 64 * h;

#ifndef NO_ATTN0
                    attn_unit<0>(d, lds, lam, oml, subg);
#endif

                } else if (kind == 2 || kind == 3) {
                    int h;
                    if (kind == 2) {
                        h = idx & 7; const int cp = idx >> 3, c0 = max(0, 2 * cp - 8); const size_t r0 = (size_t)128 * cp;
                        d.q = Z + r0 * ZLD + 64 * h; d.nq = 128; d.nt = 2 * cp + 2 - c0; d.kz = Z + (size_t)64 * c0 * ZLD + 512 + 64 * h; d.vz = Z + (size_t)64 * c0 * ZLD + 1024 + 64 * h;
                        d.tlo0 = 0; d.thi0 = 2 * cp - c0; d.tlo1 = max(0, 2 * cp + 1 - 8) - c0; d.thi1 = 2 * cp + 1 - c0; d.qpos0 = 128 * cp; d.kpos0 = 64 * c0;
                        d.gate = Z + r0 * ZLD + 1536 + 64 * h; d.y = YMIX + r0 * 1024 + 64 * h;
                    } else {
                        h = idx & 7; const int b = idx >> 3; const size_t r0 = (size_t)NPROMPT + 16 * b;
                        d.q = Z + r0 * ZLD + 64 * h; d.nq = 16; d.nt = 9; d.ntc = 8; d.cp = 512;
                        d.kc = args.in[2] + ((size_t)(l * 16 + b) * 512) * 512 + 64 * h; d.vc = args.in[3] + ((size_t)(l * 16 + b) * 512) * 512 + 64 * h;
                        d.kz = Z + r0 * ZLD + 512 + 64 * h; d.vz = Z + r0 * ZLD + 1024 + 64 * h; d.lastv = 16; d.nqg = 1; d.tlo0 = 0; d.thi0 = 8; d.qpos0 = 512; d.kpos0 = 0;
                        d.gate = Z + r0 * ZLD + 1536 + 64 * h; d.y = YMIX + r0 * 1024 + 64 * h;
                    }
                    if (tid < 257) ((LAS float*)(lds + TAB_OFF))[tid] = args.in[10][(size_t)(l * 8 + h) * 257 + tid] * LOG2E;

#ifndef NO_ATTN1
                    attn_unit<1>(d, lds, 0.f, 0.f, nullptr);
#endif

                } else {
                    int tq_ = threadIdx.x; asm volatile("" : "+v"(tq_));
                    const int c8 = (tq_ & 31) * 8, rr = tq_ >> 5;
                    const float* cw = args.in[11] + (size_t)l * 3 * 256 + c8;
                    float w0[8], w1[8], w2[8];
#pragma unroll
                    for (int j = 0; j < 8; ++j) { w0[j] = cw[j]; w1[j] = cw[256 + j]; w2[j] = cw[512 + j]; }
                    for (int g = 0; g < 8; ++g) {
                        const int row = 128 * idx + 16 * g + rr; const bool smp = row >= NPROMPT; const int t = smp ? ((row - NPROMPT) & 15) : row, b = (row - NPROMPT) >> 4;
                        const bf16_t* zr = Z + (size_t)row * ZLD;
                        float u0[8], u1[8], u2[8];
                        { const u32x4 c = *(const u32x4*)(zr + 2304 + c8), hh = *(const u32x4*)(zr + 2560 + c8);
#pragma unroll
                          for (int j = 0; j < 4; ++j) { u0[2 * j] = bf_lo(c[j]) * bf_lo(hh[j]); u0[2 * j + 1] = bf_hi(c[j]) * bf_hi(hh[j]); } }
                        if (t >= 1) { const u32x4 c = *(const u32x4*)(zr - ZLD + 2304 + c8), hh = *(const u32x4*)(zr - ZLD + 2560 + c8);
#pragma unroll
                          for (int j = 0; j < 4; ++j) { u1[2 * j] = bf_lo(c[j]) * bf_lo(hh[j]); u1[2 * j + 1] = bf_hi(c[j]) * bf_hi(hh[j]); } }
                        else if (smp) { const float* sp = args.in[4] + ((size_t)(l * 16 + b) * 2 + 1) * 256 + c8;
#pragma unroll
                          for (int j = 0; j < 8; ++j) u1[j] = sp[j]; }
                        else {
#pragma unroll
                          for (int j = 0; j < 8; ++j) u1[j] = 0.f; }
                        if (t >= 2) { const u32x4 c = *(const u32x4*)(zr - 2 * ZLD + 2304 + c8), hh = *(const u32x4*)(zr - 2 * ZLD + 2560 + c8);
#pragma unroll
                          for (int j = 0; j < 4; ++j) { u2[2 * j] = bf_lo(c[j]) * bf_lo(hh[j]); u2[2 * j + 1] = bf_hi(c[j]) * bf_hi(hh[j]); } }
                        else if (smp) { const float* sp = args.in[4] + ((size_t)(l * 16 + b) * 2 + t) * 256 + c8;
#pragma unroll
                          for (int j = 0; j < 8; ++j) u2[j] = sp[j]; }
                        else {
#pragma unroll
                          for (int j = 0; j < 8; ++j) u2[j] = 0.f; }
                        const u32x4 bb = *(const u32x4*)(zr + 2048 + c8), bg = *(const u32x4*)(zr + 2816 + c8);
                        float y[8];
#pragma unroll
                        for (int j = 0; j < 4; ++j) {
                            y[2 * j] = bf_lo(bb[j]) * (u2[2 * j] * w0[2 * j] + u1[2 * j] * w1[2 * j] + u0[2 * j] * w2[2 * j]) * bf_lo(bg[j]);
                            y[2 * j + 1] = bf_hi(bb[j]) * (u2[2 * j + 1] * w0[2 * j + 1] + u1[2 * j + 1] * w1[2 * j + 1] + u0[2 * j + 1] * w2[2 * j + 1]) * bf_hi(bg[j]); }
                        *(u32x4*)(YMIX + (size_t)row * 1024 + 512 + c8) = (u32x4){cvtpk(y[0], y[1]), cvtpk(y[2], y[3]), cvtpk(y[4], y[5]), cvtpk(y[6], y[7])};
                        float* so = nullptr;
                        if (!smp && row >= NPROMPT - 2) so = out + O_CONVP + (size_t)l * 512 + (size_t)(row - (NPROMPT - 2)) * 256 + c8;
                        if (smp && t >= 14) so = out + O_CONVS + (size_t)l * 8192 + (size_t)b * 512 + (size_t)(t - 14) * 256 + c8;
                        if (so) { *(f32x4*)so = (f32x4){u0[0], u0[1], u0[2], u0[3]}; *(f32x4*)(so + 4) = (f32x4){u0[4], u0[5], u0[6], u0[7]}; }
                    }
                }
                if (smp_unit || kind == 5) {
                    asm volatile("s_waitcnt vmcnt(0)" ::: "memory");
                    __syncthreads();
                    if (tid == 0) { __builtin_amdgcn_fence(__ATOMIC_RELEASE, "agent"); asm volatile("s_waitcnt vmcnt(0)" ::: "memory");
                        __hip_atomic_fetch_add(ctl + (kind == 5 ? CTL_SI : CTL_SM) + l, 1u, __ATOMIC_RELAXED, __HIP_MEMORY_SCOPE_AGENT); }
                }
            }
            }
        }
        grid.sync();
        {
            pg8::Gemm g{YMIX, WOUT + (size_t)l * 1024 * 1024, NPROMPT, 1024, 1024}; pg8::StaticOrder S; S.init(NPROMPT, 1024, G, bx);
            pg8::EpiOut E{ws, x_p, x_s, l, args.in[17], out};

#ifndef NO_GEMM2
            pg8::gemm_phase<pg8::EpiOut, pg8::StaticOrder, true, true>(lds, g, S, E);
#endif

            if (l == 1 && wave == 0 && bx < MROWS - NPROMPT) {
                int ln_ = threadIdx.x & 63; asm volatile("" : "+v"(ln_));
                const int lane = ln_;
                const int m = NPROMPT + bx; const float rs = __builtin_amdgcn_rsqf(SSQ2[m] * (1.0f / 1024.0f) + 1e-6f);
#pragma unroll
                for (int j = 0; j < 4; ++j) { const f32x4 v = *((const f32x4*)(X1 + (size_t)m * 1024) + lane + 64 * j); *((f32x4*)(out + O_Y + (size_t)m * 1024) + lane + 64 * j) = v * rs * *((const f32x4*)args.in[17] + lane + 64 * j); }
            }
        }
        if (l == 0) grid.sync();
    }
}

extern "C" void kernel_launch(void* const* d_in, const int* in_sizes, int n_in, void* d_out, int out_size, void* d_ws, size_t ws_size, hipStream_t stream) {
    static int grid_blocks = 0;
    if (!grid_blocks) {
        if (n_in != 18 || (size_t)out_size != O_END || ws_size < WS_END) { fprintf(stderr, "kernel_launch: unexpected shapes n_in %d out %d ws %zu\n", n_in, out_size, ws_size); grid_blocks = -1; return; }
        int dev = 0, cus = 0, per_cu = 0;
        hipGetDevice(&dev); hipDeviceGetAttribute(&cus, hipDeviceAttributeMultiprocessorCount, dev);
        hipFuncSetAttribute((const void*)fwd_megakernel, hipFuncAttributeMaxDynamicSharedMemorySize, LDS_BYTES);
        hipOccupancyMaxActiveBlocksPerMultiprocessor(&per_cu, (const void*)fwd_megakernel, 512, LDS_BYTES);
        if (per_cu < 1) { fprintf(stderr, "kernel_launch: occupancy query says %d blocks per CU\n", per_cu); per_cu = 1; }
        if (per_cu > 1) per_cu = 1;
        grid_blocks = cus * per_cu;
    }
    if (grid_blocks < 0) return;
    hipMemsetAsync((char*)d_ws + WS_CTL, 0, CTL_BYTES, stream);
    Args a{};
    for (int i = 0; i < 18; ++i) a.in[i] = (const float*)d_in[i];
    a.out = (float*)d_out; a.ws = (unsigned char*)d_ws;
    void* kargs[] = {&a};
    hipError_t e = hipLaunchCooperativeKernel((const void*)fwd_megakernel, dim3(grid_blocks), dim3(512), kargs, LDS_BYTES, stream);
    if (e != hipSuccess) fprintf(stderr, "cooperative launch failed: %s (grid %d)\n", hipGetErrorString(e), grid_blocks);
}
```

```cpp
#include <hip/hip_runtime.h>
#include <hip/hip_cooperative_groups.h>
#include <cstdio>
#include <cstdint>
namespace cg = cooperative_groups;
namespace pg8 {
#define PG8_LAS __attribute__((address_space(3)))
typedef unsigned short bf16_t;
typedef short bf16x8 __attribute__((ext_vector_type(8)));
typedef float f32x4 __attribute__((ext_vector_type(4)));
typedef unsigned u32x4 __attribute__((ext_vector_type(4)));
constexpr int BM = 256, BK = 64, HALF = 128, HTB = HALF * BK * 2  , STAGE_BYTES = 8 * HTB, NXCD = 8, WGM = 8;

__host__ __device__ __forceinline__ int lds_byte(int r, int c) { const int st = (r >> 4) * 2 + (c >> 5), rr = r & 15, cc = c & 31, ob = rr * 64 + cc * 2; return st * 1024 + (ob ^ (((ob >> 9) & 1) << 5)); }
__host__ __device__ __forceinline__ void stage_rc(int b, int& R, int& C) { const int st = b / 1024, sb = b % 1024, swz = sb ^ (((sb >> 9) & 1) << 5); R = (st >> 1) * 16 + swz / 64; C = (st & 1) * 32 + (swz % 64) / 2; }
__host__ __device__ __forceinline__ int perm32(int rho) { const int n = rho >> 4, i = rho & 15; return 8 * (i >> 2) + 4 * n + (i & 3); }

struct Unit { int pm, pn; };
struct Gemm { const bf16_t* A; const bf16_t* Bt; int M, N, K; };

struct StaticOrder {
    int nM, nN, nwg, G, c;
    __host__ __device__ void init(int M, int N, int G_, int c_) { nM = M / BM; nN = N / BM; nwg = nM * nN; G = G_; c = c_; }
    __host__ __device__ bool next(int i, Unit& u) const {
        const long L = (long)i * G + c; if (L >= nwg) return false;
        int wgid = (int)L; { const int q = nwg / NXCD, r = nwg % NXCD, xcd = wgid % NXCD, off = wgid / NXCD; wgid = (xcd < r ? xcd * (q + 1) : r * (q + 1) + (xcd - r) * q) + off; }
        const int nig = WGM * nN, gid = wgid / nig, fm = gid * WGM, gsz = (nM - fm) < WGM ? (nM - fm) : WGM;
        u.pm = fm + ((wgid % nig) % gsz); u.pn = (wgid % nig) / gsz; return true;
    }
    __device__ __forceinline__ void a_ready(const Unit&) const {}
    __device__ __forceinline__ void done(const Unit&) const {}
};
struct OneUnit {
    int pm, pn;
    __host__ __device__ bool next(int i, Unit& u) const { if (i) return false; u.pm = pm; u.pn = pn; return true; }
    __device__ __forceinline__ void a_ready(const Unit&) const {}
    __device__ __forceinline__ void done(const Unit&) const {}
};
__device__ __forceinline__ unsigned cvt_pk_bf16(float lo, float hi) { unsigned r; asm volatile("v_cvt_pk_bf16_f32 %0, %1, %2" : "=v"(r) : "v"(lo), "v"(hi)); return r; }
typedef float f32x2 __attribute__((ext_vector_type(2)));
constexpr float LOG2E = 1.4426950408889634f;
constexpr float SC_QA = 0.125f * LOG2E;
constexpr float SC_QC = 0.17677669529663687f * LOG2E;
constexpr int ZLD = 4096, MROWS = 16640, NPROMPT = 16384;
constexpr size_t WSO_MiB = 1u << 20;
constexpr size_t WSO_PANEL = 512 * 4  , WSO_CTL = 0, WSO_SSQ1 = 16384 * 4, WSO_SSQ2 = (16384 + 32768) * 4, WSO_SSQ0 = 1 * WSO_MiB, WSO_ROPE = 2 * WSO_MiB, WSO_WIN = 4 * WSO_MiB, WSO_WOUT = 20 * WSO_MiB, WSO_XB = 24 * WSO_MiB,
                 WSO_YMIX = 60 * WSO_MiB, WSO_X1 = 96 * WSO_MiB, WSO_Z = 164 * WSO_MiB, WSO_END = 296 * WSO_MiB;
constexpr size_t OO_Y = 0, OO_AKP = 17039360, OO_AVP = OO_AKP + 524288, OO_CONVP = OO_AVP + 524288, OO_CKP = OO_CONVP + 1024, OO_CVP = OO_CKP + 8388608,
                 OO_AKS = OO_CVP + 8388608, OO_AVS = OO_AKS + 262144, OO_CONVS = OO_AVS + 262144, OO_CKS = OO_CONVS + 16384, OO_CVS = OO_CKS + 131072, OO_END = OO_CVS + 131072;
__device__ __forceinline__ float silu_f(float x) { return x * __builtin_amdgcn_rcpf(1.0f + __builtin_amdgcn_exp2f(-x * LOG2E)); }
struct EpiIn {
    static constexpr bool PERM = true, AFTER_DRAIN = false;
    unsigned char* ws; float* out; int l;
    __device__ __forceinline__ void operator()(const f32x4 (&acc)[2][2][4][2], const Unit& u, int wr, int wc, int fr, int fq) const {
        const int pn = u.pn, pm = u.pm;
        bf16_t* Z = (bf16_t*)(ws + WSO_Z); const float* ssq = (const float*)(ws + (l == 0 ? WSO_SSQ0 : WSO_SSQ1)); const float* rope = (const float*)(ws + WSO_ROPE);
        float* o_ak_p = out + OO_AKP + (size_t)l * 262144; float* o_av_p = out + OO_AVP + (size_t)l * 262144; float* o_ak_s = out + OO_AKS + (size_t)l * 131072; float* o_av_s = out + OO_AVS + (size_t)l * 131072;
        float* o_ck_p = out + OO_CKP + (size_t)l * 4194304; float* o_cv_p = out + OO_CVP + (size_t)l * 4194304; float* o_ck_s = out + OO_CKS + (size_t)l * 65536; float* o_cv_s = out + OO_CVS + (size_t)l * 65536;
        const int rowl = wr * 64 + fr;
        const int colb = pn * BM + wc * 32 + 8 * fq;
        const bool rope_tile = (pn == 12 || pn == 13);
        const bool do_rope = rope_tile && fq == 0;
        const float sc = (pn < 2) ? SC_QA : (pn == 12 ? SC_QC : 1.f);
        const bool do_silu = (pn == 6 || pn == 7 || pn == 11 || pn == 15);
        float* ob = nullptr; int old = 0, ocol0 = 0;
        if (pn >= 2 && pn <= 5) { old = 512; ocol0 = (pn >= 4) ? 1024 : 512;
            if (pm == 64) ob = (pn >= 4) ? o_av_s : o_ak_s; else if (pm >= 62) ob = ((pn >= 4) ? o_av_p : o_ak_p) + (size_t)(pm - 62) * 256 * 512; }
        else if (pn == 13 || pn == 14) { old = 256; ocol0 = (pn == 13) ? 3328 : 3584;
            if (pm == 64) ob = (pn == 13) ? o_ck_s : o_cv_s; else ob = ((pn == 13) ? o_ck_p : o_cv_p) + (size_t)pm * 256 * 256; }
#pragma unroll
        for (int ai = 0; ai < 2; ++ai)
#pragma unroll
            for (int m = 0; m < 4; ++m) {
                const int rl = rowl + ai * HALF + m * 16, row = pm * BM + rl;
                const float rs = __builtin_amdgcn_rsqf(ssq[row] * (1.0f / 1024.0f) + 1e-6f);
                f32x4 rc = {1.f, 1.f, 1.f, 1.f}, rsn = {0.f, 0.f, 0.f, 0.f};
                if (do_rope) { rc = *(const f32x4*)(rope + (size_t)row * 8); rsn = *(const f32x4*)(rope + (size_t)row * 8 + 4); }
#pragma unroll
                for (int bj = 0; bj < 2; ++bj) {
                    f32x4 v0 = acc[ai][bj][m][0] * rs, v1 = acc[ai][bj][m][1] * rs;
                    const int col = colb + bj * HALF;
                    if (rope_tile) { const f32x4 a = v0 * rc - v1 * rsn, b = v1 * rc + v0 * rsn; v0 = a; v1 = b; }
                    if (ob) { float* op = ob + (size_t)rl * old + (col - ocol0); *(f32x4*)op = v0; *(f32x4*)(op + 4) = v1; }
                    if (do_silu) { v0 = (f32x4){silu_f(v0[0]), silu_f(v0[1]), silu_f(v0[2]), silu_f(v0[3])}; v1 = (f32x4){silu_f(v1[0]), silu_f(v1[1]), silu_f(v1[2]), silu_f(v1[3])}; }
                    v0 = v0 * sc; v1 = v1 * sc;
                    u32x4 w; w.x = cvt_pk_bf16(v0[0], v0[1]); w.y = cvt_pk_bf16(v0[2], v0[3]); w.z = cvt_pk_bf16(v1[0], v1[1]); w.w = cvt_pk_bf16(v1[2], v1[3]);
                    *(u32x4*)(Z + (size_t)row * ZLD + col) = w;
                }
                asm volatile("" ::: "memory");
            }
    }
};
struct EpiOut {
    static constexpr bool PERM = true, AFTER_DRAIN = false;
    unsigned char* ws; const float* x_p; const float* x_s; int l; const float* fg; float* yout;
    __device__ __forceinline__ void operator()(f32x4 (&acc)[2][2][4][2], const Unit& u, int wr, int wc, int fr, int fq) const {
        const int pm = u.pm; const int colb = u.pn * BM + wc * 32 + 8 * fq;
        float* X1 = (float*)(ws + WSO_X1) + (size_t)pm * BM * 1024; bf16_t* XB = (bf16_t*)(ws + WSO_XB) + (size_t)pm * BM * 1024; float* ssq = (float*)(ws + (l == 0 ? WSO_SSQ1 : WSO_SSQ2)) + pm * BM;
        const float* res = (l == 0) ? ((pm == 64) ? x_s : x_p + (size_t)pm * BM * 1024) : X1;
        const unsigned off0 = (unsigned)(wr * 64 + fr) * 1024u + (unsigned)colb;
        const bool fuse = (l == 1 && pm < 64);
#pragma unroll
        for (int ai = 0; ai < 2; ++ai)
#pragma unroll
            for (int m = 0; m < 4; ++m) {
                const unsigned offr = off0 + (unsigned)(ai * HALF + m * 16) * 1024u; float q = 0.f;
#pragma unroll
                for (int bj = 0; bj < 2; ++bj) { const unsigned off = offr + bj * HALF;
                    const f32x4 v0 = acc[ai][bj][m][0] + *(const f32x4*)(res + off), v1 = acc[ai][bj][m][1] + *(const f32x4*)(res + off + 4);
                    if (fuse) { acc[ai][bj][m][0] = v0; acc[ai][bj][m][1] = v1; }
                    else {
                        *(f32x4*)(X1 + off) = v0; *(f32x4*)(X1 + off + 4) = v1;
                        u32x4 w; w.x = cvt_pk_bf16(v0[0], v0[1]); w.y = cvt_pk_bf16(v0[2], v0[3]); w.z = cvt_pk_bf16(v1[0], v1[1]); w.w = cvt_pk_bf16(v1[2], v1[3]);
                        *(u32x4*)(XB + off) = w; }
                    q += (v0[0] * v0[0] + v0[1] * v0[1]) + (v0[2] * v0[2] + v0[3] * v0[3]) + (v1[0] * v1[0] + v1[1] * v1[1]) + (v1[2] * v1[2] + v1[3] * v1[3]);
                    asm volatile("" ::: "memory"); }
                q += __shfl_xor(q, 16); q += __shfl_xor(q, 32);
                if (fq == 0) atomicAdd(ssq + (wr * 64 + fr + ai * HALF + m * 16), q);
                asm volatile("" ::: "memory");
            }
        if (fuse) {
            unsigned* cnt = (unsigned*)(ws + WSO_PANEL) + 64 * pm;
            asm volatile("s_waitcnt vmcnt(0)" ::: "memory");
            if (__builtin_amdgcn_readfirstlane(fr + 16 * fq) == (fr + 16 * fq)) __hip_atomic_fetch_add(cnt, 1u, __ATOMIC_RELAXED, __HIP_MEMORY_SCOPE_AGENT);
            unsigned spins = 0;
            while (__hip_atomic_load(cnt, __ATOMIC_RELAXED, __HIP_MEMORY_SCOPE_AGENT) < 32u) { __builtin_amdgcn_s_sleep(2); if (++spins > (1u << 22)) break; }
            float* yo = yout + (size_t)pm * BM * 1024;
#pragma unroll
            for (int ai = 0; ai < 2; ++ai)
#pragma unroll
                for (int m = 0; m < 4; ++m) {
                    const int rl = wr * 64 + fr + ai * HALF + m * 16;
                    const float sq = __hip_atomic_load(ssq + rl, __ATOMIC_RELAXED, __HIP_MEMORY_SCOPE_AGENT);
                    const float rs = __builtin_amdgcn_rsqf(sq * (1.0f / 1024.0f) + 1e-6f);
                    const unsigned offr = off0 + (unsigned)(ai * HALF + m * 16) * 1024u;
#pragma unroll
                    for (int bj = 0; bj < 2; ++bj) {
                        const f32x4 g0 = *(const f32x4*)(fg + colb + bj * HALF), g1 = *(const f32x4*)(fg + colb + bj * HALF + 4);
                        *(f32x4*)(yo + offr + bj * HALF) = acc[ai][bj][m][0] * rs * g0; *(f32x4*)(yo + offr + bj * HALF + 4) = acc[ai][bj][m][1] * rs * g1;
                        asm volatile("" ::: "memory"); }
                }
        }
    }
};
template <class Epi, class Sched, bool ALIGN_EPI = false, bool SP2 = false>
__device__ __forceinline__ void gemm_phase(PG8_LAS unsigned char* lds, const Gemm g, const Sched& S, const Epi& E) {
    int tid_ = threadIdx.x; asm volatile("" : "+v"(tid_));
    const int tid = tid_, wid = __builtin_amdgcn_readfirstlane(tid >> 6), lane = tid & 63, wr = wid >> 2, wc = wid & 3, fr = lane & 15, fq = lane >> 4;
    const int K = g.K, nt = K / BK;
    unsigned voffA[2], voffB[2];
#pragma unroll
    for (int i = 0; i < 2; ++i) { int R, C; stage_rc(tid * 16 + i * 8192, R, C); const int Rb = Epi::PERM ? ((R & ~31) + perm32(R & 31)) : R;
        voffA[i] = (unsigned)(R * K + C) * 2u; voffB[i] = (unsigned)(Rb * K + C) * 2u; }
    const size_t kstep = (size_t)(BK * 2);
    const size_t hstep = (size_t)HALF * K * 2;
    const size_t tstep = 2 * hstep;
    const unsigned ldsw = (unsigned)wid * 1024u;
    const int aoff = lds_byte(wr * 64 + fr, fq * 8), boff = lds_byte(wc * 32 + fr, fq * 8);
#define PG8_SA(b, h) (((b) * 2 + (h)) * HTB)
#define PG8_SB(b, h) ((4 + (b) * 2 + (h)) * HTB)
#define PG8_STAGE(bufoff, gbase, voff) do { _Pragma("unroll") for (int _i = 0; _i < 2; ++_i) \
        __builtin_amdgcn_global_load_lds((const unsigned*)((const char*)(gbase) + (voff)[_i]), (PG8_LAS unsigned*)(lds + (bufoff) + ldsw + _i * 8192), 16, 0, 0); } while (0)
#define PG8_LDA(dst, b, h) do { _Pragma("unroll") for (int m = 0; m < 4; ++m) _Pragma("unroll") for (int k = 0; k < 2; ++k) dst[m][k] = *(const PG8_LAS bf16x8*)(lds + PG8_SA(b, h) + aoff + m * 2048 + k * 1024); } while (0)
#define PG8_LDB(dst, b, h) do { _Pragma("unroll") for (int n = 0; n < 2; ++n) _Pragma("unroll") for (int k = 0; k < 2; ++k) dst[n][k] = *(const PG8_LAS bf16x8*)(lds + PG8_SB(b, h) + boff + n * 2048 + k * 1024); } while (0)
#define PG8_MMA(ai, bj, At, Bt) do { __builtin_amdgcn_s_setprio(1); _Pragma("unroll") for (int m = 0; m < 4; ++m) _Pragma("unroll") for (int n = 0; n < 2; ++n) _Pragma("unroll") for (int k = 0; k < 2; ++k) \
        acc[ai][bj][m][n] = __builtin_amdgcn_mfma_f32_16x16x32_bf16(Bt[n][k], At[m][k], acc[ai][bj][m][n], 0, 0, 0); __builtin_amdgcn_s_setprio(0); } while (0)
#define PG8_WAIT_V(n) asm volatile("s_waitcnt vmcnt(" #n ")" ::: "memory")
#define PG8_WAIT_L(n) asm volatile("s_waitcnt lgkmcnt(" #n ")" ::: "memory")
#define PG8_BAR __builtin_amdgcn_s_barrier()
#define PG8_SCHED __builtin_amdgcn_sched_barrier(0)
    Unit cur, nxt; int ui = 0;
    if (!S.next(0, cur)) return;
    f32x4 acc[2][2][4][2];
#pragma unroll
    for (int a = 0; a < 2; ++a)
#pragma unroll
        for (int b = 0; b < 2; ++b)
#pragma unroll
            for (int m = 0; m < 4; ++m)
#pragma unroll
                for (int n = 0; n < 2; ++n) acc[a][b][m][n] = (f32x4){0.f, 0.f, 0.f, 0.f};
    bf16x8 At[4][2], B0[2][2], B1[2][2];
    const char* cA = (const char*)g.A + (size_t)cur.pm * tstep; const char* cB = (const char*)g.Bt + (size_t)cur.pn * tstep;
    S.a_ready(cur);
    if constexpr (SP2) {
        PG8_STAGE(PG8_SB(0, 0), cB, voffB); PG8_STAGE(PG8_SB(0, 1), cB + hstep, voffB); PG8_STAGE(PG8_SA(0, 0), cA, voffA); PG8_STAGE(PG8_SA(0, 1), cA + hstep, voffA);
        if (wr == 1) PG8_BAR;
        PG8_WAIT_V(2); PG8_BAR;
        PG8_STAGE(PG8_SB(1, 0), cB + kstep, voffB); PG8_STAGE(PG8_SA(1, 0), cA + kstep, voffA); PG8_STAGE(PG8_SB(1, 1), cB + hstep + kstep, voffB);
        PG8_WAIT_V(6); PG8_BAR;
    } else {
        PG8_STAGE(PG8_SB(0, 0), cB, voffB); PG8_STAGE(PG8_SA(0, 0), cA, voffA); PG8_STAGE(PG8_SB(0, 1), cB + hstep, voffB); PG8_STAGE(PG8_SA(0, 1), cA + hstep, voffA);
        if (wr == 1) PG8_BAR;
        PG8_WAIT_V(4); PG8_BAR;
        PG8_STAGE(PG8_SB(1, 0), cB + kstep, voffB); PG8_STAGE(PG8_SA(1, 0), cA + kstep, voffA); PG8_STAGE(PG8_SB(1, 1), cB + hstep + kstep, voffB);
        PG8_WAIT_V(6); PG8_BAR;
    }
    for (;;) {
        const bool has_next = S.next(ui + 1, nxt);
        const char* nA = has_next ? (const char*)g.A + (size_t)nxt.pm * tstep : cA; const char* nB = has_next ? (const char*)g.Bt + (size_t)nxt.pn * tstep : cB;
        for (int t = 0; t < nt; t += 2) {
            const bool last = (t == nt - 2);
            const char* a1 = cA + (size_t)(t + 1) * kstep;
            const char* a2 = last ? nA : cA + (size_t)(t + 2) * kstep; const char* b2 = last ? nB : cB + (size_t)(t + 2) * kstep;
            const char* a3 = a2 + kstep; const char* b3 = b2 + kstep;
            if (last && has_next) S.a_ready(nxt);
            if constexpr (SP2) {
            PG8_LDB(B0, 0, 0); PG8_LDB(B1, 0, 1); PG8_SCHED; PG8_LDA(At, 0, 0); PG8_STAGE(PG8_SA(1, 1), a1 + hstep, voffA);
            PG8_WAIT_V(8); PG8_WAIT_L(0); PG8_BAR; PG8_MMA(0, 0, At, B0); PG8_MMA(0, 1, At, B1); PG8_BAR; PG8_SCHED;
            PG8_LDA(At, 0, 1); PG8_STAGE(PG8_SB(0, 0), b2, voffB); PG8_STAGE(PG8_SB(0, 1), b2 + hstep, voffB); PG8_STAGE(PG8_SA(0, 0), a2, voffA);
            PG8_WAIT_V(8); PG8_WAIT_L(0); PG8_BAR; PG8_MMA(1, 0, At, B0); PG8_MMA(1, 1, At, B1); PG8_BAR; PG8_SCHED;
            PG8_LDB(B0, 1, 0); PG8_LDB(B1, 1, 1); PG8_SCHED; PG8_LDA(At, 1, 0); PG8_STAGE(PG8_SA(0, 1), a2 + hstep, voffA);
            PG8_WAIT_V(8); PG8_WAIT_L(0); PG8_BAR; PG8_MMA(0, 0, At, B0); PG8_MMA(0, 1, At, B1); PG8_BAR; PG8_SCHED;
            PG8_LDA(At, 1, 1); PG8_STAGE(PG8_SB(1, 0), b3, voffB); PG8_STAGE(PG8_SB(1, 1), b3 + hstep, voffB); PG8_STAGE(PG8_SA(1, 0), a3, voffA);
            PG8_WAIT_V(8); PG8_WAIT_L(0); PG8_BAR; PG8_MMA(1, 0, At, B0); PG8_MMA(1, 1, At, B1); PG8_BAR; PG8_SCHED;
            } else {
            PG8_LDB(B0, 0, 0); PG8_SCHED; PG8_LDA(At, 0, 0); PG8_STAGE(PG8_SA(1, 1), a1 + hstep, voffA);
            PG8_WAIT_L(8); PG8_BAR; PG8_WAIT_L(0); PG8_MMA(0, 0, At, B0); PG8_BAR; PG8_SCHED;
            PG8_LDB(B1, 0, 1); PG8_STAGE(PG8_SB(0, 0), b2, voffB);
            PG8_BAR; PG8_WAIT_L(0); PG8_MMA(0, 1, At, B1); PG8_BAR;
            PG8_LDA(At, 0, 1); PG8_STAGE(PG8_SA(0, 0), a2, voffA);
            PG8_BAR; PG8_WAIT_L(0); PG8_MMA(1, 0, At, B0); PG8_BAR; PG8_SCHED;
            PG8_STAGE(PG8_SB(0, 1), b2 + hstep, voffB);
            PG8_WAIT_V(6); PG8_BAR; PG8_MMA(1, 1, At, B1); PG8_BAR;
            PG8_LDB(B0, 1, 0); PG8_SCHED; PG8_LDA(At, 1, 0); PG8_STAGE(PG8_SA(0, 1), a2 + hstep, voffA);
            PG8_WAIT_L(8); PG8_BAR; PG8_WAIT_L(0); PG8_MMA(0, 0, At, B0); PG8_BAR; PG8_SCHED;
            PG8_LDB(B1, 1, 1); PG8_STAGE(PG8_SB(1, 0), b3, voffB);
            PG8_BAR; PG8_WAIT_L(0); PG8_MMA(0, 1, At, B1); PG8_BAR;
            PG8_LDA(At, 1, 1); PG8_STAGE(PG8_SA(1, 0), a3, voffA);
            PG8_BAR; PG8_WAIT_L(0); PG8_MMA(1, 0, At, B0); PG8_BAR; PG8_SCHED;
            PG8_STAGE(PG8_SB(1, 1), b3 + hstep, voffB);
            PG8_WAIT_V(6); PG8_BAR; PG8_MMA(1, 1, At, B1); PG8_BAR;
            }
        }
        if constexpr (ALIGN_EPI) { if (wr == 0) PG8_BAR; }
        if constexpr (!Epi::AFTER_DRAIN) { E(acc, cur, wr, wc, fr, fq); S.done(cur); }
        if (!has_next) break;
#pragma unroll
        for (int a = 0; a < 2; ++a)
#pragma unroll
            for (int b = 0; b < 2; ++b)
#pragma unroll
                for (int m = 0; m < 4; ++m)
#pragma unroll
                    for (int n = 0; n < 2; ++n) acc[a][b][m][n] = (f32x4){0.f, 0.f, 0.f, 0.f};
        cur = nxt; cA = nA; cB = nB; ++ui;
        if constexpr (ALIGN_EPI) { if (wr == 1) PG8_BAR; }
    }
    PG8_WAIT_V(0);
    if constexpr (!ALIGN_EPI) { if (wr == 0) PG8_BAR; }
    PG8_BAR;
    if constexpr (Epi::AFTER_DRAIN) { E.fused(acc, cur, wr, wc, fr, fq, lds, wid, lane); S.done(cur); }
#undef PG8_SA
#undef PG8_SB
#undef PG8_STAGE
#undef PG8_LDA
#undef PG8_LDB
#undef PG8_MMA
#undef PG8_WAIT_V
#undef PG8_WAIT_L
#undef PG8_BAR
#undef PG8_SCHED
}
}
#define LAS __attribute__((address_space(3)))
typedef unsigned short bf16_t;
typedef LAS unsigned char* ldsp;
typedef short bf16x8 __attribute__((ext_vector_type(8)));
typedef short s16x4 __attribute__((ext_vector_type(4)));
typedef float f32x16 __attribute__((ext_vector_type(16)));
typedef float f32x4 __attribute__((ext_vector_type(4)));
typedef float f32x2 __attribute__((ext_vector_type(2)));
typedef unsigned u32x4 __attribute__((ext_vector_type(4)));
typedef unsigned u32x2 __attribute__((ext_vector_type(2)));
typedef __bf16 bf16x2_t __attribute__((ext_vector_type(2)));
using pg8::ZLD; using pg8::MROWS; using pg8::NPROMPT; using pg8::LOG2E;
__device__ __forceinline__ int crow(int r, int hi) { return (r & 3) + 8 * (r >> 2) + 4 * hi; }
__device__ __forceinline__ unsigned cvtpk(float lo, float hi) { f32x2 v = {lo, hi}; bf16x2_t b = __builtin_convertvector(v, bf16x2_t); return __builtin_bit_cast(unsigned, b); }
__device__ __forceinline__ float bf_lo(unsigned w) { return __uint_as_float(w << 16); }
__device__ __forceinline__ float bf_hi(unsigned w) { return __uint_as_float(w & 0xffff0000u); }
__device__ __forceinline__ float xhalf_max(float m) { auto rr = __builtin_amdgcn_permlane32_swap(__float_as_uint(m), __float_as_uint(m), false, false); return fmaxf(__uint_as_float(rr[0]), __uint_as_float(rr[1])); }
__device__ __forceinline__ float xhalf_sum(float m) { auto rr = __builtin_amdgcn_permlane32_swap(__float_as_uint(m), __float_as_uint(m), false, false); return __uint_as_float(rr[0]) + __uint_as_float(rr[1]); }
__device__ __forceinline__ s16x4 vtr(ldsp p) { typedef short v4i16_t __attribute__((ext_vector_type(4))); return __builtin_bit_cast(s16x4, __builtin_amdgcn_ds_read_tr16_b64_v4i16((LAS v4i16_t*)p)); }
__device__ __forceinline__ float max3f(float a, float b, float c) { float r; asm("v_max3_f32 %0, %1, %2, %3" : "=v"(r) : "v"(a), "v"(b), "v"(c)); return r; }
__device__ __forceinline__ float max2f(float a, float b) { float r; asm("v_max_f32_e32 %0, %1, %2" : "=v"(r) : "v"(a), "v"(b)); return r; }
__device__ __forceinline__ float sum8_s(float acc, float a, float b, float c, float d, float e, float f, float g, float h) {
    asm("s_nop 0\n\tv_add_f32_e32 %0, %0, %1\n\tv_add_f32_e32 %0, %0, %2\n\tv_add_f32_e32 %0, %0, %3\n\tv_add_f32_e32 %0, %0, %4\n\tv_add_f32_e32 %0, %0, %5\n\tv_add_f32_e32 %0, %0, %6\n\tv_add_f32_e32 %0, %0, %7\n\tv_add_f32_e32 %0, %0, %8"
        : "+v"(acc) : "v"(a), "v"(b), "v"(c), "v"(d), "v"(e), "v"(f), "v"(g), "v"(h));
    return acc; }
__device__ __forceinline__ float sum4_s(float acc, float a, float b, float c, float d) {
    asm("s_nop 0\n\tv_add_f32_e32 %0, %0, %1\n\tv_add_f32_e32 %0, %0, %2\n\tv_add_f32_e32 %0, %0, %3\n\tv_add_f32_e32 %0, %0, %4" : "+v"(acc) : "v"(a), "v"(b), "v"(c), "v"(d));
    return acc; }
__device__ __forceinline__ float fadd_s(float a, float b) { float r; asm("v_add_f32_e32 %0, %1, %2" : "=v"(r) : "v"(a), "v"(b)); return r; }
#define MFMA32(a, b, c) __builtin_amdgcn_mfma_f32_32x32x16_bf16((a), (b), (c), 0, 0, 0)

constexpr int KPITCH = 144, KT_BYTES = 64 * KPITCH, VT_BYTES = 8192, TILE_BYTES = KT_BYTES + VT_BYTES, BUF_BYTES = 2 * TILE_BYTES;
constexpr int COMB_OFF = 2 * BUF_BYTES, COMB_WAVE = 17408, TAB_OFF = COMB_OFF + 4 * COMB_WAVE, TAB_N = 640, TAB_DDMAX = 576, MISC_OFF = TAB_OFF + TAB_N * 4 + 16, LDS_BYTES = 147456;
static_assert(MISC_OFF + 64 <= LDS_BYTES, "LDS map");
constexpr float NEG_BIG = -1.0e30f, THR = 8.0f;
struct AU {
    const bf16_t* q; int nq; int nt, ntc; const float* kc; const float* vc; int cp; const bf16_t* kz; const bf16_t* vz; int lastv; int nqg;
    int tlo0, thi0, tlo1, thi1; int qpos0, kpos0; const bf16_t* gate; bf16_t* y; const float* tabsrc;
};
#ifndef ATTN_INL
#define ATTN_INL __forceinline__
#endif
template <int MODE  >
__device__ ATTN_INL void attn_unit(const AU& d, ldsp lds, float lam, int lsel, const float* subg) {
    constexpr bool WIDE = (MODE == 2), BIAS = (MODE != 0);
    constexpr int NMAP = (MODE == 1) ? 1 : 2, NSTEP = (MODE == 0) ? 2 : 4, NSUB = WIDE ? 2 : 1;
#define KC(MP) ((MODE == 0) ? (MP) * 32 : 0)
    int tid_ = threadIdx.x; asm volatile("" : "+v"(tid_));
    const int tid = tid_, lane = tid & 63, wid = __builtin_amdgcn_readfirstlane(tid >> 6), qg = WIDE ? wid : (wid & 3), ks = WIDE ? 0 : (wid >> 2), r32 = lane & 31, hi = lane >> 5;
    int tlo = (qg >> 1) ? d.tlo1 : d.tlo0; int thi = (qg >> 1) ? d.thi1 : d.thi0; if (qg >= d.nqg) thi = -1;
    if (WIDE) { thi = d.tlo0 + wid; tlo = max(thi - 8, 0); }
    const int qoff0 = WIDE ? 64 * wid : 32 * qg;
    const LAS float* tab = (const LAS float*)(lds + TAB_OFF);
    if (BIAS) { for (int j = tid; j < TAB_N; j += 512) ((LAS float*)(lds + TAB_OFF))[j] = d.tabsrc[min(max(TAB_DDMAX - j, -128), 128) + 128] * LOG2E; }
    bf16x8 qf[NMAP][NSTEP];
    const ldsp Qw = lds + COMB_OFF + wid * 8192;
    if (WIDE) {
        u32x4 qv_[8];
#pragma unroll
        for (int j = 0; j < 8; ++j) qv_[j] = *(const u32x4*)(d.q + (size_t)(qoff0 + lane) * ZLD + j * 8);
#pragma unroll
        for (int j = 0; j < 8; ++j) *(LAS u32x4*)(Qw + lane * 128 + ((j ^ (lane & 7)) * 16)) = qv_[j];
    }
#define QFRAG(MP, ST) (WIDE ? *(const LAS bf16x8*)(Qw + (32 * (MP) + r32) * 128 + ((((ST) * 2 + hi) ^ (r32 & 7)) * 16)) : qf[MP][ST])
#pragma unroll
    for (int mp = 0; mp < (WIDE ? 0 : NMAP); ++mp) { int qrow = qoff0 + r32; if (qrow >= d.nq) qrow = d.nq - 1;
      const bf16_t* qp = d.q + (size_t)qrow * ZLD;
#pragma unroll
      for (int st = 0; st < NSTEP; ++st) qf[mp][st] = *(const bf16x8*)(qp + KC(mp) + st * 16 + hi * 8); }
    f32x16 O[NMAP][2]; float mref[NMAP], lsum[NMAP];
#pragma unroll
    for (int mp = 0; mp < NMAP; ++mp) { mref[mp] = 0.f; lsum[mp] = 0.f;
#pragma unroll
        for (int db = 0; db < 2; ++db)
#pragma unroll
            for (int i = 0; i < 16; ++i) O[mp][db][i] = 0.f; }
    const int lrow = tid >> 3, lch = tid & 7;
    const int kwoff = lrow * KPITCH + lch * 16, vwoff = (lch >> 2) * 4096 + lrow * 64 + (lch & 3) * 16;
    const int kroff = r32 * KPITCH + hi * 16;
    const int vroff = (4 * hi + ((lane & 15) >> 2)) * 64 + ((lane >> 4) & 1) * 32 + (lane & 3) * 8;
    u32x4 stK[2], stV[2];
    const int nit = (d.nt + 1) >> 1; bool started = false;
#define AT_ISSUE(IT) do { if (!WIDE) _Pragma("unroll") for (int i_ = 0; i_ < 2; ++i_) { const int t_ = 2 * (IT) + i_; if (t_ < d.nt && t_ >= d.ntc) { int r_ = lrow; if (t_ == d.nt - 1 && r_ >= d.lastv) r_ = d.lastv - 1; \
        const size_t off_ = ((size_t)(t_ - d.ntc) * 64 + r_) * ZLD + lch * 8; stK[i_] = *(const u32x4*)(d.kz + off_); stV[i_] = *(const u32x4*)(d.vz + off_); } } } while (0)
#define AT_WRITE(IT, BUF) do { _Pragma("unroll") for (int i_ = 0; i_ < 2; ++i_) { const int t_ = 2 * (IT) + i_; if (t_ < d.nt) { u32x4 kk_, vv_; if (WIDE) { const size_t off_ = ((size_t)t_ * 64 + lrow) * ZLD + lch * 8; kk_ = *(const u32x4*)(d.kz + off_); vv_ = *(const u32x4*)(d.vz + off_); } else if (t_ >= d.ntc) { kk_ = stK[i_]; vv_ = stV[i_]; } else { \
        const size_t off_ = ((size_t)t_ * 64 + lrow) * d.cp + lch * 8; const f32x4 a_ = *(const f32x4*)(d.kc + off_), b_ = *(const f32x4*)(d.kc + off_ + 4), c_ = *(const f32x4*)(d.vc + off_), e_ = *(const f32x4*)(d.vc + off_ + 4); \
        kk_ = (u32x4){cvtpk(a_[0], a_[1]), cvtpk(a_[2], a_[3]), cvtpk(b_[0], b_[1]), cvtpk(b_[2], b_[3])}; vv_ = (u32x4){cvtpk(c_[0], c_[1]), cvtpk(c_[2], c_[3]), cvtpk(e_[0], e_[1]), cvtpk(e_[2], e_[3])}; } \
        *(LAS u32x4*)((BUF) + i_ * TILE_BYTES + kwoff) = kk_; *(LAS u32x4*)((BUF) + i_ * TILE_BYTES + KT_BYTES + vwoff) = vv_; } } } while (0)
    AT_ISSUE(0);
    for (int it = 0; it < nit; ++it) {
        const ldsp buf = lds + (it & 1) * BUF_BYTES;
        AT_WRITE(it, buf);
        __builtin_amdgcn_s_waitcnt(0);
        __syncthreads();
#pragma nounroll
        for (int sub = 0; sub < NSUB; ++sub) {
        const int t = 2 * it + (WIDE ? sub : ks);
        const bool vis = (t >= tlo && t <= thi);
        const ldsp Kt = buf + (WIDE ? sub : ks) * TILE_BYTES, Vt = Kt + KT_BYTES;
        bf16x8 kf0[2 * NSTEP];
        if (vis) {
#pragma unroll
            for (int st = 0; st < (WIDE ? 2 : NSTEP); ++st) { kf0[2 * st] = *(const LAS bf16x8*)(Kt + kroff + (st * 16) * 2); kf0[2 * st + 1] = *(const LAS bf16x8*)(Kt + kroff + 32 * KPITCH + (st * 16) * 2); }
        }
        __builtin_amdgcn_sched_barrier(0);
        if (sub == 0 && it + 1 < nit) AT_ISSUE(it + 1);
        __builtin_amdgcn_sched_barrier(0);
        if (vis) {
            const int valid = (t == d.nt - 1) ? d.lastv : 64;
            f32x16 S0[NMAP], S1[NMAP];
#define AT_BIAS(MP) do { const int qb_ = d.qpos0 + qoff0 + (WIDE ? 32 * (MP) : 0), kp0_ = d.kpos0 + 64 * t; \
                if (qb_ - (kp0_ + 63) >= 128) { const float c_ = tab[TAB_DDMAX - 128]; _Pragma("unroll") for (int i = 0; i < 16; ++i) { S0[MP][i] += c_; S1[MP][i] += c_; } } \
                else { int j0_ = TAB_DDMAX - (qb_ + r32 - kp0_ - 4 * hi); asm volatile("" : "+v"(j0_)); const LAS float* tb_ = tab + j0_; \
                    _Pragma("unroll") for (int i = 0; i < 16; ++i) { S0[MP][i] += tb_[(i & 3) + 8 * (i >> 2)]; S1[MP][i] += tb_[(i & 3) + 8 * (i >> 2) + 32]; } } } while (0)
#define AT_QK(MP) do { f32x16 negm_; _Pragma("unroll") for (int i = 0; i < 16; ++i) negm_[i] = -mref[MP]; \
                _Pragma("unroll") for (int st = 0; st < NSTEP; ++st) { \
                    const bf16x8 a0_ = *(const LAS bf16x8*)(Kt + kroff + (KC(MP) + st * 16) * 2); \
                    const bf16x8 a1_ = *(const LAS bf16x8*)(Kt + kroff + 32 * KPITCH + (KC(MP) + st * 16) * 2); \
                    if (st == 0) { S0[MP] = MFMA32(a0_, QFRAG(MP, st), negm_); S1[MP] = MFMA32(a1_, QFRAG(MP, st), negm_); } \
                    else { S0[MP] = MFMA32(a0_, QFRAG(MP, st), S0[MP]); S1[MP] = MFMA32(a1_, QFRAG(MP, st), S1[MP]); } } \
                if (BIAS) AT_BIAS(MP); \
                if (0) { const int qpos = d.qpos0 + 32 * qg + r32, kp0 = d.kpos0 + 64 * t; \
                    if (d.qpos0 + 32 * qg - (kp0 + 63) >= 128) { const float c = tab[256]; _Pragma("unroll") for (int i = 0; i < 16; ++i) { S0[MP][i] += c; S1[MP][i] += c; } } \
                    else { _Pragma("unroll") for (int i = 0; i < 16; ++i) { int dd = qpos - (kp0 + crow(i, hi)); int d0 = min(max(dd, -128), 128), d1 = min(max(dd - 32, -128), 128); S0[MP][i] += tab[d0 + 128]; S1[MP][i] += tab[d1 + 128]; } } } \
                if (valid < 64) { _Pragma("unroll") for (int i = 0; i < 16; ++i) { const int k = crow(i, hi); if (k >= valid) S0[MP][i] = NEG_BIG; if (k + 32 >= valid) S1[MP][i] = NEG_BIG; } } } while (0)
#define AT_SLOW(MP) do { asm volatile("s_nop 15\n\ts_nop 7" : "+v"(S0[MP]), "+v"(S1[MP])); \
                float ra_ = max3f(S0[MP][0], S0[MP][1], S1[MP][0]), rb_ = max3f(S0[MP][2], S0[MP][3], S1[MP][1]); ra_ = max3f(ra_, S1[MP][2], S1[MP][3]); \
                _Pragma("unroll") for (int i = 4; i < 16; i += 4) { ra_ = max3f(ra_, S0[MP][i], S0[MP][i + 1]); rb_ = max3f(rb_, S0[MP][i + 2], S0[MP][i + 3]); ra_ = max3f(ra_, S1[MP][i], S1[MP][i + 1]); rb_ = max3f(rb_, S1[MP][i + 2], S1[MP][i + 3]); } \
                const float rm_ = xhalf_max(max2f(ra_, rb_)); \
                const float dl_ = started ? fmaxf(rm_, 0.f) : rm_, al_ = started ? __builtin_amdgcn_exp2f(-dl_) : 1.f; \
                mref[MP] += dl_; lsum[MP] *= al_; \
                _Pragma("unroll") for (int i = 0; i < 16; ++i) { S0[MP][i] -= dl_; S1[MP][i] -= dl_; } \
                _Pragma("unroll") for (int db = 0; db < 2; ++db) _Pragma("unroll") for (int i = 0; i < 16; ++i) O[MP][db][i] *= al_; } while (0)
#define AT_EXPSUM(MP) do { sa = 0.f; sb = 0.f; \
                _Pragma("unroll") for (int i = 0; i < 16; ++i) { S0[MP][i] = __builtin_amdgcn_exp2f(S0[MP][i]); S1[MP][i] = __builtin_amdgcn_exp2f(S1[MP][i]); } \
                _Pragma("unroll") for (int i = 0; i < 16; i += 8) { sa = sum8_s(sa, S0[MP][i], S0[MP][i + 1], S0[MP][i + 2], S0[MP][i + 3], S0[MP][i + 4], S0[MP][i + 5], S0[MP][i + 6], S0[MP][i + 7]); \
                    sb = sum8_s(sb, S1[MP][i], S1[MP][i + 1], S1[MP][i + 2], S1[MP][i + 3], S1[MP][i + 4], S1[MP][i + 5], S1[MP][i + 6], S1[MP][i + 7]); } } while (0)
#define AT_CVT(MP) do { _Pragma("unroll") for (int s_ = 0; s_ < 2; ++s_) { \
                u32x4 w0_ = {cvtpk(S0[MP][8 * s_], S0[MP][8 * s_ + 1]), cvtpk(S0[MP][8 * s_ + 2], S0[MP][8 * s_ + 3]), cvtpk(S0[MP][8 * s_ + 4], S0[MP][8 * s_ + 5]), cvtpk(S0[MP][8 * s_ + 6], S0[MP][8 * s_ + 7])}; \
                u32x4 w1_ = {cvtpk(S1[MP][8 * s_], S1[MP][8 * s_ + 1]), cvtpk(S1[MP][8 * s_ + 2], S1[MP][8 * s_ + 3]), cvtpk(S1[MP][8 * s_ + 4], S1[MP][8 * s_ + 5]), cvtpk(S1[MP][8 * s_ + 6], S1[MP][8 * s_ + 7])}; \
                Pf[s_] = __builtin_bit_cast(bf16x8, w0_); Pf[2 + s_] = __builtin_bit_cast(bf16x8, w1_); } } while (0)
#define AT_VF(J) ({ const s16x4 lo_ = vfr[2 * (J)], hh_ = vfr[2 * (J) + 1]; (bf16x8){lo_[0], lo_[1], lo_[2], lo_[3], hh_[0], hh_[1], hh_[2], hh_[3]}; })
#define AT_VLOAD() do { _Pragma("unroll") for (int j_ = 0; j_ < 8; ++j_) { vfr[2 * j_] = vtr(Vt + vroff + (j_ & 1) * 4096 + (j_ >> 1) * 1024); vfr[2 * j_ + 1] = vtr(Vt + vroff + (j_ & 1) * 4096 + (j_ >> 1) * 1024 + 512); } } while (0)
#define SBAR() __builtin_amdgcn_sched_barrier(0)
            float sa, sb; bf16x8 Pf[4]; s16x4 vfr[16];
            { f32x16 negm_;
#pragma unroll
              for (int i = 0; i < 16; ++i) negm_[i] = -mref[0];
#pragma unroll
              for (int st = 0; st < NSTEP; ++st) {
                  const bf16x8 q_ = QFRAG(0, st);
                  const bf16x8 ka_ = (WIDE && st >= 2) ? *(const LAS bf16x8*)(Kt + kroff + (st * 16) * 2) : kf0[2 * st], kb_ = (WIDE && st >= 2) ? *(const LAS bf16x8*)(Kt + kroff + 32 * KPITCH + (st * 16) * 2) : kf0[2 * st + 1];
                  if (st == 0) { S0[0] = MFMA32(ka_, q_, negm_); S1[0] = MFMA32(kb_, q_, negm_); }
                  else { S0[0] = MFMA32(ka_, q_, S0[0]); S1[0] = MFMA32(kb_, q_, S1[0]); } }
              if (BIAS) AT_BIAS(0);
              if (0) { const int qpos = d.qpos0 + 32 * qg + r32, kp0 = d.kpos0 + 64 * t;
                  if (d.qpos0 + 32 * qg - (kp0 + 63) >= 128) { const float c = tab[256];
#pragma unroll
                      for (int i = 0; i < 16; ++i) { S0[0][i] += c; S1[0][i] += c; } }
                  else {
#pragma unroll
                      for (int i = 0; i < 16; ++i) { int dd = qpos - (kp0 + crow(i, hi)); int d0 = min(max(dd, -128), 128), d1 = min(max(dd - 32, -128), 128); S0[0][i] += tab[d0 + 128]; S1[0][i] += tab[d1 + 128]; } } }
              if (valid < 64) {
#pragma unroll
                  for (int i = 0; i < 16; ++i) { const int k = crow(i, hi); if (k >= valid) S0[0][i] = NEG_BIG; if (k + 32 >= valid) S1[0][i] = NEG_BIG; } } }
            if (!started) AT_SLOW(0);
            if (NMAP == 2) {
                constexpr int M1 = NMAP - 1;
                bf16x8 kf1[4]; f32x16 negm1; bf16x8 wka = kf1[0], wkb = kf1[0];
                bf16x8 wq = wka;
                if (WIDE) { wka = *(const LAS bf16x8*)(Kt + kroff); wkb = *(const LAS bf16x8*)(Kt + kroff + 32 * KPITCH); wq = QFRAG(M1, 0); }
                if (!WIDE) {
#pragma unroll
                for (int st = 0; st < 2; ++st) { kf1[2 * st] = *(const LAS bf16x8*)(Kt + kroff + (32 + st * 16) * 2); kf1[2 * st + 1] = *(const LAS bf16x8*)(Kt + kroff + 32 * KPITCH + (32 + st * 16) * 2); } }
#pragma unroll
                for (int i = 0; i < 16; ++i) negm1[i] = -mref[M1];
                sa = 0.f; sb = 0.f;
                SBAR();
#pragma unroll
                for (int g = 0; g < 4; ++g) {
                    if (WIDE) {
                        bf16x8 na_ = wka, nb_ = wkb;
                        if (g < 3) { na_ = *(const LAS bf16x8*)(Kt + kroff + ((g + 1) * 16) * 2); nb_ = *(const LAS bf16x8*)(Kt + kroff + 32 * KPITCH + ((g + 1) * 16) * 2); }
                        bf16x8 nq_ = wq;
                        if (g < 3) nq_ = QFRAG(M1, (g + 1) % NSTEP);
                        if (g == 0) { S0[M1] = MFMA32(wka, wq, negm1); S1[M1] = MFMA32(wkb, wq, negm1); }
                        else { S0[M1] = MFMA32(wka, wq, S0[M1]); S1[M1] = MFMA32(wkb, wq, S1[M1]); }
                        wka = na_; wkb = nb_; wq = nq_;
                    } else {
                    if (g == 0) S0[M1] = MFMA32(kf1[0], qf[M1][0], negm1); else if (g == 1) S1[M1] = MFMA32(kf1[1], qf[M1][0], negm1);
                    else if (g == 2) S0[M1] = MFMA32(kf1[2], qf[M1][1], S0[M1]); else S1[M1] = MFMA32(kf1[3], qf[M1][1], S1[M1]); }
                    SBAR();
#pragma unroll
                    for (int i = 4 * g; i < 4 * g + 4; ++i) { S0[0][i] = __builtin_amdgcn_exp2f(S0[0][i]); S1[0][i] = __builtin_amdgcn_exp2f(S1[0][i]); }
                    if (g & 1) sb = sum8_s(sb, S0[0][4 * g], S0[0][4 * g + 1], S0[0][4 * g + 2], S0[0][4 * g + 3], S1[0][4 * g], S1[0][4 * g + 1], S1[0][4 * g + 2], S1[0][4 * g + 3]);
                    else sa = sum8_s(sa, S0[0][4 * g], S0[0][4 * g + 1], S0[0][4 * g + 2], S0[0][4 * g + 3], S1[0][4 * g], S1[0][4 * g + 1], S1[0][4 * g + 2], S1[0][4 * g + 3]);
                    SBAR();
                }
                if (WIDE) AT_BIAS(M1);
                if (valid < 64) {
#pragma unroll
                    for (int i = 0; i < 16; ++i) { const int k = crow(i, hi); if (k >= valid) S0[M1][i] = NEG_BIG; if (k + 32 >= valid) S1[M1][i] = NEG_BIG; } }
            } else AT_EXPSUM(0);
            if (started && __any(!(sa + sb <= 256.0f))) { AT_QK(0); AT_SLOW(0); AT_EXPSUM(0); }
            lsum[0] += sa + sb;
            AT_VLOAD();
            AT_CVT(0);
            if (NMAP == 2) {
                constexpr int M1 = NMAP - 1;
                if (!started) AT_SLOW(M1);
                sa = 0.f; sb = 0.f;
                SBAR();
#pragma unroll
                for (int j = 0; j < 8; ++j) {
                    O[0][j & 1] = MFMA32(AT_VF(j), Pf[j >> 1], O[0][j & 1]);
                    SBAR();
                    S0[M1][2 * j] = __builtin_amdgcn_exp2f(S0[M1][2 * j]); S0[M1][2 * j + 1] = __builtin_amdgcn_exp2f(S0[M1][2 * j + 1]);
                    S1[M1][2 * j] = __builtin_amdgcn_exp2f(S1[M1][2 * j]); S1[M1][2 * j + 1] = __builtin_amdgcn_exp2f(S1[M1][2 * j + 1]);
                    if (j & 1) sb = sum4_s(sb, S0[M1][2 * j], S0[M1][2 * j + 1], S1[M1][2 * j], S1[M1][2 * j + 1]); else sa = sum4_s(sa, S0[M1][2 * j], S0[M1][2 * j + 1], S1[M1][2 * j], S1[M1][2 * j + 1]);
                    SBAR();
                }
                if (started && __any(!(sa + sb <= 256.0f))) { AT_QK(M1); AT_SLOW(M1); AT_EXPSUM(M1); }
                lsum[M1] += sa + sb;
#pragma unroll
                for (int k = 0; k < 4; ++k) {
                    const f32x16& sx = (k < 2) ? S0[M1] : S1[M1]; const int b = 8 * (k & 1);
                    const u32x4 w_ = {cvtpk(sx[b], sx[b + 1]), cvtpk(sx[b + 2], sx[b + 3]), cvtpk(sx[b + 4], sx[b + 5]), cvtpk(sx[b + 6], sx[b + 7])};
                    Pf[k] = __builtin_bit_cast(bf16x8, w_);
                    SBAR();
                    O[M1][0] = MFMA32(AT_VF(2 * k), Pf[k], O[M1][0]); O[M1][1] = MFMA32(AT_VF(2 * k + 1), Pf[k], O[M1][1]);
                    SBAR();
                }
            } else {
#pragma unroll
                for (int j = 0; j < 8; ++j) O[0][j & 1] = MFMA32(AT_VF(j), Pf[j >> 1], O[0][j & 1]);
            }
#undef AT_SLOW
#undef AT_EXPSUM
#undef AT_CVT
#undef AT_VF
#undef AT_VLOAD
#undef SBAR
#undef AT_BIAS
            started = true;
#undef AT_QK
        }
        }
    }
#undef AT_ISSUE
#undef AT_WRITE
    __syncthreads();
    if (!started) {
#pragma unroll
        for (int mp = 0; mp < NMAP; ++mp) mref[mp] = NEG_BIG;
    }
    const ldsp cw = lds + COMB_OFF + qg * COMB_WAVE;
    if (!WIDE && ks == 1 && qg < d.nqg) {
#pragma unroll
        for (int mp = 0; mp < NMAP; ++mp) {
#pragma unroll
            for (int db = 0; db < 2; ++db)
#pragma unroll
                for (int i = 0; i < 16; ++i) *(LAS float*)(cw + ((mp * 2 + db) * 16 + i) * 256 + lane * 4) = O[mp][db][i];
            *(LAS float*)(cw + 16384 + (mp * 2) * 256 + lane * 4) = mref[mp]; *(LAS float*)(cw + 16384 + (mp * 2 + 1) * 256 + lane * 4) = lsum[mp];
        }
    }
    __syncthreads();
    if (WIDE) {
#pragma unroll
        for (int mp = 0; mp < NMAP; ++mp) {
            const float fin = 1.0f / xhalf_sum(lsum[mp]); const int row = qoff0 + 32 * mp + r32;
#pragma unroll
            for (int db = 0; db < 2; ++db)
#pragma unroll
                for (int g4 = 0; g4 < 4; ++g4) {
                    const int d0 = 32 * db + 8 * g4 + 4 * hi;
                    const u32x2 gw = *(const u32x2*)(d.gate + (size_t)row * ZLD + d0);
                    const float y0 = O[mp][db][4 * g4] * fin * bf_lo(gw.x), y1 = O[mp][db][4 * g4 + 1] * fin * bf_hi(gw.x), y2 = O[mp][db][4 * g4 + 2] * fin * bf_lo(gw.y), y3 = O[mp][db][4 * g4 + 3] * fin * bf_hi(gw.y);
                    *(u32x2*)(d.y + (size_t)row * 1024 + d0) = (u32x2){cvtpk(y0, y1), cvtpk(y2, y3)};
                }
        }
    } else
    if (ks == 0 && qg < d.nqg) {
        float linv[NMAP];
#pragma unroll
        for (int mp = 0; mp < NMAP; ++mp) {
            const float mb = *(const LAS float*)(cw + 16384 + (mp * 2) * 256 + lane * 4), lb = *(const LAS float*)(cw + 16384 + (mp * 2 + 1) * 256 + lane * 4);
            const float mt = fmaxf(mref[mp], mb), aa = __builtin_amdgcn_exp2f(mref[mp] - mt), ab = __builtin_amdgcn_exp2f(mb - mt);
            const float l = xhalf_sum(lsum[mp] * aa + lb * ab);
            linv[mp] = 1.0f / l;
#pragma unroll
            for (int db = 0; db < 2; ++db)
#pragma unroll
                for (int i = 0; i < 16; ++i) O[mp][db][i] = O[mp][db][i] * aa + *(const LAS float*)(cw + ((mp * 2 + db) * 16 + i) * 256 + lane * 4) * ab;
        }
        float fin = 1.f;
        if (MODE == 0) {
            const float i1 = linv[0], i2 = lam * linv[NMAP - 1]; float ss = 0.f;
#pragma unroll
            for (int db = 0; db < 2; ++db)
#pragma unroll
                for (int i = 0; i < 16; ++i) { const float o = O[0][db][i] * i1 - O[NMAP - 1][db][i] * i2; O[0][db][i] = o; ss += o * o; }
            ss = xhalf_sum(ss);
            int sel_ = lsel; asm volatile("" : "+s"(sel_));
            fin = __builtin_amdgcn_rsqf(ss * (1.0f / 64.0f) + 1e-5f) * ((sel_ == 0) ? 0.8f : 0.6444909324090307f);
        } else fin = linv[0];
        const int row = 32 * qg + r32;
        if (row < d.nq) {
#pragma unroll
            for (int db = 0; db < 2; ++db)
#pragma unroll
                for (int g4 = 0; g4 < 4; ++g4) {
                    const int d0 = 32 * db + 8 * g4 + 4 * hi;
                    const u32x2 gw = *(const u32x2*)(d.gate + (size_t)row * ZLD + d0);
                    f32x4 sg = {1.f, 1.f, 1.f, 1.f}; if (MODE == 0) sg = *(const f32x4*)(subg + d0);
                    const float y0 = O[0][db][4 * g4] * fin * sg[0] * bf_lo(gw.x), y1 = O[0][db][4 * g4 + 1] * fin * sg[1] * bf_hi(gw.x);
                    const float y2 = O[0][db][4 * g4 + 2] * fin * sg[2] * bf_lo(gw.y), y3 = O[0][db][4 * g4 + 3] * fin * sg[3] * bf_hi(gw.y);
                    *(u32x2*)(d.y + (size_t)row * 1024 + d0) = (u32x2){cvtpk(y0, y1), cvtpk(y2, y3)};
                }
        }
    }
}
#undef KC
#undef QFRAG
using namespace pg8;
constexpr size_t WS_CTL = WSO_CTL, CTL_BYTES = 1u << 20, WS_SSQ0 = WSO_SSQ0, WS_ROPE = WSO_ROPE, WS_WIN = WSO_WIN, WS_WOUT = WSO_WOUT, WS_XB = WSO_XB, WS_YMIX = WSO_YMIX, WS_X1 = WSO_X1, WS_Z = WSO_Z, WS_END = WSO_END;
static_assert((size_t)MROWS * 1024 * 2 <= 36u * (1u << 20) && (size_t)MROWS * 1024 * 4 <= 68u * (1u << 20) && (size_t)MROWS * 4096 * 2 <= 132u * (1u << 20), "ws map");
constexpr int CTL_Q0 = 0, CTL_SI = 64, CTL_SM = 128, CTL_SSQ1 = 16384, CTL_SSQ2 = 16384 + 32768;
static_assert((CTL_SSQ2 + MROWS) * 4 <= (int)CTL_BYTES, "ctl");
constexpr size_t O_Y = OO_Y, O_CONVP = OO_CONVP, O_CONVS = OO_CONVS, O_END = OO_END;
struct Args { const float* in[18]; float* out; unsigned char* ws; };

__device__ __forceinline__ float wave_sum(float v) {
#pragma unroll
    for (int o = 1; o < 64; o <<= 1) v += __shfl_xor(v, o);
    return v;
}
__device__ __forceinline__ unsigned f2bf(float f) { unsigned u = __builtin_bit_cast(unsigned, f); return (u + 0x7fffu + ((u >> 16) & 1u)) >> 16; }
__device__ __forceinline__ unsigned pk2(float lo, float hi) { return f2bf(lo) | (f2bf(hi) << 16); }
__device__ __forceinline__ void p0_transpose_item(const float* W, const float* g, int K, int N, bf16_t* WT, LAS float* scr, int item, int lane) {
    const int nblk = N / 32, kb = item / nblk, nb = item % nblk, k0 = 64 * kb, n0 = 32 * nb;
#pragma unroll 8
    for (int i = 0; i < 32; ++i) { const int kk = 2 * i + (lane >> 5); const float gs = g ? g[k0 + kk] : 1.f; scr[kk * 33 + (lane & 31)] = W[(size_t)(k0 + kk) * N + n0 + (lane & 31)] * gs; }
    asm volatile("s_waitcnt lgkmcnt(0)" ::: "memory");
    const int c = lane & 7;
#pragma unroll
    for (int j = 0; j < 4; ++j) { const int n = (lane >> 3) + 8 * j; const LAS float* s = scr + (8 * c) * 33 + n;
        u32x4 o; o.x = pk2(s[0 * 33], s[1 * 33]); o.y = pk2(s[2 * 33], s[3 * 33]); o.z = pk2(s[4 * 33], s[5 * 33]); o.w = pk2(s[6 * 33], s[7 * 33]);
        *(u32x4*)(WT + (size_t)(n0 + n) * K + k0 + 8 * c) = o; }
    asm volatile("s_waitcnt lgkmcnt(0)" ::: "memory");
}

__global__ void __launch_bounds__(512) fwd_megakernel(Args args) {
    extern __shared__ __attribute__((aligned(16))) unsigned char lds_raw[];
    cg::grid_group grid = cg::this_grid();
    const ldsp lds = (ldsp)lds_raw;
    const int tid = threadIdx.x, lane = tid & 63, wave = __builtin_amdgcn_readfirstlane(tid >> 6);
    const int G = gridDim.x, bx = blockIdx.x;
    unsigned char* ws = args.ws; float* out = args.out;
    unsigned* ctl = (unsigned*)(ws + WS_CTL);
    float* SSQ0 = (float*)(ws + WS_SSQ0); float* SSQ1 = (float*)ctl + CTL_SSQ1; float* SSQ2 = (float*)ctl + CTL_SSQ2;
    float* ROPE = (float*)(ws + WS_ROPE);
    bf16_t* WIN = (bf16_t*)(ws + WS_WIN); bf16_t* WOUT = (bf16_t*)(ws + WS_WOUT);
    bf16_t* XB = (bf16_t*)(ws + WS_XB); bf16_t* YMIX = (bf16_t*)(ws + WS_YMIX); float* X1 = (float*)(ws + WS_X1); bf16_t* Z = (bf16_t*)(ws + WS_Z);
    const float* x_p = args.in[0]; const float* x_s = args.in[1];

    {
        LAS float* scr = (LAS float*)(lds + wave * 16384);
        const int gw = bx * 8 + wave, NGW = G * 8;
        constexpr int I_IN = (1024 / 64) * (4096 / 32), I_OUT = (1024 / 64) * (1024 / 32), NITEMS = 2 * I_IN + 2 * I_OUT;
        for (int it = gw; it < NITEMS; it += NGW) {
            int r = it;
            if (r < 2 * I_IN) { const int l = r / I_IN; r -= l * I_IN; p0_transpose_item(args.in[8] + (size_t)l * 1024 * 4096, args.in[7] + l * 1024, 1024, 4096, WIN + (size_t)l * 4096 * 1024, scr, r, lane); }
            else { r -= 2 * I_IN; const int l = r / I_OUT; r -= l * I_OUT; p0_transpose_item(args.in[9] + (size_t)l * 1024 * 1024, nullptr, 1024, 1024, WOUT + (size_t)l * 1024 * 1024, scr, r, lane); }
        }
        for (int m = gw; m < MROWS; m += NGW) {
            const float* xr = (m < NPROMPT) ? x_p + (size_t)m * 1024 : x_s + (size_t)(m - NPROMPT) * 1024;
            f32x4 v[4]; float s = 0.f;
#pragma unroll
            for (int j = 0; j < 4; ++j) { v[j] = *((const f32x4*)xr + lane + 64 * j); s += (v[j][0] * v[j][0] + v[j][1] * v[j][1]) + (v[j][2] * v[j][2] + v[j][3] * v[j][3]); }
            s = wave_sum(s);
            if (lane == 0) SSQ0[m] = s;
#pragma unroll
            for (int j = 0; j < 4; ++j) *((u32x2*)(XB + (size_t)m * 1024) + lane + 64 * j) = (u32x2){cvtpk(v[j][0], v[j][1]), cvtpk(v[j][2], v[j][3])};
        }
        for (int e = bx * 512 + tid; e < MROWS * 4; e += G * 512) {
            const int row = e >> 2, i = e & 3; const int pos = (row < NPROMPT) ? row : 4096 + ((row - NPROMPT) & 15);
            const float invf = (i == 0) ? 1.0f : (i == 1 ? 0.037606030930863934f : (i == 2 ? 0.0014142135623730950f : 5.318295896944988e-05f));
            const float ang = (float)pos * invf;
            const double rev = (double)ang * 0.15915494309189535; const float fr = (float)(rev - __builtin_rint(rev));
            ROPE[(size_t)row * 8 + i] = __builtin_amdgcn_cosf(fr); ROPE[(size_t)row * 8 + 4 + i] = __builtin_amdgcn_sinf(fr);
        }
    }
    grid.sync();

    for (int l = 0; l < 2; ++l) {
        {
            pg8::Gemm g{XB, WIN + (size_t)l * 4096 * 1024, NPROMPT, 4096, 1024}; pg8::StaticOrder S; S.init(NPROMPT, 4096, G, bx);
            pg8::EpiIn E{ws, out, l};

#ifndef NO_GEMM1
            pg8::gemm_phase<pg8::EpiIn, pg8::StaticOrder, true, true>(lds, g, S, E);
#ifdef PROBE_P1X
            if (l == 0) { grid.sync(); pg8::gemm_phase<pg8::EpiIn, pg8::StaticOrder, true, true>(lds, g, S, E); }
#endif
#endif

        }
        grid.sync();
        {
            const float lam_init = (l == 0) ? 0.2f : 0.35550906759096927f;
            float d1 = 0.f, d2 = 0.f;
            for (int i = 0; i < 32; ++i) { d1 += args.in[12][l * 32 + i] * args.in[13][l * 32 + i]; d2 += args.in[14][l * 32 + i] * args.in[15][l * 32 + i]; }
            const float lam = __int_as_float(__builtin_amdgcn_readfirstlane(__float_as_int(__expf(d1) - __expf(d2) + lam_init))), dummy_oml_ = 0.f; const int oml = l;
            const float* subg = args.in[16] + l * 64;
            volatile LAS int* misc = (volatile LAS int*)(lds + MISC_OFF);
            constexpr int N_SI = 16, N_PC = 512, N_SC = 64, N_PA = 1024, N_SA = 128, N_CV = 130, N_SO = 4, N_TOT = N_SI + N_PC + N_SC + N_PA + N_SA + N_CV + N_SO;
            constexpr unsigned N_SMIX = N_SC + N_SA + 2;
#ifndef PROBE_P2X
#define PROBE_P2X 1
#endif
            for (int rep = 0; rep < ((l == 0) ? PROBE_P2X : 1); ++rep) {
            if (rep > 0) grid.sync();
            for (;;) {
                __syncthreads();
                if (tid == 0) misc[0] = (int)atomicAdd(ctl + CTL_Q0 + l + 2 * rep, 1u);
                __syncthreads();
                int ui = misc[0]; ui = __builtin_amdgcn_readfirstlane(ui);
                if (ui >= N_TOT) break;
                AU d; d.tabsrc = nullptr; d.kc = nullptr; d.vc = nullptr; d.cp = 0; d.ntc = 0; d.lastv = 64; d.nqg = 4; d.tlo1 = 0; d.thi1 = -1; d.qpos0 = 0; d.kpos0 = 0;
                int kind;
                int idx = ui;
                if (idx < 16) kind = 5; else if (idx < 256) { kind = 0; idx -= 16; } else if (idx < 320) { kind = 1; idx -= 256; } else if (idx < 448) { kind = 3; idx -= 320; } else if (idx < 450) { kind = 4; idx = 128 + (idx - 448); }
                else if (idx < 454) { kind = 6; idx -= 450; } else if (idx < 726) { kind = 0; idx = 240 + (idx - 454); } else if (idx < 1750) { kind = 2; idx -= 726; } else { kind = 4; idx -= 1750; }
#ifdef PROBE_ONLY_KIND
                if (rep > 0 && kind != PROBE_ONLY_KIND) continue;
#endif
                if (rep > 0 && kind >= 5) continue;
                const bool smp_unit = (kind == 1 || kind == 3 || (kind == 4 && idx >= 128));
                if (smp_unit || kind == 6) {
                    if (tid == 0) {
                        unsigned* cnt = ctl + (kind == 6 ? CTL_SM : CTL_SI) + l; const unsigned want = (kind == 6) ? N_SMIX : (unsigned)N_SI;
                        while (__hip_atomic_load(cnt, __ATOMIC_RELAXED, __HIP_MEMORY_SCOPE_AGENT) < want) __builtin_amdgcn_s_sleep(8);
                        __builtin_amdgcn_fence(__ATOMIC_ACQUIRE, "agent");
                        asm volatile("s_waitcnt vmcnt(0)" ::: "memory");
                    }
                    __syncthreads();
                }
                if (kind >= 5) {
                    if (kind == 5) { pg8::Gemm g{XB, WIN + (size_t)l * 4096 * 1024, MROWS, 4096, 1024}; pg8::OneUnit S{64, idx}; pg8::EpiIn E{ws, out, l};
                        pg8::gemm_phase<pg8::EpiIn, pg8::OneUnit, false, true>(lds, g, S, E); }
                    else { pg8::Gemm g{YMIX, WOUT + (size_t)l * 1024 * 1024, MROWS, 1024, 1024}; pg8::OneUnit S{64, idx}; pg8::EpiOut E{ws, x_p, x_s, l, args.in[17], out};
                        pg8::gemm_phase<pg8::EpiOut, pg8::OneUnit, false, true>(lds, g, S, E); }
                }
                else if (kind == 0) {
                    const int u = 127 - (idx >> 2), h = idx & 3; const size_t r0 = (size_t)128 * u;
                    d.q = Z + r0 * ZLD + 3072 + 64 * h; d.nq = 128; d.nt = 2 * u + 2; d.kz = Z + 3328 + 64 * h; d.vz = Z + 3584 + 64 * h;
                    d.tlo0 = 0; d.thi0 = d.nt - 2; d.tlo1 = 0; d.thi1 = d.nt - 1; d.gate = Z + r0 * ZLD + 3840 + 64 * h; d.y = YMIX + r0 * 1024 + 768 + 64 * h;

#ifndef NO_ATTN0
                    attn_unit<0>(d, lds, lam, oml, subg);
#endif

                } else if (kind == 1) {
                    const int b = idx >> 2, h = idx & 3; const size_t r0 = (size_t)NPROMPT + 16 * b;
                    d.q = Z + r0 * ZLD + 3072 + 64 * h; d.nq = 16; d.nt = 65; d.ntc = 64; d.cp = 256;
                    d.kc = args.in[5] + ((size_t)(l * 16 + b) * 4096) * 256 + 64 * h; d.vc = args.in[6] + ((size_t)(l * 16 + b) * 4096) * 256 + 64 * h;
                    d.kz = Z + r0 * ZLD + 3328 + 64 * h; d.vz = Z + r0 * ZLD + 3584 + 64 * h; d.lastv = 16; d.nqg = 1; d.tlo0 = 0; d.thi0 = 64;
                    d.gate = Z + r0 * ZLD + 3840 + 64 * h; d.y = YMIX + r0 * 1024 + 768 + 64 * h;

#ifndef NO_ATTN0
                    attn_unit<0>(d, lds, lam, oml, subg);
#endif

                } else if (kind == 2 || kind == 3) {
                    int h;
                    if (kind == 2) {
                        h = idx & 7; const int cp = idx >> 3, c0 = max(0, 2 * cp - 8); const size_t r0 = (size_t)128 * cp;
                        d.q = Z + r0 * ZLD + 64 * h; d.nq = 128; d.nt = 2 * cp + 2 - c0; d.kz = Z + (size_t)64 * c0 * ZLD + 512 + 64 * h; d.vz = Z + (size_t)64 * c0 * ZLD + 1024 + 64 * h;
                        d.tlo0 = 0; d.thi0 = 2 * cp - c0; d.tlo1 = max(0, 2 * cp + 1 - 8) - c0; d.thi1 = 2 * cp + 1 - c0; d.qpos0 = 128 * cp; d.kpos0 = 64 * c0;
                        d.gate = Z + r0 * ZLD + 1536 + 64 * h; d.y = YMIX + r0 * 1024 + 64 * h;
                    } else {
                        h = idx & 7; const int b = idx >> 3; const size_t r0 = (size_t)NPROMPT + 16 * b;
                        d.q = Z + r0 * ZLD + 64 * h; d.nq = 16; d.nt = 9; d.ntc = 8; d.cp = 512;
                        d.kc = args.in[2] + ((size_t)(l * 16 + b) * 512) * 512 + 64 * h; d.vc = args.in[3] + ((size_t)(l * 16 + b) * 512) * 512 + 64 * h;
                        d.kz = Z + r0 * ZLD + 512 + 64 * h; d.vz = Z + r0 * ZLD + 1024 + 64 * h; d.lastv = 16; d.nqg = 1; d.tlo0 = 0; d.thi0 = 8; d.qpos0 = 512; d.kpos0 = 0;
                        d.gate = Z + r0 * ZLD + 1536 + 64 * h; d.y = YMIX + r0 * 1024 + 64 * h;
                    }
                    d.tabsrc = args.in[10] + (size_t)(l * 8 + h) * 257;

#ifndef NO_ATTN1
                    attn_unit<1>(d, lds, 0.f, 0, nullptr);
#endif

                } else {
                    int tq_ = threadIdx.x; asm volatile("" : "+v"(tq_));
                    const int c8 = (tq_ & 31) * 8, rr = tq_ >> 5;
                    const float* cw = args.in[11] + (size_t)l * 3 * 256 + c8;
                    float w0[8], w1[8], w2[8];
#pragma unroll
                    for (int j = 0; j < 8; ++j) { w0[j] = cw[j]; w1[j] = cw[256 + j]; w2[j] = cw[512 + j]; }
                    for (int g = 0; g < 8; ++g) {
                        const int row = 128 * idx + 16 * g + rr; const bool smp = row >= NPROMPT; const int t = smp ? ((row - NPROMPT) & 15) : row, b = (row - NPROMPT) >> 4;
                        const bf16_t* zr = Z + (size_t)row * ZLD;
                        float u0[8], u1[8], u2[8];
                        { const u32x4 c = *(const u32x4*)(zr + 2304 + c8), hh = *(const u32x4*)(zr + 2560 + c8);
#pragma unroll
                          for (int j = 0; j < 4; ++j) { u0[2 * j] = bf_lo(c[j]) * bf_lo(hh[j]); u0[2 * j + 1] = bf_hi(c[j]) * bf_hi(hh[j]); } }
                        if (t >= 1) { const u32x4 c = *(const u32x4*)(zr - ZLD + 2304 + c8), hh = *(const u32x4*)(zr - ZLD + 2560 + c8);
#pragma unroll
                          for (int j = 0; j < 4; ++j) { u1[2 * j] = bf_lo(c[j]) * bf_lo(hh[j]); u1[2 * j + 1] = bf_hi(c[j]) * bf_hi(hh[j]); } }
                        else if (smp) { const float* sp = args.in[4] + ((size_t)(l * 16 + b) * 2 + 1) * 256 + c8;
#pragma unroll
                          for (int j = 0; j < 8; ++j) u1[j] = sp[j]; }
                        else {
#pragma unroll
                          for (int j = 0; j < 8; ++j) u1[j] = 0.f; }
                        if (t >= 2) { const u32x4 c = *(const u32x4*)(zr - 2 * ZLD + 2304 + c8), hh = *(const u32x4*)(zr - 2 * ZLD + 2560 + c8);
#pragma unroll
                          for (int j = 0; j < 4; ++j) { u2[2 * j] = bf_lo(c[j]) * bf_lo(hh[j]); u2[2 * j + 1] = bf_hi(c[j]) * bf_hi(hh[j]); } }
                        else if (smp) { const float* sp = args.in[4] + ((size_t)(l * 16 + b) * 2 + t) * 256 + c8;
#pragma unroll
                          for (int j = 0; j < 8; ++j) u2[j] = sp[j]; }
                        else {
#pragma unroll
                          for (int j = 0; j < 8; ++j) u2[j] = 0.f; }
                        const u32x4 bb = *(const u32x4*)(zr + 2048 + c8), bg = *(const u32x4*)(zr + 2816 + c8);
                        float y[8];
#pragma unroll
                        for (int j = 0; j < 4; ++j) {
                            y[2 * j] = bf_lo(bb[j]) * (u2[2 * j] * w0[2 * j] + u1[2 * j] * w1[2 * j] + u0[2 * j] * w2[2 * j]) * bf_lo(bg[j]);
                            y[2 * j + 1] = bf_hi(bb[j]) * (u2[2 * j + 1] * w0[2 * j + 1] + u1[2 * j + 1] * w1[2 * j + 1] + u0[2 * j + 1] * w2[2 * j + 1]) * bf_hi(bg[j]); }
                        *(u32x4*)(YMIX + (size_t)row * 1024 + 512 + c8) = (u32x4){cvtpk(y[0], y[1]), cvtpk(y[2], y[3]), cvtpk(y[4], y[5]), cvtpk(y[6], y[7])};
                        float* so = nullptr;
                        if (!smp && row >= NPROMPT - 2) so = out + O_CONVP + (size_t)l * 512 + (size_t)(row - (NPROMPT - 2)) * 256 + c8;
                        if (smp && t >= 14) so = out + O_CONVS + (size_t)l * 8192 + (size_t)b * 512 + (size_t)(t - 14) * 256 + c8;
                        if (so) { *(f32x4*)so = (f32x4){u0[0], u0[1], u0[2], u0[3]}; *(f32x4*)(so + 4) = (f32x4){u0[4], u0[5], u0[6], u0[7]}; }
                    }
                }
                if (smp_unit || kind == 5) {
                    asm volatile("s_waitcnt vmcnt(0)" ::: "memory");
                    __syncthreads();
                    if (tid == 0) { __builtin_amdgcn_fence(__ATOMIC_RELEASE, "agent"); asm volatile("s_waitcnt vmcnt(0)" ::: "memory");
                        __hip_atomic_fetch_add(ctl + (kind == 5 ? CTL_SI : CTL_SM) + l, 1u, __ATOMIC_RELAXED, __HIP_MEMORY_SCOPE_AGENT); }
                }
            }
            }
        }
        grid.sync();
        {
            pg8::Gemm g{YMIX, WOUT + (size_t)l * 1024 * 1024, NPROMPT, 1024, 1024}; pg8::StaticOrder S; S.init(NPROMPT, 1024, G, bx);
            pg8::EpiOut E{ws, x_p, x_s, l, args.in[17], out};

#ifndef NO_GEMM2
            pg8::gemm_phase<pg8::EpiOut, pg8::StaticOrder, true, true>(lds, g, S, E);
#endif

            if (l == 1 && wave == 0 && bx < MROWS - NPROMPT) {
                int ln_ = threadIdx.x; asm volatile("" : "+v"(ln_)); ln_ &= 63;
                const int lane = ln_;
                const int m = NPROMPT + bx; const float rs = __builtin_amdgcn_rsqf(SSQ2[m] * (1.0f / 1024.0f) + 1e-6f);
#pragma unroll
                for (int j = 0; j < 4; ++j) { const f32x4 v = *((const f32x4*)(X1 + (size_t)m * 1024) + lane + 64 * j); *((f32x4*)(out + O_Y + (size_t)m * 1024) + lane + 64 * j) = v * rs * *((const f32x4*)args.in[17] + lane + 64 * j); }
            }
        }
        if (l == 0) grid.sync();
    }
}

extern "C" void kernel_launch(void* const* d_in, const int* in_sizes, int n_in, void* d_out, int out_size, void* d_ws, size_t ws_size, hipStream_t stream) {
    static int grid_blocks = 0;
    if (!grid_blocks) {
        if (n_in != 18 || (size_t)out_size != O_END || ws_size < WS_END) { fprintf(stderr, "kernel_launch: unexpected shapes n_in %d out %d ws %zu\n", n_in, out_size, ws_size); grid_blocks = -1; return; }
        int dev = 0, cus = 0, per_cu = 0;
        hipGetDevice(&dev); hipDeviceGetAttribute(&cus, hipDeviceAttributeMultiprocessorCount, dev);
        hipFuncSetAttribute((const void*)fwd_megakernel, hipFuncAttributeMaxDynamicSharedMemorySize, LDS_BYTES);
        hipOccupancyMaxActiveBlocksPerMultiprocessor(&per_cu, (const void*)fwd_megakernel, 512, LDS_BYTES);
        if (per_cu < 1) { fprintf(stderr, "kernel_launch: occupancy query says %d blocks per CU\n", per_cu); per_cu = 1; }
        if (per_cu > 1) per_cu = 1;
        grid_blocks = cus * per_cu;
    }
    if (grid_blocks < 0) return;
    hipMemsetAsync((char*)d_ws + WS_CTL, 0, CTL_BYTES, stream);
    Args a{};
    for (int i = 0; i < 18; ++i) a.in[i] = (const float*)d_in[i];
    a.out = (float*)d_out; a.ws = (unsigned char*)d_ws;
    void* kargs[] = {&a};
    hipError_t e = hipLaunchCooperativeKernel((const void*)fwd_megakernel, dim3(grid_blocks), dim3(512), kargs, LDS_BYTES, stream);
    if (e != hipSuccess) fprintf(stderr, "cooperative launch failed: %s (grid %d)\n", hipGetErrorString(e), grid_blocks);
}
```

```cpp
#include <hip/hip_runtime.h>
#include <hip/hip_cooperative_groups.h>
#include <cstdio>
#include <cstdint>
namespace cg = cooperative_groups;
namespace pg8 {
#define PG8_LAS __attribute__((address_space(3)))
typedef unsigned short bf16_t;
typedef short bf16x8 __attribute__((ext_vector_type(8)));
typedef float f32x4 __attribute__((ext_vector_type(4)));
typedef unsigned u32x4 __attribute__((ext_vector_type(4)));
constexpr int BM = 256, BK = 64, HALF = 128, HTB = HALF * BK * 2  , STAGE_BYTES = 8 * HTB, NXCD = 8, WGM = 8;

__host__ __device__ __forceinline__ int lds_byte(int r, int c) { const int st = (r >> 4) * 2 + (c >> 5), rr = r & 15, cc = c & 31, ob = rr * 64 + cc * 2; return st * 1024 + (ob ^ (((ob >> 9) & 1) << 5)); }
__host__ __device__ __forceinline__ void stage_rc(int b, int& R, int& C) { const int st = b / 1024, sb = b % 1024, swz = sb ^ (((sb >> 9) & 1) << 5); R = (st >> 1) * 16 + swz / 64; C = (st & 1) * 32 + (swz % 64) / 2; }
__host__ __device__ __forceinline__ int perm32(int rho) { const int n = rho >> 4, i = rho & 15; return 8 * (i >> 2) + 4 * n + (i & 3); }

struct Unit { int pm, pn; };
struct Gemm { const bf16_t* A; const bf16_t* Bt; int M, N, K; };

struct StaticOrder {
    int nM, nN, nwg, G, c;
    __host__ __device__ void init(int M, int N, int G_, int c_) { nM = M / BM; nN = N / BM; nwg = nM * nN; G = G_; c = c_; }
    __host__ __device__ bool next(int i, Unit& u) const {
        const long L = (long)i * G + c; if (L >= nwg) return false;
        int wgid = (int)L; { const int q = nwg / NXCD, r = nwg % NXCD, xcd = wgid % NXCD, off = wgid / NXCD; wgid = (xcd < r ? xcd * (q + 1) : r * (q + 1) + (xcd - r) * q) + off; }
        const int nig = WGM * nN, gid = wgid / nig, fm = gid * WGM, gsz = (nM - fm) < WGM ? (nM - fm) : WGM;
        u.pm = fm + ((wgid % nig) % gsz); u.pn = (wgid % nig) / gsz; return true;
    }
    __device__ __forceinline__ void a_ready(const Unit&) const {}
    __device__ __forceinline__ void done(const Unit&) const {}
};
struct OneUnit {
    int pm, pn;
    __host__ __device__ bool next(int i, Unit& u) const { if (i) return false; u.pm = pm; u.pn = pn; return true; }
    __device__ __forceinline__ void a_ready(const Unit&) const {}
    __device__ __forceinline__ void done(const Unit&) const {}
};
__device__ __forceinline__ unsigned cvt_pk_bf16(float lo, float hi) { unsigned r; asm volatile("v_cvt_pk_bf16_f32 %0, %1, %2" : "=v"(r) : "v"(lo), "v"(hi)); return r; }
typedef float f32x2 __attribute__((ext_vector_type(2)));
constexpr float LOG2E = 1.4426950408889634f;
constexpr float SC_QA = 0.125f * LOG2E;
constexpr float SC_QC = 0.17677669529663687f * LOG2E;
constexpr int ZLD = 4096, MROWS = 16640, NPROMPT = 16384;
constexpr size_t WSO_MiB = 1u << 20;
constexpr size_t WSO_PANEL = 512 * 4  , WSO_CTL = 0, WSO_SSQ1 = 16384 * 4, WSO_SSQ2 = (16384 + 32768) * 4, WSO_SSQ0 = 1 * WSO_MiB, WSO_ROPE = 2 * WSO_MiB, WSO_WIN = 4 * WSO_MiB, WSO_WOUT = 20 * WSO_MiB, WSO_XB = 24 * WSO_MiB,
                 WSO_YMIX = 60 * WSO_MiB, WSO_X1 = 96 * WSO_MiB, WSO_Z = 164 * WSO_MiB, WSO_END = 296 * WSO_MiB;
constexpr size_t OO_Y = 0, OO_AKP = 17039360, OO_AVP = OO_AKP + 524288, OO_CONVP = OO_AVP + 524288, OO_CKP = OO_CONVP + 1024, OO_CVP = OO_CKP + 8388608,
                 OO_AKS = OO_CVP + 8388608, OO_AVS = OO_AKS + 262144, OO_CONVS = OO_AVS + 262144, OO_CKS = OO_CONVS + 16384, OO_CVS = OO_CKS + 131072, OO_END = OO_CVS + 131072;
__device__ __forceinline__ float silu_f(float x) { return x * __builtin_amdgcn_rcpf(1.0f + __builtin_amdgcn_exp2f(-x * LOG2E)); }
struct EpiIn {
    static constexpr bool PERM = true, AFTER_DRAIN = false;
    unsigned char* ws; float* out; int l;
    __device__ __forceinline__ void operator()(const f32x4 (&acc)[2][2][4][2], const Unit& u, int wr, int wc, int fr, int fq) const {
        const int pn = u.pn, pm = u.pm;
        bf16_t* Z = (bf16_t*)(ws + WSO_Z); const float* ssq = (const float*)(ws + (l == 0 ? WSO_SSQ0 : WSO_SSQ1)); const float* rope = (const float*)(ws + WSO_ROPE);
        float* o_ak_p = out + OO_AKP + (size_t)l * 262144; float* o_av_p = out + OO_AVP + (size_t)l * 262144; float* o_ak_s = out + OO_AKS + (size_t)l * 131072; float* o_av_s = out + OO_AVS + (size_t)l * 131072;
        float* o_ck_p = out + OO_CKP + (size_t)l * 4194304; float* o_cv_p = out + OO_CVP + (size_t)l * 4194304; float* o_ck_s = out + OO_CKS + (size_t)l * 65536; float* o_cv_s = out + OO_CVS + (size_t)l * 65536;
        const int rowl = wr * 64 + fr;
        const int colb = pn * BM + wc * 32 + 8 * fq;
        const bool rope_tile = (pn == 12 || pn == 13);
        const bool do_rope = rope_tile && fq == 0;
        const float sc = (pn < 2) ? SC_QA : (pn == 12 ? SC_QC : 1.f);
        const bool do_silu = (pn == 6 || pn == 7 || pn == 11 || pn == 15);
        float* ob = nullptr; int old = 0, ocol0 = 0;
        if (pn >= 2 && pn <= 5) { old = 512; ocol0 = (pn >= 4) ? 1024 : 512;
            if (pm == 64) ob = (pn >= 4) ? o_av_s : o_ak_s; else if (pm >= 62) ob = ((pn >= 4) ? o_av_p : o_ak_p) + (size_t)(pm - 62) * 256 * 512; }
        else if (pn == 13 || pn == 14) { old = 256; ocol0 = (pn == 13) ? 3328 : 3584;
            if (pm == 64) ob = (pn == 13) ? o_ck_s : o_cv_s; else ob = ((pn == 13) ? o_ck_p : o_cv_p) + (size_t)pm * 256 * 256; }
#pragma unroll
        for (int ai = 0; ai < 2; ++ai)
#pragma unroll
            for (int m = 0; m < 4; ++m) {
                const int rl = rowl + ai * HALF + m * 16, row = pm * BM + rl;
                const float rs = __builtin_amdgcn_rsqf(ssq[row] * (1.0f / 1024.0f) + 1e-6f);
                f32x4 rc = {1.f, 1.f, 1.f, 1.f}, rsn = {0.f, 0.f, 0.f, 0.f};
                if (do_rope) { rc = *(const f32x4*)(rope + (size_t)row * 8); rsn = *(const f32x4*)(rope + (size_t)row * 8 + 4); }
#pragma unroll
                for (int bj = 0; bj < 2; ++bj) {
                    f32x4 v0 = acc[ai][bj][m][0] * rs, v1 = acc[ai][bj][m][1] * rs;
                    const int col = colb + bj * HALF;
                    if (rope_tile) { const f32x4 a = v0 * rc - v1 * rsn, b = v1 * rc + v0 * rsn; v0 = a; v1 = b; }
                    if (ob) { float* op = ob + (size_t)rl * old + (col - ocol0); *(f32x4*)op = v0; *(f32x4*)(op + 4) = v1; }
                    if (do_silu) { v0 = (f32x4){silu_f(v0[0]), silu_f(v0[1]), silu_f(v0[2]), silu_f(v0[3])}; v1 = (f32x4){silu_f(v1[0]), silu_f(v1[1]), silu_f(v1[2]), silu_f(v1[3])}; }
                    v0 = v0 * sc; v1 = v1 * sc;
                    u32x4 w; w.x = cvt_pk_bf16(v0[0], v0[1]); w.y = cvt_pk_bf16(v0[2], v0[3]); w.z = cvt_pk_bf16(v1[0], v1[1]); w.w = cvt_pk_bf16(v1[2], v1[3]);
                    *(u32x4*)(Z + (size_t)row * ZLD + col) = w;
                }
                asm volatile("" ::: "memory");
            }
    }
};
struct EpiOut {
    static constexpr bool PERM = true, AFTER_DRAIN = false;
    unsigned char* ws; const float* x_p; const float* x_s; int l; const float* fg; float* yout;
    __device__ __forceinline__ void operator()(f32x4 (&acc)[2][2][4][2], const Unit& u, int wr, int wc, int fr, int fq) const {
        const int pm = u.pm; const int colb = u.pn * BM + wc * 32 + 8 * fq;
        float* X1 = (float*)(ws + WSO_X1) + (size_t)pm * BM * 1024; bf16_t* XB = (bf16_t*)(ws + WSO_XB) + (size_t)pm * BM * 1024; float* ssq = (float*)(ws + (l == 0 ? WSO_SSQ1 : WSO_SSQ2)) + pm * BM;
        const float* res = (l == 0) ? ((pm == 64) ? x_s : x_p + (size_t)pm * BM * 1024) : X1;
        const unsigned off0 = (unsigned)(wr * 64 + fr) * 1024u + (unsigned)colb;
        const bool fuse = (l == 1 && pm < 64);
#pragma unroll
        for (int ai = 0; ai < 2; ++ai)
#pragma unroll
            for (int m = 0; m < 4; ++m) {
                const unsigned offr = off0 + (unsigned)(ai * HALF + m * 16) * 1024u; float q = 0.f;
#pragma unroll
                for (int bj = 0; bj < 2; ++bj) { const unsigned off = offr + bj * HALF;
                    const f32x4 v0 = acc[ai][bj][m][0] + *(const f32x4*)(res + off), v1 = acc[ai][bj][m][1] + *(const f32x4*)(res + off + 4);
                    if (fuse) { acc[ai][bj][m][0] = v0; acc[ai][bj][m][1] = v1; }
                    else {
                        *(f32x4*)(X1 + off) = v0; *(f32x4*)(X1 + off + 4) = v1;
                        u32x4 w; w.x = cvt_pk_bf16(v0[0], v0[1]); w.y = cvt_pk_bf16(v0[2], v0[3]); w.z = cvt_pk_bf16(v1[0], v1[1]); w.w = cvt_pk_bf16(v1[2], v1[3]);
                        *(u32x4*)(XB + off) = w; }
                    q += (v0[0] * v0[0] + v0[1] * v0[1]) + (v0[2] * v0[2] + v0[3] * v0[3]) + (v1[0] * v1[0] + v1[1] * v1[1]) + (v1[2] * v1[2] + v1[3] * v1[3]);
                    asm volatile("" ::: "memory"); }
                q += __shfl_xor(q, 16); q += __shfl_xor(q, 32);
                if (fq == 0) atomicAdd(ssq + (wr * 64 + fr + ai * HALF + m * 16), q);
                asm volatile("" ::: "memory");
            }
        if (fuse) {
            unsigned* cnt = (unsigned*)(ws + WSO_PANEL) + 64 * pm;
            asm volatile("s_waitcnt vmcnt(0)" ::: "memory");
            if (__builtin_amdgcn_readfirstlane(fr + 16 * fq) == (fr + 16 * fq)) __hip_atomic_fetch_add(cnt, 1u, __ATOMIC_RELAXED, __HIP_MEMORY_SCOPE_AGENT);
            unsigned spins = 0;
            while (__hip_atomic_load(cnt, __ATOMIC_RELAXED, __HIP_MEMORY_SCOPE_AGENT) < 32u) { __builtin_amdgcn_s_sleep(2); if (++spins > (1u << 22)) break; }
            float* yo = yout + (size_t)pm * BM * 1024;
#pragma unroll
            for (int ai = 0; ai < 2; ++ai)
#pragma unroll
                for (int m = 0; m < 4; ++m) {
                    const int rl = wr * 64 + fr + ai * HALF + m * 16;
                    const float sq = __hip_atomic_load(ssq + rl, __ATOMIC_RELAXED, __HIP_MEMORY_SCOPE_AGENT);
                    const float rs = __builtin_amdgcn_rsqf(sq * (1.0f / 1024.0f) + 1e-6f);
                    const unsigned offr = off0 + (unsigned)(ai * HALF + m * 16) * 1024u;
#pragma unroll
                    for (int bj = 0; bj < 2; ++bj) {
                        const f32x4 g0 = *(const f32x4*)(fg + colb + bj * HALF), g1 = *(const f32x4*)(fg + colb + bj * HALF + 4);
                        *(f32x4*)(yo + offr + bj * HALF) = acc[ai][bj][m][0] * rs * g0; *(f32x4*)(yo + offr + bj * HALF + 4) = acc[ai][bj][m][1] * rs * g1;
                        asm volatile("" ::: "memory"); }
                }
        }
    }
};
template <class Epi, class Sched, bool ALIGN_EPI = false, bool SP2 = false>
__device__ __forceinline__ void gemm_phase(PG8_LAS unsigned char* lds, const Gemm g, const Sched& S, const Epi& E) {
    int tid_ = threadIdx.x; asm volatile("" : "+v"(tid_));
    const int tid = tid_, wid = __builtin_amdgcn_readfirstlane(tid >> 6), lane = tid & 63, wr = wid >> 2, wc = wid & 3, fr = lane & 15, fq = lane >> 4;
    const int K = g.K, nt = K / BK;
    unsigned voffA[2], voffB[2];
#pragma unroll
    for (int i = 0; i < 2; ++i) { int R, C; stage_rc(tid * 16 + i * 8192, R, C); const int Rb = Epi::PERM ? ((R & ~31) + perm32(R & 31)) : R;
        voffA[i] = (unsigned)(R * K + C) * 2u; voffB[i] = (unsigned)(Rb * K + C) * 2u; }
    const size_t kstep = (size_t)(BK * 2);
    const size_t hstep = (size_t)HALF * K * 2;
    const size_t tstep = 2 * hstep;
    const unsigned ldsw = (unsigned)wid * 1024u;
    const int aoff = lds_byte(wr * 64 + fr, fq * 8), boff = lds_byte(wc * 32 + fr, fq * 8);
#define PG8_SA(b, h) (((b) * 2 + (h)) * HTB)
#define PG8_SB(b, h) ((4 + (b) * 2 + (h)) * HTB)
#define PG8_STAGE(bufoff, gbase, voff) do { _Pragma("unroll") for (int _i = 0; _i < 2; ++_i) \
        __builtin_amdgcn_global_load_lds((const unsigned*)((const char*)(gbase) + (voff)[_i]), (PG8_LAS unsigned*)(lds + (bufoff) + ldsw + _i * 8192), 16, 0, 0); } while (0)
#define PG8_LDA(dst, b, h) do { _Pragma("unroll") for (int m = 0; m < 4; ++m) _Pragma("unroll") for (int k = 0; k < 2; ++k) dst[m][k] = *(const PG8_LAS bf16x8*)(lds + PG8_SA(b, h) + aoff + m * 2048 + k * 1024); } while (0)
#define PG8_LDB(dst, b, h) do { _Pragma("unroll") for (int n = 0; n < 2; ++n) _Pragma("unroll") for (int k = 0; k < 2; ++k) dst[n][k] = *(const PG8_LAS bf16x8*)(lds + PG8_SB(b, h) + boff + n * 2048 + k * 1024); } while (0)
#define PG8_MMA(ai, bj, At, Bt) do { __builtin_amdgcn_s_setprio(1); _Pragma("unroll") for (int m = 0; m < 4; ++m) _Pragma("unroll") for (int n = 0; n < 2; ++n) _Pragma("unroll") for (int k = 0; k < 2; ++k) \
        acc[ai][bj][m][n] = __builtin_amdgcn_mfma_f32_16x16x32_bf16(Bt[n][k], At[m][k], acc[ai][bj][m][n], 0, 0, 0); __builtin_amdgcn_s_setprio(0); } while (0)
#define PG8_WAIT_V(n) asm volatile("s_waitcnt vmcnt(" #n ")" ::: "memory")
#define PG8_WAIT_L(n) asm volatile("s_waitcnt lgkmcnt(" #n ")" ::: "memory")
#define PG8_BAR __builtin_amdgcn_s_barrier()
#define PG8_SCHED __builtin_amdgcn_sched_barrier(0)
    Unit cur, nxt; int ui = 0;
    if (!S.next(0, cur)) return;
    f32x4 acc[2][2][4][2];
#pragma unroll
    for (int a = 0; a < 2; ++a)
#pragma unroll
        for (int b = 0; b < 2; ++b)
#pragma unroll
            for (int m = 0; m < 4; ++m)
#pragma unroll
                for (int n = 0; n < 2; ++n) acc[a][b][m][n] = (f32x4){0.f, 0.f, 0.f, 0.f};
    bf16x8 At[4][2], B0[2][2], B1[2][2];
    const char* cA = (const char*)g.A + (size_t)cur.pm * tstep; const char* cB = (const char*)g.Bt + (size_t)cur.pn * tstep;
    S.a_ready(cur);
    if constexpr (SP2) {
        PG8_STAGE(PG8_SB(0, 0), cB, voffB); PG8_STAGE(PG8_SB(0, 1), cB + hstep, voffB); PG8_STAGE(PG8_SA(0, 0), cA, voffA); PG8_STAGE(PG8_SA(0, 1), cA + hstep, voffA);
        if (wr == 1) PG8_BAR;
        PG8_WAIT_V(2); PG8_BAR;
        PG8_STAGE(PG8_SB(1, 0), cB + kstep, voffB); PG8_STAGE(PG8_SA(1, 0), cA + kstep, voffA); PG8_STAGE(PG8_SB(1, 1), cB + hstep + kstep, voffB);
        PG8_WAIT_V(6); PG8_BAR;
    } else {
        PG8_STAGE(PG8_SB(0, 0), cB, voffB); PG8_STAGE(PG8_SA(0, 0), cA, voffA); PG8_STAGE(PG8_SB(0, 1), cB + hstep, voffB); PG8_STAGE(PG8_SA(0, 1), cA + hstep, voffA);
        if (wr == 1) PG8_BAR;
        PG8_WAIT_V(4); PG8_BAR;
        PG8_STAGE(PG8_SB(1, 0), cB + kstep, voffB); PG8_STAGE(PG8_SA(1, 0), cA + kstep, voffA); PG8_STAGE(PG8_SB(1, 1), cB + hstep + kstep, voffB);
        PG8_WAIT_V(6); PG8_BAR;
    }
    for (;;) {
        const bool has_next = S.next(ui + 1, nxt);
        const char* nA = has_next ? (const char*)g.A + (size_t)nxt.pm * tstep : cA; const char* nB = has_next ? (const char*)g.Bt + (size_t)nxt.pn * tstep : cB;
        for (int t = 0; t < nt; t += 2) {
            const bool last = (t == nt - 2);
            const char* a1 = cA + (size_t)(t + 1) * kstep;
            const char* a2 = last ? nA : cA + (size_t)(t + 2) * kstep; const char* b2 = last ? nB : cB + (size_t)(t + 2) * kstep;
            const char* a3 = a2 + kstep; const char* b3 = b2 + kstep;
            if (last && has_next) S.a_ready(nxt);
            if constexpr (SP2) {
            PG8_LDB(B0, 0, 0); PG8_LDB(B1, 0, 1); PG8_SCHED; PG8_LDA(At, 0, 0); PG8_STAGE(PG8_SA(1, 1), a1 + hstep, voffA);
            PG8_WAIT_V(8); PG8_WAIT_L(0); PG8_BAR; PG8_MMA(0, 0, At, B0); PG8_MMA(0, 1, At, B1); PG8_BAR; PG8_SCHED;
            PG8_LDA(At, 0, 1); PG8_STAGE(PG8_SB(0, 0), b2, voffB); PG8_STAGE(PG8_SB(0, 1), b2 + hstep, voffB); PG8_STAGE(PG8_SA(0, 0), a2, voffA);
            PG8_WAIT_V(8); PG8_WAIT_L(0); PG8_BAR; PG8_MMA(1, 0, At, B0); PG8_MMA(1, 1, At, B1); PG8_BAR; PG8_SCHED;
            PG8_LDB(B0, 1, 0); PG8_LDB(B1, 1, 1); PG8_SCHED; PG8_LDA(At, 1, 0); PG8_STAGE(PG8_SA(0, 1), a2 + hstep, voffA);
            PG8_WAIT_V(8); PG8_WAIT_L(0); PG8_BAR; PG8_MMA(0, 0, At, B0); PG8_MMA(0, 1, At, B1); PG8_BAR; PG8_SCHED;
            PG8_LDA(At, 1, 1); PG8_STAGE(PG8_SB(1, 0), b3, voffB); PG8_STAGE(PG8_SB(1, 1), b3 + hstep, voffB); PG8_STAGE(PG8_SA(1, 0), a3, voffA);
            PG8_WAIT_V(8); PG8_WAIT_L(0); PG8_BAR; PG8_MMA(1, 0, At, B0); PG8_MMA(1, 1, At, B1); PG8_BAR; PG8_SCHED;
            } else {
            PG8_LDB(B0, 0, 0); PG8_SCHED; PG8_LDA(At, 0, 0); PG8_STAGE(PG8_SA(1, 1), a1 + hstep, voffA);
            PG8_WAIT_L(8); PG8_BAR; PG8_WAIT_L(0); PG8_MMA(0, 0, At, B0); PG8_BAR; PG8_SCHED;
            PG8_LDB(B1, 0, 1); PG8_STAGE(PG8_SB(0, 0), b2, voffB);
            PG8_BAR; PG8_WAIT_L(0); PG8_MMA(0, 1, At, B1); PG8_BAR;
            PG8_LDA(At, 0, 1); PG8_STAGE(PG8_SA(0, 0), a2, voffA);
            PG8_BAR; PG8_WAIT_L(0); PG8_MMA(1, 0, At, B0); PG8_BAR; PG8_SCHED;
            PG8_STAGE(PG8_SB(0, 1), b2 + hstep, voffB);
            PG8_WAIT_V(6); PG8_BAR; PG8_MMA(1, 1, At, B1); PG8_BAR;
            PG8_LDB(B0, 1, 0); PG8_SCHED; PG8_LDA(At, 1, 0); PG8_STAGE(PG8_SA(0, 1), a2 + hstep, voffA);
            PG8_WAIT_L(8); PG8_BAR; PG8_WAIT_L(0); PG8_MMA(0, 0, At, B0); PG8_BAR; PG8_SCHED;
            PG8_LDB(B1, 1, 1); PG8_STAGE(PG8_SB(1, 0), b3, voffB);
            PG8_BAR; PG8_WAIT_L(0); PG8_MMA(0, 1, At, B1); PG8_BAR;
            PG8_LDA(At, 1, 1); PG8_STAGE(PG8_SA(1, 0), a3, voffA);
            PG8_BAR; PG8_WAIT_L(0); PG8_MMA(1, 0, At, B0); PG8_BAR; PG8_SCHED;
            PG8_STAGE(PG8_SB(1, 1), b3 + hstep, voffB);
            PG8_WAIT_V(6); PG8_BAR; PG8_MMA(1, 1, At, B1); PG8_BAR;
            }
        }
        if constexpr (ALIGN_EPI) { if (wr == 0) PG8_BAR; }
        if constexpr (!Epi::AFTER_DRAIN) { E(acc, cur, wr, wc, fr, fq); S.done(cur); }
        if (!has_next) break;
#pragma unroll
        for (int a = 0; a < 2; ++a)
#pragma unroll
            for (int b = 0; b < 2; ++b)
#pragma unroll
                for (int m = 0; m < 4; ++m)
#pragma unroll
                    for (int n = 0; n < 2; ++n) acc[a][b][m][n] = (f32x4){0.f, 0.f, 0.f, 0.f};
        cur = nxt; cA = nA; cB = nB; ++ui;
        if constexpr (ALIGN_EPI) { if (wr == 1) PG8_BAR; }
    }
    PG8_WAIT_V(0);
    if constexpr (!ALIGN_EPI) { if (wr == 0) PG8_BAR; }
    PG8_BAR;
    if constexpr (Epi::AFTER_DRAIN) { E.fused(acc, cur, wr, wc, fr, fq, lds, wid, lane); S.done(cur); }
#undef PG8_SA
#undef PG8_SB
#undef PG8_STAGE
#undef PG8_LDA
#undef PG8_LDB
#undef PG8_MMA
#undef PG8_WAIT_V
#undef PG8_WAIT_L
#undef PG8_BAR
#undef PG8_SCHED
}
}
#define LAS __attribute__((address_space(3)))
typedef unsigned short bf16_t;
typedef LAS unsigned char* ldsp;
typedef short bf16x8 __attribute__((ext_vector_type(8)));
typedef short s16x4 __attribute__((ext_vector_type(4)));
typedef float f32x16 __attribute__((ext_vector_type(16)));
typedef float f32x4 __attribute__((ext_vector_type(4)));
typedef float f32x2 __attribute__((ext_vector_type(2)));
typedef unsigned u32x4 __attribute__((ext_vector_type(4)));
typedef unsigned u32x2 __attribute__((ext_vector_type(2)));
typedef __bf16 bf16x2_t __attribute__((ext_vector_type(2)));
using pg8::ZLD; using pg8::MROWS; using pg8::NPROMPT; using pg8::LOG2E;
__device__ __forceinline__ int crow(int r, int hi) { return (r & 3) + 8 * (r >> 2) + 4 * hi; }
__device__ __forceinline__ unsigned cvtpk(float lo, float hi) { f32x2 v = {lo, hi}; bf16x2_t b = __builtin_convertvector(v, bf16x2_t); return __builtin_bit_cast(unsigned, b); }
__device__ __forceinline__ float bf_lo(unsigned w) { return __uint_as_float(w << 16); }
__device__ __forceinline__ float bf_hi(unsigned w) { return __uint_as_float(w & 0xffff0000u); }
__device__ __forceinline__ float xhalf_max(float m) { auto rr = __builtin_amdgcn_permlane32_swap(__float_as_uint(m), __float_as_uint(m), false, false); return fmaxf(__uint_as_float(rr[0]), __uint_as_float(rr[1])); }
__device__ __forceinline__ float xhalf_sum(float m) { auto rr = __builtin_amdgcn_permlane32_swap(__float_as_uint(m), __float_as_uint(m), false, false); return __uint_as_float(rr[0]) + __uint_as_float(rr[1]); }
__device__ __forceinline__ s16x4 vtr(ldsp p) { typedef short v4i16_t __attribute__((ext_vector_type(4))); return __builtin_bit_cast(s16x4, __builtin_amdgcn_ds_read_tr16_b64_v4i16((LAS v4i16_t*)p)); }
__device__ __forceinline__ float max3f(float a, float b, float c) { float r; asm("v_max3_f32 %0, %1, %2, %3" : "=v"(r) : "v"(a), "v"(b), "v"(c)); return r; }
__device__ __forceinline__ float max2f(float a, float b) { float r; asm("v_max_f32_e32 %0, %1, %2" : "=v"(r) : "v"(a), "v"(b)); return r; }
__device__ __forceinline__ float sum8_s(float acc, float a, float b, float c, float d, float e, float f, float g, float h) {
    asm("s_nop 0\n\tv_add_f32_e32 %0, %0, %1\n\tv_add_f32_e32 %0, %0, %2\n\tv_add_f32_e32 %0, %0, %3\n\tv_add_f32_e32 %0, %0, %4\n\tv_add_f32_e32 %0, %0, %5\n\tv_add_f32_e32 %0, %0, %6\n\tv_add_f32_e32 %0, %0, %7\n\tv_add_f32_e32 %0, %0, %8"
        : "+v"(acc) : "v"(a), "v"(b), "v"(c), "v"(d), "v"(e), "v"(f), "v"(g), "v"(h));
    return acc; }
__device__ __forceinline__ float sum4_s(float acc, float a, float b, float c, float d) {
    asm("s_nop 0\n\tv_add_f32_e32 %0, %0, %1\n\tv_add_f32_e32 %0, %0, %2\n\tv_add_f32_e32 %0, %0, %3\n\tv_add_f32_e32 %0, %0, %4" : "+v"(acc) : "v"(a), "v"(b), "v"(c), "v"(d));
    return acc; }
__device__ __forceinline__ float fadd_s(float a, float b) { float r; asm("v_add_f32_e32 %0, %1, %2" : "=v"(r) : "v"(a), "v"(b)); return r; }
#define MFMA32(a, b, c) __builtin_amdgcn_mfma_f32_32x32x16_bf16((a), (b), (c), 0, 0, 0)

constexpr int KPITCH = 144, KT_BYTES = 64 * KPITCH, VT_BYTES = 8192, TILE_BYTES = KT_BYTES + VT_BYTES, BUF_BYTES = 2 * TILE_BYTES;
constexpr int COMB_OFF = 2 * BUF_BYTES, COMB_WAVE = 17408, TAB_OFF = COMB_OFF + 4 * COMB_WAVE, TAB_N = 640, TAB_DDMAX = 576, MISC_OFF = TAB_OFF + TAB_N * 4 + 16, LDS_BYTES = 147456;
static_assert(MISC_OFF + 64 <= LDS_BYTES, "LDS map");
constexpr float NEG_BIG = -1.0e30f, THR = 8.0f;
#ifndef REDO_LIMIT
#define REDO_LIMIT 256.0f
#endif
struct AU {
    const bf16_t* q; int nq; int nt, ntc; const float* kc; const float* vc; int cp; const bf16_t* kz; const bf16_t* vz; int lastv; int nqg;
    int tlo0, thi0, tlo1, thi1; int qpos0, kpos0; const bf16_t* gate; bf16_t* y; const float* tabsrc;
};
#ifndef ATTN_INL
#define ATTN_INL __forceinline__
#endif
template <int MODE  >
__device__ ATTN_INL void attn_unit(const AU& d, ldsp lds, float lam, int lsel, const float* subg) {
    constexpr bool WIDE = (MODE == 2), BIAS = (MODE != 0);
    constexpr int NMAP = (MODE == 1) ? 1 : 2, NSTEP = (MODE == 0) ? 2 : 4, NSUB = WIDE ? 2 : 1;
#define KC(MP) ((MODE == 0) ? (MP) * 32 : 0)
    int tid_ = threadIdx.x; asm volatile("" : "+v"(tid_));
    const int tid = tid_, lane = tid & 63, wid = __builtin_amdgcn_readfirstlane(tid >> 6), qg = WIDE ? wid : (wid & 3), ks = WIDE ? 0 : (wid >> 2), r32 = lane & 31, hi = lane >> 5;
    int tlo = (qg >> 1) ? d.tlo1 : d.tlo0; int thi = (qg >> 1) ? d.thi1 : d.thi0; if (qg >= d.nqg) thi = -1;
    if (WIDE) { thi = d.tlo0 + wid; tlo = max(thi - 8, 0); }
    const int qoff0 = WIDE ? 64 * wid : 32 * qg;
    const LAS float* tab = (const LAS float*)(lds + TAB_OFF);
    float tabv0 = 0.f, tabv1 = 0.f;
    if (BIAS) { tabv0 = d.tabsrc[min(max(TAB_DDMAX - tid, -128), 128) + 128]; if (tid + 512 < TAB_N) tabv1 = d.tabsrc[min(max(TAB_DDMAX - (tid + 512), -128), 128) + 128]; }
    bf16x8 qf[NMAP][NSTEP];
    const ldsp Qw = lds + COMB_OFF + wid * 8192;
    if (WIDE) {
        u32x4 qv_[8];
#pragma unroll
        for (int j = 0; j < 8; ++j) qv_[j] = *(const u32x4*)(d.q + (size_t)(qoff0 + lane) * ZLD + j * 8);
#pragma unroll
        for (int j = 0; j < 8; ++j) *(LAS u32x4*)(Qw + lane * 128 + ((j ^ (lane & 7)) * 16)) = qv_[j];
    }
#define QFRAG(MP, ST) (WIDE ? *(const LAS bf16x8*)(Qw + (32 * (MP) + r32) * 128 + ((((ST) * 2 + hi) ^ (r32 & 7)) * 16)) : qf[MP][ST])
#pragma unroll
    for (int mp = 0; mp < (WIDE ? 0 : NMAP); ++mp) { int qrow = qoff0 + r32; if (qrow >= d.nq) qrow = d.nq - 1;
      const bf16_t* qp = d.q + (size_t)qrow * ZLD;
#pragma unroll
      for (int st = 0; st < NSTEP; ++st) qf[mp][st] = *(const bf16x8*)(qp + KC(mp) + st * 16 + hi * 8); }
    f32x16 O[NMAP][2]; float mref[NMAP], lsum[NMAP];
#pragma unroll
    for (int mp = 0; mp < NMAP; ++mp) { mref[mp] = 0.f; lsum[mp] = 0.f;
#pragma unroll
        for (int db = 0; db < 2; ++db)
#pragma unroll
            for (int i = 0; i < 16; ++i) O[mp][db][i] = 0.f; }
    const int lrow = tid >> 3, lch = tid & 7;
    const int kwoff = lrow * KPITCH + lch * 16, vwoff = (lch >> 2) * 4096 + lrow * 64 + (lch & 3) * 16;
    const int kroff = r32 * KPITCH + hi * 16;
    const int vroff = (4 * hi + ((lane & 15) >> 2)) * 64 + ((lane >> 4) & 1) * 32 + (lane & 3) * 8;
    u32x4 stK[2], stV[2];
    const int nit = (d.nt + 1) >> 1; bool started = false;
#define AT_ISSUE(IT) do { if (!WIDE) _Pragma("unroll") for (int i_ = 0; i_ < 2; ++i_) { const int t_ = 2 * (IT) + i_; if (t_ < d.nt && t_ >= d.ntc) { int r_ = lrow; if (t_ == d.nt - 1 && r_ >= d.lastv) r_ = d.lastv - 1; \
        const size_t off_ = ((size_t)(t_ - d.ntc) * 64 + r_) * ZLD + lch * 8; stK[i_] = *(const u32x4*)(d.kz + off_); stV[i_] = *(const u32x4*)(d.vz + off_); } } } while (0)
#define AT_WRITE(IT, BUF) do { _Pragma("unroll") for (int i_ = 0; i_ < 2; ++i_) { const int t_ = 2 * (IT) + i_; if (t_ < d.nt) { u32x4 kk_, vv_; if (WIDE) { const size_t off_ = ((size_t)t_ * 64 + lrow) * ZLD + lch * 8; kk_ = *(const u32x4*)(d.kz + off_); vv_ = *(const u32x4*)(d.vz + off_); } else if (t_ >= d.ntc) { kk_ = stK[i_]; vv_ = stV[i_]; } else { \
        const size_t off_ = ((size_t)t_ * 64 + lrow) * d.cp + lch * 8; const f32x4 a_ = *(const f32x4*)(d.kc + off_), b_ = *(const f32x4*)(d.kc + off_ + 4), c_ = *(const f32x4*)(d.vc + off_), e_ = *(const f32x4*)(d.vc + off_ + 4); \
        kk_ = (u32x4){cvtpk(a_[0], a_[1]), cvtpk(a_[2], a_[3]), cvtpk(b_[0], b_[1]), cvtpk(b_[2], b_[3])}; vv_ = (u32x4){cvtpk(c_[0], c_[1]), cvtpk(c_[2], c_[3]), cvtpk(e_[0], e_[1]), cvtpk(e_[2], e_[3])}; } \
        *(LAS u32x4*)((BUF) + i_ * TILE_BYTES + kwoff) = kk_; *(LAS u32x4*)((BUF) + i_ * TILE_BYTES + KT_BYTES + vwoff) = vv_; } } } while (0)
    AT_ISSUE(0);
    if (BIAS) { ((LAS float*)(lds + TAB_OFF))[tid] = tabv0 * LOG2E; if (tid + 512 < TAB_N) ((LAS float*)(lds + TAB_OFF))[tid + 512] = tabv1 * LOG2E; }
    for (int it = 0; it < nit; ++it) {
        const ldsp buf = lds + (it & 1) * BUF_BYTES;
        AT_WRITE(it, buf);
        __builtin_amdgcn_s_waitcnt(0);
        __syncthreads();
#pragma nounroll
        for (int sub = 0; sub < NSUB; ++sub) {
        const int t = 2 * it + (WIDE ? sub : ks);
        const bool vis = (t >= tlo && t <= thi);
        const ldsp Kt = buf + (WIDE ? sub : ks) * TILE_BYTES, Vt = Kt + KT_BYTES;
        bf16x8 kf0[2 * NSTEP];
        if (vis) {
#pragma unroll
            for (int st = 0; st < (WIDE ? 2 : NSTEP); ++st) { kf0[2 * st] = *(const LAS bf16x8*)(Kt + kroff + (st * 16) * 2); kf0[2 * st + 1] = *(const LAS bf16x8*)(Kt + kroff + 32 * KPITCH + (st * 16) * 2); }
        }
        __builtin_amdgcn_sched_barrier(0);
        if (sub == 0 && it + 1 < nit) AT_ISSUE(it + 1);
        __builtin_amdgcn_sched_barrier(0);
        if (vis) {
            const int valid = (t == d.nt - 1) ? d.lastv : 64;
            f32x16 S0[NMAP], S1[NMAP];
#define AT_BIAS(MP) do { const int qb_ = d.qpos0 + qoff0 + (WIDE ? 32 * (MP) : 0), kp0_ = d.kpos0 + 64 * t; \
                if (qb_ - (kp0_ + 63) >= 128) { const float c_ = tab[TAB_DDMAX - 128]; _Pragma("unroll") for (int i = 0; i < 16; ++i) { S0[MP][i] += c_; S1[MP][i] += c_; } } \
                else { int j0_ = TAB_DDMAX - (qb_ + r32 - kp0_ - 4 * hi); asm volatile("" : "+v"(j0_)); const LAS float* tb_ = tab + j0_; \
                    _Pragma("unroll") for (int i = 0; i < 16; ++i) { S0[MP][i] += tb_[(i & 3) + 8 * (i >> 2)]; S1[MP][i] += tb_[(i & 3) + 8 * (i >> 2) + 32]; } } } while (0)
#define AT_QK(MP) do { f32x16 negm_; _Pragma("unroll") for (int i = 0; i < 16; ++i) negm_[i] = -mref[MP]; \
                _Pragma("unroll") for (int st = 0; st < NSTEP; ++st) { \
                    const bf16x8 a0_ = *(const LAS bf16x8*)(Kt + kroff + (KC(MP) + st * 16) * 2); \
                    const bf16x8 a1_ = *(const LAS bf16x8*)(Kt + kroff + 32 * KPITCH + (KC(MP) + st * 16) * 2); \
                    if (st == 0) { S0[MP] = MFMA32(a0_, QFRAG(MP, st), negm_); S1[MP] = MFMA32(a1_, QFRAG(MP, st), negm_); } \
                    else { S0[MP] = MFMA32(a0_, QFRAG(MP, st), S0[MP]); S1[MP] = MFMA32(a1_, QFRAG(MP, st), S1[MP]); } } \
                if (BIAS) AT_BIAS(MP); \
                if (0) { const int qpos = d.qpos0 + 32 * qg + r32, kp0 = d.kpos0 + 64 * t; \
                    if (d.qpos0 + 32 * qg - (kp0 + 63) >= 128) { const float c = tab[256]; _Pragma("unroll") for (int i = 0; i < 16; ++i) { S0[MP][i] += c; S1[MP][i] += c; } } \
                    else { _Pragma("unroll") for (int i = 0; i < 16; ++i) { int dd = qpos - (kp0 + crow(i, hi)); int d0 = min(max(dd, -128), 128), d1 = min(max(dd - 32, -128), 128); S0[MP][i] += tab[d0 + 128]; S1[MP][i] += tab[d1 + 128]; } } } \
                if (valid < 64) { _Pragma("unroll") for (int i = 0; i < 16; ++i) { const int k = crow(i, hi); if (k >= valid) S0[MP][i] = NEG_BIG; if (k + 32 >= valid) S1[MP][i] = NEG_BIG; } } } while (0)
#define AT_SLOW(MP) do { asm volatile("s_nop 15\n\ts_nop 7" : "+v"(S0[MP]), "+v"(S1[MP])); \
                float ra_ = max3f(S0[MP][0], S0[MP][1], S1[MP][0]), rb_ = max3f(S0[MP][2], S0[MP][3], S1[MP][1]); ra_ = max3f(ra_, S1[MP][2], S1[MP][3]); \
                _Pragma("unroll") for (int i = 4; i < 16; i += 4) { ra_ = max3f(ra_, S0[MP][i], S0[MP][i + 1]); rb_ = max3f(rb_, S0[MP][i + 2], S0[MP][i + 3]); ra_ = max3f(ra_, S1[MP][i], S1[MP][i + 1]); rb_ = max3f(rb_, S1[MP][i + 2], S1[MP][i + 3]); } \
                const float rm_ = xhalf_max(max2f(ra_, rb_)); \
                const float dl_ = started ? fmaxf(rm_, 0.f) : rm_, al_ = started ? __builtin_amdgcn_exp2f(-dl_) : 1.f; \
                mref[MP] += dl_; lsum[MP] *= al_; \
                _Pragma("unroll") for (int i = 0; i < 16; ++i) { S0[MP][i] -= dl_; S1[MP][i] -= dl_; } \
                _Pragma("unroll") for (int db = 0; db < 2; ++db) _Pragma("unroll") for (int i = 0; i < 16; ++i) O[MP][db][i] *= al_; } while (0)
#define AT_EXPSUM(MP) do { sa = 0.f; sb = 0.f; \
                _Pragma("unroll") for (int i = 0; i < 16; ++i) { S0[MP][i] = __builtin_amdgcn_exp2f(S0[MP][i]); S1[MP][i] = __builtin_amdgcn_exp2f(S1[MP][i]); } \
                _Pragma("unroll") for (int i = 0; i < 16; i += 8) { sa = sum8_s(sa, S0[MP][i], S0[MP][i + 1], S0[MP][i + 2], S0[MP][i + 3], S0[MP][i + 4], S0[MP][i + 5], S0[MP][i + 6], S0[MP][i + 7]); \
                    sb = sum8_s(sb, S1[MP][i], S1[MP][i + 1], S1[MP][i + 2], S1[MP][i + 3], S1[MP][i + 4], S1[MP][i + 5], S1[MP][i + 6], S1[MP][i + 7]); } } while (0)
#define AT_CVT(MP) do { _Pragma("unroll") for (int s_ = 0; s_ < 2; ++s_) { \
                u32x4 w0_ = {cvtpk(S0[MP][8 * s_], S0[MP][8 * s_ + 1]), cvtpk(S0[MP][8 * s_ + 2], S0[MP][8 * s_ + 3]), cvtpk(S0[MP][8 * s_ + 4], S0[MP][8 * s_ + 5]), cvtpk(S0[MP][8 * s_ + 6], S0[MP][8 * s_ + 7])}; \
                u32x4 w1_ = {cvtpk(S1[MP][8 * s_], S1[MP][8 * s_ + 1]), cvtpk(S1[MP][8 * s_ + 2], S1[MP][8 * s_ + 3]), cvtpk(S1[MP][8 * s_ + 4], S1[MP][8 * s_ + 5]), cvtpk(S1[MP][8 * s_ + 6], S1[MP][8 * s_ + 7])}; \
                Pf[s_] = __builtin_bit_cast(bf16x8, w0_); Pf[2 + s_] = __builtin_bit_cast(bf16x8, w1_); } } while (0)
#define AT_VF(J) ({ const s16x4 lo_ = vfr[2 * (J)], hh_ = vfr[2 * (J) + 1]; (bf16x8){lo_[0], lo_[1], lo_[2], lo_[3], hh_[0], hh_[1], hh_[2], hh_[3]}; })
#define AT_VLOAD() do { _Pragma("unroll") for (int j_ = 0; j_ < 8; ++j_) { vfr[2 * j_] = vtr(Vt + vroff + (j_ & 1) * 4096 + (j_ >> 1) * 1024); vfr[2 * j_ + 1] = vtr(Vt + vroff + (j_ & 1) * 4096 + (j_ >> 1) * 1024 + 512); } } while (0)
#define SBAR() __builtin_amdgcn_sched_barrier(0)
            float sa, sb; bf16x8 Pf[4]; s16x4 vfr[16];
            { f32x16 negm_;
#pragma unroll
              for (int i = 0; i < 16; ++i) negm_[i] = -mref[0];
#pragma unroll
              for (int st = 0; st < NSTEP; ++st) {
                  const bf16x8 q_ = QFRAG(0, st);
                  const bf16x8 ka_ = (WIDE && st >= 2) ? *(const LAS bf16x8*)(Kt + kroff + (st * 16) * 2) : kf0[2 * st], kb_ = (WIDE && st >= 2) ? *(const LAS bf16x8*)(Kt + kroff + 32 * KPITCH + (st * 16) * 2) : kf0[2 * st + 1];
                  if (st == 0) { S0[0] = MFMA32(ka_, q_, negm_); S1[0] = MFMA32(kb_, q_, negm_); }
                  else { S0[0] = MFMA32(ka_, q_, S0[0]); S1[0] = MFMA32(kb_, q_, S1[0]); } }
              if (BIAS) AT_BIAS(0);
              if (0) { const int qpos = d.qpos0 + 32 * qg + r32, kp0 = d.kpos0 + 64 * t;
                  if (d.qpos0 + 32 * qg - (kp0 + 63) >= 128) { const float c = tab[256];
#pragma unroll
                      for (int i = 0; i < 16; ++i) { S0[0][i] += c; S1[0][i] += c; } }
                  else {
#pragma unroll
                      for (int i = 0; i < 16; ++i) { int dd = qpos - (kp0 + crow(i, hi)); int d0 = min(max(dd, -128), 128), d1 = min(max(dd - 32, -128), 128); S0[0][i] += tab[d0 + 128]; S1[0][i] += tab[d1 + 128]; } } }
              if (valid < 64) {
#pragma unroll
                  for (int i = 0; i < 16; ++i) { const int k = crow(i, hi); if (k >= valid) S0[0][i] = NEG_BIG; if (k + 32 >= valid) S1[0][i] = NEG_BIG; } } }
            if (!started) AT_SLOW(0);
            if (NMAP == 2) {
                constexpr int M1 = NMAP - 1;
                bf16x8 kf1[4]; f32x16 negm1; bf16x8 wka = kf1[0], wkb = kf1[0];
                bf16x8 wq = wka;
                if (WIDE) { wka = *(const LAS bf16x8*)(Kt + kroff); wkb = *(const LAS bf16x8*)(Kt + kroff + 32 * KPITCH); wq = QFRAG(M1, 0); }
                if (!WIDE) {
#pragma unroll
                for (int st = 0; st < 2; ++st) { kf1[2 * st] = *(const LAS bf16x8*)(Kt + kroff + (32 + st * 16) * 2); kf1[2 * st + 1] = *(const LAS bf16x8*)(Kt + kroff + 32 * KPITCH + (32 + st * 16) * 2); } }
#pragma unroll
                for (int i = 0; i < 16; ++i) negm1[i] = -mref[M1];
                sa = 0.f; sb = 0.f;
                SBAR();
#pragma unroll
                for (int g = 0; g < 4; ++g) {
                    if (WIDE) {
                        bf16x8 na_ = wka, nb_ = wkb;
                        if (g < 3) { na_ = *(const LAS bf16x8*)(Kt + kroff + ((g + 1) * 16) * 2); nb_ = *(const LAS bf16x8*)(Kt + kroff + 32 * KPITCH + ((g + 1) * 16) * 2); }
                        bf16x8 nq_ = wq;
                        if (g < 3) nq_ = QFRAG(M1, (g + 1) % NSTEP);
                        if (g == 0) { S0[M1] = MFMA32(wka, wq, negm1); S1[M1] = MFMA32(wkb, wq, negm1); }
                        else { S0[M1] = MFMA32(wka, wq, S0[M1]); S1[M1] = MFMA32(wkb, wq, S1[M1]); }
                        wka = na_; wkb = nb_; wq = nq_;
                    } else {
                    if (g == 0) S0[M1] = MFMA32(kf1[0], qf[M1][0], negm1); else if (g == 1) S1[M1] = MFMA32(kf1[1], qf[M1][0], negm1);
                    else if (g == 2) S0[M1] = MFMA32(kf1[2], qf[M1][1], S0[M1]); else S1[M1] = MFMA32(kf1[3], qf[M1][1], S1[M1]); }
                    SBAR();
#pragma unroll
                    for (int i = 4 * g; i < 4 * g + 4; ++i) { S0[0][i] = __builtin_amdgcn_exp2f(S0[0][i]); S1[0][i] = __builtin_amdgcn_exp2f(S1[0][i]); }
                    if (g & 1) sb = sum8_s(sb, S0[0][4 * g], S0[0][4 * g + 1], S0[0][4 * g + 2], S0[0][4 * g + 3], S1[0][4 * g], S1[0][4 * g + 1], S1[0][4 * g + 2], S1[0][4 * g + 3]);
                    else sa = sum8_s(sa, S0[0][4 * g], S0[0][4 * g + 1], S0[0][4 * g + 2], S0[0][4 * g + 3], S1[0][4 * g], S1[0][4 * g + 1], S1[0][4 * g + 2], S1[0][4 * g + 3]);
                    SBAR();
                }
                if (WIDE) AT_BIAS(M1);
                if (valid < 64) {
#pragma unroll
                    for (int i = 0; i < 16; ++i) { const int k = crow(i, hi); if (k >= valid) S0[M1][i] = NEG_BIG; if (k + 32 >= valid) S1[M1][i] = NEG_BIG; } }
            } else AT_EXPSUM(0);
            if (started && __any(!(sa + sb <= REDO_LIMIT))) { AT_QK(0); AT_SLOW(0); AT_EXPSUM(0); }
            lsum[0] += sa + sb;
            AT_VLOAD();
            AT_CVT(0);
            if (NMAP == 2) {
                constexpr int M1 = NMAP - 1;
                if (!started) AT_SLOW(M1);
                sa = 0.f; sb = 0.f;
                SBAR();
#pragma unroll
                for (int j = 0; j < 8; ++j) {
                    O[0][j & 1] = MFMA32(AT_VF(j), Pf[j >> 1], O[0][j & 1]);
                    SBAR();
                    S0[M1][2 * j] = __builtin_amdgcn_exp2f(S0[M1][2 * j]); S0[M1][2 * j + 1] = __builtin_amdgcn_exp2f(S0[M1][2 * j + 1]);
                    S1[M1][2 * j] = __builtin_amdgcn_exp2f(S1[M1][2 * j]); S1[M1][2 * j + 1] = __builtin_amdgcn_exp2f(S1[M1][2 * j + 1]);
                    if (j & 1) sb = sum4_s(sb, S0[M1][2 * j], S0[M1][2 * j + 1], S1[M1][2 * j], S1[M1][2 * j + 1]); else sa = sum4_s(sa, S0[M1][2 * j], S0[M1][2 * j + 1], S1[M1][2 * j], S1[M1][2 * j + 1]);
                    SBAR();
                }
                if (started && __any(!(sa + sb <= REDO_LIMIT))) { AT_QK(M1); AT_SLOW(M1); AT_EXPSUM(M1); }
                lsum[M1] += sa + sb;
#pragma unroll
                for (int k = 0; k < 4; ++k) {
                    const f32x16& sx = (k < 2) ? S0[M1] : S1[M1]; const int b = 8 * (k & 1);
                    const u32x4 w_ = {cvtpk(sx[b], sx[b + 1]), cvtpk(sx[b + 2], sx[b + 3]), cvtpk(sx[b + 4], sx[b + 5]), cvtpk(sx[b + 6], sx[b + 7])};
                    Pf[k] = __builtin_bit_cast(bf16x8, w_);
                    SBAR();
                    O[M1][0] = MFMA32(AT_VF(2 * k), Pf[k], O[M1][0]); O[M1][1] = MFMA32(AT_VF(2 * k + 1), Pf[k], O[M1][1]);
                    SBAR();
                }
            } else {
#pragma unroll
                for (int j = 0; j < 8; ++j) O[0][j & 1] = MFMA32(AT_VF(j), Pf[j >> 1], O[0][j & 1]);
            }
#undef AT_SLOW
#undef AT_EXPSUM
#undef AT_CVT
#undef AT_VF
#undef AT_VLOAD
#undef SBAR
#undef AT_BIAS
            started = true;
#undef AT_QK
        }
        }
    }
#undef AT_ISSUE
#undef AT_WRITE
    __syncthreads();
    if (!started) {
#pragma unroll
        for (int mp = 0; mp < NMAP; ++mp) mref[mp] = NEG_BIG;
    }
    u32x2 gpre[8];
    if (MODE == 1 && ks == 0 && qg < d.nqg) { const int row_ = min(32 * qg + r32, d.nq - 1);
#pragma unroll
        for (int j = 0; j < 8; ++j) gpre[j] = *(const u32x2*)(d.gate + (size_t)row_ * ZLD + 32 * (j >> 2) + 8 * (j & 3) + 4 * hi); }
    const ldsp cw = lds + COMB_OFF + qg * COMB_WAVE;
    if (!WIDE && ks == 1 && qg < d.nqg) {
#pragma unroll
        for (int mp = 0; mp < NMAP; ++mp) {
#pragma unroll
            for (int db = 0; db < 2; ++db)
#pragma unroll
                for (int i = 0; i < 16; ++i) *(LAS float*)(cw + ((mp * 2 + db) * 16 + i) * 256 + lane * 4) = O[mp][db][i];
            *(LAS float*)(cw + 16384 + (mp * 2) * 256 + lane * 4) = mref[mp]; *(LAS float*)(cw + 16384 + (mp * 2 + 1) * 256 + lane * 4) = lsum[mp];
        }
    }
    __syncthreads();
    if (WIDE) {
#pragma unroll
        for (int mp = 0; mp < NMAP; ++mp) {
            const float fin = 1.0f / xhalf_sum(lsum[mp]); const int row = qoff0 + 32 * mp + r32;
#pragma unroll
            for (int db = 0; db < 2; ++db)
#pragma unroll
                for (int g4 = 0; g4 < 4; ++g4) {
                    const int d0 = 32 * db + 8 * g4 + 4 * hi;
                    const u32x2 gw = *(const u32x2*)(d.gate + (size_t)row * ZLD + d0);
                    const float y0 = O[mp][db][4 * g4] * fin * bf_lo(gw.x), y1 = O[mp][db][4 * g4 + 1] * fin * bf_hi(gw.x), y2 = O[mp][db][4 * g4 + 2] * fin * bf_lo(gw.y), y3 = O[mp][db][4 * g4 + 3] * fin * bf_hi(gw.y);
                    *(u32x2*)(d.y + (size_t)row * 1024 + d0) = (u32x2){cvtpk(y0, y1), cvtpk(y2, y3)};
                }
        }
    } else
    if (ks == 0 && qg < d.nqg) {
        float linv[NMAP];
#pragma unroll
        for (int mp = 0; mp < NMAP; ++mp) {
            const float mb = *(const LAS float*)(cw + 16384 + (mp * 2) * 256 + lane * 4), lb = *(const LAS float*)(cw + 16384 + (mp * 2 + 1) * 256 + lane * 4);
            const float mt = fmaxf(mref[mp], mb), aa = __builtin_amdgcn_exp2f(mref[mp] - mt), ab = __builtin_amdgcn_exp2f(mb - mt);
            const float l = xhalf_sum(lsum[mp] * aa + lb * ab);
            linv[mp] = 1.0f / l;
#pragma unroll
            for (int db = 0; db < 2; ++db)
#pragma unroll
                for (int i = 0; i < 16; ++i) O[mp][db][i] = O[mp][db][i] * aa + *(const LAS float*)(cw + ((mp * 2 + db) * 16 + i) * 256 + lane * 4) * ab;
        }
        float fin = 1.f;
        if (MODE == 0) {
            const float i1 = linv[0], i2 = lam * linv[NMAP - 1]; float ss = 0.f;
#pragma unroll
            for (int db = 0; db < 2; ++db)
#pragma unroll
                for (int i = 0; i < 16; ++i) { const float o = O[0][db][i] * i1 - O[NMAP - 1][db][i] * i2; O[0][db][i] = o; ss += o * o; }
            ss = xhalf_sum(ss);
            int sel_ = lsel; asm volatile("" : "+s"(sel_));
            fin = __builtin_amdgcn_rsqf(ss * (1.0f / 64.0f) + 1e-5f) * ((sel_ == 0) ? 0.8f : 0.6444909324090307f);
        } else fin = linv[0];
        const int row = 32 * qg + r32;
        if (row < d.nq) {
#pragma unroll
            for (int db = 0; db < 2; ++db)
#pragma unroll
                for (int g4 = 0; g4 < 4; ++g4) {
                    const int d0 = 32 * db + 8 * g4 + 4 * hi;
                    const u32x2 gw = (MODE == 1) ? gpre[db * 4 + g4] : *(const u32x2*)(d.gate + (size_t)row * ZLD + d0);
                    f32x4 sg = {1.f, 1.f, 1.f, 1.f}; if (MODE == 0) sg = *(const f32x4*)(subg + d0);
                    const float y0 = O[0][db][4 * g4] * fin * sg[0] * bf_lo(gw.x), y1 = O[0][db][4 * g4 + 1] * fin * sg[1] * bf_hi(gw.x);
                    const float y2 = O[0][db][4 * g4 + 2] * fin * sg[2] * bf_lo(gw.y), y3 = O[0][db][4 * g4 + 3] * fin * sg[3] * bf_hi(gw.y);
                    *(u32x2*)(d.y + (size_t)row * 1024 + d0) = (u32x2){cvtpk(y0, y1), cvtpk(y2, y3)};
                }
        }
    }
}
#undef KC
#undef QFRAG
using namespace pg8;
#ifndef P1_ALIGN
#define P1_ALIGN true
#endif
constexpr size_t WS_CTL = WSO_CTL, CTL_BYTES = 1u << 20, WS_SSQ0 = WSO_SSQ0, WS_ROPE = WSO_ROPE, WS_WIN = WSO_WIN, WS_WOUT = WSO_WOUT, WS_XB = WSO_XB, WS_YMIX = WSO_YMIX, WS_X1 = WSO_X1, WS_Z = WSO_Z, WS_END = WSO_END;
static_assert((size_t)MROWS * 1024 * 2 <= 36u * (1u << 20) && (size_t)MROWS * 1024 * 4 <= 68u * (1u << 20) && (size_t)MROWS * 4096 * 2 <= 132u * (1u << 20), "ws map");
constexpr int CTL_Q0 = 0, CTL_SI = 64, CTL_SM = 128, CTL_SSQ1 = 16384, CTL_SSQ2 = 16384 + 32768;
static_assert((CTL_SSQ2 + MROWS) * 4 <= (int)CTL_BYTES, "ctl");
constexpr size_t O_Y = OO_Y, O_CONVP = OO_CONVP, O_CONVS = OO_CONVS, O_END = OO_END;
struct Args { const float* in[18]; float* out; unsigned char* ws; };

__device__ __forceinline__ float wave_sum(float v) {
#pragma unroll
    for (int o = 1; o < 64; o <<= 1) v += __shfl_xor(v, o);
    return v;
}
__device__ __forceinline__ unsigned f2bf(float f) { unsigned u = __builtin_bit_cast(unsigned, f); return (u + 0x7fffu + ((u >> 16) & 1u)) >> 16; }
__device__ __forceinline__ unsigned pk2(float lo, float hi) { return f2bf(lo) | (f2bf(hi) << 16); }
__device__ __forceinline__ void p0_transpose_item(const float* W, const float* g, int K, int N, bf16_t* WT, LAS float* scr, int item, int lane) {
    const int nblk = N / 32, kb = item / nblk, nb = item % nblk, k0 = 64 * kb, n0 = 32 * nb;
#pragma unroll 8
    for (int i = 0; i < 32; ++i) { const int kk = 2 * i + (lane >> 5); const float gs = g ? g[k0 + kk] : 1.f; scr[kk * 33 + (lane & 31)] = W[(size_t)(k0 + kk) * N + n0 + (lane & 31)] * gs; }
    asm volatile("s_waitcnt lgkmcnt(0)" ::: "memory");
    const int c = lane & 7;
#pragma unroll
    for (int j = 0; j < 4; ++j) { const int n = (lane >> 3) + 8 * j; const LAS float* s = scr + (8 * c) * 33 + n;
        u32x4 o; o.x = pk2(s[0 * 33], s[1 * 33]); o.y = pk2(s[2 * 33], s[3 * 33]); o.z = pk2(s[4 * 33], s[5 * 33]); o.w = pk2(s[6 * 33], s[7 * 33]);
        *(u32x4*)(WT + (size_t)(n0 + n) * K + k0 + 8 * c) = o; }
    asm volatile("s_waitcnt lgkmcnt(0)" ::: "memory");
}

__global__ void __launch_bounds__(512) fwd_megakernel(Args args) {
    extern __shared__ __attribute__((aligned(16))) unsigned char lds_raw[];
    cg::grid_group grid = cg::this_grid();
    const ldsp lds = (ldsp)lds_raw;
    const int tid = threadIdx.x, lane = tid & 63, wave = __builtin_amdgcn_readfirstlane(tid >> 6);
    const int G = gridDim.x, bx = blockIdx.x;
    unsigned char* ws = args.ws; float* out = args.out;
    unsigned* ctl = (unsigned*)(ws + WS_CTL);
    float* SSQ0 = (float*)(ws + WS_SSQ0); float* SSQ1 = (float*)ctl + CTL_SSQ1; float* SSQ2 = (float*)ctl + CTL_SSQ2;
    float* ROPE = (float*)(ws + WS_ROPE);
    bf16_t* WIN = (bf16_t*)(ws + WS_WIN); bf16_t* WOUT = (bf16_t*)(ws + WS_WOUT);
    bf16_t* XB = (bf16_t*)(ws + WS_XB); bf16_t* YMIX = (bf16_t*)(ws + WS_YMIX); float* X1 = (float*)(ws + WS_X1); bf16_t* Z = (bf16_t*)(ws + WS_Z);
    const float* x_p = args.in[0]; const float* x_s = args.in[1];

    {
        LAS float* scr = (LAS float*)(lds + wave * 16384);
        const int gw = bx * 8 + wave, NGW = G * 8;
        constexpr int I_IN = (1024 / 64) * (4096 / 32), I_OUT = (1024 / 64) * (1024 / 32), NITEMS = 2 * I_IN + 2 * I_OUT;
        for (int it = gw; it < NITEMS; it += NGW) {
            int r = it;
            if (r < 2 * I_IN) { const int l = r / I_IN; r -= l * I_IN; p0_transpose_item(args.in[8] + (size_t)l * 1024 * 4096, args.in[7] + l * 1024, 1024, 4096, WIN + (size_t)l * 4096 * 1024, scr, r, lane); }
            else { r -= 2 * I_IN; const int l = r / I_OUT; r -= l * I_OUT; p0_transpose_item(args.in[9] + (size_t)l * 1024 * 1024, nullptr, 1024, 1024, WOUT + (size_t)l * 1024 * 1024, scr, r, lane); }
        }
        for (int m = gw; m < MROWS; m += NGW) {
            const float* xr = (m < NPROMPT) ? x_p + (size_t)m * 1024 : x_s + (size_t)(m - NPROMPT) * 1024;
            f32x4 v[4]; float s = 0.f;
#pragma unroll
            for (int j = 0; j < 4; ++j) { v[j] = *((const f32x4*)xr + lane + 64 * j); s += (v[j][0] * v[j][0] + v[j][1] * v[j][1]) + (v[j][2] * v[j][2] + v[j][3] * v[j][3]); }
            s = wave_sum(s);
            if (lane == 0) SSQ0[m] = s;
#pragma unroll
            for (int j = 0; j < 4; ++j) *((u32x2*)(XB + (size_t)m * 1024) + lane + 64 * j) = (u32x2){cvtpk(v[j][0], v[j][1]), cvtpk(v[j][2], v[j][3])};
        }
        for (int e = bx * 512 + tid; e < MROWS * 4; e += G * 512) {
            const int row = e >> 2, i = e & 3; const int pos = (row < NPROMPT) ? row : 4096 + ((row - NPROMPT) & 15);
            const float invf = (i == 0) ? 1.0f : (i == 1 ? 0.037606030930863934f : (i == 2 ? 0.0014142135623730950f : 5.318295896944988e-05f));
            const float ang = (float)pos * invf;
            const double rev = (double)ang * 0.15915494309189535; const float fr = (float)(rev - __builtin_rint(rev));
            ROPE[(size_t)row * 8 + i] = __builtin_amdgcn_cosf(fr); ROPE[(size_t)row * 8 + 4 + i] = __builtin_amdgcn_sinf(fr);
        }
    }
    grid.sync();

    for (int l = 0; l < 2; ++l) {
        {
            pg8::Gemm g{XB, WIN + (size_t)l * 4096 * 1024, NPROMPT, 4096, 1024}; pg8::StaticOrder S; S.init(NPROMPT, 4096, G, bx);
            pg8::EpiIn E{ws, out, l};

#ifndef NO_GEMM1
            pg8::gemm_phase<pg8::EpiIn, pg8::StaticOrder, P1_ALIGN, true>(lds, g, S, E);
#ifdef PROBE_P1X
            if (l == 0) { grid.sync(); pg8::gemm_phase<pg8::EpiIn, pg8::StaticOrder, true, true>(lds, g, S, E); }
#endif
#endif

        }
        grid.sync();
        {
            const float lam_init = (l == 0) ? 0.2f : 0.35550906759096927f;
            float d1 = 0.f, d2 = 0.f;
            for (int i = 0; i < 32; ++i) { d1 += args.in[12][l * 32 + i] * args.in[13][l * 32 + i]; d2 += args.in[14][l * 32 + i] * args.in[15][l * 32 + i]; }
            const float lam = __int_as_float(__builtin_amdgcn_readfirstlane(__float_as_int(__expf(d1) - __expf(d2) + lam_init))), dummy_oml_ = 0.f; const int oml = l;
            const float* subg = args.in[16] + l * 64;
            volatile LAS int* misc = (volatile LAS int*)(lds + MISC_OFF);
            constexpr int N_SI = 16, N_PC = 512, N_SC = 64, N_PA = 1024, N_SA = 128, N_CV = 130, N_SO = 4, N_TOT = N_SI + N_PC + N_SC + N_PA + N_SA + N_CV + N_SO;
            constexpr unsigned N_SMIX = N_SC + N_SA + 2;
#ifndef PROBE_P2X
#define PROBE_P2X 1
#endif
            for (int rep = 0; rep < ((l == 0) ? PROBE_P2X : 1); ++rep) {
            if (rep > 0) grid.sync();
            for (;;) {
                __syncthreads();
                if (tid == 0) misc[0] = (int)atomicAdd(ctl + CTL_Q0 + l + 2 * rep, 1u);
                __syncthreads();
                int ui = misc[0]; ui = __builtin_amdgcn_readfirstlane(ui);
                if (ui >= N_TOT) break;
                AU d; d.tabsrc = nullptr; d.kc = nullptr; d.vc = nullptr; d.cp = 0; d.ntc = 0; d.lastv = 64; d.nqg = 4; d.tlo1 = 0; d.thi1 = -1; d.qpos0 = 0; d.kpos0 = 0;
                int kind;
                int idx = ui;
                if (idx < 16) kind = 5; else if (idx < 256) { kind = 0; idx -= 16; } else if (idx < 320) { kind = 1; idx -= 256; } else if (idx < 448) { kind = 3; idx -= 320; } else if (idx < 450) { kind = 4; idx = 128 + (idx - 448); }
                else if (idx < 454) { kind = 6; idx -= 450; } else if (idx < 726) { kind = 0; idx = 240 + (idx - 454); } else if (idx < 1750) { kind = 2; idx -= 726; } else { kind = 4; idx -= 1750; }
#ifdef PROBE_ONLY_KIND
                if (rep > 0 && kind != PROBE_ONLY_KIND) continue;
#endif
                if (rep > 0 && kind >= 5) continue;
                const bool smp_unit = (kind == 1 || kind == 3 || (kind == 4 && idx >= 128));
                if (smp_unit || kind == 6) {
                    if (tid == 0) {
                        unsigned* cnt = ctl + (kind == 6 ? CTL_SM : CTL_SI) + l; const unsigned want = (kind == 6) ? N_SMIX : (unsigned)N_SI;
                        while (__hip_atomic_load(cnt, __ATOMIC_RELAXED, __HIP_MEMORY_SCOPE_AGENT) < want) __builtin_amdgcn_s_sleep(8);
                        __builtin_amdgcn_fence(__ATOMIC_ACQUIRE, "agent");
                        asm volatile("s_waitcnt vmcnt(0)" ::: "memory");
                    }
                    __syncthreads();
                }
                if (kind >= 5) {
                    if (kind == 5) { pg8::Gemm g{XB, WIN + (size_t)l * 4096 * 1024, MROWS, 4096, 1024}; pg8::OneUnit S{64, idx}; pg8::EpiIn E{ws, out, l};
                        pg8::gemm_phase<pg8::EpiIn, pg8::OneUnit, false, true>(lds, g, S, E); }
                    else { pg8::Gemm g{YMIX, WOUT + (size_t)l * 1024 * 1024, MROWS, 1024, 1024}; pg8::OneUnit S{64, idx}; pg8::EpiOut E{ws, x_p, x_s, l, args.in[17], out};
                        pg8::gemm_phase<pg8::EpiOut, pg8::OneUnit, false, true>(lds, g, S, E); }
                }
                else if (kind == 0) {
                    const int u = 127 - (idx >> 2), h = idx & 3; const size_t r0 = (size_t)128 * u;
                    d.q = Z + r0 * ZLD + 3072 + 64 * h; d.nq = 128; d.nt = 2 * u + 2; d.kz = Z + 3328 + 64 * h; d.vz = Z + 3584 + 64 * h;
                    d.tlo0 = 0; d.thi0 = d.nt - 2; d.tlo1 = 0; d.thi1 = d.nt - 1; d.gate = Z + r0 * ZLD + 3840 + 64 * h; d.y = YMIX + r0 * 1024 + 768 + 64 * h;

#ifndef NO_ATTN0
                    attn_unit<0>(d, lds, lam, oml, subg);
#endif

                } else if (kind == 1) {
                    const int b = idx >> 2, h = idx & 3; const size_t r0 = (size_t)NPROMPT + 16 * b;
                    d.q = Z + r0 * ZLD + 3072 + 64 * h; d.nq = 16; d.nt = 65; d.ntc = 64; d.cp = 256;
                    d.kc = args.in[5] + ((size_t)(l * 16 + b) * 4096) * 256 + 64 * h; d.vc = args.in[6] + ((size_t)(l * 16 + b) * 4096) * 256 + 64 * h;
                    d.kz = Z + r0 * ZLD + 3328 + 64 * h; d.vz = Z + r0 * ZLD + 3584 + 64 * h; d.lastv = 16; d.nqg = 1; d.tlo0 = 0; d.thi0 = 64;
                    d.gate = Z + r0 * ZLD + 3840 + 64 * h; d.y = YMIX + r0 * 1024 + 768 + 64 * h;

#ifndef NO_ATTN0
                    attn_unit<0>(d, lds, lam, oml, subg);
#endif

                } else if (kind == 2 || kind == 3) {
                    int h;
                    if (kind == 2) {
                        h = idx & 7; const int cp = idx >> 3, c0 = max(0, 2 * cp - 8); const size_t r0 = (size_t)128 * cp;
                        d.q = Z + r0 * ZLD + 64 * h; d.nq = 128; d.nt = 2 * cp + 2 - c0; d.kz = Z + (size_t)64 * c0 * ZLD + 512 + 64 * h; d.vz = Z + (size_t)64 * c0 * ZLD + 1024 + 64 * h;
                        d.tlo0 = 0; d.thi0 = 2 * cp - c0; d.tlo1 = max(0, 2 * cp + 1 - 8) - c0; d.thi1 = 2 * cp + 1 - c0; d.qpos0 = 128 * cp; d.kpos0 = 64 * c0;
                        d.gate = Z + r0 * ZLD + 1536 + 64 * h; d.y = YMIX + r0 * 1024 + 64 * h;
                    } else {
                        h = idx & 7; const int b = idx >> 3; const size_t r0 = (size_t)NPROMPT + 16 * b;
                        d.q = Z + r0 * ZLD + 64 * h; d.nq = 16; d.nt = 9; d.ntc = 8; d.cp = 512;
                        d.kc = args.in[2] + ((size_t)(l * 16 + b) * 512) * 512 + 64 * h; d.vc = args.in[3] + ((size_t)(l * 16 + b) * 512) * 512 + 64 * h;
                        d.kz = Z + r0 * ZLD + 512 + 64 * h; d.vz = Z + r0 * ZLD + 1024 + 64 * h; d.lastv = 16; d.nqg = 1; d.tlo0 = 0; d.thi0 = 8; d.qpos0 = 512; d.kpos0 = 0;
                        d.gate = Z + r0 * ZLD + 1536 + 64 * h; d.y = YMIX + r0 * 1024 + 64 * h;
                    }
                    d.tabsrc = args.in[10] + (size_t)(l * 8 + h) * 257;

#ifndef NO_ATTN1
                    attn_unit<1>(d, lds, 0.f, 0, nullptr);
#endif

                } else {
                    int tq_ = threadIdx.x; asm volatile("" : "+v"(tq_));
                    const int c8 = (tq_ & 31) * 8, rr = tq_ >> 5;
                    const float* cw = args.in[11] + (size_t)l * 3 * 256 + c8;
                    float w0[8], w1[8], w2[8];
#pragma unroll
                    for (int j = 0; j < 8; ++j) { w0[j] = cw[j]; w1[j] = cw[256 + j]; w2[j] = cw[512 + j]; }
                    for (int g = 0; g < 8; ++g) {
                        const int row = 128 * idx + 16 * g + rr; const bool smp = row >= NPROMPT; const int t = smp ? ((row - NPROMPT) & 15) : row, b = (row - NPROMPT) >> 4;
                        const bf16_t* zr = Z + (size_t)row * ZLD;
                        float u0[8], u1[8], u2[8];
                        { const u32x4 c = *(const u32x4*)(zr + 2304 + c8), hh = *(const u32x4*)(zr + 2560 + c8);
#pragma unroll
                          for (int j = 0; j < 4; ++j) { u0[2 * j] = bf_lo(c[j]) * bf_lo(hh[j]); u0[2 * j + 1] = bf_hi(c[j]) * bf_hi(hh[j]); } }
                        if (t >= 1) { const u32x4 c = *(const u32x4*)(zr - ZLD + 2304 + c8), hh = *(const u32x4*)(zr - ZLD + 2560 + c8);
#pragma unroll
                          for (int j = 0; j < 4; ++j) { u1[2 * j] = bf_lo(c[j]) * bf_lo(hh[j]); u1[2 * j + 1] = bf_hi(c[j]) * bf_hi(hh[j]); } }
                        else if (smp) { const float* sp = args.in[4] + ((size_t)(l * 16 + b) * 2 + 1) * 256 + c8;
#pragma unroll
                          for (int j = 0; j < 8; ++j) u1[j] = sp[j]; }
                        else {
#pragma unroll
                          for (int j = 0; j < 8; ++j) u1[j] = 0.f; }
                        if (t >= 2) { const u32x4 c = *(const u32x4*)(zr - 2 * ZLD + 2304 + c8), hh = *(const u32x4*)(zr - 2 * ZLD + 2560 + c8);
#pragma unroll
                          for (int j = 0; j < 4; ++j) { u2[2 * j] = bf_lo(c[j]) * bf_lo(hh[j]); u2[2 * j + 1] = bf_hi(c[j]) * bf_hi(hh[j]); } }
                        else if (smp) { const float* sp = args.in[4] + ((size_t)(l * 16 + b) * 2 + t) * 256 + c8;
#pragma unroll
                          for (int j = 0; j < 8; ++j) u2[j] = sp[j]; }
                        else {
#pragma unroll
                          for (int j = 0; j < 8; ++j) u2[j] = 0.f; }
                        const u32x4 bb = *(const u32x4*)(zr + 2048 + c8), bg = *(const u32x4*)(zr + 2816 + c8);
                        float y[8];
#pragma unroll
                        for (int j = 0; j < 4; ++j) {
                            y[2 * j] = bf_lo(bb[j]) * (u2[2 * j] * w0[2 * j] + u1[2 * j] * w1[2 * j] + u0[2 * j] * w2[2 * j]) * bf_lo(bg[j]);
                            y[2 * j + 1] = bf_hi(bb[j]) * (u2[2 * j + 1] * w0[2 * j + 1] + u1[2 * j + 1] * w1[2 * j + 1] + u0[2 * j + 1] * w2[2 * j + 1]) * bf_hi(bg[j]); }
                        *(u32x4*)(YMIX + (size_t)row * 1024 + 512 + c8) = (u32x4){cvtpk(y[0], y[1]), cvtpk(y[2], y[3]), cvtpk(y[4], y[5]), cvtpk(y[6], y[7])};
                        float* so = nullptr;
                        if (!smp && row >= NPROMPT - 2) so = out + O_CONVP + (size_t)l * 512 + (size_t)(row - (NPROMPT - 2)) * 256 + c8;
                        if (smp && t >= 14) so = out + O_CONVS + (size_t)l * 8192 + (size_t)b * 512 + (size_t)(t - 14) * 256 + c8;
                        if (so) { *(f32x4*)so = (f32x4){u0[0], u0[1], u0[2], u0[3]}; *(f32x4*)(so + 4) = (f32x4){u0[4], u0[5], u0[6], u0[7]}; }
                    }
                }
                if (smp_unit || kind == 5) {
                    asm volatile("s_waitcnt vmcnt(0)" ::: "memory");
                    __syncthreads();
                    if (tid == 0) { __builtin_amdgcn_fence(__ATOMIC_RELEASE, "agent"); asm volatile("s_waitcnt vmcnt(0)" ::: "memory");
                        __hip_atomic_fetch_add(ctl + (kind == 5 ? CTL_SI : CTL_SM) + l, 1u, __ATOMIC_RELAXED, __HIP_MEMORY_SCOPE_AGENT); }
                }
            }
            }
        }
        grid.sync();
        {
            pg8::Gemm g{YMIX, WOUT + (size_t)l * 1024 * 1024, NPROMPT, 1024, 1024}; pg8::StaticOrder S; S.init(NPROMPT, 1024, G, bx);
            pg8::EpiOut E{ws, x_p, x_s, l, args.in[17], out};

#ifndef NO_GEMM2
            pg8::gemm_phase<pg8::EpiOut, pg8::StaticOrder, true, true>(lds, g, S, E);
#endif

            if (l == 1 && wave == 0 && bx < MROWS - NPROMPT) {
                int ln_ = threadIdx.x; asm volatile("" : "+v"(ln_)); ln_ &= 63;
                const int lane = ln_;
                const int m = NPROMPT + bx; const float rs = __builtin_amdgcn_rsqf(SSQ2[m] * (1.0f / 1024.0f) + 1e-6f);
#pragma unroll
                for (int j = 0; j < 4; ++j) { const f32x4 v = *((const f32x4*)(X1 + (size_t)m * 1024) + lane + 64 * j); *((f32x4*)(out + O_Y + (size_t)m * 1024) + lane + 64 * j) = v * rs * *((const f32x4*)args.in[17] + lane + 64 * j); }
            }
        }
        if (l == 0) grid.sync();
    }
}

extern "C" void kernel_launch(void* const* d_in, const int* in_sizes, int n_in, void* d_out, int out_size, void* d_ws, size_t ws_size, hipStream_t stream) {
    static int grid_blocks = 0;
    if (!grid_blocks) {
        if (n_in != 18 || (size_t)out_size != O_END || ws_size < WS_END) { fprintf(stderr, "kernel_launch: unexpected shapes n_in %d out %d ws %zu\n", n_in, out_size, ws_size); grid_blocks = -1; return; }
        int dev = 0, cus = 0, per_cu = 0;
        hipGetDevice(&dev); hipDeviceGetAttribute(&cus, hipDeviceAttributeMultiprocessorCount, dev);
        hipFuncSetAttribute((const void*)fwd_megakernel, hipFuncAttributeMaxDynamicSharedMemorySize, LDS_BYTES);
        hipOccupancyMaxActiveBlocksPerMultiprocessor(&per_cu, (const void*)fwd_megakernel, 512, LDS_BYTES);
        if (per_cu < 1) { fprintf(stderr, "kernel_launch: occupancy query says %d blocks per CU\n", per_cu); per_cu = 1; }
        if (per_cu > 1) per_cu = 1;
        grid_blocks = cus * per_cu;
    }
    if (grid_blocks < 0) return;
    hipMemsetAsync((char*)d_ws + WS_CTL, 0, CTL_BYTES, stream);
    Args a{};
    for (int i = 0; i < 18; ++i) a.in[i] = (const float*)d_in[i];
    a.out = (float*)d_out; a.ws = (unsigned char*)d_ws;
    void* kargs[] = {&a};
    hipError_t e = hipLaunchCooperativeKernel((const void*)fwd_megakernel, dim3(grid_blocks), dim3(512), kargs, LDS_BYTES, stream);
    if (e != hipSuccess) fprintf(stderr, "cooperative launch failed: %s (grid %d)\n", hipGetErrorString(e), grid_blocks);
}
```

```cpp
#include <hip/hip_runtime.h>
#include <hip/hip_cooperative_groups.h>
#include <cstdio>
#include <cstdint>
namespace cg = cooperative_groups;
namespace pg8 {
#define PG8_LAS __attribute__((address_space(3)))
typedef unsigned short bf16_t;
typedef short bf16x8 __attribute__((ext_vector_type(8)));
typedef float f32x4 __attribute__((ext_vector_type(4)));
typedef unsigned u32x4 __attribute__((ext_vector_type(4)));
constexpr int BM = 256, BK = 64, HALF = 128, HTB = HALF * BK * 2  , STAGE_BYTES = 8 * HTB, NXCD = 8, WGM = 8;

__host__ __device__ __forceinline__ int lds_byte(int r, int c) { const int st = (r >> 4) * 2 + (c >> 5), rr = r & 15, cc = c & 31, ob = rr * 64 + cc * 2; return st * 1024 + (ob ^ (((ob >> 9) & 1) << 5)); }
__host__ __device__ __forceinline__ void stage_rc(int b, int& R, int& C) { const int st = b / 1024, sb = b % 1024, swz = sb ^ (((sb >> 9) & 1) << 5); R = (st >> 1) * 16 + swz / 64; C = (st & 1) * 32 + (swz % 64) / 2; }
__host__ __device__ __forceinline__ int perm32(int rho) { const int n = rho >> 4, i = rho & 15; return 8 * (i >> 2) + 4 * n + (i & 3); }

struct Unit { int pm, pn; };
struct Gemm { const bf16_t* A; const bf16_t* Bt; int M, N, K; };

struct StaticOrder {
    int nM, nN, nwg, G, c;
    __host__ __device__ void init(int M, int N, int G_, int c_) { nM = M / BM; nN = N / BM; nwg = nM * nN; G = G_; c = c_; }
    __host__ __device__ bool next(int i, Unit& u) const {
        const long L = (long)i * G + c; if (L >= nwg) return false;
        int wgid = (int)L; { const int q = nwg / NXCD, r = nwg % NXCD, xcd = wgid % NXCD, off = wgid / NXCD; wgid = (xcd < r ? xcd * (q + 1) : r * (q + 1) + (xcd - r) * q) + off; }
        const int nig = WGM * nN, gid = wgid / nig, fm = gid * WGM, gsz = (nM - fm) < WGM ? (nM - fm) : WGM;
        u.pm = fm + ((wgid % nig) % gsz); u.pn = (wgid % nig) / gsz; return true;
    }
    __device__ __forceinline__ void a_ready(const Unit&) const {}
    __device__ __forceinline__ void done(const Unit&) const {}
};
struct OneUnit {
    int pm, pn;
    __host__ __device__ bool next(int i, Unit& u) const { if (i) return false; u.pm = pm; u.pn = pn; return true; }
    __device__ __forceinline__ void a_ready(const Unit&) const {}
    __device__ __forceinline__ void done(const Unit&) const {}
};
__device__ __forceinline__ unsigned cvt_pk_bf16(float lo, float hi) { unsigned r; asm volatile("v_cvt_pk_bf16_f32 %0, %1, %2" : "=v"(r) : "v"(lo), "v"(hi)); return r; }
typedef float f32x2 __attribute__((ext_vector_type(2)));
constexpr float LOG2E = 1.4426950408889634f;
constexpr float SC_QA = 0.125f * LOG2E;
constexpr float SC_QC = 0.17677669529663687f * LOG2E;
constexpr int ZLD = 4096, MROWS = 16640, NPROMPT = 16384;
constexpr size_t WSO_MiB = 1u << 20;
constexpr size_t WSO_PANEL = 512 * 4  , WSO_CTL = 0, WSO_SSQ1 = 16384 * 4, WSO_SSQ2 = (16384 + 32768) * 4, WSO_SSQ0 = 1 * WSO_MiB, WSO_ROPE = 2 * WSO_MiB, WSO_WIN = 4 * WSO_MiB, WSO_WOUT = 20 * WSO_MiB, WSO_XB = 24 * WSO_MiB,
                 WSO_YMIX = 60 * WSO_MiB, WSO_X1 = 96 * WSO_MiB, WSO_Z = 164 * WSO_MiB, WSO_END = 296 * WSO_MiB;
constexpr size_t OO_Y = 0, OO_AKP = 17039360, OO_AVP = OO_AKP + 524288, OO_CONVP = OO_AVP + 524288, OO_CKP = OO_CONVP + 1024, OO_CVP = OO_CKP + 8388608,
                 OO_AKS = OO_CVP + 8388608, OO_AVS = OO_AKS + 262144, OO_CONVS = OO_AVS + 262144, OO_CKS = OO_CONVS + 16384, OO_CVS = OO_CKS + 131072, OO_END = OO_CVS + 131072;
__device__ __forceinline__ float silu_f(float x) { return x * __builtin_amdgcn_rcpf(1.0f + __builtin_amdgcn_exp2f(-x * LOG2E)); }
struct EpiIn {
    static constexpr bool PERM = true, AFTER_DRAIN = false;
    unsigned char* ws; float* out; int l;
    __device__ __forceinline__ void operator()(const f32x4 (&acc)[2][2][4][2], const Unit& u, int wr, int wc, int fr, int fq) const {
        const int pn = u.pn, pm = u.pm;
        bf16_t* Z = (bf16_t*)(ws + WSO_Z); const float* ssq = (const float*)(ws + (l == 0 ? WSO_SSQ0 : WSO_SSQ1)); const float* rope = (const float*)(ws + WSO_ROPE);
        float* o_ak_p = out + OO_AKP + (size_t)l * 262144; float* o_av_p = out + OO_AVP + (size_t)l * 262144; float* o_ak_s = out + OO_AKS + (size_t)l * 131072; float* o_av_s = out + OO_AVS + (size_t)l * 131072;
        float* o_ck_p = out + OO_CKP + (size_t)l * 4194304; float* o_cv_p = out + OO_CVP + (size_t)l * 4194304; float* o_ck_s = out + OO_CKS + (size_t)l * 65536; float* o_cv_s = out + OO_CVS + (size_t)l * 65536;
        const int rowl = wr * 64 + fr;
        const int colb = pn * BM + wc * 32 + 8 * fq;
        const bool rope_tile = (pn == 12 || pn == 13);
        const bool do_rope = rope_tile && fq == 0;
        const float sc = (pn < 2) ? SC_QA : (pn == 12 ? SC_QC : 1.f);
        const bool do_silu = (pn == 6 || pn == 7 || pn == 11 || pn == 15);
        float* ob = nullptr; int old = 0, ocol0 = 0;
        if (pn >= 2 && pn <= 5) { old = 512; ocol0 = (pn >= 4) ? 1024 : 512;
            if (pm == 64) ob = (pn >= 4) ? o_av_s : o_ak_s; else if (pm >= 62) ob = ((pn >= 4) ? o_av_p : o_ak_p) + (size_t)(pm - 62) * 256 * 512; }
        else if (pn == 13 || pn == 14) { old = 256; ocol0 = (pn == 13) ? 3328 : 3584;
            if (pm == 64) ob = (pn == 13) ? o_ck_s : o_cv_s; else ob = ((pn == 13) ? o_ck_p : o_cv_p) + (size_t)pm * 256 * 256; }
#pragma unroll
        for (int ai = 0; ai < 2; ++ai)
#pragma unroll
            for (int m = 0; m < 4; ++m) {
                const int rl = rowl + ai * HALF + m * 16, row = pm * BM + rl;
                const float rs = __builtin_amdgcn_rsqf(ssq[row] * (1.0f / 1024.0f) + 1e-6f);
                f32x4 rc = {1.f, 1.f, 1.f, 1.f}, rsn = {0.f, 0.f, 0.f, 0.f};
                if (do_rope) { rc = *(const f32x4*)(rope + (size_t)row * 8); rsn = *(const f32x4*)(rope + (size_t)row * 8 + 4); }
#pragma unroll
                for (int bj = 0; bj < 2; ++bj) {
                    f32x4 v0 = acc[ai][bj][m][0] * rs, v1 = acc[ai][bj][m][1] * rs;
                    const int col = colb + bj * HALF;
                    if (rope_tile) { const f32x4 a = v0 * rc - v1 * rsn, b = v1 * rc + v0 * rsn; v0 = a; v1 = b; }
                    if (ob) { float* op = ob + (size_t)rl * old + (col - ocol0); *(f32x4*)op = v0; *(f32x4*)(op + 4) = v1; }
                    if (do_silu) { v0 = (f32x4){silu_f(v0[0]), silu_f(v0[1]), silu_f(v0[2]), silu_f(v0[3])}; v1 = (f32x4){silu_f(v1[0]), silu_f(v1[1]), silu_f(v1[2]), silu_f(v1[3])}; }
                    v0 = v0 * sc; v1 = v1 * sc;
                    u32x4 w; w.x = cvt_pk_bf16(v0[0], v0[1]); w.y = cvt_pk_bf16(v0[2], v0[3]); w.z = cvt_pk_bf16(v1[0], v1[1]); w.w = cvt_pk_bf16(v1[2], v1[3]);
                    *(u32x4*)(Z + (size_t)row * ZLD + col) = w;
                }
                asm volatile("" ::: "memory");
            }
    }
};
struct EpiOut {
    static constexpr bool PERM = true, AFTER_DRAIN = false;
    unsigned char* ws; const float* x_p; const float* x_s; int l; const float* fg; float* yout;
    __device__ __forceinline__ void operator()(f32x4 (&acc)[2][2][4][2], const Unit& u, int wr, int wc, int fr, int fq) const {
        const int pm = u.pm; const int colb = u.pn * BM + wc * 32 + 8 * fq;
        float* X1 = (float*)(ws + WSO_X1) + (size_t)pm * BM * 1024; bf16_t* XB = (bf16_t*)(ws + WSO_XB) + (size_t)pm * BM * 1024; float* ssq = (float*)(ws + (l == 0 ? WSO_SSQ1 : WSO_SSQ2)) + pm * BM;
        const float* res = (l == 0) ? ((pm == 64) ? x_s : x_p + (size_t)pm * BM * 1024) : X1;
        const unsigned off0 = (unsigned)(wr * 64 + fr) * 1024u + (unsigned)colb;
        const bool fuse = (l == 1 && pm < 64);
#pragma unroll
        for (int ai = 0; ai < 2; ++ai)
#pragma unroll
            for (int m = 0; m < 4; ++m) {
                const unsigned offr = off0 + (unsigned)(ai * HALF + m * 16) * 1024u; float q = 0.f;
#pragma unroll
                for (int bj = 0; bj < 2; ++bj) { const unsigned off = offr + bj * HALF;
                    const f32x4 v0 = acc[ai][bj][m][0] + *(const f32x4*)(res + off), v1 = acc[ai][bj][m][1] + *(const f32x4*)(res + off + 4);
                    if (fuse) { acc[ai][bj][m][0] = v0; acc[ai][bj][m][1] = v1; }
                    else {
                        *(f32x4*)(X1 + off) = v0; *(f32x4*)(X1 + off + 4) = v1;
                        u32x4 w; w.x = cvt_pk_bf16(v0[0], v0[1]); w.y = cvt_pk_bf16(v0[2], v0[3]); w.z = cvt_pk_bf16(v1[0], v1[1]); w.w = cvt_pk_bf16(v1[2], v1[3]);
                        *(u32x4*)(XB + off) = w; }
                    q += (v0[0] * v0[0] + v0[1] * v0[1]) + (v0[2] * v0[2] + v0[3] * v0[3]) + (v1[0] * v1[0] + v1[1] * v1[1]) + (v1[2] * v1[2] + v1[3] * v1[3]);
                    asm volatile("" ::: "memory"); }
                q += __shfl_xor(q, 16); q += __shfl_xor(q, 32);
                if (fq == 0) atomicAdd(ssq + (wr * 64 + fr + ai * HALF + m * 16), q);
                asm volatile("" ::: "memory");
            }
        if (fuse) {
            unsigned* cnt = (unsigned*)(ws + WSO_PANEL) + 64 * pm;
            asm volatile("s_waitcnt vmcnt(0)" ::: "memory");
            if (__builtin_amdgcn_readfirstlane(fr + 16 * fq) == (fr + 16 * fq)) __hip_atomic_fetch_add(cnt, 1u, __ATOMIC_RELAXED, __HIP_MEMORY_SCOPE_AGENT);
            unsigned spins = 0;
            while (__hip_atomic_load(cnt, __ATOMIC_RELAXED, __HIP_MEMORY_SCOPE_AGENT) < 32u) { __builtin_amdgcn_s_sleep(2); if (++spins > (1u << 22)) break; }
            float* yo = yout + (size_t)pm * BM * 1024;
#pragma unroll
            for (int ai = 0; ai < 2; ++ai)
#pragma unroll
                for (int m = 0; m < 4; ++m) {
                    const int rl = wr * 64 + fr + ai * HALF + m * 16;
                    const float sq = __hip_atomic_load(ssq + rl, __ATOMIC_RELAXED, __HIP_MEMORY_SCOPE_AGENT);
                    const float rs = __builtin_amdgcn_rsqf(sq * (1.0f / 1024.0f) + 1e-6f);
                    const unsigned offr = off0 + (unsigned)(ai * HALF + m * 16) * 1024u;
#pragma unroll
                    for (int bj = 0; bj < 2; ++bj) {
                        const f32x4 g0 = *(const f32x4*)(fg + colb + bj * HALF), g1 = *(const f32x4*)(fg + colb + bj * HALF + 4);
                        *(f32x4*)(yo + offr + bj * HALF) = acc[ai][bj][m][0] * rs * g0; *(f32x4*)(yo + offr + bj * HALF + 4) = acc[ai][bj][m][1] * rs * g1;
                        asm volatile("" ::: "memory"); }
                }
        }
    }
};
template <class Epi, class Sched, bool ALIGN_EPI = false, bool SP2 = false>
__device__ __forceinline__ void gemm_phase(PG8_LAS unsigned char* lds, const Gemm g, const Sched& S, const Epi& E) {
    int tid_ = threadIdx.x; asm volatile("" : "+v"(tid_));
    const int tid = tid_, wid = __builtin_amdgcn_readfirstlane(tid >> 6), lane = tid & 63, wr = wid >> 2, wc = wid & 3, fr = lane & 15, fq = lane >> 4;
    const int K = g.K, nt = K / BK;
    unsigned voffA[2], voffB[2];
#pragma unroll
    for (int i = 0; i < 2; ++i) { int R, C; stage_rc(tid * 16 + i * 8192, R, C); const int Rb = Epi::PERM ? ((R & ~31) + perm32(R & 31)) : R;
        voffA[i] = (unsigned)(R * K + C) * 2u; voffB[i] = (unsigned)(Rb * K + C) * 2u; }
    const size_t kstep = (size_t)(BK * 2);
    const size_t hstep = (size_t)HALF * K * 2;
    const size_t tstep = 2 * hstep;
    const unsigned ldsw = (unsigned)wid * 1024u;
    const int aoff = lds_byte(wr * 64 + fr, fq * 8), boff = lds_byte(wc * 32 + fr, fq * 8);
#define PG8_SA(b, h) (((b) * 2 + (h)) * HTB)
#define PG8_SB(b, h) ((4 + (b) * 2 + (h)) * HTB)
#define PG8_STAGE(bufoff, gbase, voff) do { _Pragma("unroll") for (int _i = 0; _i < 2; ++_i) \
        __builtin_amdgcn_global_load_lds((const unsigned*)((const char*)(gbase) + (voff)[_i]), (PG8_LAS unsigned*)(lds + (bufoff) + ldsw + _i * 8192), 16, 0, 0); } while (0)
#define PG8_LDA(dst, b, h) do { _Pragma("unroll") for (int m = 0; m < 4; ++m) _Pragma("unroll") for (int k = 0; k < 2; ++k) dst[m][k] = *(const PG8_LAS bf16x8*)(lds + PG8_SA(b, h) + aoff + m * 2048 + k * 1024); } while (0)
#define PG8_LDB(dst, b, h) do { _Pragma("unroll") for (int n = 0; n < 2; ++n) _Pragma("unroll") for (int k = 0; k < 2; ++k) dst[n][k] = *(const PG8_LAS bf16x8*)(lds + PG8_SB(b, h) + boff + n * 2048 + k * 1024); } while (0)
#define PG8_MMA(ai, bj, At, Bt) do { __builtin_amdgcn_s_setprio(1); _Pragma("unroll") for (int m = 0; m < 4; ++m) _Pragma("unroll") for (int n = 0; n < 2; ++n) _Pragma("unroll") for (int k = 0; k < 2; ++k) \
        acc[ai][bj][m][n] = __builtin_amdgcn_mfma_f32_16x16x32_bf16(Bt[n][k], At[m][k], acc[ai][bj][m][n], 0, 0, 0); __builtin_amdgcn_s_setprio(0); } while (0)
#define PG8_WAIT_V(n) asm volatile("s_waitcnt vmcnt(" #n ")" ::: "memory")
#define PG8_WAIT_L(n) asm volatile("s_waitcnt lgkmcnt(" #n ")" ::: "memory")
#define PG8_BAR __builtin_amdgcn_s_barrier()
#define PG8_SCHED __builtin_amdgcn_sched_barrier(0)
    Unit cur, nxt; int ui = 0;
    if (!S.next(0, cur)) return;
    f32x4 acc[2][2][4][2];
#pragma unroll
    for (int a = 0; a < 2; ++a)
#pragma unroll
        for (int b = 0; b < 2; ++b)
#pragma unroll
            for (int m = 0; m < 4; ++m)
#pragma unroll
                for (int n = 0; n < 2; ++n) acc[a][b][m][n] = (f32x4){0.f, 0.f, 0.f, 0.f};
    bf16x8 At[4][2], B0[2][2], B1[2][2];
    const char* cA = (const char*)g.A + (size_t)cur.pm * tstep; const char* cB = (const char*)g.Bt + (size_t)cur.pn * tstep;
    S.a_ready(cur);
    if constexpr (SP2) {
        PG8_STAGE(PG8_SB(0, 0), cB, voffB); PG8_STAGE(PG8_SB(0, 1), cB + hstep, voffB); PG8_STAGE(PG8_SA(0, 0), cA, voffA); PG8_STAGE(PG8_SA(0, 1), cA + hstep, voffA);
        if (wr == 1) PG8_BAR;
        PG8_WAIT_V(2); PG8_BAR;
        PG8_STAGE(PG8_SB(1, 0), cB + kstep, voffB); PG8_STAGE(PG8_SA(1, 0), cA + kstep, voffA); PG8_STAGE(PG8_SB(1, 1), cB + hstep + kstep, voffB);
        PG8_WAIT_V(6); PG8_BAR;
    } else {
        PG8_STAGE(PG8_SB(0, 0), cB, voffB); PG8_STAGE(PG8_SA(0, 0), cA, voffA); PG8_STAGE(PG8_SB(0, 1), cB + hstep, voffB); PG8_STAGE(PG8_SA(0, 1), cA + hstep, voffA);
        if (wr == 1) PG8_BAR;
        PG8_WAIT_V(4); PG8_BAR;
        PG8_STAGE(PG8_SB(1, 0), cB + kstep, voffB); PG8_STAGE(PG8_SA(1, 0), cA + kstep, voffA); PG8_STAGE(PG8_SB(1, 1), cB + hstep + kstep, voffB);
        PG8_WAIT_V(6); PG8_BAR;
    }
    for (;;) {
        const bool has_next = S.next(ui + 1, nxt);
        const char* nA = has_next ? (const char*)g.A + (size_t)nxt.pm * tstep : cA; const char* nB = has_next ? (const char*)g.Bt + (size_t)nxt.pn * tstep : cB;
        for (int t = 0; t < nt; t += 2) {
            const bool last = (t == nt - 2);
            const char* a1 = cA + (size_t)(t + 1) * kstep;
            const char* a2 = last ? nA : cA + (size_t)(t + 2) * kstep; const char* b2 = last ? nB : cB + (size_t)(t + 2) * kstep;
            const char* a3 = a2 + kstep; const char* b3 = b2 + kstep;
            if (last && has_next) S.a_ready(nxt);
            if constexpr (SP2) {
            PG8_LDB(B0, 0, 0); PG8_LDB(B1, 0, 1); PG8_SCHED; PG8_LDA(At, 0, 0); PG8_STAGE(PG8_SA(1, 1), a1 + hstep, voffA);
            PG8_WAIT_V(8); PG8_WAIT_L(0); PG8_BAR; PG8_MMA(0, 0, At, B0); PG8_MMA(0, 1, At, B1); PG8_BAR; PG8_SCHED;
            PG8_LDA(At, 0, 1); PG8_STAGE(PG8_SB(0, 0), b2, voffB); PG8_STAGE(PG8_SB(0, 1), b2 + hstep, voffB); PG8_STAGE(PG8_SA(0, 0), a2, voffA);
            PG8_WAIT_V(8); PG8_WAIT_L(0); PG8_BAR; PG8_MMA(1, 0, At, B0); PG8_MMA(1, 1, At, B1); PG8_BAR; PG8_SCHED;
            PG8_LDB(B0, 1, 0); PG8_LDB(B1, 1, 1); PG8_SCHED; PG8_LDA(At, 1, 0); PG8_STAGE(PG8_SA(0, 1), a2 + hstep, voffA);
            PG8_WAIT_V(8); PG8_WAIT_L(0); PG8_BAR; PG8_MMA(0, 0, At, B0); PG8_MMA(0, 1, At, B1); PG8_BAR; PG8_SCHED;
            PG8_LDA(At, 1, 1); PG8_STAGE(PG8_SB(1, 0), b3, voffB); PG8_STAGE(PG8_SB(1, 1), b3 + hstep, voffB); PG8_STAGE(PG8_SA(1, 0), a3, voffA);
            PG8_WAIT_V(8); PG8_WAIT_L(0); PG8_BAR; PG8_MMA(1, 0, At, B0); PG8_MMA(1, 1, At, B1); PG8_BAR; PG8_SCHED;
            } else {
            PG8_LDB(B0, 0, 0); PG8_SCHED; PG8_LDA(At, 0, 0); PG8_STAGE(PG8_SA(1, 1), a1 + hstep, voffA);
            PG8_WAIT_L(8); PG8_BAR; PG8_WAIT_L(0); PG8_MMA(0, 0, At, B0); PG8_BAR; PG8_SCHED;
            PG8_LDB(B1, 0, 1); PG8_STAGE(PG8_SB(0, 0), b2, voffB);
            PG8_BAR; PG8_WAIT_L(0); PG8_MMA(0, 1, At, B1); PG8_BAR;
            PG8_LDA(At, 0, 1); PG8_STAGE(PG8_SA(0, 0), a2, voffA);
            PG8_BAR; PG8_WAIT_L(0); PG8_MMA(1, 0, At, B0); PG8_BAR; PG8_SCHED;
            PG8_STAGE(PG8_SB(0, 1), b2 + hstep, voffB);
            PG8_WAIT_V(6); PG8_BAR; PG8_MMA(1, 1, At, B1); PG8_BAR;
            PG8_LDB(B0, 1, 0); PG8_SCHED; PG8_LDA(At, 1, 0); PG8_STAGE(PG8_SA(0, 1), a2 + hstep, voffA);
            PG8_WAIT_L(8); PG8_BAR; PG8_WAIT_L(0); PG8_MMA(0, 0, At, B0); PG8_BAR; PG8_SCHED;
            PG8_LDB(B1, 1, 1); PG8_STAGE(PG8_SB(1, 0), b3, voffB);
            PG8_BAR; PG8_WAIT_L(0); PG8_MMA(0, 1, At, B1); PG8_BAR;
            PG8_LDA(At, 1, 1); PG8_STAGE(PG8_SA(1, 0), a3, voffA);
            PG8_BAR; PG8_WAIT_L(0); PG8_MMA(1, 0, At, B0); PG8_BAR; PG8_SCHED;
            PG8_STAGE(PG8_SB(1, 1), b3 + hstep, voffB);
            PG8_WAIT_V(6); PG8_BAR; PG8_MMA(1, 1, At, B1); PG8_BAR;
            }
        }
        if constexpr (ALIGN_EPI) { if (wr == 0) PG8_BAR; }
        if constexpr (!Epi::AFTER_DRAIN) { E(acc, cur, wr, wc, fr, fq); S.done(cur); }
        if (!has_next) break;
#pragma unroll
        for (int a = 0; a < 2; ++a)
#pragma unroll
            for (int b = 0; b < 2; ++b)
#pragma unroll
                for (int m = 0; m < 4; ++m)
#pragma unroll
                    for (int n = 0; n < 2; ++n) acc[a][b][m][n] = (f32x4){0.f, 0.f, 0.f, 0.f};
        cur = nxt; cA = nA; cB = nB; ++ui;
        if constexpr (ALIGN_EPI) { if (wr == 1) PG8_BAR; }
    }
    PG8_WAIT_V(0);
    if constexpr (!ALIGN_EPI) { if (wr == 0) PG8_BAR; }
    PG8_BAR;
    if constexpr (Epi::AFTER_DRAIN) { E.fused(acc, cur, wr, wc, fr, fq, lds, wid, lane); S.done(cur); }
#undef PG8_SA
#undef PG8_SB
#undef PG8_STAGE
#undef PG8_LDA
#undef PG8_LDB
#undef PG8_MMA
#undef PG8_WAIT_V
#undef PG8_WAIT_L
#undef PG8_BAR
#undef PG8_SCHED
}
}
#define LAS __attribute__((address_space(3)))
typedef unsigned short bf16_t;
typedef LAS unsigned char* ldsp;
typedef short bf16x8 __attribute__((ext_vector_type(8)));
typedef short s16x4 __attribute__((ext_vector_type(4)));
typedef float f32x16 __attribute__((ext_vector_type(16)));
typedef float f32x4 __attribute__((ext_vector_type(4)));
typedef float f32x2 __attribute__((ext_vector_type(2)));
typedef unsigned u32x4 __attribute__((ext_vector_type(4)));
typedef unsigned u32x2 __attribute__((ext_vector_type(2)));
typedef __bf16 bf16x2_t __attribute__((ext_vector_type(2)));
using pg8::ZLD; using pg8::MROWS; using pg8::NPROMPT; using pg8::LOG2E;
__device__ __forceinline__ int crow(int r, int hi) { return (r & 3) + 8 * (r >> 2) + 4 * hi; }
__device__ __forceinline__ unsigned cvtpk(float lo, float hi) { f32x2 v = {lo, hi}; bf16x2_t b = __builtin_convertvector(v, bf16x2_t); return __builtin_bit_cast(unsigned, b); }
__device__ __forceinline__ float bf_lo(unsigned w) { return __uint_as_float(w << 16); }
__device__ __forceinline__ float bf_hi(unsigned w) { return __uint_as_float(w & 0xffff0000u); }
__device__ __forceinline__ float xhalf_max(float m) { auto rr = __builtin_amdgcn_permlane32_swap(__float_as_uint(m), __float_as_uint(m), false, false); return fmaxf(__uint_as_float(rr[0]), __uint_as_float(rr[1])); }
__device__ __forceinline__ float xhalf_sum(float m) { auto rr = __builtin_amdgcn_permlane32_swap(__float_as_uint(m), __float_as_uint(m), false, false); return __uint_as_float(rr[0]) + __uint_as_float(rr[1]); }
__device__ __forceinline__ s16x4 vtr(ldsp p) { typedef short v4i16_t __attribute__((ext_vector_type(4))); return __builtin_bit_cast(s16x4, __builtin_amdgcn_ds_read_tr16_b64_v4i16((LAS v4i16_t*)p)); }
__device__ __forceinline__ float max3f(float a, float b, float c) { float r; asm("v_max3_f32 %0, %1, %2, %3" : "=v"(r) : "v"(a), "v"(b), "v"(c)); return r; }
__device__ __forceinline__ float max2f(float a, float b) { float r; asm("v_max_f32_e32 %0, %1, %2" : "=v"(r) : "v"(a), "v"(b)); return r; }
__device__ __forceinline__ float sum8_s(float acc, float a, float b, float c, float d, float e, float f, float g, float h) {
    asm("s_nop 0\n\tv_add_f32_e32 %0, %0, %1\n\tv_add_f32_e32 %0, %0, %2\n\tv_add_f32_e32 %0, %0, %3\n\tv_add_f32_e32 %0, %0, %4\n\tv_add_f32_e32 %0, %0, %5\n\tv_add_f32_e32 %0, %0, %6\n\tv_add_f32_e32 %0, %0, %7\n\tv_add_f32_e32 %0, %0, %8"
        : "+v"(acc) : "v"(a), "v"(b), "v"(c), "v"(d), "v"(e), "v"(f), "v"(g), "v"(h));
    return acc; }
__device__ __forceinline__ float sum4_s(float acc, float a, float b, float c, float d) {
    asm("s_nop 0\n\tv_add_f32_e32 %0, %0, %1\n\tv_add_f32_e32 %0, %0, %2\n\tv_add_f32_e32 %0, %0, %3\n\tv_add_f32_e32 %0, %0, %4" : "+v"(acc) : "v"(a), "v"(b), "v"(c), "v"(d));
    return acc; }
__device__ __forceinline__ float fadd_s(float a, float b) { float r; asm("v_add_f32_e32 %0, %1, %2" : "=v"(r) : "v"(a), "v"(b)); return r; }
#define MFMA32(a, b, c) __builtin_amdgcn_mfma_f32_32x32x16_bf16((a), (b), (c), 0, 0, 0)

constexpr int KPITCH = 144, KT_BYTES = 64 * KPITCH, VT_BYTES = 8192, TILE_BYTES = KT_BYTES + VT_BYTES, BUF_BYTES = 2 * TILE_BYTES;
constexpr int COMB_OFF = 2 * BUF_BYTES, COMB_WAVE = 17408, TAB_OFF = COMB_OFF + 4 * COMB_WAVE, TAB_N = 640, TAB_DDMAX = 576, MISC_OFF = TAB_OFF + TAB_N * 4 + 16, LDS_BYTES = 147456;
static_assert(MISC_OFF + 64 <= LDS_BYTES, "LDS map");
constexpr float NEG_BIG = -1.0e30f, THR = 8.0f;
#ifndef REDO_LIMIT
#define REDO_LIMIT 256.0f
#endif
struct AU {
    const bf16_t* q; int nq; int nt, ntc; const float* kc; const float* vc; int cp; const bf16_t* kz; const bf16_t* vz; int lastv; int nqg;
    int tlo0, thi0, tlo1, thi1; int qpos0, kpos0; const bf16_t* gate; bf16_t* y; const float* tabsrc;
};
#ifndef ATTN_INL
#define ATTN_INL __forceinline__
#endif
template <int MODE  >
__device__ ATTN_INL void attn_unit(const AU& d, ldsp lds, float lam, int lsel, const float* subg) {
    constexpr bool WIDE = (MODE == 2), BIAS = (MODE != 0);
    constexpr int NMAP = (MODE == 1) ? 1 : 2, NSTEP = (MODE == 0) ? 2 : 4, NSUB = WIDE ? 2 : 1;
#define KC(MP) ((MODE == 0) ? (MP) * 32 : 0)
    int tid_ = threadIdx.x; asm volatile("" : "+v"(tid_));
    const int tid = tid_, lane = tid & 63, wid = __builtin_amdgcn_readfirstlane(tid >> 6), qg = WIDE ? wid : (wid & 3), ks = WIDE ? 0 : (wid >> 2), r32 = lane & 31, hi = lane >> 5;
    int tlo = (qg >> 1) ? d.tlo1 : d.tlo0; int thi = (qg >> 1) ? d.thi1 : d.thi0; if (qg >= d.nqg) thi = -1;
    if (WIDE) { thi = d.tlo0 + wid; tlo = max(thi - 8, 0); }
    const int qoff0 = WIDE ? 64 * wid : 32 * qg;
    const LAS float* tab = (const LAS float*)(lds + TAB_OFF);
    float tabv0 = 0.f, tabv1 = 0.f;
    if (BIAS) { tabv0 = d.tabsrc[min(max(TAB_DDMAX - tid, -128), 128) + 128]; if (tid + 512 < TAB_N) tabv1 = d.tabsrc[min(max(TAB_DDMAX - (tid + 512), -128), 128) + 128]; }
    bf16x8 qf[NMAP][NSTEP];
    const ldsp Qw = lds + COMB_OFF + wid * 8192;
    if (WIDE) {
        u32x4 qv_[8];
#pragma unroll
        for (int j = 0; j < 8; ++j) qv_[j] = *(const u32x4*)(d.q + (size_t)(qoff0 + lane) * ZLD + j * 8);
#pragma unroll
        for (int j = 0; j < 8; ++j) *(LAS u32x4*)(Qw + lane * 128 + ((j ^ (lane & 7)) * 16)) = qv_[j];
    }
#define QFRAG(MP, ST) (WIDE ? *(const LAS bf16x8*)(Qw + (32 * (MP) + r32) * 128 + ((((ST) * 2 + hi) ^ (r32 & 7)) * 16)) : qf[MP][ST])
#pragma unroll
    for (int mp = 0; mp < (WIDE ? 0 : NMAP); ++mp) { int qrow = qoff0 + r32; if (qrow >= d.nq) qrow = d.nq - 1;
      const bf16_t* qp = d.q + (size_t)qrow * ZLD;
#pragma unroll
      for (int st = 0; st < NSTEP; ++st) qf[mp][st] = *(const bf16x8*)(qp + KC(mp) + st * 16 + hi * 8); }
    f32x16 O[NMAP][2]; float mref[NMAP], lsum[NMAP];
#pragma unroll
    for (int mp = 0; mp < NMAP; ++mp) { mref[mp] = 0.f; lsum[mp] = 0.f;
#pragma unroll
        for (int db = 0; db < 2; ++db)
#pragma unroll
            for (int i = 0; i < 16; ++i) O[mp][db][i] = 0.f; }
    const int lrow = tid >> 3, lch = tid & 7;
    const int kwoff = lrow * KPITCH + lch * 16, vwoff = (lch >> 2) * 4096 + lrow * 64 + (lch & 3) * 16;
    const int kroff = r32 * KPITCH + hi * 16;
    const int vroff = (4 * hi + ((lane & 15) >> 2)) * 64 + ((lane >> 4) & 1) * 32 + (lane & 3) * 8;
    u32x4 stK[2], stV[2];
    const int nit = (d.nt + 1) >> 1; bool started = false;
#define AT_ISSUE(IT) do { if (!WIDE) _Pragma("unroll") for (int i_ = 0; i_ < 2; ++i_) { const int t_ = 2 * (IT) + i_; if (t_ < d.nt && t_ >= d.ntc) { int r_ = lrow; if (t_ == d.nt - 1 && r_ >= d.lastv) r_ = d.lastv - 1; \
        const size_t off_ = ((size_t)(t_ - d.ntc) * 64 + r_) * ZLD + lch * 8; stK[i_] = *(const u32x4*)(d.kz + off_); stV[i_] = *(const u32x4*)(d.vz + off_); } } } while (0)
#define AT_WRITE(IT, BUF) do { _Pragma("unroll") for (int i_ = 0; i_ < 2; ++i_) { const int t_ = 2 * (IT) + i_; if (t_ < d.nt) { u32x4 kk_, vv_; if (WIDE) { const size_t off_ = ((size_t)t_ * 64 + lrow) * ZLD + lch * 8; kk_ = *(const u32x4*)(d.kz + off_); vv_ = *(const u32x4*)(d.vz + off_); } else if (t_ >= d.ntc) { kk_ = stK[i_]; vv_ = stV[i_]; } else { \
        const size_t off_ = ((size_t)t_ * 64 + lrow) * d.cp + lch * 8; const f32x4 a_ = *(const f32x4*)(d.kc + off_), b_ = *(const f32x4*)(d.kc + off_ + 4), c_ = *(const f32x4*)(d.vc + off_), e_ = *(const f32x4*)(d.vc + off_ + 4); \
        kk_ = (u32x4){cvtpk(a_[0], a_[1]), cvtpk(a_[2], a_[3]), cvtpk(b_[0], b_[1]), cvtpk(b_[2], b_[3])}; vv_ = (u32x4){cvtpk(c_[0], c_[1]), cvtpk(c_[2], c_[3]), cvtpk(e_[0], e_[1]), cvtpk(e_[2], e_[3])}; } \
        *(LAS u32x4*)((BUF) + i_ * TILE_BYTES + kwoff) = kk_; *(LAS u32x4*)((BUF) + i_ * TILE_BYTES + KT_BYTES + vwoff) = vv_; } } } while (0)
    unsigned pf_dummy = 0;
    const int pf_tile = tid >> 8, pf_v = (tid >> 7) & 1, pf_row = (tid >> 1) & 63, pf_line = tid & 1;
#define AT_TOUCH(IT) do { const int t_ = 2 * (IT) + pf_tile; if (t_ < d.ntc) { const float* p_ = (pf_v ? d.vc : d.kc) + ((size_t)t_ * 64 + pf_row) * d.cp + pf_line * 32; \
        asm volatile("global_load_dword %0, %1, off" : "=v"(pf_dummy) : "v"(p_) : "memory"); } } while (0)
    if (d.ntc > 0) { AT_TOUCH(1); AT_TOUCH(2); }
    AT_ISSUE(0);
    if (BIAS) { ((LAS float*)(lds + TAB_OFF))[tid] = tabv0 * LOG2E; if (tid + 512 < TAB_N) ((LAS float*)(lds + TAB_OFF))[tid + 512] = tabv1 * LOG2E; }
    for (int it = 0; it < nit; ++it) {
        const ldsp buf = lds + (it & 1) * BUF_BYTES;
        AT_WRITE(it, buf);
        __builtin_amdgcn_s_waitcnt(0); asm volatile("" : "+v"(pf_dummy));
        __syncthreads();
#pragma nounroll
        for (int sub = 0; sub < NSUB; ++sub) {
        const int t = 2 * it + (WIDE ? sub : ks);
        const bool vis = (t >= tlo && t <= thi);
        const ldsp Kt = buf + (WIDE ? sub : ks) * TILE_BYTES, Vt = Kt + KT_BYTES;
        bf16x8 kf0[2 * NSTEP];
        if (vis) {
#pragma unroll
            for (int st = 0; st < (WIDE ? 2 : NSTEP); ++st) { kf0[2 * st] = *(const LAS bf16x8*)(Kt + kroff + (st * 16) * 2); kf0[2 * st + 1] = *(const LAS bf16x8*)(Kt + kroff + 32 * KPITCH + (st * 16) * 2); }
        }
        __builtin_amdgcn_sched_barrier(0);
        if (sub == 0 && it + 1 < nit) AT_ISSUE(it + 1);
        if (sub == 0 && d.ntc > 0) AT_TOUCH(it + 3);
        __builtin_amdgcn_sched_barrier(0);
        if (vis) {
            const int valid = (t == d.nt - 1) ? d.lastv : 64;
            f32x16 S0[NMAP], S1[NMAP];
#define AT_BIAS(MP) do { const int qb_ = d.qpos0 + qoff0 + (WIDE ? 32 * (MP) : 0), kp0_ = d.kpos0 + 64 * t; \
                if (qb_ - (kp0_ + 63) >= 128) { const float c_ = tab[TAB_DDMAX - 128]; _Pragma("unroll") for (int i = 0; i < 16; ++i) { S0[MP][i] += c_; S1[MP][i] += c_; } } \
                else { int j0_ = TAB_DDMAX - (qb_ + r32 - kp0_ - 4 * hi); asm volatile("" : "+v"(j0_)); const LAS float* tb_ = tab + j0_; \
                    _Pragma("unroll") for (int i = 0; i < 16; ++i) { S0[MP][i] += tb_[(i & 3) + 8 * (i >> 2)]; S1[MP][i] += tb_[(i & 3) + 8 * (i >> 2) + 32]; } } } while (0)
#define AT_QK(MP) do { f32x16 negm_; _Pragma("unroll") for (int i = 0; i < 16; ++i) negm_[i] = -mref[MP]; \
                _Pragma("unroll") for (int st = 0; st < NSTEP; ++st) { \
                    const bf16x8 a0_ = *(const LAS bf16x8*)(Kt + kroff + (KC(MP) + st * 16) * 2); \
                    const bf16x8 a1_ = *(const LAS bf16x8*)(Kt + kroff + 32 * KPITCH + (KC(MP) + st * 16) * 2); \
                    if (st == 0) { S0[MP] = MFMA32(a0_, QFRAG(MP, st), negm_); S1[MP] = MFMA32(a1_, QFRAG(MP, st), negm_); } \
                    else { S0[MP] = MFMA32(a0_, QFRAG(MP, st), S0[MP]); S1[MP] = MFMA32(a1_, QFRAG(MP, st), S1[MP]); } } \
                if (BIAS) AT_BIAS(MP); \
                if (0) { const int qpos = d.qpos0 + 32 * qg + r32, kp0 = d.kpos0 + 64 * t; \
                    if (d.qpos0 + 32 * qg - (kp0 + 63) >= 128) { const float c = tab[256]; _Pragma("unroll") for (int i = 0; i < 16; ++i) { S0[MP][i] += c; S1[MP][i] += c; } } \
                    else { _Pragma("unroll") for (int i = 0; i < 16; ++i) { int dd = qpos - (kp0 + crow(i, hi)); int d0 = min(max(dd, -128), 128), d1 = min(max(dd - 32, -128), 128); S0[MP][i] += tab[d0 + 128]; S1[MP][i] += tab[d1 + 128]; } } } \
                if (valid < 64) { _Pragma("unroll") for (int i = 0; i < 16; ++i) { const int k = crow(i, hi); if (k >= valid) S0[MP][i] = NEG_BIG; if (k + 32 >= valid) S1[MP][i] = NEG_BIG; } } } while (0)
#define AT_SLOW(MP) do { asm volatile("s_nop 15\n\ts_nop 7" : "+v"(S0[MP]), "+v"(S1[MP])); \
                float ra_ = max3f(S0[MP][0], S0[MP][1], S1[MP][0]), rb_ = max3f(S0[MP][2], S0[MP][3], S1[MP][1]); ra_ = max3f(ra_, S1[MP][2], S1[MP][3]); \
                _Pragma("unroll") for (int i = 4; i < 16; i += 4) { ra_ = max3f(ra_, S0[MP][i], S0[MP][i + 1]); rb_ = max3f(rb_, S0[MP][i + 2], S0[MP][i + 3]); ra_ = max3f(ra_, S1[MP][i], S1[MP][i + 1]); rb_ = max3f(rb_, S1[MP][i + 2], S1[MP][i + 3]); } \
                const float rm_ = xhalf_max(max2f(ra_, rb_)); \
                const float dl_ = started ? fmaxf(rm_, 0.f) : rm_, al_ = started ? __builtin_amdgcn_exp2f(-dl_) : 1.f; \
                mref[MP] += dl_; lsum[MP] *= al_; \
                _Pragma("unroll") for (int i = 0; i < 16; ++i) { S0[MP][i] -= dl_; S1[MP][i] -= dl_; } \
                _Pragma("unroll") for (int db = 0; db < 2; ++db) _Pragma("unroll") for (int i = 0; i < 16; ++i) O[MP][db][i] *= al_; } while (0)
#define AT_EXPSUM(MP) do { sa = 0.f; sb = 0.f; \
                _Pragma("unroll") for (int i = 0; i < 16; ++i) { S0[MP][i] = __builtin_amdgcn_exp2f(S0[MP][i]); S1[MP][i] = __builtin_amdgcn_exp2f(S1[MP][i]); } \
                _Pragma("unroll") for (int i = 0; i < 16; i += 8) { sa = sum8_s(sa, S0[MP][i], S0[MP][i + 1], S0[MP][i + 2], S0[MP][i + 3], S0[MP][i + 4], S0[MP][i + 5], S0[MP][i + 6], S0[MP][i + 7]); \
                    sb = sum8_s(sb, S1[MP][i], S1[MP][i + 1], S1[MP][i + 2], S1[MP][i + 3], S1[MP][i + 4], S1[MP][i + 5], S1[MP][i + 6], S1[MP][i + 7]); } } while (0)
#define AT_CVT(MP) do { _Pragma("unroll") for (int s_ = 0; s_ < 2; ++s_) { \
                u32x4 w0_ = {cvtpk(S0[MP][8 * s_], S0[MP][8 * s_ + 1]), cvtpk(S0[MP][8 * s_ + 2], S0[MP][8 * s_ + 3]), cvtpk(S0[MP][8 * s_ + 4], S0[MP][8 * s_ + 5]), cvtpk(S0[MP][8 * s_ + 6], S0[MP][8 * s_ + 7])}; \
                u32x4 w1_ = {cvtpk(S1[MP][8 * s_], S1[MP][8 * s_ + 1]), cvtpk(S1[MP][8 * s_ + 2], S1[MP][8 * s_ + 3]), cvtpk(S1[MP][8 * s_ + 4], S1[MP][8 * s_ + 5]), cvtpk(S1[MP][8 * s_ + 6], S1[MP][8 * s_ + 7])}; \
                Pf[s_] = __builtin_bit_cast(bf16x8, w0_); Pf[2 + s_] = __builtin_bit_cast(bf16x8, w1_); } } while (0)
#define AT_VF(J) ({ const s16x4 lo_ = vfr[2 * (J)], hh_ = vfr[2 * (J) + 1]; (bf16x8){lo_[0], lo_[1], lo_[2], lo_[3], hh_[0], hh_[1], hh_[2], hh_[3]}; })
#define AT_VLOAD() do { _Pragma("unroll") for (int j_ = 0; j_ < 8; ++j_) { vfr[2 * j_] = vtr(Vt + vroff + (j_ & 1) * 4096 + (j_ >> 1) * 1024); vfr[2 * j_ + 1] = vtr(Vt + vroff + (j_ & 1) * 4096 + (j_ >> 1) * 1024 + 512); } } while (0)
#define SBAR() __builtin_amdgcn_sched_barrier(0)
            float sa, sb; bf16x8 Pf[4]; s16x4 vfr[16];
            { f32x16 negm_;
#pragma unroll
              for (int i = 0; i < 16; ++i) negm_[i] = -mref[0];
#pragma unroll
              for (int st = 0; st < NSTEP; ++st) {
                  const bf16x8 q_ = QFRAG(0, st);
                  const bf16x8 ka_ = (WIDE && st >= 2) ? *(const LAS bf16x8*)(Kt + kroff + (st * 16) * 2) : kf0[2 * st], kb_ = (WIDE && st >= 2) ? *(const LAS bf16x8*)(Kt + kroff + 32 * KPITCH + (st * 16) * 2) : kf0[2 * st + 1];
                  if (st == 0) { S0[0] = MFMA32(ka_, q_, negm_); S1[0] = MFMA32(kb_, q_, negm_); }
                  else { S0[0] = MFMA32(ka_, q_, S0[0]); S1[0] = MFMA32(kb_, q_, S1[0]); } }
              if (BIAS) AT_BIAS(0);
              if (0) { const int qpos = d.qpos0 + 32 * qg + r32, kp0 = d.kpos0 + 64 * t;
                  if (d.qpos0 + 32 * qg - (kp0 + 63) >= 128) { const float c = tab[256];
#pragma unroll
                      for (int i = 0; i < 16; ++i) { S0[0][i] += c; S1[0][i] += c; } }
                  else {
#pragma unroll
                      for (int i = 0; i < 16; ++i) { int dd = qpos - (kp0 + crow(i, hi)); int d0 = min(max(dd, -128), 128), d1 = min(max(dd - 32, -128), 128); S0[0][i] += tab[d0 + 128]; S1[0][i] += tab[d1 + 128]; } } }
              if (valid < 64) {
#pragma unroll
                  for (int i = 0; i < 16; ++i) { const int k = crow(i, hi); if (k >= valid) S0[0][i] = NEG_BIG; if (k + 32 >= valid) S1[0][i] = NEG_BIG; } } }
            if (!started) AT_SLOW(0);
            if (NMAP == 2) {
                constexpr int M1 = NMAP - 1;
                bf16x8 kf1[4]; f32x16 negm1; bf16x8 wka = kf1[0], wkb = kf1[0];
                bf16x8 wq = wka;
                if (WIDE) { wka = *(const LAS bf16x8*)(Kt + kroff); wkb = *(const LAS bf16x8*)(Kt + kroff + 32 * KPITCH); wq = QFRAG(M1, 0); }
                if (!WIDE) {
#pragma unroll
                for (int st = 0; st < 2; ++st) { kf1[2 * st] = *(const LAS bf16x8*)(Kt + kroff + (32 + st * 16) * 2); kf1[2 * st + 1] = *(const LAS bf16x8*)(Kt + kroff + 32 * KPITCH + (32 + st * 16) * 2); } }
#pragma unroll
                for (int i = 0; i < 16; ++i) negm1[i] = -mref[M1];
                sa = 0.f; sb = 0.f;
                SBAR();
#pragma unroll
                for (int g = 0; g < 4; ++g) {
                    if (WIDE) {
                        bf16x8 na_ = wka, nb_ = wkb;
                        if (g < 3) { na_ = *(const LAS bf16x8*)(Kt + kroff + ((g + 1) * 16) * 2); nb_ = *(const LAS bf16x8*)(Kt + kroff + 32 * KPITCH + ((g + 1) * 16) * 2); }
                        bf16x8 nq_ = wq;
                        if (g < 3) nq_ = QFRAG(M1, (g + 1) % NSTEP);
                        if (g == 0) { S0[M1] = MFMA32(wka, wq, negm1); S1[M1] = MFMA32(wkb, wq, negm1); }
                        else { S0[M1] = MFMA32(wka, wq, S0[M1]); S1[M1] = MFMA32(wkb, wq, S1[M1]); }
                        wka = na_; wkb = nb_; wq = nq_;
                    } else {
                    if (g == 0) S0[M1] = MFMA32(kf1[0], qf[M1][0], negm1); else if (g == 1) S1[M1] = MFMA32(kf1[1], qf[M1][0], negm1);
                    else if (g == 2) S0[M1] = MFMA32(kf1[2], qf[M1][1], S0[M1]); else S1[M1] = MFMA32(kf1[3], qf[M1][1], S1[M1]); }
                    SBAR();
#pragma unroll
                    for (int i = 4 * g; i < 4 * g + 4; ++i) { S0[0][i] = __builtin_amdgcn_exp2f(S0[0][i]); S1[0][i] = __builtin_amdgcn_exp2f(S1[0][i]); }
                    if (g & 1) sb = sum8_s(sb, S0[0][4 * g], S0[0][4 * g + 1], S0[0][4 * g + 2], S0[0][4 * g + 3], S1[0][4 * g], S1[0][4 * g + 1], S1[0][4 * g + 2], S1[0][4 * g + 3]);
                    else sa = sum8_s(sa, S0[0][4 * g], S0[0][4 * g + 1], S0[0][4 * g + 2], S0[0][4 * g + 3], S1[0][4 * g], S1[0][4 * g + 1], S1[0][4 * g + 2], S1[0][4 * g + 3]);
                    SBAR();
                }
                if (WIDE) AT_BIAS(M1);
                if (valid < 64) {
#pragma unroll
                    for (int i = 0; i < 16; ++i) { const int k = crow(i, hi); if (k >= valid) S0[M1][i] = NEG_BIG; if (k + 32 >= valid) S1[M1][i] = NEG_BIG; } }
            } else AT_EXPSUM(0);
            if (started && __any(!(sa + sb <= REDO_LIMIT))) { AT_QK(0); AT_SLOW(0); AT_EXPSUM(0); }
            lsum[0] += sa + sb;
            AT_VLOAD();
            AT_CVT(0);
            if (NMAP == 2) {
                constexpr int M1 = NMAP - 1;
                if (!started) AT_SLOW(M1);
                sa = 0.f; sb = 0.f;
                SBAR();
#pragma unroll
                for (int j = 0; j < 8; ++j) {
                    O[0][j & 1] = MFMA32(AT_VF(j), Pf[j >> 1], O[0][j & 1]);
                    SBAR();
                    S0[M1][2 * j] = __builtin_amdgcn_exp2f(S0[M1][2 * j]); S0[M1][2 * j + 1] = __builtin_amdgcn_exp2f(S0[M1][2 * j + 1]);
                    S1[M1][2 * j] = __builtin_amdgcn_exp2f(S1[M1][2 * j]); S1[M1][2 * j + 1] = __builtin_amdgcn_exp2f(S1[M1][2 * j + 1]);
                    if (j & 1) sb = sum4_s(sb, S0[M1][2 * j], S0[M1][2 * j + 1], S1[M1][2 * j], S1[M1][2 * j + 1]); else sa = sum4_s(sa, S0[M1][2 * j], S0[M1][2 * j + 1], S1[M1][2 * j], S1[M1][2 * j + 1]);
                    SBAR();
                }
                if (started && __any(!(sa + sb <= REDO_LIMIT))) { AT_QK(M1); AT_SLOW(M1); AT_EXPSUM(M1); }
                lsum[M1] += sa + sb;
#pragma unroll
                for (int k = 0; k < 4; ++k) {
                    const f32x16& sx = (k < 2) ? S0[M1] : S1[M1]; const int b = 8 * (k & 1);
                    const u32x4 w_ = {cvtpk(sx[b], sx[b + 1]), cvtpk(sx[b + 2], sx[b + 3]), cvtpk(sx[b + 4], sx[b + 5]), cvtpk(sx[b + 6], sx[b + 7])};
                    Pf[k] = __builtin_bit_cast(bf16x8, w_);
                    SBAR();
                    O[M1][0] = MFMA32(AT_VF(2 * k), Pf[k], O[M1][0]); O[M1][1] = MFMA32(AT_VF(2 * k + 1), Pf[k], O[M1][1]);
                    SBAR();
                }
            } else {
#pragma unroll
                for (int j = 0; j < 8; ++j) O[0][j & 1] = MFMA32(AT_VF(j), Pf[j >> 1], O[0][j & 1]);
            }
#undef AT_SLOW
#undef AT_EXPSUM
#undef AT_CVT
#undef AT_VF
#undef AT_VLOAD
#undef SBAR
#undef AT_BIAS
            started = true;
#undef AT_QK
        }
        }
    }
#undef AT_ISSUE
#undef AT_TOUCH
#undef AT_WRITE
    __syncthreads();
    if (!started) {
#pragma unroll
        for (int mp = 0; mp < NMAP; ++mp) mref[mp] = NEG_BIG;
    }
    u32x2 gpre[8];
    if (MODE == 1 && ks == 0 && qg < d.nqg) { const int row_ = min(32 * qg + r32, d.nq - 1);
#pragma unroll
        for (int j = 0; j < 8; ++j) gpre[j] = *(const u32x2*)(d.gate + (size_t)row_ * ZLD + 32 * (j >> 2) + 8 * (j & 3) + 4 * hi); }
    const ldsp cw = lds + COMB_OFF + qg * COMB_WAVE;
    if (!WIDE && ks == 1 && qg < d.nqg) {
#pragma unroll
        for (int mp = 0; mp < NMAP; ++mp) {
#pragma unroll
            for (int db = 0; db < 2; ++db)
#pragma unroll
                for (int i = 0; i < 16; ++i) *(LAS float*)(cw + ((mp * 2 + db) * 16 + i) * 256 + lane * 4) = O[mp][db][i];
            *(LAS float*)(cw + 16384 + (mp * 2) * 256 + lane * 4) = mref[mp]; *(LAS float*)(cw + 16384 + (mp * 2 + 1) * 256 + lane * 4) = lsum[mp];
        }
    }
    __syncthreads();
    if (WIDE) {
#pragma unroll
        for (int mp = 0; mp < NMAP; ++mp) {
            const float fin = 1.0f / xhalf_sum(lsum[mp]); const int row = qoff0 + 32 * mp + r32;
#pragma unroll
            for (int db = 0; db < 2; ++db)
#pragma unroll
                for (int g4 = 0; g4 < 4; ++g4) {
                    const int d0 = 32 * db + 8 * g4 + 4 * hi;
                    const u32x2 gw = *(const u32x2*)(d.gate + (size_t)row * ZLD + d0);
                    const float y0 = O[mp][db][4 * g4] * fin * bf_lo(gw.x), y1 = O[mp][db][4 * g4 + 1] * fin * bf_hi(gw.x), y2 = O[mp][db][4 * g4 + 2] * fin * bf_lo(gw.y), y3 = O[mp][db][4 * g4 + 3] * fin * bf_hi(gw.y);
                    *(u32x2*)(d.y + (size_t)row * 1024 + d0) = (u32x2){cvtpk(y0, y1), cvtpk(y2, y3)};
                }
        }
    } else
    if (ks == 0 && qg < d.nqg) {
        float linv[NMAP];
#pragma unroll
        for (int mp = 0; mp < NMAP; ++mp) {
            const float mb = *(const LAS float*)(cw + 16384 + (mp * 2) * 256 + lane * 4), lb = *(const LAS float*)(cw + 16384 + (mp * 2 + 1) * 256 + lane * 4);
            const float mt = fmaxf(mref[mp], mb), aa = __builtin_amdgcn_exp2f(mref[mp] - mt), ab = __builtin_amdgcn_exp2f(mb - mt);
            const float l = xhalf_sum(lsum[mp] * aa + lb * ab);
            linv[mp] = 1.0f / l;
#pragma unroll
            for (int db = 0; db < 2; ++db)
#pragma unroll
                for (int i = 0; i < 16; ++i) O[mp][db][i] = O[mp][db][i] * aa + *(const LAS float*)(cw + ((mp * 2 + db) * 16 + i) * 256 + lane * 4) * ab;
        }
        float fin = 1.f;
        if (MODE == 0) {
            const float i1 = linv[0], i2 = lam * linv[NMAP - 1]; float ss = 0.f;
#pragma unroll
            for (int db = 0; db < 2; ++db)
#pragma unroll
                for (int i = 0; i < 16; ++i) { const float o = O[0][db][i] * i1 - O[NMAP - 1][db][i] * i2; O[0][db][i] = o; ss += o * o; }
            ss = xhalf_sum(ss);
            int sel_ = lsel; asm volatile("" : "+s"(sel_));
            fin = __builtin_amdgcn_rsqf(ss * (1.0f / 64.0f) + 1e-5f) * ((sel_ == 0) ? 0.8f : 0.6444909324090307f);
        } else fin = linv[0];
        const int row = 32 * qg + r32;
        if (row < d.nq) {
#pragma unroll
            for (int db = 0; db < 2; ++db)
#pragma unroll
                for (int g4 = 0; g4 < 4; ++g4) {
                    const int d0 = 32 * db + 8 * g4 + 4 * hi;
                    const u32x2 gw = (MODE == 1) ? gpre[db * 4 + g4] : *(const u32x2*)(d.gate + (size_t)row * ZLD + d0);
                    f32x4 sg = {1.f, 1.f, 1.f, 1.f}; if (MODE == 0) sg = *(const f32x4*)(subg + d0);
                    const float y0 = O[0][db][4 * g4] * fin * sg[0] * bf_lo(gw.x), y1 = O[0][db][4 * g4 + 1] * fin * sg[1] * bf_hi(gw.x);
                    const float y2 = O[0][db][4 * g4 + 2] * fin * sg[2] * bf_lo(gw.y), y3 = O[0][db][4 * g4 + 3] * fin * sg[3] * bf_hi(gw.y);
                    *(u32x2*)(d.y + (size_t)row * 1024 + d0) = (u32x2){cvtpk(y0, y1), cvtpk(y2, y3)};
                }
        }
    }
}
#undef KC
#undef QFRAG
using namespace pg8;
#ifndef P1_ALIGN
#define P1_ALIGN true
#endif
constexpr size_t WS_CTL = WSO_CTL, CTL_BYTES = 1u << 20, WS_SSQ0 = WSO_SSQ0, WS_ROPE = WSO_ROPE, WS_WIN = WSO_WIN, WS_WOUT = WSO_WOUT, WS_XB = WSO_XB, WS_YMIX = WSO_YMIX, WS_X1 = WSO_X1, WS_Z = WSO_Z, WS_END = WSO_END;
static_assert((size_t)MROWS * 1024 * 2 <= 36u * (1u << 20) && (size_t)MROWS * 1024 * 4 <= 68u * (1u << 20) && (size_t)MROWS * 4096 * 2 <= 132u * (1u << 20), "ws map");
constexpr int CTL_Q0 = 0, CTL_SI = 64, CTL_SM = 128, CTL_SSQ1 = 16384, CTL_SSQ2 = 16384 + 32768;
static_assert((CTL_SSQ2 + MROWS) * 4 <= (int)CTL_BYTES, "ctl");
constexpr size_t O_Y = OO_Y, O_CONVP = OO_CONVP, O_CONVS = OO_CONVS, O_END = OO_END;
struct Args { const float* in[18]; float* out; unsigned char* ws; };

__device__ __forceinline__ float wave_sum(float v) {
#pragma unroll
    for (int o = 1; o < 64; o <<= 1) v += __shfl_xor(v, o);
    return v;
}
__device__ __forceinline__ unsigned f2bf(float f) { unsigned u = __builtin_bit_cast(unsigned, f); return (u + 0x7fffu + ((u >> 16) & 1u)) >> 16; }
__device__ __forceinline__ unsigned pk2(float lo, float hi) { return f2bf(lo) | (f2bf(hi) << 16); }
__device__ __forceinline__ void p0_transpose_item(const float* W, const float* g, int K, int N, bf16_t* WT, LAS float* scr, int item, int lane) {
    const int nblk = N / 32, kb = item / nblk, nb = item % nblk, k0 = 64 * kb, n0 = 32 * nb;
#pragma unroll 8
    for (int i = 0; i < 32; ++i) { const int kk = 2 * i + (lane >> 5); const float gs = g ? g[k0 + kk] : 1.f; scr[kk * 33 + (lane & 31)] = W[(size_t)(k0 + kk) * N + n0 + (lane & 31)] * gs; }
    asm volatile("s_waitcnt lgkmcnt(0)" ::: "memory");
    const int c = lane & 7;
#pragma unroll
    for (int j = 0; j < 4; ++j) { const int n = (lane >> 3) + 8 * j; const LAS float* s = scr + (8 * c) * 33 + n;
        u32x4 o; o.x = pk2(s[0 * 33], s[1 * 33]); o.y = pk2(s[2 * 33], s[3 * 33]); o.z = pk2(s[4 * 33], s[5 * 33]); o.w = pk2(s[6 * 33], s[7 * 33]);
        *(u32x4*)(WT + (size_t)(n0 + n) * K + k0 + 8 * c) = o; }
    asm volatile("s_waitcnt lgkmcnt(0)" ::: "memory");
}

__global__ void __launch_bounds__(512) fwd_megakernel(Args args) {
    extern __shared__ __attribute__((aligned(16))) unsigned char lds_raw[];
    cg::grid_group grid = cg::this_grid();
    const ldsp lds = (ldsp)lds_raw;
    const int tid = threadIdx.x, lane = tid & 63, wave = __builtin_amdgcn_readfirstlane(tid >> 6);
    const int G = gridDim.x, bx = blockIdx.x;
    unsigned char* ws = args.ws; float* out = args.out;
    unsigned* ctl = (unsigned*)(ws + WS_CTL);
    float* SSQ0 = (float*)(ws + WS_SSQ0); float* SSQ1 = (float*)ctl + CTL_SSQ1; float* SSQ2 = (float*)ctl + CTL_SSQ2;
    float* ROPE = (float*)(ws + WS_ROPE);
    bf16_t* WIN = (bf16_t*)(ws + WS_WIN); bf16_t* WOUT = (bf16_t*)(ws + WS_WOUT);
    bf16_t* XB = (bf16_t*)(ws + WS_XB); bf16_t* YMIX = (bf16_t*)(ws + WS_YMIX); float* X1 = (float*)(ws + WS_X1); bf16_t* Z = (bf16_t*)(ws + WS_Z);
    const float* x_p = args.in[0]; const float* x_s = args.in[1];

    {
        LAS float* scr = (LAS float*)(lds + wave * 16384);
        const int gw = bx * 8 + wave, NGW = G * 8;
        constexpr int I_IN = (1024 / 64) * (4096 / 32), I_OUT = (1024 / 64) * (1024 / 32), NITEMS = 2 * I_IN + 2 * I_OUT;
        for (int it = gw; it < NITEMS; it += NGW) {
            int r = it;
            if (r < 2 * I_IN) { const int l = r / I_IN; r -= l * I_IN; p0_transpose_item(args.in[8] + (size_t)l * 1024 * 4096, args.in[7] + l * 1024, 1024, 4096, WIN + (size_t)l * 4096 * 1024, scr, r, lane); }
            else { r -= 2 * I_IN; const int l = r / I_OUT; r -= l * I_OUT; p0_transpose_item(args.in[9] + (size_t)l * 1024 * 1024, nullptr, 1024, 1024, WOUT + (size_t)l * 1024 * 1024, scr, r, lane); }
        }
        for (int m = gw; m < MROWS; m += NGW) {
            const float* xr = (m < NPROMPT) ? x_p + (size_t)m * 1024 : x_s + (size_t)(m - NPROMPT) * 1024;
            f32x4 v[4]; float s = 0.f;
#pragma unroll
            for (int j = 0; j < 4; ++j) { v[j] = *((const f32x4*)xr + lane + 64 * j); s += (v[j][0] * v[j][0] + v[j][1] * v[j][1]) + (v[j][2] * v[j][2] + v[j][3] * v[j][3]); }
            s = wave_sum(s);
            if (lane == 0) SSQ0[m] = s;
#pragma unroll
            for (int j = 0; j < 4; ++j) *((u32x2*)(XB + (size_t)m * 1024) + lane + 64 * j) = (u32x2){cvtpk(v[j][0], v[j][1]), cvtpk(v[j][2], v[j][3])};
        }
        for (int e = bx * 512 + tid; e < MROWS * 4; e += G * 512) {
            const int row = e >> 2, i = e & 3; const int pos = (row < NPROMPT) ? row : 4096 + ((row - NPROMPT) & 15);
            const float invf = (i == 0) ? 1.0f : (i == 1 ? 0.037606030930863934f : (i == 2 ? 0.0014142135623730950f : 5.318295896944988e-05f));
            const float ang = (float)pos * invf;
            const double rev = (double)ang * 0.15915494309189535; const float fr = (float)(rev - __builtin_rint(rev));
            ROPE[(size_t)row * 8 + i] = __builtin_amdgcn_cosf(fr); ROPE[(size_t)row * 8 + 4 + i] = __builtin_amdgcn_sinf(fr);
        }
    }
    grid.sync();

    for (int l = 0; l < 2; ++l) {
        {
            pg8::Gemm g{XB, WIN + (size_t)l * 4096 * 1024, NPROMPT, 4096, 1024}; pg8::StaticOrder S; S.init(NPROMPT, 4096, G, bx);
            pg8::EpiIn E{ws, out, l};

#ifndef NO_GEMM1
            pg8::gemm_phase<pg8::EpiIn, pg8::StaticOrder, P1_ALIGN, true>(lds, g, S, E);
#ifdef PROBE_P1X
            if (l == 0) { grid.sync(); pg8::gemm_phase<pg8::EpiIn, pg8::StaticOrder, true, true>(lds, g, S, E); }
#endif
#endif

        }
        grid.sync();
        {
            const float lam_init = (l == 0) ? 0.2f : 0.35550906759096927f;
            float d1 = 0.f, d2 = 0.f;
            for (int i = 0; i < 32; ++i) { d1 += args.in[12][l * 32 + i] * args.in[13][l * 32 + i]; d2 += args.in[14][l * 32 + i] * args.in[15][l * 32 + i]; }
            const float lam = __int_as_float(__builtin_amdgcn_readfirstlane(__float_as_int(__expf(d1) - __expf(d2) + lam_init))), dummy_oml_ = 0.f; const int oml = l;
            const float* subg = args.in[16] + l * 64;
            volatile LAS int* misc = (volatile LAS int*)(lds + MISC_OFF);
            constexpr int N_SI = 16, N_PC = 512, N_SC = 64, N_PA = 1024, N_SA = 128, N_CV = 130, N_SO = 4, N_TOT = N_SI + N_PC + N_SC + N_PA + N_SA + N_CV + N_SO;
            constexpr unsigned N_SMIX = N_SC + N_SA + 2;
#ifndef PROBE_P2X
#define PROBE_P2X 1
#endif
            for (int rep = 0; rep < ((l == 0) ? PROBE_P2X : 1); ++rep) {
            if (rep > 0) grid.sync();
            for (;;) {
                __syncthreads();
                if (tid == 0) misc[0] = (int)atomicAdd(ctl + CTL_Q0 + l + 2 * rep, 1u);
                __syncthreads();
                int ui = misc[0]; ui = __builtin_amdgcn_readfirstlane(ui);
                if (ui >= N_TOT) break;
                AU d; d.tabsrc = nullptr; d.kc = nullptr; d.vc = nullptr; d.cp = 0; d.ntc = 0; d.lastv = 64; d.nqg = 4; d.tlo1 = 0; d.thi1 = -1; d.qpos0 = 0; d.kpos0 = 0;
                int kind;
                int idx = ui;
                if (idx < 16) kind = 5; else if (idx < 256) { kind = 0; idx -= 16; } else if (idx < 320) { kind = 1; idx -= 256; } else if (idx < 448) { kind = 3; idx -= 320; } else if (idx < 450) { kind = 4; idx = 128 + (idx - 448); }
                else if (idx < 454) { kind = 6; idx -= 450; } else if (idx < 726) { kind = 0; idx = 240 + (idx - 454); } else if (idx < 1750) { kind = 2; idx -= 726; } else { kind = 4; idx -= 1750; }
#ifdef PROBE_ONLY_KIND
                if (rep > 0 && kind != PROBE_ONLY_KIND) continue;
#endif
                if (rep > 0 && kind >= 5) continue;
                const bool smp_unit = (kind == 1 || kind == 3 || (kind == 4 && idx >= 128));
                if (smp_unit || kind == 6) {
                    if (tid == 0) {
                        unsigned* cnt = ctl + (kind == 6 ? CTL_SM : CTL_SI) + l; const unsigned want = (kind == 6) ? N_SMIX : (unsigned)N_SI;
                        while (__hip_atomic_load(cnt, __ATOMIC_RELAXED, __HIP_MEMORY_SCOPE_AGENT) < want) __builtin_amdgcn_s_sleep(8);
                        __builtin_amdgcn_fence(__ATOMIC_ACQUIRE, "agent");
                        asm volatile("s_waitcnt vmcnt(0)" ::: "memory");
                    }
                    __syncthreads();
                }
                if (kind >= 5) {
                    if (kind == 5) { pg8::Gemm g{XB, WIN + (size_t)l * 4096 * 1024, MROWS, 4096, 1024}; pg8::OneUnit S{64, idx}; pg8::EpiIn E{ws, out, l};
                        pg8::gemm_phase<pg8::EpiIn, pg8::OneUnit, false, true>(lds, g, S, E); }
                    else { pg8::Gemm g{YMIX, WOUT + (size_t)l * 1024 * 1024, MROWS, 1024, 1024}; pg8::OneUnit S{64, idx}; pg8::EpiOut E{ws, x_p, x_s, l, args.in[17], out};
                        pg8::gemm_phase<pg8::EpiOut, pg8::OneUnit, false, true>(lds, g, S, E); }
                }
                else if (kind == 0) {
                    const int u = 127 - (idx >> 2), h = idx & 3; const size_t r0 = (size_t)128 * u;
                    d.q = Z + r0 * ZLD + 3072 + 64 * h; d.nq = 128; d.nt = 2 * u + 2; d.kz = Z + 3328 + 64 * h; d.vz = Z + 3584 + 64 * h;
                    d.tlo0 = 0; d.thi0 = d.nt - 2; d.tlo1 = 0; d.thi1 = d.nt - 1; d.gate = Z + r0 * ZLD + 3840 + 64 * h; d.y = YMIX + r0 * 1024 + 768 + 64 * h;

#ifndef NO_ATTN0
                    attn_unit<0>(d, lds, lam, oml, subg);
#endif

                } else if (kind == 1) {
                    const int b = idx >> 2, h = idx & 3; const size_t r0 = (size_t)NPROMPT + 16 * b;
                    d.q = Z + r0 * ZLD + 3072 + 64 * h; d.nq = 16; d.nt = 65; d.ntc = 64; d.cp = 256;
                    d.kc = args.in[5] + ((size_t)(l * 16 + b) * 4096) * 256 + 64 * h; d.vc = args.in[6] + ((size_t)(l * 16 + b) * 4096) * 256 + 64 * h;
                    d.kz = Z + r0 * ZLD + 3328 + 64 * h; d.vz = Z + r0 * ZLD + 3584 + 64 * h; d.lastv = 16; d.nqg = 1; d.tlo0 = 0; d.thi0 = 64;
                    d.gate = Z + r0 * ZLD + 3840 + 64 * h; d.y = YMIX + r0 * 1024 + 768 + 64 * h;

#ifndef NO_ATTN0
                    attn_unit<0>(d, lds, lam, oml, subg);
#endif

                } else if (kind == 2 || kind == 3) {
                    int h;
                    if (kind == 2) {
                        h = idx & 7; const int cp = idx >> 3, c0 = max(0, 2 * cp - 8); const size_t r0 = (size_t)128 * cp;
                        d.q = Z + r0 * ZLD + 64 * h; d.nq = 128; d.nt = 2 * cp + 2 - c0; d.kz = Z + (size_t)64 * c0 * ZLD + 512 + 64 * h; d.vz = Z + (size_t)64 * c0 * ZLD + 1024 + 64 * h;
                        d.tlo0 = 0; d.thi0 = 2 * cp - c0; d.tlo1 = max(0, 2 * cp + 1 - 8) - c0; d.thi1 = 2 * cp + 1 - c0; d.qpos0 = 128 * cp; d.kpos0 = 64 * c0;
                        d.gate = Z + r0 * ZLD + 1536 + 64 * h; d.y = YMIX + r0 * 1024 + 64 * h;
                    } else {
                        h = idx & 7; const int b = idx >> 3; const size_t r0 = (size_t)NPROMPT + 16 * b;
                        d.q = Z + r0 * ZLD + 64 * h; d.nq = 16; d.nt = 9; d.ntc = 8; d.cp = 512;
                        d.kc = args.in[2] + ((size_t)(l * 16 + b) * 512) * 512 + 64 * h; d.vc = args.in[3] + ((size_t)(l * 16 + b) * 512) * 512 + 64 * h;
                        d.kz = Z + r0 * ZLD + 512 + 64 * h; d.vz = Z + r0 * ZLD + 1024 + 64 * h; d.lastv = 16; d.nqg = 1; d.tlo0 = 0; d.thi0 = 8; d.qpos0 = 512; d.kpos0 = 0;
                        d.gate = Z + r0 * ZLD + 1536 + 64 * h; d.y = YMIX + r0 * 1024 + 64 * h;
                    }
                    d.tabsrc = args.in[10] + (size_t)(l * 8 + h) * 257;

#ifndef NO_ATTN1
                    attn_unit<1>(d, lds, 0.f, 0, nullptr);
#endif

                } else {
                    int tq_ = threadIdx.x; asm volatile("" : "+v"(tq_));
                    const int c8 = (tq_ & 31) * 8, rr = tq_ >> 5;
                    const float* cw = args.in[11] + (size_t)l * 3 * 256 + c8;
                    float w0[8], w1[8], w2[8];
#pragma unroll
                    for (int j = 0; j < 8; ++j) { w0[j] = cw[j]; w1[j] = cw[256 + j]; w2[j] = cw[512 + j]; }
                    for (int g = 0; g < 8; ++g) {
                        const int row = 128 * idx + 16 * g + rr; const bool smp = row >= NPROMPT; const int t = smp ? ((row - NPROMPT) & 15) : row, b = (row - NPROMPT) >> 4;
                        const bf16_t* zr = Z + (size_t)row * ZLD;
                        float u0[8], u1[8], u2[8];
                        { const u32x4 c = *(const u32x4*)(zr + 2304 + c8), hh = *(const u32x4*)(zr + 2560 + c8);
#pragma unroll
                          for (int j = 0; j < 4; ++j) { u0[2 * j] = bf_lo(c[j]) * bf_lo(hh[j]); u0[2 * j + 1] = bf_hi(c[j]) * bf_hi(hh[j]); } }
                        if (t >= 1) { const u32x4 c = *(const u32x4*)(zr - ZLD + 2304 + c8), hh = *(const u32x4*)(zr - ZLD + 2560 + c8);
#pragma unroll
                          for (int j = 0; j < 4; ++j) { u1[2 * j] = bf_lo(c[j]) * bf_lo(hh[j]); u1[2 * j + 1] = bf_hi(c[j]) * bf_hi(hh[j]); } }
                        else if (smp) { const float* sp = args.in[4] + ((size_t)(l * 16 + b) * 2 + 1) * 256 + c8;
#pragma unroll
                          for (int j = 0; j < 8; ++j) u1[j] = sp[j]; }
                        else {
#pragma unroll
                          for (int j = 0; j < 8; ++j) u1[j] = 0.f; }
                        if (t >= 2) { const u32x4 c = *(const u32x4*)(zr - 2 * ZLD + 2304 + c8), hh = *(const u32x4*)(zr - 2 * ZLD + 2560 + c8);
#pragma unroll
                          for (int j = 0; j < 4; ++j) { u2[2 * j] = bf_lo(c[j]) * bf_lo(hh[j]); u2[2 * j + 1] = bf_hi(c[j]) * bf_hi(hh[j]); } }
                        else if (smp) { const float* sp = args.in[4] + ((size_t)(l * 16 + b) * 2 + t) * 256 + c8;
#pragma unroll
                          for (int j = 0; j < 8; ++j) u2[j] = sp[j]; }
                        else {
#pragma unroll
                          for (int j = 0; j < 8; ++j) u2[j] = 0.f; }
                        const u32x4 bb = *(const u32x4*)(zr + 2048 + c8), bg = *(const u32x4*)(zr + 2816 + c8);
                        float y[8];
#pragma unroll
                        for (int j = 0; j < 4; ++j) {
                            y[2 * j] = bf_lo(bb[j]) * (u2[2 * j] * w0[2 * j] + u1[2 * j] * w1[2 * j] + u0[2 * j] * w2[2 * j]) * bf_lo(bg[j]);
                            y[2 * j + 1] = bf_hi(bb[j]) * (u2[2 * j + 1] * w0[2 * j + 1] + u1[2 * j + 1] * w1[2 * j + 1] + u0[2 * j + 1] * w2[2 * j + 1]) * bf_hi(bg[j]); }
                        *(u32x4*)(YMIX + (size_t)row * 1024 + 512 + c8) = (u32x4){cvtpk(y[0], y[1]), cvtpk(y[2], y[3]), cvtpk(y[4], y[5]), cvtpk(y[6], y[7])};
                        float* so = nullptr;
                        if (!smp && row >= NPROMPT - 2) so = out + O_CONVP + (size_t)l * 512 + (size_t)(row - (NPROMPT - 2)) * 256 + c8;
                        if (smp && t >= 14) so = out + O_CONVS + (size_t)l * 8192 + (size_t)b * 512 + (size_t)(t - 14) * 256 + c8;
                        if (so) { *(f32x4*)so = (f32x4){u0[0], u0[1], u0[2], u0[3]}; *(f32x4*)(so + 4) = (f32x4){u0[4], u0[5], u0[6], u0[7]}; }
                    }
                }
                if (smp_unit || kind == 5) {
                    asm volatile("s_waitcnt vmcnt(0)" ::: "memory");
                    __syncthreads();
                    if (tid == 0) { __builtin_amdgcn_fence(__ATOMIC_RELEASE, "agent"); asm volatile("s_waitcnt vmcnt(0)" ::: "memory");
                        __hip_atomic_fetch_add(ctl + (kind == 5 ? CTL_SI : CTL_SM) + l, 1u, __ATOMIC_RELAXED, __HIP_MEMORY_SCOPE_AGENT); }
                }
            }
            }
        }
        grid.sync();
        {
            pg8::Gemm g{YMIX, WOUT + (size_t)l * 1024 * 1024, NPROMPT, 1024, 1024}; pg8::StaticOrder S; S.init(NPROMPT, 1024, G, bx);
            pg8::EpiOut E{ws, x_p, x_s, l, args.in[17], out};

#ifndef NO_GEMM2
            pg8::gemm_phase<pg8::EpiOut, pg8::StaticOrder, true, true>(lds, g, S, E);
#endif

            if (l == 1 && wave == 0 && bx < MROWS - NPROMPT) {
                int ln_ = threadIdx.x; asm volatile("" : "+v"(ln_)); ln_ &= 63;
                const int lane = ln_;
                const int m = NPROMPT + bx; const float rs = __builtin_amdgcn_rsqf(SSQ2[m] * (1.0f / 1024.0f) + 1e-6f);
#pragma unroll
                for (int j = 0; j < 4; ++j) { const f32x4 v = *((const f32x4*)(X1 + (size_t)m * 1024) + lane + 64 * j); *((f32x4*)(out + O_Y + (size_t)m * 1024) + lane + 64 * j) = v * rs * *((const f32x4*)args.in[17] + lane + 64 * j); }
            }
        }
        if (l == 0) grid.sync();
    }
}

extern "C" void kernel_launch(void* const* d_in, const int* in_sizes, int n_in, void* d_out, int out_size, void* d_ws, size_t ws_size, hipStream_t stream) {
    static int grid_blocks = 0;
    if (!grid_blocks) {
        if (n_in != 18 || (size_t)out_size != O_END || ws_size < WS_END) { fprintf(stderr, "kernel_launch: unexpected shapes n_in %d out %d ws %zu\n", n_in, out_size, ws_size); grid_blocks = -1; return; }
        int dev = 0, cus = 0, per_cu = 0;
        hipGetDevice(&dev); hipDeviceGetAttribute(&cus, hipDeviceAttributeMultiprocessorCount, dev);
        hipFuncSetAttribute((const void*)fwd_megakernel, hipFuncAttributeMaxDynamicSharedMemorySize, LDS_BYTES);
        hipOccupancyMaxActiveBlocksPerMultiprocessor(&per_cu, (const void*)fwd_megakernel, 512, LDS_BYTES);
        if (per_cu < 1) { fprintf(stderr, "kernel_launch: occupancy query says %d blocks per CU\n", per_cu); per_cu = 1; }
        if (per_cu > 1) per_cu = 1;
        grid_blocks = cus * per_cu;
    }
    if (grid_blocks < 0) return;
    hipMemsetAsync((char*)d_ws + WS_CTL, 0, CTL_BYTES, stream);
    Args a{};
    for (int i = 0; i < 18; ++i) a.in[i] = (const float*)d_in[i];
    a.out = (float*)d_out; a.ws = (unsigned char*)d_ws;
    void* kargs[] = {&a};
    hipError_t e = hipLaunchCooperativeKernel((const void*)fwd_megakernel, dim3(grid_blocks), dim3(512), kargs, LDS_BYTES, stream);
    if (e != hipSuccess) fprintf(stderr, "cooperative launch failed: %s (grid %d)\n", hipGetErrorString(e), grid_blocks);
}
```

```cpp
#include <hip/hip_runtime.h>
#include <hip/hip_cooperative_groups.h>
#include <cstdio>
#include <cstdint>
namespace cg = cooperative_groups;
namespace pg8 {
#define PG8_LAS __attribute__((address_space(3)))
typedef unsigned short bf16_t;
typedef short bf16x8 __attribute__((ext_vector_type(8)));
typedef float f32x4 __attribute__((ext_vector_type(4)));
typedef unsigned u32x4 __attribute__((ext_vector_type(4)));
constexpr int BM = 256, BK = 64, HALF = 128, HTB = HALF * BK * 2  , STAGE_BYTES = 8 * HTB, NXCD = 8, WGM = 8;

__host__ __device__ __forceinline__ int lds_byte(int r, int c) { const int st = (r >> 4) * 2 + (c >> 5), rr = r & 15, cc = c & 31, ob = rr * 64 + cc * 2; return st * 1024 + (ob ^ (((ob >> 9) & 1) << 5)); }
__host__ __device__ __forceinline__ void stage_rc(int b, int& R, int& C) { const int st = b / 1024, sb = b % 1024, swz = sb ^ (((sb >> 9) & 1) << 5); R = (st >> 1) * 16 + swz / 64; C = (st & 1) * 32 + (swz % 64) / 2; }
__host__ __device__ __forceinline__ int perm32(int rho) { const int n = rho >> 4, i = rho & 15; return 8 * (i >> 2) + 4 * n + (i & 3); }

struct Unit { int pm, pn; };
struct Gemm { const bf16_t* A; const bf16_t* Bt; int M, N, K; };

struct StaticOrder {
    int nM, nN, nwg, G, c;
    __host__ __device__ void init(int M, int N, int G_, int c_) { nM = M / BM; nN = N / BM; nwg = nM * nN; G = G_; c = c_; }
    __host__ __device__ bool next(int i, Unit& u) const {
        const long L = (long)i * G + c; if (L >= nwg) return false;
        int wgid = (int)L; { const int q = nwg / NXCD, r = nwg % NXCD, xcd = wgid % NXCD, off = wgid / NXCD; wgid = (xcd < r ? xcd * (q + 1) : r * (q + 1) + (xcd - r) * q) + off; }
        const int nig = WGM * nN, gid = wgid / nig, fm = gid * WGM, gsz = (nM - fm) < WGM ? (nM - fm) : WGM;
        u.pm = fm + ((wgid % nig) % gsz); u.pn = (wgid % nig) / gsz; return true;
    }
    __device__ __forceinline__ void a_ready(const Unit&) const {}
    __device__ __forceinline__ void done(const Unit&) const {}
};
struct OneUnit {
    int pm, pn;
    __host__ __device__ bool next(int i, Unit& u) const { if (i) return false; u.pm = pm; u.pn = pn; return true; }
    __device__ __forceinline__ void a_ready(const Unit&) const {}
    __device__ __forceinline__ void done(const Unit&) const {}
};
__device__ __forceinline__ unsigned cvt_pk_bf16(float lo, float hi) { unsigned r; asm volatile("v_cvt_pk_bf16_f32 %0, %1, %2" : "=v"(r) : "v"(lo), "v"(hi)); return r; }
typedef float f32x2 __attribute__((ext_vector_type(2)));
constexpr float LOG2E = 1.4426950408889634f;
constexpr float SC_QA = 0.125f * LOG2E;
constexpr float SC_QC = 0.17677669529663687f * LOG2E;
constexpr int ZLD = 4096, MROWS = 16640, NPROMPT = 16384;
constexpr size_t WSO_MiB = 1u << 20;
constexpr size_t WSO_PANEL = 512 * 4  , WSO_CTL = 0, WSO_SSQ1 = 16384 * 4, WSO_SSQ2 = (16384 + 32768) * 4, WSO_SSQ0 = 1 * WSO_MiB, WSO_ROPE = 2 * WSO_MiB, WSO_WIN = 4 * WSO_MiB, WSO_WOUT = 20 * WSO_MiB, WSO_XB = 24 * WSO_MiB,
                 WSO_YMIX = 60 * WSO_MiB, WSO_X1 = 96 * WSO_MiB, WSO_Z = 164 * WSO_MiB, WSO_END = 296 * WSO_MiB;
constexpr size_t OO_Y = 0, OO_AKP = 17039360, OO_AVP = OO_AKP + 524288, OO_CONVP = OO_AVP + 524288, OO_CKP = OO_CONVP + 1024, OO_CVP = OO_CKP + 8388608,
                 OO_AKS = OO_CVP + 8388608, OO_AVS = OO_AKS + 262144, OO_CONVS = OO_AVS + 262144, OO_CKS = OO_CONVS + 16384, OO_CVS = OO_CKS + 131072, OO_END = OO_CVS + 131072;
__device__ __forceinline__ float silu_f(float x) { return x * __builtin_amdgcn_rcpf(1.0f + __builtin_amdgcn_exp2f(-x * LOG2E)); }
struct EpiIn {
    static constexpr bool PERM = true, AFTER_DRAIN = false;
    unsigned char* ws; float* out; int l;
    __device__ __forceinline__ void operator()(const f32x4 (&acc)[2][2][4][2], const Unit& u, int wr, int wc, int fr, int fq) const {
        const int pn = u.pn, pm = u.pm;
        bf16_t* Z = (bf16_t*)(ws + WSO_Z); const float* ssq = (const float*)(ws + (l == 0 ? WSO_SSQ0 : WSO_SSQ1)); const float* rope = (const float*)(ws + WSO_ROPE);
        float* o_ak_p = out + OO_AKP + (size_t)l * 262144; float* o_av_p = out + OO_AVP + (size_t)l * 262144; float* o_ak_s = out + OO_AKS + (size_t)l * 131072; float* o_av_s = out + OO_AVS + (size_t)l * 131072;
        float* o_ck_p = out + OO_CKP + (size_t)l * 4194304; float* o_cv_p = out + OO_CVP + (size_t)l * 4194304; float* o_ck_s = out + OO_CKS + (size_t)l * 65536; float* o_cv_s = out + OO_CVS + (size_t)l * 65536;
        const int rowl = wr * 64 + fr;
        const int colb = pn * BM + wc * 32 + 8 * fq;
        const bool rope_tile = (pn == 12 || pn == 13);
        const bool do_rope = rope_tile && fq == 0;
        const float sc = (pn < 2) ? SC_QA : (pn == 12 ? SC_QC : 1.f);
        const bool do_silu = (pn == 6 || pn == 7 || pn == 11 || pn == 15);
        float* ob = nullptr; int old = 0, ocol0 = 0;
        if (pn >= 2 && pn <= 5) { old = 512; ocol0 = (pn >= 4) ? 1024 : 512;
            if (pm == 64) ob = (pn >= 4) ? o_av_s : o_ak_s; else if (pm >= 62) ob = ((pn >= 4) ? o_av_p : o_ak_p) + (size_t)(pm - 62) * 256 * 512; }
        else if (pn == 13 || pn == 14) { old = 256; ocol0 = (pn == 13) ? 3328 : 3584;
            if (pm == 64) ob = (pn == 13) ? o_ck_s : o_cv_s; else ob = ((pn == 13) ? o_ck_p : o_cv_p) + (size_t)pm * 256 * 256; }
#pragma unroll
        for (int ai = 0; ai < 2; ++ai)
#pragma unroll
            for (int m = 0; m < 4; ++m) {
                const int rl = rowl + ai * HALF + m * 16, row = pm * BM + rl;
                const float rs = __builtin_amdgcn_rsqf(ssq[row] * (1.0f / 1024.0f) + 1e-6f);
                f32x4 rc = {1.f, 1.f, 1.f, 1.f}, rsn = {0.f, 0.f, 0.f, 0.f};
                if (do_rope) { rc = *(const f32x4*)(rope + (size_t)row * 8); rsn = *(const f32x4*)(rope + (size_t)row * 8 + 4); }
#pragma unroll
                for (int bj = 0; bj < 2; ++bj) {
                    f32x4 v0 = acc[ai][bj][m][0] * rs, v1 = acc[ai][bj][m][1] * rs;
                    const int col = colb + bj * HALF;
                    if (rope_tile) { const f32x4 a = v0 * rc - v1 * rsn, b = v1 * rc + v0 * rsn; v0 = a; v1 = b; }
                    if (ob) { float* op = ob + (size_t)rl * old + (col - ocol0); *(f32x4*)op = v0; *(f32x4*)(op + 4) = v1; }
                    if (do_silu) { v0 = (f32x4){silu_f(v0[0]), silu_f(v0[1]), silu_f(v0[2]), silu_f(v0[3])}; v1 = (f32x4){silu_f(v1[0]), silu_f(v1[1]), silu_f(v1[2]), silu_f(v1[3])}; }
                    v0 = v0 * sc; v1 = v1 * sc;
                    u32x4 w; w.x = cvt_pk_bf16(v0[0], v0[1]); w.y = cvt_pk_bf16(v0[2], v0[3]); w.z = cvt_pk_bf16(v1[0], v1[1]); w.w = cvt_pk_bf16(v1[2], v1[3]);
                    *(u32x4*)(Z + (size_t)row * ZLD + col) = w;
                }
                asm volatile("" ::: "memory");
            }
    }
};
struct EpiOut {
    static constexpr bool PERM = true, AFTER_DRAIN = false;
    unsigned char* ws; const float* x_p; const float* x_s; int l; const float* fg; float* yout;
    __device__ __forceinline__ void operator()(f32x4 (&acc)[2][2][4][2], const Unit& u, int wr, int wc, int fr, int fq) const {
        const int pm = u.pm; const int colb = u.pn * BM + wc * 32 + 8 * fq;
        float* X1 = (float*)(ws + WSO_X1) + (size_t)pm * BM * 1024; bf16_t* XB = (bf16_t*)(ws + WSO_XB) + (size_t)pm * BM * 1024; float* ssq = (float*)(ws + (l == 0 ? WSO_SSQ1 : WSO_SSQ2)) + pm * BM;
        const float* res = (l == 0) ? ((pm == 64) ? x_s : x_p + (size_t)pm * BM * 1024) : X1;
        const unsigned off0 = (unsigned)(wr * 64 + fr) * 1024u + (unsigned)colb;
        const bool fuse = (l == 1 && pm < 64);
#pragma unroll
        for (int ai = 0; ai < 2; ++ai)
#pragma unroll
            for (int m = 0; m < 4; ++m) {
                const unsigned offr = off0 + (unsigned)(ai * HALF + m * 16) * 1024u; float q = 0.f;
#pragma unroll
                for (int bj = 0; bj < 2; ++bj) { const unsigned off = offr + bj * HALF;
                    const f32x4 v0 = acc[ai][bj][m][0] + *(const f32x4*)(res + off), v1 = acc[ai][bj][m][1] + *(const f32x4*)(res + off + 4);
                    if (fuse) { acc[ai][bj][m][0] = v0; acc[ai][bj][m][1] = v1; }
                    else {
                        *(f32x4*)(X1 + off) = v0; *(f32x4*)(X1 + off + 4) = v1;
                        u32x4 w; w.x = cvt_pk_bf16(v0[0], v0[1]); w.y = cvt_pk_bf16(v0[2], v0[3]); w.z = cvt_pk_bf16(v1[0], v1[1]); w.w = cvt_pk_bf16(v1[2], v1[3]);
                        *(u32x4*)(XB + off) = w; }
                    q += (v0[0] * v0[0] + v0[1] * v0[1]) + (v0[2] * v0[2] + v0[3] * v0[3]) + (v1[0] * v1[0] + v1[1] * v1[1]) + (v1[2] * v1[2] + v1[3] * v1[3]);
                    asm volatile("" ::: "memory"); }
                q += __shfl_xor(q, 16); q += __shfl_xor(q, 32);
                if (fq == 0) atomicAdd(ssq + (wr * 64 + fr + ai * HALF + m * 16), q);
                asm volatile("" ::: "memory");
            }
        if (fuse) {
            unsigned* cnt = (unsigned*)(ws + WSO_PANEL) + 64 * pm;
            asm volatile("s_waitcnt vmcnt(0)" ::: "memory");
            if (__builtin_amdgcn_readfirstlane(fr + 16 * fq) == (fr + 16 * fq)) __hip_atomic_fetch_add(cnt, 1u, __ATOMIC_RELAXED, __HIP_MEMORY_SCOPE_AGENT);
            unsigned spins = 0;
            while (__hip_atomic_load(cnt, __ATOMIC_RELAXED, __HIP_MEMORY_SCOPE_AGENT) < 32u) { __builtin_amdgcn_s_sleep(2); if (++spins > (1u << 22)) break; }
            float* yo = yout + (size_t)pm * BM * 1024;
#pragma unroll
            for (int ai = 0; ai < 2; ++ai)
#pragma unroll
                for (int m = 0; m < 4; ++m) {
                    const int rl = wr * 64 + fr + ai * HALF + m * 16;
                    const float sq = __hip_atomic_load(ssq + rl, __ATOMIC_RELAXED, __HIP_MEMORY_SCOPE_AGENT);
                    const float rs = __builtin_amdgcn_rsqf(sq * (1.0f / 1024.0f) + 1e-6f);
                    const unsigned offr = off0 + (unsigned)(ai * HALF + m * 16) * 1024u;
#pragma unroll
                    for (int bj = 0; bj < 2; ++bj) {
                        const f32x4 g0 = *(const f32x4*)(fg + colb + bj * HALF), g1 = *(const f32x4*)(fg + colb + bj * HALF + 4);
                        *(f32x4*)(yo + offr + bj * HALF) = acc[ai][bj][m][0] * rs * g0; *(f32x4*)(yo + offr + bj * HALF + 4) = acc[ai][bj][m][1] * rs * g1;
                        asm volatile("" ::: "memory"); }
                }
        }
    }
};
template <class Epi, class Sched, bool ALIGN_EPI = false, bool SP2 = false>
__device__ __forceinline__ void gemm_phase(PG8_LAS unsigned char* lds, const Gemm g, const Sched& S, const Epi& E) {
    int tid_ = threadIdx.x; asm volatile("" : "+v"(tid_));
    const int tid = tid_, wid = __builtin_amdgcn_readfirstlane(tid >> 6), lane = tid & 63, wr = wid >> 2, wc = wid & 3, fr = lane & 15, fq = lane >> 4;
    const int K = g.K, nt = K / BK;
    unsigned voffA[2], voffB[2];
#pragma unroll
    for (int i = 0; i < 2; ++i) { int R, C; stage_rc(tid * 16 + i * 8192, R, C); const int Rb = Epi::PERM ? ((R & ~31) + perm32(R & 31)) : R;
        voffA[i] = (unsigned)(R * K + C) * 2u; voffB[i] = (unsigned)(Rb * K + C) * 2u; }
    const size_t kstep = (size_t)(BK * 2);
    const size_t hstep = (size_t)HALF * K * 2;
    const size_t tstep = 2 * hstep;
    const unsigned ldsw = (unsigned)wid * 1024u;
    const int aoff = lds_byte(wr * 64 + fr, fq * 8), boff = lds_byte(wc * 32 + fr, fq * 8);
#define PG8_SA(b, h) (((b) * 2 + (h)) * HTB)
#define PG8_SB(b, h) ((4 + (b) * 2 + (h)) * HTB)
#define PG8_STAGE(bufoff, gbase, voff) do { _Pragma("unroll") for (int _i = 0; _i < 2; ++_i) \
        __builtin_amdgcn_global_load_lds((const unsigned*)((const char*)(gbase) + (voff)[_i]), (PG8_LAS unsigned*)(lds + (bufoff) + ldsw + _i * 8192), 16, 0, 0); } while (0)
#define PG8_LDA(dst, b, h) do { _Pragma("unroll") for (int m = 0; m < 4; ++m) _Pragma("unroll") for (int k = 0; k < 2; ++k) dst[m][k] = *(const PG8_LAS bf16x8*)(lds + PG8_SA(b, h) + aoff + m * 2048 + k * 1024); } while (0)
#define PG8_LDB(dst, b, h) do { _Pragma("unroll") for (int n = 0; n < 2; ++n) _Pragma("unroll") for (int k = 0; k < 2; ++k) dst[n][k] = *(const PG8_LAS bf16x8*)(lds + PG8_SB(b, h) + boff + n * 2048 + k * 1024); } while (0)
#define PG8_MMA(ai, bj, At, Bt) do { __builtin_amdgcn_s_setprio(1); _Pragma("unroll") for (int m = 0; m < 4; ++m) _Pragma("unroll") for (int n = 0; n < 2; ++n) _Pragma("unroll") for (int k = 0; k < 2; ++k) \
        acc[ai][bj][m][n] = __builtin_amdgcn_mfma_f32_16x16x32_bf16(Bt[n][k], At[m][k], acc[ai][bj][m][n], 0, 0, 0); __builtin_amdgcn_s_setprio(0); } while (0)
#define PG8_WAIT_V(n) asm volatile("s_waitcnt vmcnt(" #n ")" ::: "memory")
#define PG8_WAIT_L(n) asm volatile("s_waitcnt lgkmcnt(" #n ")" ::: "memory")
#define PG8_BAR __builtin_amdgcn_s_barrier()
#define PG8_SCHED __builtin_amdgcn_sched_barrier(0)
    Unit cur, nxt; int ui = 0;
    if (!S.next(0, cur)) return;
    f32x4 acc[2][2][4][2];
#pragma unroll
    for (int a = 0; a < 2; ++a)
#pragma unroll
        for (int b = 0; b < 2; ++b)
#pragma unroll
            for (int m = 0; m < 4; ++m)
#pragma unroll
                for (int n = 0; n < 2; ++n) acc[a][b][m][n] = (f32x4){0.f, 0.f, 0.f, 0.f};
    bf16x8 At[4][2], B0[2][2], B1[2][2];
    const char* cA = (const char*)g.A + (size_t)cur.pm * tstep; const char* cB = (const char*)g.Bt + (size_t)cur.pn * tstep;
    S.a_ready(cur);
    if constexpr (SP2) {
        PG8_STAGE(PG8_SB(0, 0), cB, voffB); PG8_STAGE(PG8_SB(0, 1), cB + hstep, voffB); PG8_STAGE(PG8_SA(0, 0), cA, voffA); PG8_STAGE(PG8_SA(0, 1), cA + hstep, voffA);
        if (wr == 1) PG8_BAR;
        PG8_WAIT_V(2); PG8_BAR;
        PG8_STAGE(PG8_SB(1, 0), cB + kstep, voffB); PG8_STAGE(PG8_SA(1, 0), cA + kstep, voffA); PG8_STAGE(PG8_SB(1, 1), cB + hstep + kstep, voffB);
        PG8_WAIT_V(6); PG8_BAR;
    } else {
        PG8_STAGE(PG8_SB(0, 0), cB, voffB); PG8_STAGE(PG8_SA(0, 0), cA, voffA); PG8_STAGE(PG8_SB(0, 1), cB + hstep, voffB); PG8_STAGE(PG8_SA(0, 1), cA + hstep, voffA);
        if (wr == 1) PG8_BAR;
        PG8_WAIT_V(4); PG8_BAR;
        PG8_STAGE(PG8_SB(1, 0), cB + kstep, voffB); PG8_STAGE(PG8_SA(1, 0), cA + kstep, voffA); PG8_STAGE(PG8_SB(1, 1), cB + hstep + kstep, voffB);
        PG8_WAIT_V(6); PG8_BAR;
    }
    for (;;) {
        const bool has_next = S.next(ui + 1, nxt);
        const char* nA = has_next ? (const char*)g.A + (size_t)nxt.pm * tstep : cA; const char* nB = has_next ? (const char*)g.Bt + (size_t)nxt.pn * tstep : cB;
        for (int t = 0; t < nt; t += 2) {
            const bool last = (t == nt - 2);
            const char* a1 = cA + (size_t)(t + 1) * kstep;
            const char* a2 = last ? nA : cA + (size_t)(t + 2) * kstep; const char* b2 = last ? nB : cB + (size_t)(t + 2) * kstep;
            const char* a3 = a2 + kstep; const char* b3 = b2 + kstep;
            if (last && has_next) S.a_ready(nxt);
            if constexpr (SP2) {
            PG8_LDB(B0, 0, 0); PG8_LDB(B1, 0, 1); PG8_SCHED; PG8_LDA(At, 0, 0); PG8_STAGE(PG8_SA(1, 1), a1 + hstep, voffA);
            PG8_WAIT_V(8); PG8_WAIT_L(0); PG8_BAR; PG8_MMA(0, 0, At, B0); PG8_MMA(0, 1, At, B1); PG8_BAR; PG8_SCHED;
            PG8_LDA(At, 0, 1); PG8_STAGE(PG8_SB(0, 0), b2, voffB); PG8_STAGE(PG8_SB(0, 1), b2 + hstep, voffB); PG8_STAGE(PG8_SA(0, 0), a2, voffA);
            PG8_WAIT_V(8); PG8_WAIT_L(0); PG8_BAR; PG8_MMA(1, 0, At, B0); PG8_MMA(1, 1, At, B1); PG8_BAR; PG8_SCHED;
            PG8_LDB(B0, 1, 0); PG8_LDB(B1, 1, 1); PG8_SCHED; PG8_LDA(At, 1, 0); PG8_STAGE(PG8_SA(0, 1), a2 + hstep, voffA);
            PG8_WAIT_V(8); PG8_WAIT_L(0); PG8_BAR; PG8_MMA(0, 0, At, B0); PG8_MMA(0, 1, At, B1); PG8_BAR; PG8_SCHED;
            PG8_LDA(At, 1, 1); PG8_STAGE(PG8_SB(1, 0), b3, voffB); PG8_STAGE(PG8_SB(1, 1), b3 + hstep, voffB); PG8_STAGE(PG8_SA(1, 0), a3, voffA);
            PG8_WAIT_V(8); PG8_WAIT_L(0); PG8_BAR; PG8_MMA(1, 0, At, B0); PG8_MMA(1, 1, At, B1); PG8_BAR; PG8_SCHED;
            } else {
            PG8_LDB(B0, 0, 0); PG8_SCHED; PG8_LDA(At, 0, 0); PG8_STAGE(PG8_SA(1, 1), a1 + hstep, voffA);
            PG8_WAIT_L(8); PG8_BAR; PG8_WAIT_L(0); PG8_MMA(0, 0, At, B0); PG8_BAR; PG8_SCHED;
            PG8_LDB(B1, 0, 1); PG8_STAGE(PG8_SB(0, 0), b2, voffB);
            PG8_BAR; PG8_WAIT_L(0); PG8_MMA(0, 1, At, B1); PG8_BAR;
            PG8_LDA(At, 0, 1); PG8_STAGE(PG8_SA(0, 0), a2, voffA);
            PG8_BAR; PG8_WAIT_L(0); PG8_MMA(1, 0, At, B0); PG8_BAR; PG8_SCHED;
            PG8_STAGE(PG8_SB(0, 1), b2 + hstep, voffB);
            PG8_WAIT_V(6); PG8_BAR; PG8_MMA(1, 1, At, B1); PG8_BAR;
            PG8_LDB(B0, 1, 0); PG8_SCHED; PG8_LDA(At, 1, 0); PG8_STAGE(PG8_SA(0, 1), a2 + hstep, voffA);
            PG8_WAIT_L(8); PG8_BAR; PG8_WAIT_L(0); PG8_MMA(0, 0, At, B0); PG8_BAR; PG8_SCHED;
            PG8_LDB(B1, 1, 1); PG8_STAGE(PG8_SB(1, 0), b3, voffB);
            PG8_BAR; PG8_WAIT_L(0); PG8_MMA(0, 1, At, B1); PG8_BAR;
            PG8_LDA(At, 1, 1); PG8_STAGE(PG8_SA(1, 0), a3, voffA);
            PG8_BAR; PG8_WAIT_L(0); PG8_MMA(1, 0, At, B0); PG8_BAR; PG8_SCHED;
            PG8_STAGE(PG8_SB(1, 1), b3 + hstep, voffB);
            PG8_WAIT_V(6); PG8_BAR; PG8_MMA(1, 1, At, B1); PG8_BAR;
            }
        }
        if constexpr (ALIGN_EPI) { if (wr == 0) PG8_BAR; }
        if constexpr (!Epi::AFTER_DRAIN) { E(acc, cur, wr, wc, fr, fq); S.done(cur); }
        if (!has_next) break;
#pragma unroll
        for (int a = 0; a < 2; ++a)
#pragma unroll
            for (int b = 0; b < 2; ++b)
#pragma unroll
                for (int m = 0; m < 4; ++m)
#pragma unroll
                    for (int n = 0; n < 2; ++n) acc[a][b][m][n] = (f32x4){0.f, 0.f, 0.f, 0.f};
        cur = nxt; cA = nA; cB = nB; ++ui;
        if constexpr (ALIGN_EPI) { if (wr == 1) PG8_BAR; }
    }
    PG8_WAIT_V(0);
    if constexpr (!ALIGN_EPI) { if (wr == 0) PG8_BAR; }
    PG8_BAR;
    if constexpr (Epi::AFTER_DRAIN) { E.fused(acc, cur, wr, wc, fr, fq, lds, wid, lane); S.done(cur); }
#undef PG8_SA
#undef PG8_SB
#undef PG8_STAGE
#undef PG8_LDA
#undef PG8_LDB
#undef PG8_MMA
#undef PG8_WAIT_V
#undef PG8_WAIT_L
#undef PG8_BAR
#undef PG8_SCHED
}
}
#define LAS __attribute__((address_space(3)))
typedef unsigned short bf16_t;
typedef LAS unsigned char* ldsp;
typedef short bf16x8 __attribute__((ext_vector_type(8)));
typedef short s16x4 __attribute__((ext_vector_type(4)));
typedef float f32x16 __attribute__((ext_vector_type(16)));
typedef float f32x4 __attribute__((ext_vector_type(4)));
typedef float f32x2 __attribute__((ext_vector_type(2)));
typedef unsigned u32x4 __attribute__((ext_vector_type(4)));
typedef unsigned u32x2 __attribute__((ext_vector_type(2)));
typedef __bf16 bf16x2_t __attribute__((ext_vector_type(2)));
using pg8::ZLD; using pg8::MROWS; using pg8::NPROMPT; using pg8::LOG2E;
__device__ __forceinline__ int crow(int r, int hi) { return (r & 3) + 8 * (r >> 2) + 4 * hi; }
__device__ __forceinline__ unsigned cvtpk(float lo, float hi) { f32x2 v = {lo, hi}; bf16x2_t b = __builtin_convertvector(v, bf16x2_t); return __builtin_bit_cast(unsigned, b); }
__device__ __forceinline__ float bf_lo(unsigned w) { return __uint_as_float(w << 16); }
__device__ __forceinline__ float bf_hi(unsigned w) { return __uint_as_float(w & 0xffff0000u); }
__device__ __forceinline__ float xhalf_max(float m) { auto rr = __builtin_amdgcn_permlane32_swap(__float_as_uint(m), __float_as_uint(m), false, false); return fmaxf(__uint_as_float(rr[0]), __uint_as_float(rr[1])); }
__device__ __forceinline__ float xhalf_sum(float m) { auto rr = __builtin_amdgcn_permlane32_swap(__float_as_uint(m), __float_as_uint(m), false, false); return __uint_as_float(rr[0]) + __uint_as_float(rr[1]); }
__device__ __forceinline__ s16x4 vtr(ldsp p) { typedef short v4i16_t __attribute__((ext_vector_type(4))); return __builtin_bit_cast(s16x4, __builtin_amdgcn_ds_read_tr16_b64_v4i16((LAS v4i16_t*)p)); }
__device__ __forceinline__ float max3f(float a, float b, float c) { float r; asm("v_max3_f32 %0, %1, %2, %3" : "=v"(r) : "v"(a), "v"(b), "v"(c)); return r; }
__device__ __forceinline__ float max2f(float a, float b) { float r; asm("v_max_f32_e32 %0, %1, %2" : "=v"(r) : "v"(a), "v"(b)); return r; }
__device__ __forceinline__ float sum8_s(float acc, float a, float b, float c, float d, float e, float f, float g, float h) {
    asm("s_nop 0\n\tv_add_f32_e32 %0, %0, %1\n\tv_add_f32_e32 %0, %0, %2\n\tv_add_f32_e32 %0, %0, %3\n\tv_add_f32_e32 %0, %0, %4\n\tv_add_f32_e32 %0, %0, %5\n\tv_add_f32_e32 %0, %0, %6\n\tv_add_f32_e32 %0, %0, %7\n\tv_add_f32_e32 %0, %0, %8"
        : "+v"(acc) : "v"(a), "v"(b), "v"(c), "v"(d), "v"(e), "v"(f), "v"(g), "v"(h));
    return acc; }
__device__ __forceinline__ float sum4_s(float acc, float a, float b, float c, float d) {
    asm("s_nop 0\n\tv_add_f32_e32 %0, %0, %1\n\tv_add_f32_e32 %0, %0, %2\n\tv_add_f32_e32 %0, %0, %3\n\tv_add_f32_e32 %0, %0, %4" : "+v"(acc) : "v"(a), "v"(b), "v"(c), "v"(d));
    return acc; }
__device__ __forceinline__ float fadd_s(float a, float b) { float r; asm("v_add_f32_e32 %0, %1, %2" : "=v"(r) : "v"(a), "v"(b)); return r; }
#define MFMA32(a, b, c) __builtin_amdgcn_mfma_f32_32x32x16_bf16((a), (b), (c), 0, 0, 0)

constexpr int KPITCH = 144, KT_BYTES = 64 * KPITCH, VT_BYTES = 8192, TILE_BYTES = KT_BYTES + VT_BYTES, BUF_BYTES = 2 * TILE_BYTES;
constexpr int COMB_OFF = 2 * BUF_BYTES, COMB_WAVE = 17408, TAB_OFF = COMB_OFF + 4 * COMB_WAVE, TAB_N = 640, TAB_DDMAX = 576, MISC_OFF = TAB_OFF + TAB_N * 4 + 16, LDS_BYTES = 147456;
static_assert(MISC_OFF + 64 <= LDS_BYTES, "LDS map");
constexpr float NEG_BIG = -1.0e30f, THR = 8.0f;
#ifndef REDO_LIMIT
#define REDO_LIMIT 256.0f
#endif
struct AU {
    const bf16_t* q; int nq; int nt, ntc; const float* kc; const float* vc; int cp; const bf16_t* kz; const bf16_t* vz; int lastv; int nqg;
    int tlo0, thi0, tlo1, thi1; int qpos0, kpos0; const bf16_t* gate; bf16_t* y; const float* tabsrc;
};
#ifndef ATTN_INL
#define ATTN_INL __forceinline__
#endif
template <int MODE  >
__device__ ATTN_INL void attn_unit(const AU& d, ldsp lds, float lam, int lsel, const float* subg) {
    constexpr bool WIDE = (MODE == 2), BIAS = (MODE != 0);
    constexpr int NMAP = (MODE == 1) ? 1 : 2, NSTEP = (MODE == 0) ? 2 : 4, NSUB = WIDE ? 2 : 1;
#define KC(MP) ((MODE == 0) ? (MP) * 32 : 0)
    int tid_ = threadIdx.x; asm volatile("" : "+v"(tid_));
    const int tid = tid_, lane = tid & 63, wid = __builtin_amdgcn_readfirstlane(tid >> 6), qg = WIDE ? wid : (wid & 3), ks = WIDE ? 0 : (wid >> 2), r32 = lane & 31, hi = lane >> 5;
    int tlo = (qg >> 1) ? d.tlo1 : d.tlo0; int thi = (qg >> 1) ? d.thi1 : d.thi0; if (qg >= d.nqg) thi = -1;
    if (WIDE) { thi = d.tlo0 + wid; tlo = max(thi - 8, 0); }
    const int qoff0 = WIDE ? 64 * wid : 32 * qg;
    const LAS float* tab = (const LAS float*)(lds + TAB_OFF);
    float tabv0 = 0.f, tabv1 = 0.f;
    if (BIAS) { tabv0 = d.tabsrc[min(max(TAB_DDMAX - tid, -128), 128) + 128]; if (tid + 512 < TAB_N) tabv1 = d.tabsrc[min(max(TAB_DDMAX - (tid + 512), -128), 128) + 128]; }
    bf16x8 qf[NMAP][NSTEP];
    const ldsp Qw = lds + COMB_OFF + wid * 8192;
    if (WIDE) {
        u32x4 qv_[8];
#pragma unroll
        for (int j = 0; j < 8; ++j) qv_[j] = *(const u32x4*)(d.q + (size_t)(qoff0 + lane) * ZLD + j * 8);
#pragma unroll
        for (int j = 0; j < 8; ++j) *(LAS u32x4*)(Qw + lane * 128 + ((j ^ (lane & 7)) * 16)) = qv_[j];
    }
#define QFRAG(MP, ST) (WIDE ? *(const LAS bf16x8*)(Qw + (32 * (MP) + r32) * 128 + ((((ST) * 2 + hi) ^ (r32 & 7)) * 16)) : qf[MP][ST])
#pragma unroll
    for (int mp = 0; mp < (WIDE ? 0 : NMAP); ++mp) { int qrow = qoff0 + r32; if (qrow >= d.nq) qrow = d.nq - 1;
      const bf16_t* qp = d.q + (size_t)qrow * ZLD;
#pragma unroll
      for (int st = 0; st < NSTEP; ++st) qf[mp][st] = *(const bf16x8*)(qp + KC(mp) + st * 16 + hi * 8); }
    f32x16 O[NMAP][2]; float mref[NMAP], lsum[NMAP];
#pragma unroll
    for (int mp = 0; mp < NMAP; ++mp) { mref[mp] = 0.f; lsum[mp] = 0.f;
#pragma unroll
        for (int db = 0; db < 2; ++db)
#pragma unroll
            for (int i = 0; i < 16; ++i) O[mp][db][i] = 0.f; }
    const int lrow = tid >> 3, lch = tid & 7;
    const int kwoff = lrow * KPITCH + lch * 16, vwoff = (lch >> 2) * 4096 + lrow * 64 + (lch & 3) * 16;
    const int kroff = r32 * KPITCH + hi * 16;
    const int vroff = (4 * hi + ((lane & 15) >> 2)) * 64 + ((lane >> 4) & 1) * 32 + (lane & 3) * 8;
    u32x4 stK[2], stV[2];
    const int nit = (d.nt + 1) >> 1; bool started = false;
#define AT_ISSUE(IT) do { if (!WIDE) _Pragma("unroll") for (int i_ = 0; i_ < 2; ++i_) { const int t_ = 2 * (IT) + i_; if (t_ < d.nt && t_ >= d.ntc) { int r_ = lrow; if (t_ == d.nt - 1 && r_ >= d.lastv) r_ = d.lastv - 1; \
        const size_t off_ = ((size_t)(t_ - d.ntc) * 64 + r_) * ZLD + lch * 8; stK[i_] = *(const u32x4*)(d.kz + off_); stV[i_] = *(const u32x4*)(d.vz + off_); } } } while (0)
#define AT_WRITE(IT, BUF) do { _Pragma("unroll") for (int i_ = 0; i_ < 2; ++i_) { const int t_ = 2 * (IT) + i_; if (t_ < d.nt) { u32x4 kk_, vv_; if (WIDE) { const size_t off_ = ((size_t)t_ * 64 + lrow) * ZLD + lch * 8; kk_ = *(const u32x4*)(d.kz + off_); vv_ = *(const u32x4*)(d.vz + off_); } else if (t_ >= d.ntc) { kk_ = stK[i_]; vv_ = stV[i_]; } else { \
        const size_t off_ = ((size_t)t_ * 64 + lrow) * d.cp + lch * 8; const f32x4 a_ = *(const f32x4*)(d.kc + off_), b_ = *(const f32x4*)(d.kc + off_ + 4), c_ = *(const f32x4*)(d.vc + off_), e_ = *(const f32x4*)(d.vc + off_ + 4); \
        kk_ = (u32x4){cvtpk(a_[0], a_[1]), cvtpk(a_[2], a_[3]), cvtpk(b_[0], b_[1]), cvtpk(b_[2], b_[3])}; vv_ = (u32x4){cvtpk(c_[0], c_[1]), cvtpk(c_[2], c_[3]), cvtpk(e_[0], e_[1]), cvtpk(e_[2], e_[3])}; } \
        *(LAS u32x4*)((BUF) + i_ * TILE_BYTES + kwoff) = kk_; *(LAS u32x4*)((BUF) + i_ * TILE_BYTES + KT_BYTES + vwoff) = vv_; } } } while (0)
    unsigned pf_dummy = 0;
    const int pf_tile = tid >> 8, pf_v = (tid >> 7) & 1, pf_row = (tid >> 1) & 63, pf_line = tid & 1;
#define AT_TOUCH(IT) do { const int t_ = 2 * (IT) + pf_tile; if (t_ < d.ntc) { const float* p_ = (pf_v ? d.vc : d.kc) + ((size_t)t_ * 64 + pf_row) * d.cp + pf_line * 32; \
        asm volatile("global_load_dword %0, %1, off" : "=v"(pf_dummy) : "v"(p_) : "memory"); } } while (0)
    if (d.ntc > 0) { AT_TOUCH(1); AT_TOUCH(2); }
    AT_ISSUE(0);
    if (BIAS) { ((LAS float*)(lds + TAB_OFF))[tid] = tabv0 * LOG2E; if (tid + 512 < TAB_N) ((LAS float*)(lds + TAB_OFF))[tid + 512] = tabv1 * LOG2E; }
    for (int it = 0; it < nit; ++it) {
        const ldsp buf = lds + (it & 1) * BUF_BYTES;
        AT_WRITE(it, buf);
        __builtin_amdgcn_s_waitcnt(0); asm volatile("" : "+v"(pf_dummy));
        __syncthreads();
#pragma nounroll
        for (int sub = 0; sub < NSUB; ++sub) {
        const int t = 2 * it + (WIDE ? sub : ks);
        const bool vis = (t >= tlo && t <= thi);
        const ldsp Kt = buf + (WIDE ? sub : ks) * TILE_BYTES, Vt = Kt + KT_BYTES;
        bf16x8 kf0[2 * NSTEP];
        if (vis) {
#pragma unroll
            for (int st = 0; st < (WIDE ? 2 : NSTEP); ++st) { kf0[2 * st] = *(const LAS bf16x8*)(Kt + kroff + (st * 16) * 2); kf0[2 * st + 1] = *(const LAS bf16x8*)(Kt + kroff + 32 * KPITCH + (st * 16) * 2); }
        }
        __builtin_amdgcn_sched_barrier(0);
        if (sub == 0 && it + 1 < nit) AT_ISSUE(it + 1);
        if (sub == 0 && d.ntc > 0) AT_TOUCH(it + 3);
        __builtin_amdgcn_sched_barrier(0);
        if (vis) {
            const int valid = (t == d.nt - 1) ? d.lastv : 64;
            f32x16 S0[NMAP], S1[NMAP];
#define AT_BIAS(MP) do { const int qb_ = d.qpos0 + qoff0 + (WIDE ? 32 * (MP) : 0), kp0_ = d.kpos0 + 64 * t; \
                if (qb_ - (kp0_ + 63) >= 128) { const float c_ = tab[TAB_DDMAX - 128]; _Pragma("unroll") for (int i = 0; i < 16; ++i) { S0[MP][i] += c_; S1[MP][i] += c_; } } \
                else { int j0_ = TAB_DDMAX - (qb_ + r32 - kp0_ - 4 * hi); asm volatile("" : "+v"(j0_)); const LAS float* tb_ = tab + j0_; \
                    _Pragma("unroll") for (int i = 0; i < 16; ++i) { S0[MP][i] += tb_[(i & 3) + 8 * (i >> 2)]; S1[MP][i] += tb_[(i & 3) + 8 * (i >> 2) + 32]; } } } while (0)
#define AT_QK(MP) do { f32x16 negm_; _Pragma("unroll") for (int i = 0; i < 16; ++i) negm_[i] = -mref[MP]; \
                _Pragma("unroll") for (int st = 0; st < NSTEP; ++st) { \
                    const bf16x8 a0_ = *(const LAS bf16x8*)(Kt + kroff + (KC(MP) + st * 16) * 2); \
                    const bf16x8 a1_ = *(const LAS bf16x8*)(Kt + kroff + 32 * KPITCH + (KC(MP) + st * 16) * 2); \
                    if (st == 0) { S0[MP] = MFMA32(a0_, QFRAG(MP, st), negm_); S1[MP] = MFMA32(a1_, QFRAG(MP, st), negm_); } \
                    else { S0[MP] = MFMA32(a0_, QFRAG(MP, st), S0[MP]); S1[MP] = MFMA32(a1_, QFRAG(MP, st), S1[MP]); } } \
                if (BIAS) AT_BIAS(MP); \
                if (0) { const int qpos = d.qpos0 + 32 * qg + r32, kp0 = d.kpos0 + 64 * t; \
                    if (d.qpos0 + 32 * qg - (kp0 + 63) >= 128) { const float c = tab[256]; _Pragma("unroll") for (int i = 0; i < 16; ++i) { S0[MP][i] += c; S1[MP][i] += c; } } \
                    else { _Pragma("unroll") for (int i = 0; i < 16; ++i) { int dd = qpos - (kp0 + crow(i, hi)); int d0 = min(max(dd, -128), 128), d1 = min(max(dd - 32, -128), 128); S0[MP][i] += tab[d0 + 128]; S1[MP][i] += tab[d1 + 128]; } } } \
                if (valid < 64) { _Pragma("unroll") for (int i = 0; i < 16; ++i) { const int k = crow(i, hi); if (k >= valid) S0[MP][i] = NEG_BIG; if (k + 32 >= valid) S1[MP][i] = NEG_BIG; } } } while (0)
#define AT_SLOW(MP) do { asm volatile("s_nop 15\n\ts_nop 7" : "+v"(S0[MP]), "+v"(S1[MP])); \
                float ra_ = max3f(S0[MP][0], S0[MP][1], S1[MP][0]), rb_ = max3f(S0[MP][2], S0[MP][3], S1[MP][1]); ra_ = max3f(ra_, S1[MP][2], S1[MP][3]); \
                _Pragma("unroll") for (int i = 4; i < 16; i += 4) { ra_ = max3f(ra_, S0[MP][i], S0[MP][i + 1]); rb_ = max3f(rb_, S0[MP][i + 2], S0[MP][i + 3]); ra_ = max3f(ra_, S1[MP][i], S1[MP][i + 1]); rb_ = max3f(rb_, S1[MP][i + 2], S1[MP][i + 3]); } \
                const float rm_ = xhalf_max(max2f(ra_, rb_)); \
                const float dl_ = started ? fmaxf(rm_, 0.f) : rm_, al_ = started ? __builtin_amdgcn_exp2f(-dl_) : 1.f; \
                mref[MP] += dl_; lsum[MP] *= al_; \
                _Pragma("unroll") for (int i = 0; i < 16; ++i) { S0[MP][i] -= dl_; S1[MP][i] -= dl_; } \
                _Pragma("unroll") for (int db = 0; db < 2; ++db) _Pragma("unroll") for (int i = 0; i < 16; ++i) O[MP][db][i] *= al_; } while (0)
#define AT_EXPSUM(MP) do { sa = 0.f; sb = 0.f; \
                _Pragma("unroll") for (int i = 0; i < 16; ++i) { S0[MP][i] = __builtin_amdgcn_exp2f(S0[MP][i]); S1[MP][i] = __builtin_amdgcn_exp2f(S1[MP][i]); } \
                _Pragma("unroll") for (int i = 0; i < 16; i += 8) { sa = sum8_s(sa, S0[MP][i], S0[MP][i + 1], S0[MP][i + 2], S0[MP][i + 3], S0[MP][i + 4], S0[MP][i + 5], S0[MP][i + 6], S0[MP][i + 7]); \
                    sb = sum8_s(sb, S1[MP][i], S1[MP][i + 1], S1[MP][i + 2], S1[MP][i + 3], S1[MP][i + 4], S1[MP][i + 5], S1[MP][i + 6], S1[MP][i + 7]); } } while (0)
#define AT_CVT(MP) do { _Pragma("unroll") for (int s_ = 0; s_ < 2; ++s_) { \
                u32x4 w0_ = {cvtpk(S0[MP][8 * s_], S0[MP][8 * s_ + 1]), cvtpk(S0[MP][8 * s_ + 2], S0[MP][8 * s_ + 3]), cvtpk(S0[MP][8 * s_ + 4], S0[MP][8 * s_ + 5]), cvtpk(S0[MP][8 * s_ + 6], S0[MP][8 * s_ + 7])}; \
                u32x4 w1_ = {cvtpk(S1[MP][8 * s_], S1[MP][8 * s_ + 1]), cvtpk(S1[MP][8 * s_ + 2], S1[MP][8 * s_ + 3]), cvtpk(S1[MP][8 * s_ + 4], S1[MP][8 * s_ + 5]), cvtpk(S1[MP][8 * s_ + 6], S1[MP][8 * s_ + 7])}; \
                Pf[s_] = __builtin_bit_cast(bf16x8, w0_); Pf[2 + s_] = __builtin_bit_cast(bf16x8, w1_); } } while (0)
#define AT_VF(J) ({ const s16x4 lo_ = vfr[2 * (J)], hh_ = vfr[2 * (J) + 1]; (bf16x8){lo_[0], lo_[1], lo_[2], lo_[3], hh_[0], hh_[1], hh_[2], hh_[3]}; })
#define AT_VLOAD() do { _Pragma("unroll") for (int j_ = 0; j_ < 8; ++j_) { vfr[2 * j_] = vtr(Vt + vroff + (j_ & 1) * 4096 + (j_ >> 1) * 1024); vfr[2 * j_ + 1] = vtr(Vt + vroff + (j_ & 1) * 4096 + (j_ >> 1) * 1024 + 512); } } while (0)
#define SBAR() __builtin_amdgcn_sched_barrier(0)
            float sa, sb; bf16x8 Pf[4]; s16x4 vfr[16];
            { f32x16 negm_;
#pragma unroll
              for (int i = 0; i < 16; ++i) negm_[i] = -mref[0];
#pragma unroll
              for (int st = 0; st < NSTEP; ++st) {
                  const bf16x8 q_ = QFRAG(0, st);
                  const bf16x8 ka_ = (WIDE && st >= 2) ? *(const LAS bf16x8*)(Kt + kroff + (st * 16) * 2) : kf0[2 * st], kb_ = (WIDE && st >= 2) ? *(const LAS bf16x8*)(Kt + kroff + 32 * KPITCH + (st * 16) * 2) : kf0[2 * st + 1];
                  if (st == 0) { S0[0] = MFMA32(ka_, q_, negm_); S1[0] = MFMA32(kb_, q_, negm_); }
                  else { S0[0] = MFMA32(ka_, q_, S0[0]); S1[0] = MFMA32(kb_, q_, S1[0]); } }
              if (BIAS) AT_BIAS(0);
              if (0) { const int qpos = d.qpos0 + 32 * qg + r32, kp0 = d.kpos0 + 64 * t;
                  if (d.qpos0 + 32 * qg - (kp0 + 63) >= 128) { const float c = tab[256];
#pragma unroll
                      for (int i = 0; i < 16; ++i) { S0[0][i] += c; S1[0][i] += c; } }
                  else {
#pragma unroll
                      for (int i = 0; i < 16; ++i) { int dd = qpos - (kp0 + crow(i, hi)); int d0 = min(max(dd, -128), 128), d1 = min(max(dd - 32, -128), 128); S0[0][i] += tab[d0 + 128]; S1[0][i] += tab[d1 + 128]; } } }
              if (valid < 64) {
#pragma unroll
                  for (int i = 0; i < 16; ++i) { const int k = crow(i, hi); if (k >= valid) S0[0][i] = NEG_BIG; if (k + 32 >= valid) S1[0][i] = NEG_BIG; } } }
            if (!started) AT_SLOW(0);
            if (NMAP == 2) {
                constexpr int M1 = NMAP - 1;
                bf16x8 kf1[4]; f32x16 negm1; bf16x8 wka = kf1[0], wkb = kf1[0];
                bf16x8 wq = wka;
                if (WIDE) { wka = *(const LAS bf16x8*)(Kt + kroff); wkb = *(const LAS bf16x8*)(Kt + kroff + 32 * KPITCH); wq = QFRAG(M1, 0); }
                if (!WIDE) {
#pragma unroll
                for (int st = 0; st < 2; ++st) { kf1[2 * st] = *(const LAS bf16x8*)(Kt + kroff + (32 + st * 16) * 2); kf1[2 * st + 1] = *(const LAS bf16x8*)(Kt + kroff + 32 * KPITCH + (32 + st * 16) * 2); } }
#pragma unroll
                for (int i = 0; i < 16; ++i) negm1[i] = -mref[M1];
                sa = 0.f; sb = 0.f;
                SBAR();
#pragma unroll
                for (int g = 0; g < 4; ++g) {
                    if (WIDE) {
                        bf16x8 na_ = wka, nb_ = wkb;
                        if (g < 3) { na_ = *(const LAS bf16x8*)(Kt + kroff + ((g + 1) * 16) * 2); nb_ = *(const LAS bf16x8*)(Kt + kroff + 32 * KPITCH + ((g + 1) * 16) * 2); }
                        bf16x8 nq_ = wq;
                        if (g < 3) nq_ = QFRAG(M1, (g + 1) % NSTEP);
                        if (g == 0) { S0[M1] = MFMA32(wka, wq, negm1); S1[M1] = MFMA32(wkb, wq, negm1); }
                        else { S0[M1] = MFMA32(wka, wq, S0[M1]); S1[M1] = MFMA32(wkb, wq, S1[M1]); }
                        wka = na_; wkb = nb_; wq = nq_;
                    } else {
                    if (g == 0) S0[M1] = MFMA32(kf1[0], qf[M1][0], negm1); else if (g == 1) S1[M1] = MFMA32(kf1[1], qf[M1][0], negm1);
                    else if (g == 2) S0[M1] = MFMA32(kf1[2], qf[M1][1], S0[M1]); else S1[M1] = MFMA32(kf1[3], qf[M1][1], S1[M1]); }
                    SBAR();
#pragma unroll
                    for (int i = 4 * g; i < 4 * g + 4; ++i) { S0[0][i] = __builtin_amdgcn_exp2f(S0[0][i]); S1[0][i] = __builtin_amdgcn_exp2f(S1[0][i]); }
                    if (g & 1) sb = sum8_s(sb, S0[0][4 * g], S0[0][4 * g + 1], S0[0][4 * g + 2], S0[0][4 * g + 3], S1[0][4 * g], S1[0][4 * g + 1], S1[0][4 * g + 2], S1[0][4 * g + 3]);
                    else sa = sum8_s(sa, S0[0][4 * g], S0[0][4 * g + 1], S0[0][4 * g + 2], S0[0][4 * g + 3], S1[0][4 * g], S1[0][4 * g + 1], S1[0][4 * g + 2], S1[0][4 * g + 3]);
                    SBAR();
                }
                if (WIDE) AT_BIAS(M1);
                if (valid < 64) {
#pragma unroll
                    for (int i = 0; i < 16; ++i) { const int k = crow(i, hi); if (k >= valid) S0[M1][i] = NEG_BIG; if (k + 32 >= valid) S1[M1][i] = NEG_BIG; } }
            } else AT_EXPSUM(0);
            if (started && __any(!(sa + sb <= REDO_LIMIT))) { AT_QK(0); AT_SLOW(0); AT_EXPSUM(0); }
            lsum[0] += sa + sb;
            AT_VLOAD();
            AT_CVT(0);
            if (NMAP == 2) {
                constexpr int M1 = NMAP - 1;
                if (!started) AT_SLOW(M1);
                sa = 0.f; sb = 0.f;
                SBAR();
#pragma unroll
                for (int j = 0; j < 8; ++j) {
                    O[0][j & 1] = MFMA32(AT_VF(j), Pf[j >> 1], O[0][j & 1]);
                    SBAR();
                    S0[M1][2 * j] = __builtin_amdgcn_exp2f(S0[M1][2 * j]); S0[M1][2 * j + 1] = __builtin_amdgcn_exp2f(S0[M1][2 * j + 1]);
                    S1[M1][2 * j] = __builtin_amdgcn_exp2f(S1[M1][2 * j]); S1[M1][2 * j + 1] = __builtin_amdgcn_exp2f(S1[M1][2 * j + 1]);
                    if (j & 1) sb = sum4_s(sb, S0[M1][2 * j], S0[M1][2 * j + 1], S1[M1][2 * j], S1[M1][2 * j + 1]); else sa = sum4_s(sa, S0[M1][2 * j], S0[M1][2 * j + 1], S1[M1][2 * j], S1[M1][2 * j + 1]);
                    SBAR();
                }
                if (started && __any(!(sa + sb <= REDO_LIMIT))) { AT_QK(M1); AT_SLOW(M1); AT_EXPSUM(M1); }
                lsum[M1] += sa + sb;
#pragma unroll
                for (int k = 0; k < 4; ++k) {
                    const f32x16& sx = (k < 2) ? S0[M1] : S1[M1]; const int b = 8 * (k & 1);
                    const u32x4 w_ = {cvtpk(sx[b], sx[b + 1]), cvtpk(sx[b + 2], sx[b + 3]), cvtpk(sx[b + 4], sx[b + 5]), cvtpk(sx[b + 6], sx[b + 7])};
                    Pf[k] = __builtin_bit_cast(bf16x8, w_);
                    SBAR();
                    O[M1][0] = MFMA32(AT_VF(2 * k), Pf[k], O[M1][0]); O[M1][1] = MFMA32(AT_VF(2 * k + 1), Pf[k], O[M1][1]);
                    SBAR();
                }
            } else {
#pragma unroll
                for (int j = 0; j < 8; ++j) O[0][j & 1] = MFMA32(AT_VF(j), Pf[j >> 1], O[0][j & 1]);
            }
#undef AT_SLOW
#undef AT_EXPSUM
#undef AT_CVT
#undef AT_VF
#undef AT_VLOAD
#undef SBAR
#undef AT_BIAS
            started = true;
#undef AT_QK
        }
        }
    }
#undef AT_ISSUE
#undef AT_TOUCH
#undef AT_WRITE
    __syncthreads();
    if (!started) {
#pragma unroll
        for (int mp = 0; mp < NMAP; ++mp) mref[mp] = NEG_BIG;
    }
    u32x2 gpre[8];
    if (MODE == 1 && ks == 0 && qg < d.nqg) { const int row_ = min(32 * qg + r32, d.nq - 1);
#pragma unroll
        for (int j = 0; j < 8; ++j) gpre[j] = *(const u32x2*)(d.gate + (size_t)row_ * ZLD + 32 * (j >> 2) + 8 * (j & 3) + 4 * hi); }
    const ldsp cw = lds + COMB_OFF + qg * COMB_WAVE;
    if (!WIDE && ks == 1 && qg < d.nqg) {
#pragma unroll
        for (int mp = 0; mp < NMAP; ++mp) {
#pragma unroll
            for (int db = 0; db < 2; ++db)
#pragma unroll
                for (int i = 0; i < 16; ++i) *(LAS float*)(cw + ((mp * 2 + db) * 16 + i) * 256 + lane * 4) = O[mp][db][i];
            *(LAS float*)(cw + 16384 + (mp * 2) * 256 + lane * 4) = mref[mp]; *(LAS float*)(cw + 16384 + (mp * 2 + 1) * 256 + lane * 4) = lsum[mp];
        }
    }
    __syncthreads();
    if (WIDE) {
#pragma unroll
        for (int mp = 0; mp < NMAP; ++mp) {
            const float fin = 1.0f / xhalf_sum(lsum[mp]); const int row = qoff0 + 32 * mp + r32;
#pragma unroll
            for (int db = 0; db < 2; ++db)
#pragma unroll
                for (int g4 = 0; g4 < 4; ++g4) {
                    const int d0 = 32 * db + 8 * g4 + 4 * hi;
                    const u32x2 gw = *(const u32x2*)(d.gate + (size_t)row * ZLD + d0);
                    const float y0 = O[mp][db][4 * g4] * fin * bf_lo(gw.x), y1 = O[mp][db][4 * g4 + 1] * fin * bf_hi(gw.x), y2 = O[mp][db][4 * g4 + 2] * fin * bf_lo(gw.y), y3 = O[mp][db][4 * g4 + 3] * fin * bf_hi(gw.y);
                    *(u32x2*)(d.y + (size_t)row * 1024 + d0) = (u32x2){cvtpk(y0, y1), cvtpk(y2, y3)};
                }
        }
    } else
    if (ks == 0 && qg < d.nqg) {
        float linv[NMAP];
#pragma unroll
        for (int mp = 0; mp < NMAP; ++mp) {
            const float mb = *(const LAS float*)(cw + 16384 + (mp * 2) * 256 + lane * 4), lb = *(const LAS float*)(cw + 16384 + (mp * 2 + 1) * 256 + lane * 4);
            const float mt = fmaxf(mref[mp], mb), aa = __builtin_amdgcn_exp2f(mref[mp] - mt), ab = __builtin_amdgcn_exp2f(mb - mt);
            const float l = xhalf_sum(lsum[mp] * aa + lb * ab);
            linv[mp] = 1.0f / l;
#pragma unroll
            for (int db = 0; db < 2; ++db)
#pragma unroll
                for (int i = 0; i < 16; ++i) O[mp][db][i] = O[mp][db][i] * aa + *(const LAS float*)(cw + ((mp * 2 + db) * 16 + i) * 256 + lane * 4) * ab;
        }
        float fin = 1.f;
        if (MODE == 0) {
            const float i1 = linv[0], i2 = lam * linv[NMAP - 1]; float ss = 0.f;
#pragma unroll
            for (int db = 0; db < 2; ++db)
#pragma unroll
                for (int i = 0; i < 16; ++i) { const float o = O[0][db][i] * i1 - O[NMAP - 1][db][i] * i2; O[0][db][i] = o; ss += o * o; }
            ss = xhalf_sum(ss);
            int sel_ = lsel; asm volatile("" : "+s"(sel_));
            fin = __builtin_amdgcn_rsqf(ss * (1.0f / 64.0f) + 1e-5f) * ((sel_ == 0) ? 0.8f : 0.6444909324090307f);
        } else fin = linv[0];
        const int row = 32 * qg + r32;
        if (row < d.nq) {
#pragma unroll
            for (int db = 0; db < 2; ++db)
#pragma unroll
                for (int g4 = 0; g4 < 4; ++g4) {
                    const int d0 = 32 * db + 8 * g4 + 4 * hi;
                    const u32x2 gw = (MODE == 1) ? gpre[db * 4 + g4] : *(const u32x2*)(d.gate + (size_t)row * ZLD + d0);
                    f32x4 sg = {1.f, 1.f, 1.f, 1.f}; if (MODE == 0) sg = *(const f32x4*)(subg + d0);
                    const float y0 = O[0][db][4 * g4] * fin * sg[0] * bf_lo(gw.x), y1 = O[0][db][4 * g4 + 1] * fin * sg[1] * bf_hi(gw.x);
                    const float y2 = O[0][db][4 * g4 + 2] * fin * sg[2] * bf_lo(gw.y), y3 = O[0][db][4 * g4 + 3] * fin * sg[3] * bf_hi(gw.y);
                    *(u32x2*)(d.y + (size_t)row * 1024 + d0) = (u32x2){cvtpk(y0, y1), cvtpk(y2, y3)};
                }
        }
    }
}
#undef KC
#undef QFRAG
using namespace pg8;
#ifndef P1_ALIGN
#define P1_ALIGN true
#endif
constexpr size_t WS_CTL = WSO_CTL, CTL_BYTES = 1u << 20, WS_SSQ0 = WSO_SSQ0, WS_ROPE = WSO_ROPE, WS_WIN = WSO_WIN, WS_WOUT = WSO_WOUT, WS_XB = WSO_XB, WS_YMIX = WSO_YMIX, WS_X1 = WSO_X1, WS_Z = WSO_Z, WS_END = WSO_END;
static_assert((size_t)MROWS * 1024 * 2 <= 36u * (1u << 20) && (size_t)MROWS * 1024 * 4 <= 68u * (1u << 20) && (size_t)MROWS * 4096 * 2 <= 132u * (1u << 20), "ws map");
constexpr int CTL_Q0 = 0, CTL_SI = 64, CTL_SM = 128, CTL_SSQ1 = 16384, CTL_SSQ2 = 16384 + 32768;
static_assert((CTL_SSQ2 + MROWS) * 4 <= (int)CTL_BYTES, "ctl");
constexpr size_t O_Y = OO_Y, O_CONVP = OO_CONVP, O_CONVS = OO_CONVS, O_END = OO_END;
struct Args { const float* in[18]; float* out; unsigned char* ws; };

__device__ __forceinline__ float wave_sum(float v) {
#pragma unroll
    for (int o = 1; o < 64; o <<= 1) v += __shfl_xor(v, o);
    return v;
}
__device__ __forceinline__ unsigned f2bf(float f) { unsigned u = __builtin_bit_cast(unsigned, f); return (u + 0x7fffu + ((u >> 16) & 1u)) >> 16; }
__device__ __forceinline__ unsigned pk2(float lo, float hi) { return f2bf(lo) | (f2bf(hi) << 16); }
__device__ __forceinline__ void p0_transpose_item(const float* W, const float* g, int K, int N, bf16_t* WT, LAS float* scr, int item, int lane) {
    const int nblk = N / 32, kb = item / nblk, nb = item % nblk, k0 = 64 * kb, n0 = 32 * nb;
#pragma unroll 8
    for (int i = 0; i < 32; ++i) { const int kk = 2 * i + (lane >> 5); const float gs = g ? g[k0 + kk] : 1.f; scr[kk * 33 + (lane & 31)] = W[(size_t)(k0 + kk) * N + n0 + (lane & 31)] * gs; }
    asm volatile("s_waitcnt lgkmcnt(0)" ::: "memory");
    const int c = lane & 7;
#pragma unroll
    for (int j = 0; j < 4; ++j) { const int n = (lane >> 3) + 8 * j; const LAS float* s = scr + (8 * c) * 33 + n;
        u32x4 o; o.x = pk2(s[0 * 33], s[1 * 33]); o.y = pk2(s[2 * 33], s[3 * 33]); o.z = pk2(s[4 * 33], s[5 * 33]); o.w = pk2(s[6 * 33], s[7 * 33]);
        *(u32x4*)(WT + (size_t)(n0 + n) * K + k0 + 8 * c) = o; }
    asm volatile("s_waitcnt lgkmcnt(0)" ::: "memory");
}

#define XB_TMO      128
#define XB_XCNT(j)  (256  + 64 * (j))
#define XB_XSUB(j)  (1280 + 64 * (j))
#define XB_XGEN(j)  (2304 + 64 * (j))
#define XB_TOP      3328
#define XB_TOPGEN   3392
#define XCD_BAR_WORDS 3456
#define XB_SPIN_CAP (1u << 18)

__device__ __forceinline__ unsigned xb_ld(unsigned* p)              { return __hip_atomic_load(p, __ATOMIC_RELAXED, __HIP_MEMORY_SCOPE_AGENT); }
__device__ __forceinline__ unsigned xb_add(unsigned* p, unsigned v) { return __hip_atomic_fetch_add(p, v, __ATOMIC_RELAXED, __HIP_MEMORY_SCOPE_AGENT); }
__device__ __forceinline__ unsigned xb_xcc_id() { return (unsigned)__builtin_amdgcn_s_getreg((3 << 11) | 20) & 0xFu; }
#define XB_SPIN(cond, bar) do { unsigned _sp = 0; while (cond) { __builtin_amdgcn_s_sleep(1); \
    if ((++_sp & 255u) == 0u) { if (xb_ld(&(bar)[XB_TMO])) break; if (_sp > XB_SPIN_CAP) { atomicAdd(&(bar)[XB_TMO], 1u); break; } } } } while (0)

struct XcdBarrier {
    unsigned* bar; unsigned x;
    volatile LAS unsigned* st;
};

__device__ __forceinline__ XcdBarrier xcd_barrier_post(unsigned* bar, volatile LAS unsigned* st) {
    XcdBarrier b; b.bar = bar; b.x = xb_xcc_id(); b.st = st;
    if (threadIdx.x == 0) (void)xb_add(&bar[XB_XCNT(b.x)], 1u);
    return b;
}
__device__ __forceinline__ void xcd_barrier_complete(unsigned* bar, unsigned x, unsigned& nloc, unsigned& nx) {
    const unsigned G = gridDim.x * gridDim.y * gridDim.z;
    unsigned sum, cnt, mine, sp = 0u;
    for (;;) {
        sum = 0u; cnt = 0u; mine = 0u;
#pragma unroll
        for (unsigned j = 0; j < 16; ++j) { const unsigned c = xb_ld(&bar[XB_XCNT(j)]); sum += c; cnt += (c > 0u) ? 1u : 0u; mine = (j == x) ? c : mine; }
        if (sum == G) break;
        __builtin_amdgcn_s_sleep(1);
        if ((++sp & 255u) == 0u) { if (xb_ld(&bar[XB_TMO])) break; if (sp > XB_SPIN_CAP) { atomicAdd(&bar[XB_TMO], 1u); break; } }
    }
    nloc = mine > 0u ? mine : 1u; nx = cnt > 0u ? cnt : 1u;
}

__device__ __forceinline__ void xcd_barrier(const XcdBarrier& b) {
    asm volatile("s_waitcnt vmcnt(0)" ::: "memory");
    __syncthreads();
    if (threadIdx.x == 0) {
        unsigned* bar = b.bar;
        __builtin_amdgcn_s_waitcnt(0);
        unsigned nloc = b.st[0], nx = b.st[1];
        if (nloc == 0u) { xcd_barrier_complete(bar, b.x, nloc, nx); b.st[0] = nloc; b.st[1] = nx; }
        const unsigned old = xb_add(&bar[XB_XSUB(b.x)], 1u);
        const unsigned gen = old / nloc;
        if (old + 1u == (gen + 1u) * nloc) {
            __builtin_amdgcn_fence(__ATOMIC_RELEASE, "agent");
            asm volatile("s_waitcnt vmcnt(0)" ::: "memory");
            const unsigned og = xb_add(&bar[XB_TOP], 1u);
            const unsigned tg = og / nx;
            if (og + 1u == (tg + 1u) * nx) xb_add(&bar[XB_TOPGEN], 1u);
            else XB_SPIN(xb_ld(&bar[XB_TOPGEN]) == tg, bar);
            __builtin_amdgcn_fence(__ATOMIC_ACQUIRE, "agent");
            xb_add(&bar[XB_XGEN(b.x)], 1u);
            asm volatile("s_waitcnt vmcnt(0)" ::: "memory");
        } else {
            XB_SPIN(xb_ld(&bar[XB_XGEN(b.x)]) == gen, bar);
            __builtin_amdgcn_fence(__ATOMIC_ACQUIRE, "agent");
            asm volatile("s_waitcnt vmcnt(0)" ::: "memory");
        }
    }
    __syncthreads();
}

constexpr int CTL_XBAR = 8192;
static_assert(CTL_XBAR + XCD_BAR_WORDS <= CTL_SSQ1, "ctl map");

__global__ void __launch_bounds__(512) fwd_megakernel(Args args) {
    extern __shared__ __attribute__((aligned(16))) unsigned char lds_raw[];
    cg::grid_group grid = cg::this_grid();
    const ldsp lds = (ldsp)lds_raw;
    const int tid = threadIdx.x, lane = tid & 63, wave = __builtin_amdgcn_readfirstlane(tid >> 6);
    const int G = gridDim.x, bx = blockIdx.x;
    unsigned char* ws = args.ws; float* out = args.out;
    unsigned* ctl = (unsigned*)(ws + WS_CTL);
    float* SSQ0 = (float*)(ws + WS_SSQ0); float* SSQ1 = (float*)ctl + CTL_SSQ1; float* SSQ2 = (float*)ctl + CTL_SSQ2;
    float* ROPE = (float*)(ws + WS_ROPE);
    bf16_t* WIN = (bf16_t*)(ws + WS_WIN); bf16_t* WOUT = (bf16_t*)(ws + WS_WOUT);
    bf16_t* XB = (bf16_t*)(ws + WS_XB); bf16_t* YMIX = (bf16_t*)(ws + WS_YMIX); float* X1 = (float*)(ws + WS_X1); bf16_t* Z = (bf16_t*)(ws + WS_Z);
    const float* x_p = args.in[0]; const float* x_s = args.in[1];
    volatile LAS unsigned* xb_st = (volatile LAS unsigned*)(lds + MISC_OFF + 16);
    if (tid < 2) xb_st[tid] = 0u;
    __syncthreads();
    const XcdBarrier xbar = xcd_barrier_post(ctl + CTL_XBAR, xb_st);

    {
        LAS float* scr = (LAS float*)(lds + wave * 16384);
        const int gw = bx * 8 + wave, NGW = G * 8;
        constexpr int I_IN = (1024 / 64) * (4096 / 32), I_OUT = (1024 / 64) * (1024 / 32), NITEMS = 2 * I_IN + 2 * I_OUT;
        for (int it = gw; it < NITEMS; it += NGW) {
            int r = it;
            if (r < 2 * I_IN) { const int l = r / I_IN; r -= l * I_IN; p0_transpose_item(args.in[8] + (size_t)l * 1024 * 4096, args.in[7] + l * 1024, 1024, 4096, WIN + (size_t)l * 4096 * 1024, scr, r, lane); }
            else { r -= 2 * I_IN; const int l = r / I_OUT; r -= l * I_OUT; p0_transpose_item(args.in[9] + (size_t)l * 1024 * 1024, nullptr, 1024, 1024, WOUT + (size_t)l * 1024 * 1024, scr, r, lane); }
        }
        for (int m = gw; m < MROWS; m += NGW) {
            const float* xr = (m < NPROMPT) ? x_p + (size_t)m * 1024 : x_s + (size_t)(m - NPROMPT) * 1024;
            f32x4 v[4]; float s = 0.f;
#pragma unroll
            for (int j = 0; j < 4; ++j) { v[j] = *((const f32x4*)xr + lane + 64 * j); s += (v[j][0] * v[j][0] + v[j][1] * v[j][1]) + (v[j][2] * v[j][2] + v[j][3] * v[j][3]); }
            s = wave_sum(s);
            if (lane == 0) SSQ0[m] = s;
#pragma unroll
            for (int j = 0; j < 4; ++j) *((u32x2*)(XB + (size_t)m * 1024) + lane + 64 * j) = (u32x2){cvtpk(v[j][0], v[j][1]), cvtpk(v[j][2], v[j][3])};
        }
        for (int e = bx * 512 + tid; e < MROWS * 4; e += G * 512) {
            const int row = e >> 2, i = e & 3; const int pos = (row < NPROMPT) ? row : 4096 + ((row - NPROMPT) & 15);
            const float invf = (i == 0) ? 1.0f : (i == 1 ? 0.037606030930863934f : (i == 2 ? 0.0014142135623730950f : 5.318295896944988e-05f));
            const float ang = (float)pos * invf;
            const double rev = (double)ang * 0.15915494309189535; const float fr = (float)(rev - __builtin_rint(rev));
            ROPE[(size_t)row * 8 + i] = __builtin_amdgcn_cosf(fr); ROPE[(size_t)row * 8 + 4 + i] = __builtin_amdgcn_sinf(fr);
        }
    }
    grid.sync();
#ifdef PROBE_SYNCX
    for (int i_ = 0; i_ < PROBE_SYNCX; ++i_) grid.sync();
#endif

    for (int l = 0; l < 2; ++l) {
        {
            pg8::Gemm g{XB, WIN + (size_t)l * 4096 * 1024, NPROMPT, 4096, 1024}; pg8::StaticOrder S; S.init(NPROMPT, 4096, G, bx);
            pg8::EpiIn E{ws, out, l};

#ifndef NO_GEMM1
            pg8::gemm_phase<pg8::EpiIn, pg8::StaticOrder, P1_ALIGN, true>(lds, g, S, E);
#ifdef PROBE_P1X
            if (l == 0) { grid.sync(); pg8::gemm_phase<pg8::EpiIn, pg8::StaticOrder, true, true>(lds, g, S, E); }
#endif
#endif

        }
        xcd_barrier(xbar);
        {
            const float lam_init = (l == 0) ? 0.2f : 0.35550906759096927f;
            float d1 = 0.f, d2 = 0.f;
            for (int i = 0; i < 32; ++i) { d1 += args.in[12][l * 32 + i] * args.in[13][l * 32 + i]; d2 += args.in[14][l * 32 + i] * args.in[15][l * 32 + i]; }
            const float lam = __int_as_float(__builtin_amdgcn_readfirstlane(__float_as_int(__expf(d1) - __expf(d2) + lam_init))), dummy_oml_ = 0.f; const int oml = l;
            const float* subg = args.in[16] + l * 64;
            volatile LAS int* misc = (volatile LAS int*)(lds + MISC_OFF);
            constexpr int N_SI = 16, N_PC = 512, N_SC = 64, N_PA = 1024, N_SA = 128, N_CV = 130, N_SO = 4, N_TOT = N_SI + N_PC + N_SC + N_PA + N_SA + N_CV + N_SO;
            constexpr unsigned N_SMIX = N_SC + N_SA + 2;
#ifndef PROBE_P2X
#define PROBE_P2X 1
#endif
            for (int rep = 0; rep < ((l == 0) ? PROBE_P2X : 1); ++rep) {
            if (rep > 0) grid.sync();
            for (;;) {
                __syncthreads();
                if (tid == 0) misc[0] = (int)atomicAdd(ctl + CTL_Q0 + l + 2 * rep, 1u);
                __syncthreads();
                int ui = misc[0]; ui = __builtin_amdgcn_readfirstlane(ui);
                if (ui >= N_TOT) break;
                AU d; d.tabsrc = nullptr; d.kc = nullptr; d.vc = nullptr; d.cp = 0; d.ntc = 0; d.lastv = 64; d.nqg = 4; d.tlo1 = 0; d.thi1 = -1; d.qpos0 = 0; d.kpos0 = 0;
                int kind;
                int idx = ui;
                if (idx < 16) kind = 5; else if (idx < 256) { kind = 0; idx -= 16; } else if (idx < 320) { kind = 1; idx -= 256; } else if (idx < 448) { kind = 3; idx -= 320; } else if (idx < 450) { kind = 4; idx = 128 + (idx - 448); }
                else if (idx < 454) { kind = 6; idx -= 450; } else if (idx < 726) { kind = 0; idx = 240 + (idx - 454); } else if (idx < 1750) { kind = 2; idx -= 726; } else { kind = 4; idx -= 1750; }
#ifdef PROBE_ONLY_KIND
                if (rep > 0 && kind != PROBE_ONLY_KIND) continue;
#endif
                if (rep > 0 && kind >= 5) continue;
                const bool smp_unit = (kind == 1 || kind == 3 || (kind == 4 && idx >= 128));
                if (smp_unit || kind == 6) {
                    if (tid == 0) {
                        unsigned* cnt = ctl + (kind == 6 ? CTL_SM : CTL_SI) + l; const unsigned want = (kind == 6) ? N_SMIX : (unsigned)N_SI;
                        while (__hip_atomic_load(cnt, __ATOMIC_RELAXED, __HIP_MEMORY_SCOPE_AGENT) < want) __builtin_amdgcn_s_sleep(8);
                        __builtin_amdgcn_fence(__ATOMIC_ACQUIRE, "agent");
                        asm volatile("s_waitcnt vmcnt(0)" ::: "memory");
                    }
                    __syncthreads();
                }
                if (kind >= 5) {
                    if (kind == 5) { pg8::Gemm g{XB, WIN + (size_t)l * 4096 * 1024, MROWS, 4096, 1024}; pg8::OneUnit S{64, idx}; pg8::EpiIn E{ws, out, l};
                        pg8::gemm_phase<pg8::EpiIn, pg8::OneUnit, false, true>(lds, g, S, E); }
                    else { pg8::Gemm g{YMIX, WOUT + (size_t)l * 1024 * 1024, MROWS, 1024, 1024}; pg8::OneUnit S{64, idx}; pg8::EpiOut E{ws, x_p, x_s, l, args.in[17], out};
                        pg8::gemm_phase<pg8::EpiOut, pg8::OneUnit, false, true>(lds, g, S, E); }
                }
                else if (kind == 0) {
                    const int u = 127 - (idx >> 2), h = idx & 3; const size_t r0 = (size_t)128 * u;
                    d.q = Z + r0 * ZLD + 3072 + 64 * h; d.nq = 128; d.nt = 2 * u + 2; d.kz = Z + 3328 + 64 * h; d.vz = Z + 3584 + 64 * h;
                    d.tlo0 = 0; d.thi0 = d.nt - 2; d.tlo1 = 0; d.thi1 = d.nt - 1; d.gate = Z + r0 * ZLD + 3840 + 64 * h; d.y = YMIX + r0 * 1024 + 768 + 64 * h;

#ifndef NO_ATTN0
                    attn_unit<0>(d, lds, lam, oml, subg);
#endif

                } else if (kind == 1) {
                    const int b = idx >> 2, h = idx & 3; const size_t r0 = (size_t)NPROMPT + 16 * b;
                    d.q = Z + r0 * ZLD + 3072 + 64 * h; d.nq = 16; d.nt = 65; d.ntc = 64; d.cp = 256;
                    d.kc = args.in[5] + ((size_t)(l * 16 + b) * 4096) * 256 + 64 * h; d.vc = args.in[6] + ((size_t)(l * 16 + b) * 4096) * 256 + 64 * h;
                    d.kz = Z + r0 * ZLD + 3328 + 64 * h; d.vz = Z + r0 * ZLD + 3584 + 64 * h; d.lastv = 16; d.nqg = 1; d.tlo0 = 0; d.thi0 = 64;
                    d.gate = Z + r0 * ZLD + 3840 + 64 * h; d.y = YMIX + r0 * 1024 + 768 + 64 * h;

#ifndef NO_ATTN0
                    attn_unit<0>(d, lds, lam, oml, subg);
#endif

                } else if (kind == 2 || kind == 3) {
                    int h;
                    if (kind == 2) {
                        h = idx & 7; const int cp = idx >> 3, c0 = max(0, 2 * cp - 8); const size_t r0 = (size_t)128 * cp;
                        d.q = Z + r0 * ZLD + 64 * h; d.nq = 128; d.nt = 2 * cp + 2 - c0; d.kz = Z + (size_t)64 * c0 * ZLD + 512 + 64 * h; d.vz = Z + (size_t)64 * c0 * ZLD + 1024 + 64 * h;
                        d.tlo0 = 0; d.thi0 = 2 * cp - c0; d.tlo1 = max(0, 2 * cp + 1 - 8) - c0; d.thi1 = 2 * cp + 1 - c0; d.qpos0 = 128 * cp; d.kpos0 = 64 * c0;
                        d.gate = Z + r0 * ZLD + 1536 + 64 * h; d.y = YMIX + r0 * 1024 + 64 * h;
                    } else {
                        h = idx & 7; const int b = idx >> 3; const size_t r0 = (size_t)NPROMPT + 16 * b;
                        d.q = Z + r0 * ZLD + 64 * h; d.nq = 16; d.nt = 9; d.ntc = 8; d.cp = 512;
                        d.kc = args.in[2] + ((size_t)(l * 16 + b) * 512) * 512 + 64 * h; d.vc = args.in[3] + ((size_t)(l * 16 + b) * 512) * 512 + 64 * h;
                        d.kz = Z + r0 * ZLD + 512 + 64 * h; d.vz = Z + r0 * ZLD + 1024 + 64 * h; d.lastv = 16; d.nqg = 1; d.tlo0 = 0; d.thi0 = 8; d.qpos0 = 512; d.kpos0 = 0;
                        d.gate = Z + r0 * ZLD + 1536 + 64 * h; d.y = YMIX + r0 * 1024 + 64 * h;
                    }
                    d.tabsrc = args.in[10] + (size_t)(l * 8 + h) * 257;

#ifndef NO_ATTN1
                    attn_unit<1>(d, lds, 0.f, 0, nullptr);
#endif

                } else {
                    int tq_ = threadIdx.x; asm volatile("" : "+v"(tq_));
                    const int c8 = (tq_ & 31) * 8, rr = tq_ >> 5;
                    const float* cw = args.in[11] + (size_t)l * 3 * 256 + c8;
                    float w0[8], w1[8], w2[8];
#pragma unroll
                    for (int j = 0; j < 8; ++j) { w0[j] = cw[j]; w1[j] = cw[256 + j]; w2[j] = cw[512 + j]; }
                    for (int g = 0; g < 8; ++g) {
                        const int row = 128 * idx + 16 * g + rr; const bool smp = row >= NPROMPT; const int t = smp ? ((row - NPROMPT) & 15) : row, b = (row - NPROMPT) >> 4;
                        const bf16_t* zr = Z + (size_t)row * ZLD;
                        float u0[8], u1[8], u2[8];
                        { const u32x4 c = *(const u32x4*)(zr + 2304 + c8), hh = *(const u32x4*)(zr + 2560 + c8);
#pragma unroll
                          for (int j = 0; j < 4; ++j) { u0[2 * j] = bf_lo(c[j]) * bf_lo(hh[j]); u0[2 * j + 1] = bf_hi(c[j]) * bf_hi(hh[j]); } }
                        if (t >= 1) { const u32x4 c = *(const u32x4*)(zr - ZLD + 2304 + c8), hh = *(const u32x4*)(zr - ZLD + 2560 + c8);
#pragma unroll
                          for (int j = 0; j < 4; ++j) { u1[2 * j] = bf_lo(c[j]) * bf_lo(hh[j]); u1[2 * j + 1] = bf_hi(c[j]) * bf_hi(hh[j]); } }
                        else if (smp) { const float* sp = args.in[4] + ((size_t)(l * 16 + b) * 2 + 1) * 256 + c8;
#pragma unroll
                          for (int j = 0; j < 8; ++j) u1[j] = sp[j]; }
                        else {
#pragma unroll
                          for (int j = 0; j < 8; ++j) u1[j] = 0.f; }
                        if (t >= 2) { const u32x4 c = *(const u32x4*)(zr - 2 * ZLD + 2304 + c8), hh = *(const u32x4*)(zr - 2 * ZLD + 2560 + c8);
#pragma unroll
                          for (int j = 0; j < 4; ++j) { u2[2 * j] = bf_lo(c[j]) * bf_lo(hh[j]); u2[2 * j + 1] = bf_hi(c[j]) * bf_hi(hh[j]); } }
                        else if (smp) { const float* sp = args.in[4] + ((size_t)(l * 16 + b) * 2 + t) * 256 + c8;
#pragma unroll
                          for (int j = 0; j < 8; ++j) u2[j] = sp[j]; }
                        else {
#pragma unroll
                          for (int j = 0; j < 8; ++j) u2[j] = 0.f; }
                        const u32x4 bb = *(const u32x4*)(zr + 2048 + c8), bg = *(const u32x4*)(zr + 2816 + c8);
                        float y[8];
#pragma unroll
                        for (int j = 0; j < 4; ++j) {
                            y[2 * j] = bf_lo(bb[j]) * (u2[2 * j] * w0[2 * j] + u1[2 * j] * w1[2 * j] + u0[2 * j] * w2[2 * j]) * bf_lo(bg[j]);
                            y[2 * j + 1] = bf_hi(bb[j]) * (u2[2 * j + 1] * w0[2 * j + 1] + u1[2 * j + 1] * w1[2 * j + 1] + u0[2 * j + 1] * w2[2 * j + 1]) * bf_hi(bg[j]); }
                        *(u32x4*)(YMIX + (size_t)row * 1024 + 512 + c8) = (u32x4){cvtpk(y[0], y[1]), cvtpk(y[2], y[3]), cvtpk(y[4], y[5]), cvtpk(y[6], y[7])};
                        float* so = nullptr;
                        if (!smp && row >= NPROMPT - 2) so = out + O_CONVP + (size_t)l * 512 + (size_t)(row - (NPROMPT - 2)) * 256 + c8;
                        if (smp && t >= 14) so = out + O_CONVS + (size_t)l * 8192 + (size_t)b * 512 + (size_t)(t - 14) * 256 + c8;
                        if (so) { *(f32x4*)so = (f32x4){u0[0], u0[1], u0[2], u0[3]}; *(f32x4*)(so + 4) = (f32x4){u0[4], u0[5], u0[6], u0[7]}; }
                    }
                }
                if (smp_unit || kind == 5) {
                    asm volatile("s_waitcnt vmcnt(0)" ::: "memory");
                    __syncthreads();
                    if (tid == 0) { __builtin_amdgcn_fence(__ATOMIC_RELEASE, "agent"); asm volatile("s_waitcnt vmcnt(0)" ::: "memory");
                        __hip_atomic_fetch_add(ctl + (kind == 5 ? CTL_SI : CTL_SM) + l, 1u, __ATOMIC_RELAXED, __HIP_MEMORY_SCOPE_AGENT); }
                }
            }
            }
        }
        xcd_barrier(xbar);
        {
            pg8::Gemm g{YMIX, WOUT + (size_t)l * 1024 * 1024, NPROMPT, 1024, 1024}; pg8::StaticOrder S; S.init(NPROMPT, 1024, G, bx);
            pg8::EpiOut E{ws, x_p, x_s, l, args.in[17], out};

#ifndef NO_GEMM2
            pg8::gemm_phase<pg8::EpiOut, pg8::StaticOrder, true, true>(lds, g, S, E);
#endif

            if (l == 1 && wave == 0 && bx < MROWS - NPROMPT) {
                int ln_ = threadIdx.x; asm volatile("" : "+v"(ln_)); ln_ &= 63;
                const int lane = ln_;
                const int m = NPROMPT + bx; const float rs = __builtin_amdgcn_rsqf(SSQ2[m] * (1.0f / 1024.0f) + 1e-6f);
#pragma unroll
                for (int j = 0; j < 4; ++j) { const f32x4 v = *((const f32x4*)(X1 + (size_t)m * 1024) + lane + 64 * j); *((f32x4*)(out + O_Y + (size_t)m * 1024) + lane + 64 * j) = v * rs * *((const f32x4*)args.in[17] + lane + 64 * j); }
            }
        }
        if (l == 0) xcd_barrier(xbar);
    }
}

extern "C" void kernel_launch(void* const* d_in, const int* in_sizes, int n_in, void* d_out, int out_size, void* d_ws, size_t ws_size, hipStream_t stream) {
    static int grid_blocks = 0;
    if (!grid_blocks) {
        if (n_in != 18 || (size_t)out_size != O_END || ws_size < WS_END) { fprintf(stderr, "kernel_launch: unexpected shapes n_in %d out %d ws %zu\n", n_in, out_size, ws_size); grid_blocks = -1; return; }
        int dev = 0, cus = 0, per_cu = 0;
        hipGetDevice(&dev); hipDeviceGetAttribute(&cus, hipDeviceAttributeMultiprocessorCount, dev);
        hipFuncSetAttribute((const void*)fwd_megakernel, hipFuncAttributeMaxDynamicSharedMemorySize, LDS_BYTES);
        hipOccupancyMaxActiveBlocksPerMultiprocessor(&per_cu, (const void*)fwd_megakernel, 512, LDS_BYTES);
        if (per_cu < 1) { fprintf(stderr, "kernel_launch: occupancy query says %d blocks per CU\n", per_cu); per_cu = 1; }
        if (per_cu > 1) per_cu = 1;
        grid_blocks = cus * per_cu;
    }
    if (grid_blocks < 0) return;
    hipMemsetAsync((char*)d_ws + WS_CTL, 0, CTL_BYTES, stream);
    Args a{};
    for (int i = 0; i < 18; ++i) a.in[i] = (const float*)d_in[i];
    a.out = (float*)d_out; a.ws = (unsigned char*)d_ws;
    void* kargs[] = {&a};
    hipError_t e = hipLaunchCooperativeKernel((const void*)fwd_megakernel, dim3(grid_blocks), dim3(512), kargs, LDS_BYTES, stream);
    if (e != hipSuccess) fprintf(stderr, "cooperative launch failed: %s (grid %d)\n", hipGetErrorString(e), grid_blocks);
}
```

```cpp
#include <hip/hip_runtime.h>
#include <hip/hip_cooperative_groups.h>
#include <cstdio>
#include <cstdint>
namespace cg = cooperative_groups;
namespace pg8 {
#define PG8_LAS __attribute__((address_space(3)))
typedef unsigned short bf16_t;
typedef short bf16x8 __attribute__((ext_vector_type(8)));
typedef float f32x4 __attribute__((ext_vector_type(4)));
typedef unsigned u32x4 __attribute__((ext_vector_type(4)));
constexpr int BM = 256, BK = 64, HALF = 128, HTB = HALF * BK * 2  , STAGE_BYTES = 8 * HTB, NXCD = 8, WGM = 8;

__host__ __device__ __forceinline__ int lds_byte(int r, int c) { const int st = (r >> 4) * 2 + (c >> 5), rr = r & 15, cc = c & 31, ob = rr * 64 + cc * 2; return st * 1024 + (ob ^ (((ob >> 9) & 1) << 5)); }
__host__ __device__ __forceinline__ void stage_rc(int b, int& R, int& C) { const int st = b / 1024, sb = b % 1024, swz = sb ^ (((sb >> 9) & 1) << 5); R = (st >> 1) * 16 + swz / 64; C = (st & 1) * 32 + (swz % 64) / 2; }
__host__ __device__ __forceinline__ int perm32(int rho) { const int n = rho >> 4, i = rho & 15; return 8 * (i >> 2) + 4 * n + (i & 3); }

struct Unit { int pm, pn; };
struct Gemm { const bf16_t* A; const bf16_t* Bt; int M, N, K; };

struct StaticOrder {
    int nM, nN, nwg, G, c;
    __host__ __device__ void init(int M, int N, int G_, int c_) { nM = M / BM; nN = N / BM; nwg = nM * nN; G = G_; c = c_; }
    __host__ __device__ bool next(int i, Unit& u) const {
        const long L = (long)i * G + c; if (L >= nwg) return false;
        int wgid = (int)L; { const int q = nwg / NXCD, r = nwg % NXCD, xcd = wgid % NXCD, off = wgid / NXCD; wgid = (xcd < r ? xcd * (q + 1) : r * (q + 1) + (xcd - r) * q) + off; }
        const int nig = WGM * nN, gid = wgid / nig, fm = gid * WGM, gsz = (nM - fm) < WGM ? (nM - fm) : WGM;
        u.pm = fm + ((wgid % nig) % gsz); u.pn = (wgid % nig) / gsz; return true;
    }
    __device__ __forceinline__ void a_ready(const Unit&) const {}
    __device__ __forceinline__ void done(const Unit&) const {}
};
struct OneUnit {
    int pm, pn;
    __host__ __device__ bool next(int i, Unit& u) const { if (i) return false; u.pm = pm; u.pn = pn; return true; }
    __device__ __forceinline__ void a_ready(const Unit&) const {}
    __device__ __forceinline__ void done(const Unit&) const {}
};
__device__ __forceinline__ unsigned cvt_pk_bf16(float lo, float hi) { unsigned r; asm volatile("v_cvt_pk_bf16_f32 %0, %1, %2" : "=v"(r) : "v"(lo), "v"(hi)); return r; }
typedef float f32x2 __attribute__((ext_vector_type(2)));
constexpr float LOG2E = 1.4426950408889634f;
constexpr float SC_QA = 0.125f * LOG2E;
constexpr float SC_QC = 0.17677669529663687f * LOG2E;
constexpr int ZLD = 4096, MROWS = 16640, NPROMPT = 16384;
constexpr size_t WSO_MiB = 1u << 20;
constexpr size_t WSO_PANEL = 512 * 4  , WSO_CTL = 0, WSO_SSQ1 = 16384 * 4, WSO_SSQ2 = (16384 + 32768) * 4, WSO_SSQ0 = 1 * WSO_MiB, WSO_ROPE = 2 * WSO_MiB, WSO_WIN = 4 * WSO_MiB, WSO_WOUT = 20 * WSO_MiB, WSO_XB = 24 * WSO_MiB,
                 WSO_YMIX = 60 * WSO_MiB, WSO_X1 = 96 * WSO_MiB, WSO_Z = 164 * WSO_MiB, WSO_END = 296 * WSO_MiB;
constexpr size_t OO_Y = 0, OO_AKP = 17039360, OO_AVP = OO_AKP + 524288, OO_CONVP = OO_AVP + 524288, OO_CKP = OO_CONVP + 1024, OO_CVP = OO_CKP + 8388608,
                 OO_AKS = OO_CVP + 8388608, OO_AVS = OO_AKS + 262144, OO_CONVS = OO_AVS + 262144, OO_CKS = OO_CONVS + 16384, OO_CVS = OO_CKS + 131072, OO_END = OO_CVS + 131072;
__device__ __forceinline__ float silu_f(float x) { return x * __builtin_amdgcn_rcpf(1.0f + __builtin_amdgcn_exp2f(-x * LOG2E)); }
struct EpiIn {
    static constexpr bool PERM = true, AFTER_DRAIN = false;
    unsigned char* ws; float* out; int l;
    __device__ __forceinline__ void operator()(const f32x4 (&acc)[2][2][4][2], const Unit& u, int wr, int wc, int fr, int fq) const {
        const int pn = u.pn, pm = u.pm;
        bf16_t* Z = (bf16_t*)(ws + WSO_Z); const float* ssq = (const float*)(ws + (l == 0 ? WSO_SSQ0 : WSO_SSQ1)); const float* rope = (const float*)(ws + WSO_ROPE);
        float* o_ak_p = out + OO_AKP + (size_t)l * 262144; float* o_av_p = out + OO_AVP + (size_t)l * 262144; float* o_ak_s = out + OO_AKS + (size_t)l * 131072; float* o_av_s = out + OO_AVS + (size_t)l * 131072;
        float* o_ck_p = out + OO_CKP + (size_t)l * 4194304; float* o_cv_p = out + OO_CVP + (size_t)l * 4194304; float* o_ck_s = out + OO_CKS + (size_t)l * 65536; float* o_cv_s = out + OO_CVS + (size_t)l * 65536;
        const int rowl = wr * 64 + fr;
        const int colb = pn * BM + wc * 32 + 8 * fq;
        const bool rope_tile = (pn == 12 || pn == 13);
        const bool do_rope = rope_tile && fq == 0;
        const float sc = (pn < 2) ? SC_QA : (pn == 12 ? SC_QC : 1.f);
        const bool do_silu = (pn == 6 || pn == 7 || pn == 11 || pn == 15);
        float* ob = nullptr; int old = 0, ocol0 = 0;
        if (pn >= 2 && pn <= 5) { old = 512; ocol0 = (pn >= 4) ? 1024 : 512;
            if (pm == 64) ob = (pn >= 4) ? o_av_s : o_ak_s; else if (pm >= 62) ob = ((pn >= 4) ? o_av_p : o_ak_p) + (size_t)(pm - 62) * 256 * 512; }
        else if (pn == 13 || pn == 14) { old = 256; ocol0 = (pn == 13) ? 3328 : 3584;
            if (pm == 64) ob = (pn == 13) ? o_ck_s : o_cv_s; else ob = ((pn == 13) ? o_ck_p : o_cv_p) + (size_t)pm * 256 * 256; }
#pragma unroll
        for (int ai = 0; ai < 2; ++ai)
#pragma unroll
            for (int m = 0; m < 4; ++m) {
                const int rl = rowl + ai * HALF + m * 16, row = pm * BM + rl;
                const float rs = __builtin_amdgcn_rsqf(ssq[row] * (1.0f / 1024.0f) + 1e-6f);
                f32x4 rc = {1.f, 1.f, 1.f, 1.f}, rsn = {0.f, 0.f, 0.f, 0.f};
                if (do_rope) { rc = *(const f32x4*)(rope + (size_t)row * 8); rsn = *(const f32x4*)(rope + (size_t)row * 8 + 4); }
#pragma unroll
                for (int bj = 0; bj < 2; ++bj) {
                    f32x4 v0 = acc[ai][bj][m][0] * rs, v1 = acc[ai][bj][m][1] * rs;
                    const int col = colb + bj * HALF;
                    if (rope_tile) { const f32x4 a = v0 * rc - v1 * rsn, b = v1 * rc + v0 * rsn; v0 = a; v1 = b; }
                    if (ob) { float* op = ob + (size_t)rl * old + (col - ocol0); *(f32x4*)op = v0; *(f32x4*)(op + 4) = v1; }
                    if (do_silu) { v0 = (f32x4){silu_f(v0[0]), silu_f(v0[1]), silu_f(v0[2]), silu_f(v0[3])}; v1 = (f32x4){silu_f(v1[0]), silu_f(v1[1]), silu_f(v1[2]), silu_f(v1[3])}; }
                    v0 = v0 * sc; v1 = v1 * sc;
                    u32x4 w; w.x = cvt_pk_bf16(v0[0], v0[1]); w.y = cvt_pk_bf16(v0[2], v0[3]); w.z = cvt_pk_bf16(v1[0], v1[1]); w.w = cvt_pk_bf16(v1[2], v1[3]);
                    *(u32x4*)(Z + (size_t)row * ZLD + col) = w;
                }
                asm volatile("" ::: "memory");
            }
    }
};
struct EpiOut {
    static constexpr bool PERM = true, AFTER_DRAIN = false;
    unsigned char* ws; const float* x_p; const float* x_s; int l; const float* fg; float* yout;
    __device__ __forceinline__ void operator()(f32x4 (&acc)[2][2][4][2], const Unit& u, int wr, int wc, int fr, int fq) const {
        const int pm = u.pm; const int colb = u.pn * BM + wc * 32 + 8 * fq;
        float* X1 = (float*)(ws + WSO_X1) + (size_t)pm * BM * 1024; bf16_t* XB = (bf16_t*)(ws + WSO_XB) + (size_t)pm * BM * 1024; float* ssq = (float*)(ws + (l == 0 ? WSO_SSQ1 : WSO_SSQ2)) + pm * BM;
        const float* res = (l == 0) ? ((pm == 64) ? x_s : x_p + (size_t)pm * BM * 1024) : X1;
        const unsigned off0 = (unsigned)(wr * 64 + fr) * 1024u + (unsigned)colb;
        const bool fuse = (l == 1 && pm < 64);
#pragma unroll
        for (int ai = 0; ai < 2; ++ai)
#pragma unroll
            for (int m = 0; m < 4; ++m) {
                const unsigned offr = off0 + (unsigned)(ai * HALF + m * 16) * 1024u; float q = 0.f;
#pragma unroll
                for (int bj = 0; bj < 2; ++bj) { const unsigned off = offr + bj * HALF;
                    const f32x4 v0 = acc[ai][bj][m][0] + *(const f32x4*)(res + off), v1 = acc[ai][bj][m][1] + *(const f32x4*)(res + off + 4);
                    if (fuse) { acc[ai][bj][m][0] = v0; acc[ai][bj][m][1] = v1; }
                    else {
                        *(f32x4*)(X1 + off) = v0; *(f32x4*)(X1 + off + 4) = v1;
                        u32x4 w; w.x = cvt_pk_bf16(v0[0], v0[1]); w.y = cvt_pk_bf16(v0[2], v0[3]); w.z = cvt_pk_bf16(v1[0], v1[1]); w.w = cvt_pk_bf16(v1[2], v1[3]);
                        *(u32x4*)(XB + off) = w; }
                    q += (v0[0] * v0[0] + v0[1] * v0[1]) + (v0[2] * v0[2] + v0[3] * v0[3]) + (v1[0] * v1[0] + v1[1] * v1[1]) + (v1[2] * v1[2] + v1[3] * v1[3]);
                    asm volatile("" ::: "memory"); }
                q += __shfl_xor(q, 16); q += __shfl_xor(q, 32);
                if (fq == 0) atomicAdd(ssq + (wr * 64 + fr + ai * HALF + m * 16), q);
                asm volatile("" ::: "memory");
            }
        if (fuse) {
            unsigned* cnt = (unsigned*)(ws + WSO_PANEL) + 64 * pm;
            asm volatile("s_waitcnt vmcnt(0)" ::: "memory");
            if (__builtin_amdgcn_readfirstlane(fr + 16 * fq) == (fr + 16 * fq)) __hip_atomic_fetch_add(cnt, 1u, __ATOMIC_RELAXED, __HIP_MEMORY_SCOPE_AGENT);
            unsigned spins = 0;
            while (__hip_atomic_load(cnt, __ATOMIC_RELAXED, __HIP_MEMORY_SCOPE_AGENT) < 32u) { __builtin_amdgcn_s_sleep(2); if (++spins > (1u << 22)) break; }
            float* yo = yout + (size_t)pm * BM * 1024;
#pragma unroll
            for (int ai = 0; ai < 2; ++ai)
#pragma unroll
                for (int m = 0; m < 4; ++m) {
                    const int rl = wr * 64 + fr + ai * HALF + m * 16;
                    const float sq = __hip_atomic_load(ssq + rl, __ATOMIC_RELAXED, __HIP_MEMORY_SCOPE_AGENT);
                    const float rs = __builtin_amdgcn_rsqf(sq * (1.0f / 1024.0f) + 1e-6f);
                    const unsigned offr = off0 + (unsigned)(ai * HALF + m * 16) * 1024u;
#pragma unroll
                    for (int bj = 0; bj < 2; ++bj) {
                        const f32x4 g0 = *(const f32x4*)(fg + colb + bj * HALF), g1 = *(const f32x4*)(fg + colb + bj * HALF + 4);
                        *(f32x4*)(yo + offr + bj * HALF) = acc[ai][bj][m][0] * rs * g0; *(f32x4*)(yo + offr + bj * HALF + 4) = acc[ai][bj][m][1] * rs * g1;
                        asm volatile("" ::: "memory"); }
                }
        }
    }
};
template <class Epi, class Sched, bool ALIGN_EPI = false, bool SP2 = false>
__device__ __forceinline__ void gemm_phase(PG8_LAS unsigned char* lds, const Gemm g, const Sched& S, const Epi& E) {
    int tid_ = threadIdx.x; asm volatile("" : "+v"(tid_));
    const int tid = tid_, wid = __builtin_amdgcn_readfirstlane(tid >> 6), lane = tid & 63, wr = wid >> 2, wc = wid & 3, fr = lane & 15, fq = lane >> 4;
    const int K = g.K, nt = K / BK;
    unsigned voffA[2], voffB[2];
#pragma unroll
    for (int i = 0; i < 2; ++i) { int R, C; stage_rc(tid * 16 + i * 8192, R, C); const int Rb = Epi::PERM ? ((R & ~31) + perm32(R & 31)) : R;
        voffA[i] = (unsigned)(R * K + C) * 2u; voffB[i] = (unsigned)(Rb * K + C) * 2u; }
    const size_t kstep = (size_t)(BK * 2);
    const size_t hstep = (size_t)HALF * K * 2;
    const size_t tstep = 2 * hstep;
    const unsigned ldsw = (unsigned)wid * 1024u;
    const int aoff = lds_byte(wr * 64 + fr, fq * 8), boff = lds_byte(wc * 32 + fr, fq * 8);
#define PG8_SA(b, h) (((b) * 2 + (h)) * HTB)
#define PG8_SB(b, h) ((4 + (b) * 2 + (h)) * HTB)
#define PG8_STAGE(bufoff, gbase, voff) do { _Pragma("unroll") for (int _i = 0; _i < 2; ++_i) \
        __builtin_amdgcn_global_load_lds((const unsigned*)((const char*)(gbase) + (voff)[_i]), (PG8_LAS unsigned*)(lds + (bufoff) + ldsw + _i * 8192), 16, 0, 0); } while (0)
#define PG8_LDA(dst, b, h) do { _Pragma("unroll") for (int m = 0; m < 4; ++m) _Pragma("unroll") for (int k = 0; k < 2; ++k) dst[m][k] = *(const PG8_LAS bf16x8*)(lds + PG8_SA(b, h) + aoff + m * 2048 + k * 1024); } while (0)
#define PG8_LDB(dst, b, h) do { _Pragma("unroll") for (int n = 0; n < 2; ++n) _Pragma("unroll") for (int k = 0; k < 2; ++k) dst[n][k] = *(const PG8_LAS bf16x8*)(lds + PG8_SB(b, h) + boff + n * 2048 + k * 1024); } while (0)
#define PG8_MMA(ai, bj, At, Bt) do { __builtin_amdgcn_s_setprio(1); _Pragma("unroll") for (int m = 0; m < 4; ++m) _Pragma("unroll") for (int n = 0; n < 2; ++n) _Pragma("unroll") for (int k = 0; k < 2; ++k) \
        acc[ai][bj][m][n] = __builtin_amdgcn_mfma_f32_16x16x32_bf16(Bt[n][k], At[m][k], acc[ai][bj][m][n], 0, 0, 0); __builtin_amdgcn_s_setprio(0); } while (0)
#define PG8_WAIT_V(n) asm volatile("s_waitcnt vmcnt(" #n ")" ::: "memory")
#define PG8_WAIT_L(n) asm volatile("s_waitcnt lgkmcnt(" #n ")" ::: "memory")
#define PG8_BAR __builtin_amdgcn_s_barrier()
#define PG8_SCHED __builtin_amdgcn_sched_barrier(0)
    Unit cur, nxt; int ui = 0;
    if (!S.next(0, cur)) return;
    f32x4 acc[2][2][4][2];
#pragma unroll
    for (int a = 0; a < 2; ++a)
#pragma unroll
        for (int b = 0; b < 2; ++b)
#pragma unroll
            for (int m = 0; m < 4; ++m)
#pragma unroll
                for (int n = 0; n < 2; ++n) acc[a][b][m][n] = (f32x4){0.f, 0.f, 0.f, 0.f};
    bf16x8 At[4][2], B0[2][2], B1[2][2];
    const char* cA = (const char*)g.A + (size_t)cur.pm * tstep; const char* cB = (const char*)g.Bt + (size_t)cur.pn * tstep;
    S.a_ready(cur);
    if constexpr (SP2) {
        PG8_STAGE(PG8_SB(0, 0), cB, voffB); PG8_STAGE(PG8_SB(0, 1), cB + hstep, voffB); PG8_STAGE(PG8_SA(0, 0), cA, voffA); PG8_STAGE(PG8_SA(0, 1), cA + hstep, voffA);
        if (wr == 1) PG8_BAR;
        PG8_WAIT_V(2); PG8_BAR;
        PG8_STAGE(PG8_SB(1, 0), cB + kstep, voffB); PG8_STAGE(PG8_SA(1, 0), cA + kstep, voffA); PG8_STAGE(PG8_SB(1, 1), cB + hstep + kstep, voffB);
        PG8_WAIT_V(6); PG8_BAR;
    } else {
        PG8_STAGE(PG8_SB(0, 0), cB, voffB); PG8_STAGE(PG8_SA(0, 0), cA, voffA); PG8_STAGE(PG8_SB(0, 1), cB + hstep, voffB); PG8_STAGE(PG8_SA(0, 1), cA + hstep, voffA);
        if (wr == 1) PG8_BAR;
        PG8_WAIT_V(4); PG8_BAR;
        PG8_STAGE(PG8_SB(1, 0), cB + kstep, voffB); PG8_STAGE(PG8_SA(1, 0), cA + kstep, voffA); PG8_STAGE(PG8_SB(1, 1), cB + hstep + kstep, voffB);
        PG8_WAIT_V(6); PG8_BAR;
    }
    for (;;) {
        const bool has_next = S.next(ui + 1, nxt);
        const char* nA = has_next ? (const char*)g.A + (size_t)nxt.pm * tstep : cA; const char* nB = has_next ? (const char*)g.Bt + (size_t)nxt.pn * tstep : cB;
        for (int t = 0; t < nt; t += 2) {
            const bool last = (t == nt - 2);
            const char* a1 = cA + (size_t)(t + 1) * kstep;
            const char* a2 = last ? nA : cA + (size_t)(t + 2) * kstep; const char* b2 = last ? nB : cB + (size_t)(t + 2) * kstep;
            const char* a3 = a2 + kstep; const char* b3 = b2 + kstep;
            if (last && has_next) S.a_ready(nxt);
            if constexpr (SP2) {
            PG8_LDB(B0, 0, 0); PG8_LDB(B1, 0, 1); PG8_SCHED; PG8_LDA(At, 0, 0); PG8_STAGE(PG8_SA(1, 1), a1 + hstep, voffA);
            PG8_WAIT_V(8); PG8_WAIT_L(0); PG8_BAR; PG8_MMA(0, 0, At, B0); PG8_MMA(0, 1, At, B1); PG8_BAR; PG8_SCHED;
            PG8_LDA(At, 0, 1); PG8_STAGE(PG8_SB(0, 0), b2, voffB); PG8_STAGE(PG8_SB(0, 1), b2 + hstep, voffB); PG8_STAGE(PG8_SA(0, 0), a2, voffA);
            PG8_WAIT_V(8); PG8_WAIT_L(0); PG8_BAR; PG8_MMA(1, 0, At, B0); PG8_MMA(1, 1, At, B1); PG8_BAR; PG8_SCHED;
            PG8_LDB(B0, 1, 0); PG8_LDB(B1, 1, 1); PG8_SCHED; PG8_LDA(At, 1, 0); PG8_STAGE(PG8_SA(0, 1), a2 + hstep, voffA);
            PG8_WAIT_V(8); PG8_WAIT_L(0); PG8_BAR; PG8_MMA(0, 0, At, B0); PG8_MMA(0, 1, At, B1); PG8_BAR; PG8_SCHED;
            PG8_LDA(At, 1, 1); PG8_STAGE(PG8_SB(1, 0), b3, voffB); PG8_STAGE(PG8_SB(1, 1), b3 + hstep, voffB); PG8_STAGE(PG8_SA(1, 0), a3, voffA);
            PG8_WAIT_V(8); PG8_WAIT_L(0); PG8_BAR; PG8_MMA(1, 0, At, B0); PG8_MMA(1, 1, At, B1); PG8_BAR; PG8_SCHED;
            } else {
            PG8_LDB(B0, 0, 0); PG8_SCHED; PG8_LDA(At, 0, 0); PG8_STAGE(PG8_SA(1, 1), a1 + hstep, voffA);
            PG8_WAIT_L(8); PG8_BAR; PG8_WAIT_L(0); PG8_MMA(0, 0, At, B0); PG8_BAR; PG8_SCHED;
            PG8_LDB(B1, 0, 1); PG8_STAGE(PG8_SB(0, 0), b2, voffB);
            PG8_BAR; PG8_WAIT_L(0); PG8_MMA(0, 1, At, B1); PG8_BAR;
            PG8_LDA(At, 0, 1); PG8_STAGE(PG8_SA(0, 0), a2, voffA);
            PG8_BAR; PG8_WAIT_L(0); PG8_MMA(1, 0, At, B0); PG8_BAR; PG8_SCHED;
            PG8_STAGE(PG8_SB(0, 1), b2 + hstep, voffB);
            PG8_WAIT_V(6); PG8_BAR; PG8_MMA(1, 1, At, B1); PG8_BAR;
            PG8_LDB(B0, 1, 0); PG8_SCHED; PG8_LDA(At, 1, 0); PG8_STAGE(PG8_SA(0, 1), a2 + hstep, voffA);
            PG8_WAIT_L(8); PG8_BAR; PG8_WAIT_L(0); PG8_MMA(0, 0, At, B0); PG8_BAR; PG8_SCHED;
            PG8_LDB(B1, 1, 1); PG8_STAGE(PG8_SB(1, 0), b3, voffB);
            PG8_BAR; PG8_WAIT_L(0); PG8_MMA(0, 1, At, B1); PG8_BAR;
            PG8_LDA(At, 1, 1); PG8_STAGE(PG8_SA(1, 0), a3, voffA);
            PG8_BAR; PG8_WAIT_L(0); PG8_MMA(1, 0, At, B0); PG8_BAR; PG8_SCHED;
            PG8_STAGE(PG8_SB(1, 1), b3 + hstep, voffB);
            PG8_WAIT_V(6); PG8_BAR; PG8_MMA(1, 1, At, B1); PG8_BAR;
            }
        }
        if constexpr (ALIGN_EPI) { if (wr == 0) PG8_BAR; }
        if constexpr (!Epi::AFTER_DRAIN) { E(acc, cur, wr, wc, fr, fq); S.done(cur); }
        if (!has_next) break;
#pragma unroll
        for (int a = 0; a < 2; ++a)
#pragma unroll
            for (int b = 0; b < 2; ++b)
#pragma unroll
                for (int m = 0; m < 4; ++m)
#pragma unroll
                    for (int n = 0; n < 2; ++n) acc[a][b][m][n] = (f32x4){0.f, 0.f, 0.f, 0.f};
        cur = nxt; cA = nA; cB = nB; ++ui;
        if constexpr (ALIGN_EPI) { if (wr == 1) PG8_BAR; }
    }
    PG8_WAIT_V(0);
    if constexpr (!ALIGN_EPI) { if (wr == 0) PG8_BAR; }
    PG8_BAR;
    if constexpr (Epi::AFTER_DRAIN) { E.fused(acc, cur, wr, wc, fr, fq, lds, wid, lane); S.done(cur); }
#undef PG8_SA
#undef PG8_SB
#undef PG8_STAGE
#undef PG8_LDA
#undef PG8_LDB
#undef PG8_MMA
#undef PG8_WAIT_V
#undef PG8_WAIT_L
#undef PG8_BAR
#undef PG8_SCHED
}
}
#define LAS __attribute__((address_space(3)))
typedef unsigned short bf16_t;
typedef LAS unsigned char* ldsp;
typedef short bf16x8 __attribute__((ext_vector_type(8)));
typedef short s16x4 __attribute__((ext_vector_type(4)));
typedef float f32x16 __attribute__((ext_vector_type(16)));
typedef float f32x4 __attribute__((ext_vector_type(4)));
typedef float f32x2 __attribute__((ext_vector_type(2)));
typedef unsigned u32x4 __attribute__((ext_vector_type(4)));
typedef unsigned u32x2 __attribute__((ext_vector_type(2)));
typedef __bf16 bf16x2_t __attribute__((ext_vector_type(2)));
using pg8::ZLD; using pg8::MROWS; using pg8::NPROMPT; using pg8::LOG2E;
__device__ __forceinline__ int crow(int r, int hi) { return (r & 3) + 8 * (r >> 2) + 4 * hi; }
__device__ __forceinline__ unsigned cvtpk(float lo, float hi) { f32x2 v = {lo, hi}; bf16x2_t b = __builtin_convertvector(v, bf16x2_t); return __builtin_bit_cast(unsigned, b); }
__device__ __forceinline__ float bf_lo(unsigned w) { return __uint_as_float(w << 16); }
__device__ __forceinline__ float bf_hi(unsigned w) { return __uint_as_float(w & 0xffff0000u); }
__device__ __forceinline__ float xhalf_max(float m) { auto rr = __builtin_amdgcn_permlane32_swap(__float_as_uint(m), __float_as_uint(m), false, false); return fmaxf(__uint_as_float(rr[0]), __uint_as_float(rr[1])); }
__device__ __forceinline__ float xhalf_sum(float m) { auto rr = __builtin_amdgcn_permlane32_swap(__float_as_uint(m), __float_as_uint(m), false, false); return __uint_as_float(rr[0]) + __uint_as_float(rr[1]); }
__device__ __forceinline__ s16x4 vtr(ldsp p) { typedef short v4i16_t __attribute__((ext_vector_type(4))); return __builtin_bit_cast(s16x4, __builtin_amdgcn_ds_read_tr16_b64_v4i16((LAS v4i16_t*)p)); }
__device__ __forceinline__ float max3f(float a, float b, float c) { float r; asm("v_max3_f32 %0, %1, %2, %3" : "=v"(r) : "v"(a), "v"(b), "v"(c)); return r; }
__device__ __forceinline__ float max2f(float a, float b) { float r; asm("v_max_f32_e32 %0, %1, %2" : "=v"(r) : "v"(a), "v"(b)); return r; }
__device__ __forceinline__ float sum8_s(float acc, float a, float b, float c, float d, float e, float f, float g, float h) {
    asm("s_nop 0\n\tv_add_f32_e32 %0, %0, %1\n\tv_add_f32_e32 %0, %0, %2\n\tv_add_f32_e32 %0, %0, %3\n\tv_add_f32_e32 %0, %0, %4\n\tv_add_f32_e32 %0, %0, %5\n\tv_add_f32_e32 %0, %0, %6\n\tv_add_f32_e32 %0, %0, %7\n\tv_add_f32_e32 %0, %0, %8"
        : "+v"(acc) : "v"(a), "v"(b), "v"(c), "v"(d), "v"(e), "v"(f), "v"(g), "v"(h));
    return acc; }
__device__ __forceinline__ float sum4_s(float acc, float a, float b, float c, float d) {
    asm("s_nop 0\n\tv_add_f32_e32 %0, %0, %1\n\tv_add_f32_e32 %0, %0, %2\n\tv_add_f32_e32 %0, %0, %3\n\tv_add_f32_e32 %0, %0, %4" : "+v"(acc) : "v"(a), "v"(b), "v"(c), "v"(d));
    return acc; }
__device__ __forceinline__ float fadd_s(float a, float b) { float r; asm("v_add_f32_e32 %0, %1, %2" : "=v"(r) : "v"(a), "v"(b)); return r; }
#define MFMA32(a, b, c) __builtin_amdgcn_mfma_f32_32x32x16_bf16((a), (b), (c), 0, 0, 0)

constexpr int KPITCH = 144, KT_BYTES = 64 * KPITCH, VT_BYTES = 8192, TILE_BYTES = KT_BYTES + VT_BYTES, BUF_BYTES = 2 * TILE_BYTES;
constexpr int COMB_OFF = 2 * BUF_BYTES, COMB_WAVE = 17408, TAB_OFF = COMB_OFF + 4 * COMB_WAVE, TAB_N = 640, TAB_DDMAX = 576, MISC_OFF = TAB_OFF + TAB_N * 4 + 16, LDS_BYTES = 147456;
static_assert(MISC_OFF + 64 <= LDS_BYTES, "LDS map");
constexpr float NEG_BIG = -1.0e30f, THR = 8.0f;
#ifndef REDO_LIMIT
#define REDO_LIMIT 256.0f
#endif
struct AU {
    const bf16_t* q; int nq; int nt, ntc; const float* kc; const float* vc; int cp; const bf16_t* kz; const bf16_t* vz; int lastv; int nqg;
    int tlo0, thi0, tlo1, thi1; int qpos0, kpos0; const bf16_t* gate; bf16_t* y; const float* tabsrc;
};
#ifndef ATTN_INL
#define ATTN_INL __forceinline__
#endif
template <int MODE  >
__device__ ATTN_INL void attn_unit(const AU& d, ldsp lds, float lam, int lsel, const float* subg) {
    constexpr bool WIDE = (MODE == 2), BIAS = (MODE != 0);
    constexpr int NMAP = (MODE == 1) ? 1 : 2, NSTEP = (MODE == 0) ? 2 : 4, NSUB = WIDE ? 2 : 1;
#define KC(MP) ((MODE == 0) ? (MP) * 32 : 0)
    int tid_ = threadIdx.x; asm volatile("" : "+v"(tid_));
    const int tid = tid_, lane = tid & 63, wid = __builtin_amdgcn_readfirstlane(tid >> 6), qg = WIDE ? wid : (wid & 3), ks = WIDE ? 0 : (wid >> 2), r32 = lane & 31, hi = lane >> 5;
    int tlo = (qg >> 1) ? d.tlo1 : d.tlo0; int thi = (qg >> 1) ? d.thi1 : d.thi0; if (qg >= d.nqg) thi = -1;
    if (WIDE) { thi = d.tlo0 + wid; tlo = max(thi - 8, 0); }
    const int qoff0 = WIDE ? 64 * wid : 32 * qg;
    const LAS float* tab = (const LAS float*)(lds + TAB_OFF);
    float tabv0 = 0.f, tabv1 = 0.f;
    if (BIAS) { tabv0 = d.tabsrc[min(max(TAB_DDMAX - tid, -128), 128) + 128]; if (tid + 512 < TAB_N) tabv1 = d.tabsrc[min(max(TAB_DDMAX - (tid + 512), -128), 128) + 128]; }
    bf16x8 qf[NMAP][NSTEP];
    const ldsp Qw = lds + COMB_OFF + wid * 8192;
    if (WIDE) {
        u32x4 qv_[8];
#pragma unroll
        for (int j = 0; j < 8; ++j) qv_[j] = *(const u32x4*)(d.q + (size_t)(qoff0 + lane) * ZLD + j * 8);
#pragma unroll
        for (int j = 0; j < 8; ++j) *(LAS u32x4*)(Qw + lane * 128 + ((j ^ (lane & 7)) * 16)) = qv_[j];
    }
#define QFRAG(MP, ST) (WIDE ? *(const LAS bf16x8*)(Qw + (32 * (MP) + r32) * 128 + ((((ST) * 2 + hi) ^ (r32 & 7)) * 16)) : qf[MP][ST])
#pragma unroll
    for (int mp = 0; mp < (WIDE ? 0 : NMAP); ++mp) { int qrow = qoff0 + r32; if (qrow >= d.nq) qrow = d.nq - 1;
      const bf16_t* qp = d.q + (size_t)qrow * ZLD;
#pragma unroll
      for (int st = 0; st < NSTEP; ++st) qf[mp][st] = *(const bf16x8*)(qp + KC(mp) + st * 16 + hi * 8); }
    f32x16 O[NMAP][2]; float mref[NMAP], lsum[NMAP];
#pragma unroll
    for (int mp = 0; mp < NMAP; ++mp) { mref[mp] = 0.f; lsum[mp] = 0.f;
#pragma unroll
        for (int db = 0; db < 2; ++db)
#pragma unroll
            for (int i = 0; i < 16; ++i) O[mp][db][i] = 0.f; }
    const int lrow = tid >> 3, lch = tid & 7;
    const int kwoff = lrow * KPITCH + lch * 16, vwoff = (lch >> 2) * 4096 + lrow * 64 + (lch & 3) * 16;
    const int kroff = r32 * KPITCH + hi * 16;
    const int vroff = (4 * hi + ((lane & 15) >> 2)) * 64 + ((lane >> 4) & 1) * 32 + (lane & 3) * 8;
    u32x4 stK[2], stV[2];
    const int nit = (d.nt + 1) >> 1; bool started = false;
#define AT_ISSUE(IT) do { if (!WIDE) _Pragma("unroll") for (int i_ = 0; i_ < 2; ++i_) { const int t_ = 2 * (IT) + i_; if (t_ < d.nt && t_ >= d.ntc) { int r_ = lrow; if (t_ == d.nt - 1 && r_ >= d.lastv) r_ = d.lastv - 1; \
        const size_t off_ = ((size_t)(t_ - d.ntc) * 64 + r_) * ZLD + lch * 8; stK[i_] = *(const u32x4*)(d.kz + off_); stV[i_] = *(const u32x4*)(d.vz + off_); } } } while (0)
#define AT_WRITE(IT, BUF) do { _Pragma("unroll") for (int i_ = 0; i_ < 2; ++i_) { const int t_ = 2 * (IT) + i_; if (t_ < d.nt) { u32x4 kk_, vv_; if (WIDE) { const size_t off_ = ((size_t)t_ * 64 + lrow) * ZLD + lch * 8; kk_ = *(const u32x4*)(d.kz + off_); vv_ = *(const u32x4*)(d.vz + off_); } else if (t_ >= d.ntc) { kk_ = stK[i_]; vv_ = stV[i_]; } else { \
        const size_t off_ = ((size_t)t_ * 64 + lrow) * d.cp + lch * 8; const f32x4 a_ = *(const f32x4*)(d.kc + off_), b_ = *(const f32x4*)(d.kc + off_ + 4), c_ = *(const f32x4*)(d.vc + off_), e_ = *(const f32x4*)(d.vc + off_ + 4); \
        kk_ = (u32x4){cvtpk(a_[0], a_[1]), cvtpk(a_[2], a_[3]), cvtpk(b_[0], b_[1]), cvtpk(b_[2], b_[3])}; vv_ = (u32x4){cvtpk(c_[0], c_[1]), cvtpk(c_[2], c_[3]), cvtpk(e_[0], e_[1]), cvtpk(e_[2], e_[3])}; } \
        *(LAS u32x4*)((BUF) + i_ * TILE_BYTES + kwoff) = kk_; *(LAS u32x4*)((BUF) + i_ * TILE_BYTES + KT_BYTES + vwoff) = vv_; } } } while (0)
    unsigned pf_dummy = 0;
    const int pf_tile = tid >> 8, pf_v = (tid >> 7) & 1, pf_row = (tid >> 1) & 63, pf_line = tid & 1;
#define AT_TOUCH(IT) do { const int t_ = 2 * (IT) + pf_tile; if (t_ < d.ntc) { const float* p_ = (pf_v ? d.vc : d.kc) + ((size_t)t_ * 64 + pf_row) * d.cp + pf_line * 32; \
        asm volatile("global_load_dword %0, %1, off" : "=v"(pf_dummy) : "v"(p_) : "memory"); } } while (0)
    if (d.ntc > 0) { AT_TOUCH(1); AT_TOUCH(2); }
    AT_ISSUE(0);
    if (BIAS) { ((LAS float*)(lds + TAB_OFF))[tid] = tabv0 * LOG2E; if (tid + 512 < TAB_N) ((LAS float*)(lds + TAB_OFF))[tid + 512] = tabv1 * LOG2E; }
    for (int it = 0; it < nit; ++it) {
        const ldsp buf = lds + (it & 1) * BUF_BYTES;
        AT_WRITE(it, buf);
        __builtin_amdgcn_s_waitcnt(0); asm volatile("" : "+v"(pf_dummy));
        __syncthreads();
#pragma nounroll
        for (int sub = 0; sub < NSUB; ++sub) {
        const int t = 2 * it + (WIDE ? sub : ks);
        const bool vis = (t >= tlo && t <= thi);
        const ldsp Kt = buf + (WIDE ? sub : ks) * TILE_BYTES, Vt = Kt + KT_BYTES;
        bf16x8 kf0[2 * NSTEP];
        if (vis) {
#pragma unroll
            for (int st = 0; st < (WIDE ? 2 : NSTEP); ++st) { kf0[2 * st] = *(const LAS bf16x8*)(Kt + kroff + (st * 16) * 2); kf0[2 * st + 1] = *(const LAS bf16x8*)(Kt + kroff + 32 * KPITCH + (st * 16) * 2); }
        }
        __builtin_amdgcn_sched_barrier(0);
        if (sub == 0 && it + 1 < nit) AT_ISSUE(it + 1);
        if (sub == 0 && d.ntc > 0) AT_TOUCH(it + 3);
        __builtin_amdgcn_sched_barrier(0);
        if (vis) {
            const int valid = (t == d.nt - 1) ? d.lastv : 64;
            f32x16 S0[NMAP], S1[NMAP];
#define AT_BIAS(MP) do { const int qb_ = d.qpos0 + qoff0 + (WIDE ? 32 * (MP) : 0), kp0_ = d.kpos0 + 64 * t; \
                if (qb_ - (kp0_ + 63) >= 128) { const float c_ = tab[TAB_DDMAX - 128]; _Pragma("unroll") for (int i = 0; i < 16; ++i) { S0[MP][i] += c_; S1[MP][i] += c_; } } \
                else { int j0_ = TAB_DDMAX - (qb_ + r32 - kp0_ - 4 * hi); asm volatile("" : "+v"(j0_)); const LAS float* tb_ = tab + j0_; \
                    _Pragma("unroll") for (int i = 0; i < 16; ++i) { S0[MP][i] += tb_[(i & 3) + 8 * (i >> 2)]; S1[MP][i] += tb_[(i & 3) + 8 * (i >> 2) + 32]; } } } while (0)
#define AT_QK(MP) do { f32x16 negm_; _Pragma("unroll") for (int i = 0; i < 16; ++i) negm_[i] = -mref[MP]; \
                _Pragma("unroll") for (int st = 0; st < NSTEP; ++st) { \
                    const bf16x8 a0_ = *(const LAS bf16x8*)(Kt + kroff + (KC(MP) + st * 16) * 2); \
                    const bf16x8 a1_ = *(const LAS bf16x8*)(Kt + kroff + 32 * KPITCH + (KC(MP) + st * 16) * 2); \
                    if (st == 0) { S0[MP] = MFMA32(a0_, QFRAG(MP, st), negm_); S1[MP] = MFMA32(a1_, QFRAG(MP, st), negm_); } \
                    else { S0[MP] = MFMA32(a0_, QFRAG(MP, st), S0[MP]); S1[MP] = MFMA32(a1_, QFRAG(MP, st), S1[MP]); } } \
                if (BIAS) AT_BIAS(MP); \
                if (0) { const int qpos = d.qpos0 + 32 * qg + r32, kp0 = d.kpos0 + 64 * t; \
                    if (d.qpos0 + 32 * qg - (kp0 + 63) >= 128) { const float c = tab[256]; _Pragma("unroll") for (int i = 0; i < 16; ++i) { S0[MP][i] += c; S1[MP][i] += c; } } \
                    else { _Pragma("unroll") for (int i = 0; i < 16; ++i) { int dd = qpos - (kp0 + crow(i, hi)); int d0 = min(max(dd, -128), 128), d1 = min(max(dd - 32, -128), 128); S0[MP][i] += tab[d0 + 128]; S1[MP][i] += tab[d1 + 128]; } } } \
                if (valid < 64) { _Pragma("unroll") for (int i = 0; i < 16; ++i) { const int k = crow(i, hi); if (k >= valid) S0[MP][i] = NEG_BIG; if (k + 32 >= valid) S1[MP][i] = NEG_BIG; } } } while (0)
#define AT_SLOW(MP) do { asm volatile("s_nop 15\n\ts_nop 7" : "+v"(S0[MP]), "+v"(S1[MP])); \
                float ra_ = max3f(S0[MP][0], S0[MP][1], S1[MP][0]), rb_ = max3f(S0[MP][2], S0[MP][3], S1[MP][1]); ra_ = max3f(ra_, S1[MP][2], S1[MP][3]); \
                _Pragma("unroll") for (int i = 4; i < 16; i += 4) { ra_ = max3f(ra_, S0[MP][i], S0[MP][i + 1]); rb_ = max3f(rb_, S0[MP][i + 2], S0[MP][i + 3]); ra_ = max3f(ra_, S1[MP][i], S1[MP][i + 1]); rb_ = max3f(rb_, S1[MP][i + 2], S1[MP][i + 3]); } \
                const float rm_ = xhalf_max(max2f(ra_, rb_)); \
                const float dl_ = started ? fmaxf(rm_, 0.f) : rm_, al_ = started ? __builtin_amdgcn_exp2f(-dl_) : 1.f; \
                mref[MP] += dl_; lsum[MP] *= al_; \
                _Pragma("unroll") for (int i = 0; i < 16; ++i) { S0[MP][i] -= dl_; S1[MP][i] -= dl_; } \
                _Pragma("unroll") for (int db = 0; db < 2; ++db) _Pragma("unroll") for (int i = 0; i < 16; ++i) O[MP][db][i] *= al_; } while (0)
#define AT_EXPSUM(MP) do { sa = 0.f; sb = 0.f; \
                _Pragma("unroll") for (int i = 0; i < 16; ++i) { S0[MP][i] = __builtin_amdgcn_exp2f(S0[MP][i]); S1[MP][i] = __builtin_amdgcn_exp2f(S1[MP][i]); } \
                _Pragma("unroll") for (int i = 0; i < 16; i += 8) { sa = sum8_s(sa, S0[MP][i], S0[MP][i + 1], S0[MP][i + 2], S0[MP][i + 3], S0[MP][i + 4], S0[MP][i + 5], S0[MP][i + 6], S0[MP][i + 7]); \
                    sb = sum8_s(sb, S1[MP][i], S1[MP][i + 1], S1[MP][i + 2], S1[MP][i + 3], S1[MP][i + 4], S1[MP][i + 5], S1[MP][i + 6], S1[MP][i + 7]); } } while (0)
#define AT_CVT(MP) do { _Pragma("unroll") for (int s_ = 0; s_ < 2; ++s_) { \
                u32x4 w0_ = {cvtpk(S0[MP][8 * s_], S0[MP][8 * s_ + 1]), cvtpk(S0[MP][8 * s_ + 2], S0[MP][8 * s_ + 3]), cvtpk(S0[MP][8 * s_ + 4], S0[MP][8 * s_ + 5]), cvtpk(S0[MP][8 * s_ + 6], S0[MP][8 * s_ + 7])}; \
                u32x4 w1_ = {cvtpk(S1[MP][8 * s_], S1[MP][8 * s_ + 1]), cvtpk(S1[MP][8 * s_ + 2], S1[MP][8 * s_ + 3]), cvtpk(S1[MP][8 * s_ + 4], S1[MP][8 * s_ + 5]), cvtpk(S1[MP][8 * s_ + 6], S1[MP][8 * s_ + 7])}; \
                Pf[s_] = __builtin_bit_cast(bf16x8, w0_); Pf[2 + s_] = __builtin_bit_cast(bf16x8, w1_); } } while (0)
#define AT_VF(J) ({ const s16x4 lo_ = vfr[2 * (J)], hh_ = vfr[2 * (J) + 1]; (bf16x8){lo_[0], lo_[1], lo_[2], lo_[3], hh_[0], hh_[1], hh_[2], hh_[3]}; })
#define AT_VLOAD() do { _Pragma("unroll") for (int j_ = 0; j_ < 8; ++j_) { vfr[2 * j_] = vtr(Vt + vroff + (j_ & 1) * 4096 + (j_ >> 1) * 1024); vfr[2 * j_ + 1] = vtr(Vt + vroff + (j_ & 1) * 4096 + (j_ >> 1) * 1024 + 512); } } while (0)
#define SBAR() __builtin_amdgcn_sched_barrier(0)
            float sa, sb; bf16x8 Pf[4]; s16x4 vfr[16];
            { f32x16 negm_;
#pragma unroll
              for (int i = 0; i < 16; ++i) negm_[i] = -mref[0];
#pragma unroll
              for (int st = 0; st < NSTEP; ++st) {
                  const bf16x8 q_ = QFRAG(0, st);
                  const bf16x8 ka_ = (WIDE && st >= 2) ? *(const LAS bf16x8*)(Kt + kroff + (st * 16) * 2) : kf0[2 * st], kb_ = (WIDE && st >= 2) ? *(const LAS bf16x8*)(Kt + kroff + 32 * KPITCH + (st * 16) * 2) : kf0[2 * st + 1];
                  if (st == 0) { S0[0] = MFMA32(ka_, q_, negm_); S1[0] = MFMA32(kb_, q_, negm_); }
                  else { S0[0] = MFMA32(ka_, q_, S0[0]); S1[0] = MFMA32(kb_, q_, S1[0]); } }
              if (BIAS) AT_BIAS(0);
              if (0) { const int qpos = d.qpos0 + 32 * qg + r32, kp0 = d.kpos0 + 64 * t;
                  if (d.qpos0 + 32 * qg - (kp0 + 63) >= 128) { const float c = tab[256];
#pragma unroll
                      for (int i = 0; i < 16; ++i) { S0[0][i] += c; S1[0][i] += c; } }
                  else {
#pragma unroll
                      for (int i = 0; i < 16; ++i) { int dd = qpos - (kp0 + crow(i, hi)); int d0 = min(max(dd, -128), 128), d1 = min(max(dd - 32, -128), 128); S0[0][i] += tab[d0 + 128]; S1[0][i] += tab[d1 + 128]; } } }
              if (valid < 64) {
#pragma unroll
                  for (int i = 0; i < 16; ++i) { const int k = crow(i, hi); if (k >= valid) S0[0][i] = NEG_BIG; if (k + 32 >= valid) S1[0][i] = NEG_BIG; } } }
            if (!started) AT_SLOW(0);
            if (NMAP == 2) {
                constexpr int M1 = NMAP - 1;
                bf16x8 kf1[4]; f32x16 negm1; bf16x8 wka = kf1[0], wkb = kf1[0];
                bf16x8 wq = wka;
                if (WIDE) { wka = *(const LAS bf16x8*)(Kt + kroff); wkb = *(const LAS bf16x8*)(Kt + kroff + 32 * KPITCH); wq = QFRAG(M1, 0); }
                if (!WIDE) {
#pragma unroll
                for (int st = 0; st < 2; ++st) { kf1[2 * st] = *(const LAS bf16x8*)(Kt + kroff + (32 + st * 16) * 2); kf1[2 * st + 1] = *(const LAS bf16x8*)(Kt + kroff + 32 * KPITCH + (32 + st * 16) * 2); } }
#pragma unroll
                for (int i = 0; i < 16; ++i) negm1[i] = -mref[M1];
                sa = 0.f; sb = 0.f;
                SBAR();
#pragma unroll
                for (int g = 0; g < 4; ++g) {
                    if (WIDE) {
                        bf16x8 na_ = wka, nb_ = wkb;
                        if (g < 3) { na_ = *(const LAS bf16x8*)(Kt + kroff + ((g + 1) * 16) * 2); nb_ = *(const LAS bf16x8*)(Kt + kroff + 32 * KPITCH + ((g + 1) * 16) * 2); }
                        bf16x8 nq_ = wq;
                        if (g < 3) nq_ = QFRAG(M1, (g + 1) % NSTEP);
                        if (g == 0) { S0[M1] = MFMA32(wka, wq, negm1); S1[M1] = MFMA32(wkb, wq, negm1); }
                        else { S0[M1] = MFMA32(wka, wq, S0[M1]); S1[M1] = MFMA32(wkb, wq, S1[M1]); }
                        wka = na_; wkb = nb_; wq = nq_;
                    } else {
                    if (g == 0) S0[M1] = MFMA32(kf1[0], qf[M1][0], negm1); else if (g == 1) S1[M1] = MFMA32(kf1[1], qf[M1][0], negm1);
                    else if (g == 2) S0[M1] = MFMA32(kf1[2], qf[M1][1], S0[M1]); else S1[M1] = MFMA32(kf1[3], qf[M1][1], S1[M1]); }
                    SBAR();
#pragma unroll
                    for (int i = 4 * g; i < 4 * g + 4; ++i) { S0[0][i] = __builtin_amdgcn_exp2f(S0[0][i]); S1[0][i] = __builtin_amdgcn_exp2f(S1[0][i]); }
                    if (g & 1) sb = sum8_s(sb, S0[0][4 * g], S0[0][4 * g + 1], S0[0][4 * g + 2], S0[0][4 * g + 3], S1[0][4 * g], S1[0][4 * g + 1], S1[0][4 * g + 2], S1[0][4 * g + 3]);
                    else sa = sum8_s(sa, S0[0][4 * g], S0[0][4 * g + 1], S0[0][4 * g + 2], S0[0][4 * g + 3], S1[0][4 * g], S1[0][4 * g + 1], S1[0][4 * g + 2], S1[0][4 * g + 3]);
                    SBAR();
                }
                if (WIDE) AT_BIAS(M1);
                if (valid < 64) {
#pragma unroll
                    for (int i = 0; i < 16; ++i) { const int k = crow(i, hi); if (k >= valid) S0[M1][i] = NEG_BIG; if (k + 32 >= valid) S1[M1][i] = NEG_BIG; } }
            } else AT_EXPSUM(0);
            if (started && __any(!(sa + sb <= REDO_LIMIT))) { AT_QK(0); AT_SLOW(0); AT_EXPSUM(0); }
            lsum[0] += sa + sb;
            AT_VLOAD();
            AT_CVT(0);
            if (NMAP == 2) {
                constexpr int M1 = NMAP - 1;
                if (!started) AT_SLOW(M1);
                sa = 0.f; sb = 0.f;
                SBAR();
#pragma unroll
                for (int j = 0; j < 8; ++j) {
                    O[0][j & 1] = MFMA32(AT_VF(j), Pf[j >> 1], O[0][j & 1]);
                    SBAR();
                    S0[M1][2 * j] = __builtin_amdgcn_exp2f(S0[M1][2 * j]); S0[M1][2 * j + 1] = __builtin_amdgcn_exp2f(S0[M1][2 * j + 1]);
                    S1[M1][2 * j] = __builtin_amdgcn_exp2f(S1[M1][2 * j]); S1[M1][2 * j + 1] = __builtin_amdgcn_exp2f(S1[M1][2 * j + 1]);
                    if (j & 1) sb = sum4_s(sb, S0[M1][2 * j], S0[M1][2 * j + 1], S1[M1][2 * j], S1[M1][2 * j + 1]); else sa = sum4_s(sa, S0[M1][2 * j], S0[M1][2 * j + 1], S1[M1][2 * j], S1[M1][2 * j + 1]);
                    SBAR();
                }
                if (started && __any(!(sa + sb <= REDO_LIMIT))) { AT_QK(M1); AT_SLOW(M1); AT_EXPSUM(M1); }
                lsum[M1] += sa + sb;
#pragma unroll
                for (int k = 0; k < 4; ++k) {
                    const f32x16& sx = (k < 2) ? S0[M1] : S1[M1]; const int b = 8 * (k & 1);
                    const u32x4 w_ = {cvtpk(sx[b], sx[b + 1]), cvtpk(sx[b + 2], sx[b + 3]), cvtpk(sx[b + 4], sx[b + 5]), cvtpk(sx[b + 6], sx[b + 7])};
                    Pf[k] = __builtin_bit_cast(bf16x8, w_);
                    SBAR();
                    O[M1][0] = MFMA32(AT_VF(2 * k), Pf[k], O[M1][0]); O[M1][1] = MFMA32(AT_VF(2 * k + 1), Pf[k], O[M1][1]);
                    SBAR();
                }
            } else {
#pragma unroll
                for (int j = 0; j < 8; ++j) O[0][j & 1] = MFMA32(AT_VF(j), Pf[j >> 1], O[0][j & 1]);
            }
#undef AT_SLOW
#undef AT_EXPSUM
#undef AT_CVT
#undef AT_VF
#undef AT_VLOAD
#undef SBAR
#undef AT_BIAS
            started = true;
#undef AT_QK
        }
        }
    }
#undef AT_ISSUE
#undef AT_TOUCH
#undef AT_WRITE
    __syncthreads();
    if (!started) {
#pragma unroll
        for (int mp = 0; mp < NMAP; ++mp) mref[mp] = NEG_BIG;
    }
    u32x2 gpre[8];
    if (MODE == 1 && ks == 0 && qg < d.nqg) { const int row_ = min(32 * qg + r32, d.nq - 1);
#pragma unroll
        for (int j = 0; j < 8; ++j) gpre[j] = *(const u32x2*)(d.gate + (size_t)row_ * ZLD + 32 * (j >> 2) + 8 * (j & 3) + 4 * hi); }
    const ldsp cw = lds + COMB_OFF + qg * COMB_WAVE;
    if (!WIDE && ks == 1 && qg < d.nqg) {
#pragma unroll
        for (int mp = 0; mp < NMAP; ++mp) {
#pragma unroll
            for (int db = 0; db < 2; ++db)
#pragma unroll
                for (int i = 0; i < 16; ++i) *(LAS float*)(cw + ((mp * 2 + db) * 16 + i) * 256 + lane * 4) = O[mp][db][i];
            *(LAS float*)(cw + 16384 + (mp * 2) * 256 + lane * 4) = mref[mp]; *(LAS float*)(cw + 16384 + (mp * 2 + 1) * 256 + lane * 4) = lsum[mp];
        }
    }
    __syncthreads();
    if (WIDE) {
#pragma unroll
        for (int mp = 0; mp < NMAP; ++mp) {
            const float fin = 1.0f / xhalf_sum(lsum[mp]); const int row = qoff0 + 32 * mp + r32;
#pragma unroll
            for (int db = 0; db < 2; ++db)
#pragma unroll
                for (int g4 = 0; g4 < 4; ++g4) {
                    const int d0 = 32 * db + 8 * g4 + 4 * hi;
                    const u32x2 gw = *(const u32x2*)(d.gate + (size_t)row * ZLD + d0);
                    const float y0 = O[mp][db][4 * g4] * fin * bf_lo(gw.x), y1 = O[mp][db][4 * g4 + 1] * fin * bf_hi(gw.x), y2 = O[mp][db][4 * g4 + 2] * fin * bf_lo(gw.y), y3 = O[mp][db][4 * g4 + 3] * fin * bf_hi(gw.y);
                    *(u32x2*)(d.y + (size_t)row * 1024 + d0) = (u32x2){cvtpk(y0, y1), cvtpk(y2, y3)};
                }
        }
    } else
    if (ks == 0 && qg < d.nqg) {
        float linv[NMAP];
#pragma unroll
        for (int mp = 0; mp < NMAP; ++mp) {
            const float mb = *(const LAS float*)(cw + 16384 + (mp * 2) * 256 + lane * 4), lb = *(const LAS float*)(cw + 16384 + (mp * 2 + 1) * 256 + lane * 4);
            const float mt = fmaxf(mref[mp], mb), aa = __builtin_amdgcn_exp2f(mref[mp] - mt), ab = __builtin_amdgcn_exp2f(mb - mt);
            const float l = xhalf_sum(lsum[mp] * aa + lb * ab);
            linv[mp] = 1.0f / l;
#pragma unroll
            for (int db = 0; db < 2; ++db)
#pragma unroll
                for (int i = 0; i < 16; ++i) O[mp][db][i] = O[mp][db][i] * aa + *(const LAS float*)(cw + ((mp * 2 + db) * 16 + i) * 256 + lane * 4) * ab;
        }
        float fin = 1.f;
        if (MODE == 0) {
            const float i1 = linv[0], i2 = lam * linv[NMAP - 1]; float ss = 0.f;
#pragma unroll
            for (int db = 0; db < 2; ++db)
#pragma unroll
                for (int i = 0; i < 16; ++i) { const float o = O[0][db][i] * i1 - O[NMAP - 1][db][i] * i2; O[0][db][i] = o; ss += o * o; }
            ss = xhalf_sum(ss);
            int sel_ = lsel; asm volatile("" : "+s"(sel_));
            fin = __builtin_amdgcn_rsqf(ss * (1.0f / 64.0f) + 1e-5f) * ((sel_ == 0) ? 0.8f : 0.6444909324090307f);
        } else fin = linv[0];
        const int row = 32 * qg + r32;
        if (row < d.nq) {
#pragma unroll
            for (int db = 0; db < 2; ++db)
#pragma unroll
                for (int g4 = 0; g4 < 4; ++g4) {
                    const int d0 = 32 * db + 8 * g4 + 4 * hi;
                    const u32x2 gw = (MODE == 1) ? gpre[db * 4 + g4] : *(const u32x2*)(d.gate + (size_t)row * ZLD + d0);
                    f32x4 sg = {1.f, 1.f, 1.f, 1.f}; if (MODE == 0) sg = *(const f32x4*)(subg + d0);
                    const float y0 = O[0][db][4 * g4] * fin * sg[0] * bf_lo(gw.x), y1 = O[0][db][4 * g4 + 1] * fin * sg[1] * bf_hi(gw.x);
                    const float y2 = O[0][db][4 * g4 + 2] * fin * sg[2] * bf_lo(gw.y), y3 = O[0][db][4 * g4 + 3] * fin * sg[3] * bf_hi(gw.y);
                    *(u32x2*)(d.y + (size_t)row * 1024 + d0) = (u32x2){cvtpk(y0, y1), cvtpk(y2, y3)};
                }
        }
    }
}
#undef KC
#undef QFRAG
using namespace pg8;
#ifndef P1_ALIGN
#define P1_ALIGN true
#endif
constexpr size_t WS_CTL = WSO_CTL, CTL_BYTES = 1u << 20, WS_SSQ0 = WSO_SSQ0, WS_ROPE = WSO_ROPE, WS_WIN = WSO_WIN, WS_WOUT = WSO_WOUT, WS_XB = WSO_XB, WS_YMIX = WSO_YMIX, WS_X1 = WSO_X1, WS_Z = WSO_Z, WS_END = WSO_END;
static_assert((size_t)MROWS * 1024 * 2 <= 36u * (1u << 20) && (size_t)MROWS * 1024 * 4 <= 68u * (1u << 20) && (size_t)MROWS * 4096 * 2 <= 132u * (1u << 20), "ws map");
constexpr int CTL_Q0 = 0, CTL_SI = 64, CTL_SM = 128, CTL_SSQ1 = 16384, CTL_SSQ2 = 16384 + 32768;
static_assert((CTL_SSQ2 + MROWS) * 4 <= (int)CTL_BYTES, "ctl");
constexpr size_t O_Y = OO_Y, O_CONVP = OO_CONVP, O_CONVS = OO_CONVS, O_END = OO_END;
struct Args { const float* in[18]; float* out; unsigned char* ws; };

__device__ __forceinline__ float wave_sum(float v) {
#pragma unroll
    for (int o = 1; o < 64; o <<= 1) v += __shfl_xor(v, o);
    return v;
}
__device__ __forceinline__ unsigned f2bf(float f) { unsigned u = __builtin_bit_cast(unsigned, f); return (u + 0x7fffu + ((u >> 16) & 1u)) >> 16; }
__device__ __forceinline__ unsigned pk2(float lo, float hi) { return f2bf(lo) | (f2bf(hi) << 16); }
__device__ __forceinline__ void p0_transpose_item(const float* W, const float* g, int K, int N, bf16_t* WT, LAS float* scr, int item, int lane) {
    const int nblk = N / 32, kb = item / nblk, nb = item % nblk, k0 = 64 * kb, n0 = 32 * nb;
#pragma unroll 8
    for (int i = 0; i < 32; ++i) { const int kk = 2 * i + (lane >> 5); const float gs = g ? g[k0 + kk] : 1.f; scr[kk * 33 + (lane & 31)] = W[(size_t)(k0 + kk) * N + n0 + (lane & 31)] * gs; }
    asm volatile("s_waitcnt lgkmcnt(0)" ::: "memory");
    const int c = lane & 7;
#pragma unroll
    for (int j = 0; j < 4; ++j) { const int n = (lane >> 3) + 8 * j; const LAS float* s = scr + (8 * c) * 33 + n;
        u32x4 o; o.x = pk2(s[0 * 33], s[1 * 33]); o.y = pk2(s[2 * 33], s[3 * 33]); o.z = pk2(s[4 * 33], s[5 * 33]); o.w = pk2(s[6 * 33], s[7 * 33]);
        *(u32x4*)(WT + (size_t)(n0 + n) * K + k0 + 8 * c) = o; }
    asm volatile("s_waitcnt lgkmcnt(0)" ::: "memory");
}

#define XB_TMO      128
#define XB_XCNT(j)  (256  + 64 * (j))
#define XB_XSUB(j)  (1280 + 64 * (j))
#define XB_XGEN(j)  (2304 + 64 * (j))
#define XB_TOP      3328
#define XB_TOPGEN   3392
#define XCD_BAR_WORDS 3456
#define XB_SPIN_CAP (1u << 18)

__device__ __forceinline__ unsigned xb_ld(unsigned* p)              { return __hip_atomic_load(p, __ATOMIC_RELAXED, __HIP_MEMORY_SCOPE_AGENT); }
__device__ __forceinline__ unsigned xb_add(unsigned* p, unsigned v) { return __hip_atomic_fetch_add(p, v, __ATOMIC_RELAXED, __HIP_MEMORY_SCOPE_AGENT); }
__device__ __forceinline__ unsigned xb_xcc_id() { return (unsigned)__builtin_amdgcn_s_getreg((3 << 11) | 20) & 0xFu; }
#define XB_SPIN(cond, bar) do { unsigned _sp = 0; while (cond) { __builtin_amdgcn_s_sleep(1); \
    if ((++_sp & 255u) == 0u) { if (xb_ld(&(bar)[XB_TMO])) break; if (_sp > XB_SPIN_CAP) { atomicAdd(&(bar)[XB_TMO], 1u); break; } } } } while (0)

struct XcdBarrier {
    unsigned* bar; unsigned x;
    volatile LAS unsigned* st;
};

__device__ __forceinline__ XcdBarrier xcd_barrier_post(unsigned* bar, volatile LAS unsigned* st) {
    XcdBarrier b; b.bar = bar; b.x = xb_xcc_id(); b.st = st;
    if (threadIdx.x == 0) (void)xb_add(&bar[XB_XCNT(b.x)], 1u);
    return b;
}
__device__ __forceinline__ void xcd_barrier_complete(unsigned* bar, unsigned x, unsigned& nloc, unsigned& nx) {
    const unsigned G = gridDim.x * gridDim.y * gridDim.z;
    unsigned sum, cnt, mine, sp = 0u;
    for (;;) {
        sum = 0u; cnt = 0u; mine = 0u;
#pragma unroll
        for (unsigned j = 0; j < 16; ++j) { const unsigned c = xb_ld(&bar[XB_XCNT(j)]); sum += c; cnt += (c > 0u) ? 1u : 0u; mine = (j == x) ? c : mine; }
        if (sum == G) break;
        __builtin_amdgcn_s_sleep(1);
        if ((++sp & 255u) == 0u) { if (xb_ld(&bar[XB_TMO])) break; if (sp > XB_SPIN_CAP) { atomicAdd(&bar[XB_TMO], 1u); break; } }
    }
    nloc = mine > 0u ? mine : 1u; nx = cnt > 0u ? cnt : 1u;
}

__device__ __forceinline__ void xcd_barrier(const XcdBarrier& b) {
    asm volatile("s_waitcnt vmcnt(0)" ::: "memory");
    __syncthreads();
    if (threadIdx.x == 0) {
        unsigned* bar = b.bar;
        __builtin_amdgcn_s_waitcnt(0);
        unsigned nloc = b.st[0], nx = b.st[1];
        if (nloc == 0u) { xcd_barrier_complete(bar, b.x, nloc, nx); b.st[0] = nloc; b.st[1] = nx; }
        const unsigned old = xb_add(&bar[XB_XSUB(b.x)], 1u);
        const unsigned gen = old / nloc;
        if (old + 1u == (gen + 1u) * nloc) {
            __builtin_amdgcn_fence(__ATOMIC_RELEASE, "agent");
            asm volatile("s_waitcnt vmcnt(0)" ::: "memory");
            const unsigned og = xb_add(&bar[XB_TOP], 1u);
            const unsigned tg = og / nx;
            if (og + 1u == (tg + 1u) * nx) xb_add(&bar[XB_TOPGEN], 1u);
            else XB_SPIN(xb_ld(&bar[XB_TOPGEN]) == tg, bar);
            __builtin_amdgcn_fence(__ATOMIC_ACQUIRE, "agent");
            xb_add(&bar[XB_XGEN(b.x)], 1u);
            asm volatile("s_waitcnt vmcnt(0)" ::: "memory");
        } else {
            XB_SPIN(xb_ld(&bar[XB_XGEN(b.x)]) == gen, bar);
            __builtin_amdgcn_fence(__ATOMIC_ACQUIRE, "agent");
            asm volatile("s_waitcnt vmcnt(0)" ::: "memory");
        }
    }
    __syncthreads();
}

constexpr int CTL_XBAR = 8192;
static_assert(CTL_XBAR + XCD_BAR_WORDS <= CTL_SSQ1, "ctl map");

__global__ void __launch_bounds__(512) fwd_megakernel(Args args) {
    extern __shared__ __attribute__((aligned(16))) unsigned char lds_raw[];
    cg::grid_group grid = cg::this_grid();
    const ldsp lds = (ldsp)lds_raw;
    const int tid = threadIdx.x, lane = tid & 63, wave = __builtin_amdgcn_readfirstlane(tid >> 6);
    const int G = gridDim.x, bx = blockIdx.x;
    unsigned char* ws = args.ws; float* out = args.out;
    unsigned* ctl = (unsigned*)(ws + WS_CTL);
    float* SSQ0 = (float*)(ws + WS_SSQ0); float* SSQ1 = (float*)ctl + CTL_SSQ1; float* SSQ2 = (float*)ctl + CTL_SSQ2;
    float* ROPE = (float*)(ws + WS_ROPE);
    bf16_t* WIN = (bf16_t*)(ws + WS_WIN); bf16_t* WOUT = (bf16_t*)(ws + WS_WOUT);
    bf16_t* XB = (bf16_t*)(ws + WS_XB); bf16_t* YMIX = (bf16_t*)(ws + WS_YMIX); float* X1 = (float*)(ws + WS_X1); bf16_t* Z = (bf16_t*)(ws + WS_Z);
    const float* x_p = args.in[0]; const float* x_s = args.in[1];
    volatile LAS unsigned* xb_st = (volatile LAS unsigned*)(lds + MISC_OFF + 16);
    if (tid < 2) xb_st[tid] = 0u;
    __syncthreads();
    const XcdBarrier xbar = xcd_barrier_post(ctl + CTL_XBAR, xb_st);

    {
        LAS float* scr = (LAS float*)(lds + wave * 16384);
        const int gw = bx * 8 + wave, NGW = G * 8;
        constexpr int I_IN = (1024 / 64) * (4096 / 32), I_OUT = (1024 / 64) * (1024 / 32), NITEMS = 2 * I_IN + 2 * I_OUT;
        for (int it = gw; it < NITEMS; it += NGW) {
            int r = it;
            if (r < 2 * I_IN) { const int l = r / I_IN; r -= l * I_IN; p0_transpose_item(args.in[8] + (size_t)l * 1024 * 4096, args.in[7] + l * 1024, 1024, 4096, WIN + (size_t)l * 4096 * 1024, scr, r, lane); }
            else { r -= 2 * I_IN; const int l = r / I_OUT; r -= l * I_OUT; p0_transpose_item(args.in[9] + (size_t)l * 1024 * 1024, nullptr, 1024, 1024, WOUT + (size_t)l * 1024 * 1024, scr, r, lane); }
        }
        for (int m = gw; m < MROWS; m += NGW) {
            const float* xr = (m < NPROMPT) ? x_p + (size_t)m * 1024 : x_s + (size_t)(m - NPROMPT) * 1024;
            f32x4 v[4]; float s = 0.f;
#pragma unroll
            for (int j = 0; j < 4; ++j) { v[j] = *((const f32x4*)xr + lane + 64 * j); s += (v[j][0] * v[j][0] + v[j][1] * v[j][1]) + (v[j][2] * v[j][2] + v[j][3] * v[j][3]); }
            s = wave_sum(s);
            if (lane == 0) SSQ0[m] = s;
#pragma unroll
            for (int j = 0; j < 4; ++j) *((u32x2*)(XB + (size_t)m * 1024) + lane + 64 * j) = (u32x2){cvtpk(v[j][0], v[j][1]), cvtpk(v[j][2], v[j][3])};
        }
        for (int e = bx * 512 + tid; e < MROWS * 4; e += G * 512) {
            const int row = e >> 2, i = e & 3; const int pos = (row < NPROMPT) ? row : 4096 + ((row - NPROMPT) & 15);
            const float invf = (i == 0) ? 1.0f : (i == 1 ? 0.037606030930863934f : (i == 2 ? 0.0014142135623730950f : 5.318295896944988e-05f));
            const float ang = (float)pos * invf;
            const double rev = (double)ang * 0.15915494309189535; const float fr = (float)(rev - __builtin_rint(rev));
            ROPE[(size_t)row * 8 + i] = __builtin_amdgcn_cosf(fr); ROPE[(size_t)row * 8 + 4 + i] = __builtin_amdgcn_sinf(fr);
        }
    }
    xcd_barrier(xbar);
    if (gridDim.x > 65535u) grid.sync();
#ifdef PROBE_SYNCX
    for (int i_ = 0; i_ < PROBE_SYNCX; ++i_) grid.sync();
#endif

    for (int l = 0; l < 2; ++l) {
        {
            pg8::Gemm g{XB, WIN + (size_t)l * 4096 * 1024, NPROMPT, 4096, 1024}; pg8::StaticOrder S; S.init(NPROMPT, 4096, G, bx);
            pg8::EpiIn E{ws, out, l};

#ifndef NO_GEMM1
            pg8::gemm_phase<pg8::EpiIn, pg8::StaticOrder, P1_ALIGN, true>(lds, g, S, E);
#ifdef PROBE_P1X
            if (l == 0) { grid.sync(); pg8::gemm_phase<pg8::EpiIn, pg8::StaticOrder, true, true>(lds, g, S, E); }
#endif
#endif

        }
        xcd_barrier(xbar);
        {
            const float lam_init = (l == 0) ? 0.2f : 0.35550906759096927f;
            float d1 = 0.f, d2 = 0.f;
            for (int i = 0; i < 32; ++i) { d1 += args.in[12][l * 32 + i] * args.in[13][l * 32 + i]; d2 += args.in[14][l * 32 + i] * args.in[15][l * 32 + i]; }
            const float lam = __int_as_float(__builtin_amdgcn_readfirstlane(__float_as_int(__expf(d1) - __expf(d2) + lam_init))), dummy_oml_ = 0.f; const int oml = l;
            const float* subg = args.in[16] + l * 64;
            volatile LAS int* misc = (volatile LAS int*)(lds + MISC_OFF);
            constexpr int N_SI = 16, N_PC = 512, N_SC = 64, N_PA = 1024, N_SA = 128, N_CV = 130, N_SO = 4, N_TOT = N_SI + N_PC + N_SC + N_PA + N_SA + N_CV + N_SO;
            constexpr unsigned N_SMIX = N_SC + N_SA + 2;
#ifndef PROBE_P2X
#define PROBE_P2X 1
#endif
            for (int rep = 0; rep < ((l == 0) ? PROBE_P2X : 1); ++rep) {
            if (rep > 0) grid.sync();
            for (;;) {
                __syncthreads();
                if (tid == 0) misc[0] = (int)atomicAdd(ctl + CTL_Q0 + l + 2 * rep, 1u);
                __syncthreads();
                int ui = misc[0]; ui = __builtin_amdgcn_readfirstlane(ui);
                if (ui >= N_TOT) break;
                AU d; d.tabsrc = nullptr; d.kc = nullptr; d.vc = nullptr; d.cp = 0; d.ntc = 0; d.lastv = 64; d.nqg = 4; d.tlo1 = 0; d.thi1 = -1; d.qpos0 = 0; d.kpos0 = 0;
                int kind;
                int idx = ui;
                if (idx < 16) kind = 5; else if (idx < 256) { kind = 0; idx -= 16; } else if (idx < 320) { kind = 1; idx -= 256; } else if (idx < 448) { kind = 3; idx -= 320; } else if (idx < 450) { kind = 4; idx = 128 + (idx - 448); }
                else if (idx < 454) { kind = 6; idx -= 450; } else if (idx < 726) { kind = 0; idx = 240 + (idx - 454); } else if (idx < 1750) { kind = 2; idx -= 726; } else { kind = 4; idx -= 1750; }
#ifdef PROBE_ONLY_KIND
                if (rep > 0 && kind != PROBE_ONLY_KIND) continue;
#endif
                if (rep > 0 && kind >= 5) continue;
                const bool smp_unit = (kind == 1 || kind == 3 || (kind == 4 && idx >= 128));
                if (smp_unit || kind == 6) {
                    if (tid == 0) {
                        unsigned* cnt = ctl + (kind == 6 ? CTL_SM : CTL_SI) + l; const unsigned want = (kind == 6) ? N_SMIX : (unsigned)N_SI;
                        while (__hip_atomic_load(cnt, __ATOMIC_RELAXED, __HIP_MEMORY_SCOPE_AGENT) < want) __builtin_amdgcn_s_sleep(8);
                        __builtin_amdgcn_fence(__ATOMIC_ACQUIRE, "agent");
                        asm volatile("s_waitcnt vmcnt(0)" ::: "memory");
                    }
                    __syncthreads();
                }
                if (kind >= 5) {
                    if (kind == 5) { pg8::Gemm g{XB, WIN + (size_t)l * 4096 * 1024, MROWS, 4096, 1024}; pg8::OneUnit S{64, idx}; pg8::EpiIn E{ws, out, l};
                        pg8::gemm_phase<pg8::EpiIn, pg8::OneUnit, false, true>(lds, g, S, E); }
                    else { pg8::Gemm g{YMIX, WOUT + (size_t)l * 1024 * 1024, MROWS, 1024, 1024}; pg8::OneUnit S{64, idx}; pg8::EpiOut E{ws, x_p, x_s, l, args.in[17], out};
                        pg8::gemm_phase<pg8::EpiOut, pg8::OneUnit, false, true>(lds, g, S, E); }
                }
                else if (kind == 0) {
                    const int u = 127 - (idx >> 2), h = idx & 3; const size_t r0 = (size_t)128 * u;
                    d.q = Z + r0 * ZLD + 3072 + 64 * h; d.nq = 128; d.nt = 2 * u + 2; d.kz = Z + 3328 + 64 * h; d.vz = Z + 3584 + 64 * h;
                    d.tlo0 = 0; d.thi0 = d.nt - 2; d.tlo1 = 0; d.thi1 = d.nt - 1; d.gate = Z + r0 * ZLD + 3840 + 64 * h; d.y = YMIX + r0 * 1024 + 768 + 64 * h;

#ifndef NO_ATTN0
                    attn_unit<0>(d, lds, lam, oml, subg);
#endif

                } else if (kind == 1) {
                    const int b = idx >> 2, h = idx & 3; const size_t r0 = (size_t)NPROMPT + 16 * b;
                    d.q = Z + r0 * ZLD + 3072 + 64 * h; d.nq = 16; d.nt = 65; d.ntc = 64; d.cp = 256;
                    d.kc = args.in[5] + ((size_t)(l * 16 + b) * 4096) * 256 + 64 * h; d.vc = args.in[6] + ((size_t)(l * 16 + b) * 4096) * 256 + 64 * h;
                    d.kz = Z + r0 * ZLD + 3328 + 64 * h; d.vz = Z + r0 * ZLD + 3584 + 64 * h; d.lastv = 16; d.nqg = 1; d.tlo0 = 0; d.thi0 = 64;
                    d.gate = Z + r0 * ZLD + 3840 + 64 * h; d.y = YMIX + r0 * 1024 + 768 + 64 * h;

#ifndef NO_ATTN0
                    attn_unit<0>(d, lds, lam, oml, subg);
#endif

                } else if (kind == 2 || kind == 3) {
                    int h;
                    if (kind == 2) {
                        h = idx & 7; const int cp = idx >> 3, c0 = max(0, 2 * cp - 8); const size_t r0 = (size_t)128 * cp;
                        d.q = Z + r0 * ZLD + 64 * h; d.nq = 128; d.nt = 2 * cp + 2 - c0; d.kz = Z + (size_t)64 * c0 * ZLD + 512 + 64 * h; d.vz = Z + (size_t)64 * c0 * ZLD + 1024 + 64 * h;
                        d.tlo0 = 0; d.thi0 = 2 * cp - c0; d.tlo1 = max(0, 2 * cp + 1 - 8) - c0; d.thi1 = 2 * cp + 1 - c0; d.qpos0 = 128 * cp; d.kpos0 = 64 * c0;
                        d.gate = Z + r0 * ZLD + 1536 + 64 * h; d.y = YMIX + r0 * 1024 + 64 * h;
                    } else {
                        h = idx & 7; const int b = idx >> 3; const size_t r0 = (size_t)NPROMPT + 16 * b;
                        d.q = Z + r0 * ZLD + 64 * h; d.nq = 16; d.nt = 9; d.ntc = 8; d.cp = 512;
                        d.kc = args.in[2] + ((size_t)(l * 16 + b) * 512) * 512 + 64 * h; d.vc = args.in[3] + ((size_t)(l * 16 + b) * 512) * 512 + 64 * h;
                        d.kz = Z + r0 * ZLD + 512 + 64 * h; d.vz = Z + r0 * ZLD + 1024 + 64 * h; d.lastv = 16; d.nqg = 1; d.tlo0 = 0; d.thi0 = 8; d.qpos0 = 512; d.kpos0 = 0;
                        d.gate = Z + r0 * ZLD + 1536 + 64 * h; d.y = YMIX + r0 * 1024 + 64 * h;
                    }
                    d.tabsrc = args.in[10] + (size_t)(l * 8 + h) * 257;

#ifndef NO_ATTN1
                    attn_unit<1>(d, lds, 0.f, 0, nullptr);
#endif

                } else {
                    int tq_ = threadIdx.x; asm volatile("" : "+v"(tq_));
                    const int c8 = (tq_ & 31) * 8, rr = tq_ >> 5;
                    const float* cw = args.in[11] + (size_t)l * 3 * 256 + c8;
                    float w0[8], w1[8], w2[8];
#pragma unroll
                    for (int j = 0; j < 8; ++j) { w0[j] = cw[j]; w1[j] = cw[256 + j]; w2[j] = cw[512 + j]; }
                    for (int g = 0; g < 8; ++g) {
                        const int row = 128 * idx + 16 * g + rr; const bool smp = row >= NPROMPT; const int t = smp ? ((row - NPROMPT) & 15) : row, b = (row - NPROMPT) >> 4;
                        const bf16_t* zr = Z + (size_t)row * ZLD;
                        float u0[8], u1[8], u2[8];
                        { const u32x4 c = *(const u32x4*)(zr + 2304 + c8), hh = *(const u32x4*)(zr + 2560 + c8);
#pragma unroll
                          for (int j = 0; j < 4; ++j) { u0[2 * j] = bf_lo(c[j]) * bf_lo(hh[j]); u0[2 * j + 1] = bf_hi(c[j]) * bf_hi(hh[j]); } }
                        if (t >= 1) { const u32x4 c = *(const u32x4*)(zr - ZLD + 2304 + c8), hh = *(const u32x4*)(zr - ZLD + 2560 + c8);
#pragma unroll
                          for (int j = 0; j < 4; ++j) { u1[2 * j] = bf_lo(c[j]) * bf_lo(hh[j]); u1[2 * j + 1] = bf_hi(c[j]) * bf_hi(hh[j]); } }
                        else if (smp) { const float* sp = args.in[4] + ((size_t)(l * 16 + b) * 2 + 1) * 256 + c8;
#pragma unroll
                          for (int j = 0; j < 8; ++j) u1[j] = sp[j]; }
                        else {
#pragma unroll
                          for (int j = 0; j < 8; ++j) u1[j] = 0.f; }
                        if (t >= 2) { const u32x4 c = *(const u32x4*)(zr - 2 * ZLD + 2304 + c8), hh = *(const u32x4*)(zr - 2 * ZLD + 2560 + c8);
#pragma unroll
                          for (int j = 0; j < 4; ++j) { u2[2 * j] = bf_lo(c[j]) * bf_lo(hh[j]); u2[2 * j + 1] = bf_hi(c[j]) * bf_hi(hh[j]); } }
                        else if (smp) { const float* sp = args.in[4] + ((size_t)(l * 16 + b) * 2 + t) * 256 + c8;
#pragma unroll
                          for (int j = 0; j < 8; ++j) u2[j] = sp[j]; }
                        else {
#pragma unroll
                          for (int j = 0; j < 8; ++j) u2[j] = 0.f; }
                        const u32x4 bb = *(const u32x4*)(zr + 2048 + c8), bg = *(const u32x4*)(zr + 2816 + c8);
                        float y[8];
#pragma unroll
                        for (int j = 0; j < 4; ++j) {
                            y[2 * j] = bf_lo(bb[j]) * (u2[2 * j] * w0[2 * j] + u1[2 * j] * w1[2 * j] + u0[2 * j] * w2[2 * j]) * bf_lo(bg[j]);
                            y[2 * j + 1] = bf_hi(bb[j]) * (u2[2 * j + 1] * w0[2 * j + 1] + u1[2 * j + 1] * w1[2 * j + 1] + u0[2 * j + 1] * w2[2 * j + 1]) * bf_hi(bg[j]); }
                        *(u32x4*)(YMIX + (size_t)row * 1024 + 512 + c8) = (u32x4){cvtpk(y[0], y[1]), cvtpk(y[2], y[3]), cvtpk(y[4], y[5]), cvtpk(y[6], y[7])};
                        float* so = nullptr;
                        if (!smp && row >= NPROMPT - 2) so = out + O_CONVP + (size_t)l * 512 + (size_t)(row - (NPROMPT - 2)) * 256 + c8;
                        if (smp && t >= 14) so = out + O_CONVS + (size_t)l * 8192 + (size_t)b * 512 + (size_t)(t - 14) * 256 + c8;
                        if (so) { *(f32x4*)so = (f32x4){u0[0], u0[1], u0[2], u0[3]}; *(f32x4*)(so + 4) = (f32x4){u0[4], u0[5], u0[6], u0[7]}; }
                    }
                }
                if (smp_unit || kind == 5) {
                    asm volatile("s_waitcnt vmcnt(0)" ::: "memory");
                    __syncthreads();
                    if (tid == 0) { __builtin_amdgcn_fence(__ATOMIC_RELEASE, "agent"); asm volatile("s_waitcnt vmcnt(0)" ::: "memory");
                        __hip_atomic_fetch_add(ctl + (kind == 5 ? CTL_SI : CTL_SM) + l, 1u, __ATOMIC_RELAXED, __HIP_MEMORY_SCOPE_AGENT); }
                }
            }
            }
        }
        xcd_barrier(xbar);
        {
            pg8::Gemm g{YMIX, WOUT + (size_t)l * 1024 * 1024, NPROMPT, 1024, 1024}; pg8::StaticOrder S; S.init(NPROMPT, 1024, G, bx);
            pg8::EpiOut E{ws, x_p, x_s, l, args.in[17], out};

#ifndef NO_GEMM2
            pg8::gemm_phase<pg8::EpiOut, pg8::StaticOrder, true, true>(lds, g, S, E);
#endif

            if (l == 1 && wave == 0 && bx < MROWS - NPROMPT) {
                int ln_ = threadIdx.x; asm volatile("" : "+v"(ln_)); ln_ &= 63;
                const int lane = ln_;
                const int m = NPROMPT + bx; const float rs = __builtin_amdgcn_rsqf(SSQ2[m] * (1.0f / 1024.0f) + 1e-6f);
#pragma unroll
                for (int j = 0; j < 4; ++j) { const f32x4 v = *((const f32x4*)(X1 + (size_t)m * 1024) + lane + 64 * j); *((f32x4*)(out + O_Y + (size_t)m * 1024) + lane + 64 * j) = v * rs * *((const f32x4*)args.in[17] + lane + 64 * j); }
            }
        }
        if (l == 0) xcd_barrier(xbar);
    }
}

extern "C" void kernel_launch(void* const* d_in, const int* in_sizes, int n_in, void* d_out, int out_size, void* d_ws, size_t ws_size, hipStream_t stream) {
    static int grid_blocks = 0;
    if (!grid_blocks) {
        if (n_in != 18 || (size_t)out_size != O_END || ws_size < WS_END) { fprintf(stderr, "kernel_launch: unexpected shapes n_in %d out %d ws %zu\n", n_in, out_size, ws_size); grid_blocks = -1; return; }
        int dev = 0, cus = 0, per_cu = 0;
        hipGetDevice(&dev); hipDeviceGetAttribute(&cus, hipDeviceAttributeMultiprocessorCount, dev);
        hipFuncSetAttribute((const void*)fwd_megakernel, hipFuncAttributeMaxDynamicSharedMemorySize, LDS_BYTES);
        hipOccupancyMaxActiveBlocksPerMultiprocessor(&per_cu, (const void*)fwd_megakernel, 512, LDS_BYTES);
        if (per_cu < 1) { fprintf(stderr, "kernel_launch: occupancy query says %d blocks per CU\n", per_cu); per_cu = 1; }
        if (per_cu > 1) per_cu = 1;
        grid_blocks = cus * per_cu;
    }
    if (grid_blocks < 0) return;
    hipMemsetAsync((char*)d_ws + WS_CTL, 0, CTL_BYTES, stream);
    Args a{};
    for (int i = 0; i < 18; ++i) a.in[i] = (const float*)d_in[i];
    a.out = (float*)d_out; a.ws = (unsigned char*)d_ws;
    void* kargs[] = {&a};
    hipError_t e = hipLaunchCooperativeKernel((const void*)fwd_megakernel, dim3(grid_blocks), dim3(512), kargs, LDS_BYTES, stream);
    if (e != hipSuccess) fprintf(stderr, "cooperative launch failed: %s (grid %d)\n", hipGetErrorString(e), grid_blocks);
}
```

```cpp
#include <hip/hip_runtime.h>
#include <hip/hip_cooperative_groups.h>
#include <cstdio>
#include <cstdint>
namespace cg = cooperative_groups;
__device__ __forceinline__ int lane_id_v() { int r; asm volatile("v_mbcnt_lo_u32_b32 %0, -1, 0\n\tv_mbcnt_hi_u32_b32 %0, -1, %0" : "=v"(r)); return r; }
namespace pg8 {
#define PG8_LAS __attribute__((address_space(3)))
typedef unsigned short bf16_t;
typedef short bf16x8 __attribute__((ext_vector_type(8)));
typedef float f32x4 __attribute__((ext_vector_type(4)));
typedef unsigned u32x4 __attribute__((ext_vector_type(4)));
constexpr int BM = 256, BK = 64, HALF = 128, HTB = HALF * BK * 2  , STAGE_BYTES = 8 * HTB, NXCD = 8, WGM = 8;

__host__ __device__ __forceinline__ int lds_byte(int r, int c) { const int st = (r >> 4) * 2 + (c >> 5), rr = r & 15, cc = c & 31, ob = rr * 64 + cc * 2; return st * 1024 + (ob ^ (((ob >> 9) & 1) << 5)); }
__host__ __device__ __forceinline__ void stage_rc(int b, int& R, int& C) { const int st = b / 1024, sb = b % 1024, swz = sb ^ (((sb >> 9) & 1) << 5); R = (st >> 1) * 16 + swz / 64; C = (st & 1) * 32 + (swz % 64) / 2; }
__host__ __device__ __forceinline__ int perm32(int rho) { const int n = rho >> 4, i = rho & 15; return 8 * (i >> 2) + 4 * n + (i & 3); }

struct Unit { int pm, pn; };
struct Gemm { const bf16_t* A; const bf16_t* Bt; int M, N, K; };

struct StaticOrder {
    int nM, nN, nwg, G, c;
    __host__ __device__ void init(int M, int N, int G_, int c_) { nM = M / BM; nN = N / BM; nwg = nM * nN; G = G_; c = c_; }
    __host__ __device__ bool next(int i, Unit& u) const {
        const long L = (long)i * G + c; if (L >= nwg) return false;
        int wgid = (int)L; { const int q = nwg / NXCD, r = nwg % NXCD, xcd = wgid % NXCD, off = wgid / NXCD; wgid = (xcd < r ? xcd * (q + 1) : r * (q + 1) + (xcd - r) * q) + off; }
        const int nig = WGM * nN, gid = wgid / nig, fm = gid * WGM, gsz = (nM - fm) < WGM ? (nM - fm) : WGM;
        u.pm = fm + ((wgid % nig) % gsz); u.pn = (wgid % nig) / gsz; return true;
    }
    __device__ __forceinline__ void a_ready(const Unit&) const {}
    __device__ __forceinline__ void done(const Unit&) const {}
};
struct OneUnit {
    int pm, pn;
    __host__ __device__ bool next(int i, Unit& u) const { if (i) return false; u.pm = pm; u.pn = pn; return true; }
    __device__ __forceinline__ void a_ready(const Unit&) const {}
    __device__ __forceinline__ void done(const Unit&) const {}
};
__device__ __forceinline__ unsigned cvt_pk_bf16(float lo, float hi) { unsigned r; asm volatile("v_cvt_pk_bf16_f32 %0, %1, %2" : "=v"(r) : "v"(lo), "v"(hi)); return r; }
typedef float f32x2 __attribute__((ext_vector_type(2)));
constexpr float LOG2E = 1.4426950408889634f;
constexpr float SC_QA = 0.125f * LOG2E;
constexpr float SC_QC = 0.17677669529663687f * LOG2E;
constexpr int ZLD = 4096, MROWS = 16640, NPROMPT = 16384;
constexpr size_t WSO_MiB = 1u << 20;
constexpr size_t WSO_PANEL = 512 * 4  , WSO_CTL = 0, WSO_SSQ1 = 16384 * 4, WSO_SSQ2 = (16384 + 32768) * 4, WSO_SSQ0 = 1 * WSO_MiB, WSO_ROPE = 2 * WSO_MiB, WSO_WIN = 4 * WSO_MiB, WSO_WOUT = 20 * WSO_MiB, WSO_XB = 24 * WSO_MiB,
                 WSO_YMIX = 60 * WSO_MiB, WSO_X1 = 96 * WSO_MiB, WSO_Z = 164 * WSO_MiB, WSO_END = 296 * WSO_MiB;
constexpr size_t OO_Y = 0, OO_AKP = 17039360, OO_AVP = OO_AKP + 524288, OO_CONVP = OO_AVP + 524288, OO_CKP = OO_CONVP + 1024, OO_CVP = OO_CKP + 8388608,
                 OO_AKS = OO_CVP + 8388608, OO_AVS = OO_AKS + 262144, OO_CONVS = OO_AVS + 262144, OO_CKS = OO_CONVS + 16384, OO_CVS = OO_CKS + 131072, OO_END = OO_CVS + 131072;
__device__ __forceinline__ float silu_f(float x) { return x * __builtin_amdgcn_rcpf(1.0f + __builtin_amdgcn_exp2f(-x * LOG2E)); }
struct EpiIn {
    static constexpr bool PERM = true, AFTER_DRAIN = false;
    unsigned char* ws; float* out; int l;
    __device__ __forceinline__ void operator()(const f32x4 (&acc)[2][2][4][2], const Unit& u, int wr, int wc, int fr, int fq) const {
        const int pn = u.pn, pm = u.pm;
        bf16_t* Z = (bf16_t*)(ws + WSO_Z); const float* ssq = (const float*)(ws + (l == 0 ? WSO_SSQ0 : WSO_SSQ1)); const float* rope = (const float*)(ws + WSO_ROPE);
        float* o_ak_p = out + OO_AKP + (size_t)l * 262144; float* o_av_p = out + OO_AVP + (size_t)l * 262144; float* o_ak_s = out + OO_AKS + (size_t)l * 131072; float* o_av_s = out + OO_AVS + (size_t)l * 131072;
        float* o_ck_p = out + OO_CKP + (size_t)l * 4194304; float* o_cv_p = out + OO_CVP + (size_t)l * 4194304; float* o_ck_s = out + OO_CKS + (size_t)l * 65536; float* o_cv_s = out + OO_CVS + (size_t)l * 65536;
        const int rowl = wr * 64 + fr;
        const int colb = pn * BM + wc * 32 + 8 * fq;
        const bool rope_tile = (pn == 12 || pn == 13);
        const bool do_rope = rope_tile && fq == 0;
        const float sc = (pn < 2) ? SC_QA : (pn == 12 ? SC_QC : 1.f);
        const bool do_silu = (pn == 6 || pn == 7 || pn == 11 || pn == 15);
        float* ob = nullptr; int old = 0, ocol0 = 0;
        if (pn >= 2 && pn <= 5) { old = 512; ocol0 = (pn >= 4) ? 1024 : 512;
            if (pm == 64) ob = (pn >= 4) ? o_av_s : o_ak_s; else if (pm >= 62) ob = ((pn >= 4) ? o_av_p : o_ak_p) + (size_t)(pm - 62) * 256 * 512; }
        else if (pn == 13 || pn == 14) { old = 256; ocol0 = (pn == 13) ? 3328 : 3584;
            if (pm == 64) ob = (pn == 13) ? o_ck_s : o_cv_s; else ob = ((pn == 13) ? o_ck_p : o_cv_p) + (size_t)pm * 256 * 256; }
#pragma unroll
        for (int ai = 0; ai < 2; ++ai)
#pragma unroll
            for (int m = 0; m < 4; ++m) {
                const int rl = rowl + ai * HALF + m * 16, row = pm * BM + rl;
                const float rs = __builtin_amdgcn_rsqf(ssq[row] * (1.0f / 1024.0f) + 1e-6f);
                f32x4 rc = {1.f, 1.f, 1.f, 1.f}, rsn = {0.f, 0.f, 0.f, 0.f};
                if (do_rope) { rc = *(const f32x4*)(rope + (size_t)row * 8); rsn = *(const f32x4*)(rope + (size_t)row * 8 + 4); }
#pragma unroll
                for (int bj = 0; bj < 2; ++bj) {
                    f32x4 v0 = acc[ai][bj][m][0] * rs, v1 = acc[ai][bj][m][1] * rs;
                    const int col = colb + bj * HALF;
                    if (rope_tile) { const f32x4 a = v0 * rc - v1 * rsn, b = v1 * rc + v0 * rsn; v0 = a; v1 = b; }
                    if (ob) { float* op = ob + (size_t)rl * old + (col - ocol0); *(f32x4*)op = v0; *(f32x4*)(op + 4) = v1; }
                    if (do_silu) { v0 = (f32x4){silu_f(v0[0]), silu_f(v0[1]), silu_f(v0[2]), silu_f(v0[3])}; v1 = (f32x4){silu_f(v1[0]), silu_f(v1[1]), silu_f(v1[2]), silu_f(v1[3])}; }
                    v0 = v0 * sc; v1 = v1 * sc;
                    u32x4 w; w.x = cvt_pk_bf16(v0[0], v0[1]); w.y = cvt_pk_bf16(v0[2], v0[3]); w.z = cvt_pk_bf16(v1[0], v1[1]); w.w = cvt_pk_bf16(v1[2], v1[3]);
                    *(u32x4*)(Z + (size_t)row * ZLD + col) = w;
                }
                asm volatile("" ::: "memory");
            }
    }
};
struct EpiOut {
    static constexpr bool PERM = true, AFTER_DRAIN = false;
    unsigned char* ws; const float* x_p; const float* x_s; int l; const float* fg; float* yout;
    __device__ __forceinline__ void operator()(f32x4 (&acc)[2][2][4][2], const Unit& u, int wr, int wc, int fr, int fq) const {
        const int pm = u.pm; const int colb = u.pn * BM + wc * 32 + 8 * fq;
        float* X1 = (float*)(ws + WSO_X1) + (size_t)pm * BM * 1024; bf16_t* XB = (bf16_t*)(ws + WSO_XB) + (size_t)pm * BM * 1024; float* ssq = (float*)(ws + (l == 0 ? WSO_SSQ1 : WSO_SSQ2)) + pm * BM;
        const float* res = (l == 0) ? ((pm == 64) ? x_s : x_p + (size_t)pm * BM * 1024) : X1;
        const unsigned off0 = (unsigned)(wr * 64 + fr) * 1024u + (unsigned)colb;
        const bool fuse = (l == 1 && pm < 64);
#pragma unroll
        for (int ai = 0; ai < 2; ++ai)
#pragma unroll
            for (int m = 0; m < 4; ++m) {
                const unsigned offr = off0 + (unsigned)(ai * HALF + m * 16) * 1024u; float q = 0.f;
#pragma unroll
                for (int bj = 0; bj < 2; ++bj) { const unsigned off = offr + bj * HALF;
                    const f32x4 v0 = acc[ai][bj][m][0] + *(const f32x4*)(res + off), v1 = acc[ai][bj][m][1] + *(const f32x4*)(res + off + 4);
                    if (fuse) { acc[ai][bj][m][0] = v0; acc[ai][bj][m][1] = v1; }
                    else {
                        *(f32x4*)(X1 + off) = v0; *(f32x4*)(X1 + off + 4) = v1;
                        u32x4 w; w.x = cvt_pk_bf16(v0[0], v0[1]); w.y = cvt_pk_bf16(v0[2], v0[3]); w.z = cvt_pk_bf16(v1[0], v1[1]); w.w = cvt_pk_bf16(v1[2], v1[3]);
                        *(u32x4*)(XB + off) = w; }
                    q += (v0[0] * v0[0] + v0[1] * v0[1]) + (v0[2] * v0[2] + v0[3] * v0[3]) + (v1[0] * v1[0] + v1[1] * v1[1]) + (v1[2] * v1[2] + v1[3] * v1[3]);
                    asm volatile("" ::: "memory"); }
                q += __shfl_xor(q, 16); q += __shfl_xor(q, 32);
                if (fq == 0) atomicAdd(ssq + (wr * 64 + fr + ai * HALF + m * 16), q);
                asm volatile("" ::: "memory");
            }
        if (fuse) {
            unsigned* cnt = (unsigned*)(ws + WSO_PANEL) + 64 * pm;
            asm volatile("s_waitcnt vmcnt(0)" ::: "memory");
            if (__builtin_amdgcn_readfirstlane(fr + 16 * fq) == (fr + 16 * fq)) __hip_atomic_fetch_add(cnt, 1u, __ATOMIC_RELAXED, __HIP_MEMORY_SCOPE_AGENT);
            unsigned spins = 0;
            while (__hip_atomic_load(cnt, __ATOMIC_RELAXED, __HIP_MEMORY_SCOPE_AGENT) < 32u) { __builtin_amdgcn_s_sleep(2); if (++spins > (1u << 22)) break; }
            float* yo = yout + (size_t)pm * BM * 1024;
#pragma unroll
            for (int ai = 0; ai < 2; ++ai)
#pragma unroll
                for (int m = 0; m < 4; ++m) {
                    const int rl = wr * 64 + fr + ai * HALF + m * 16;
                    const float sq = __hip_atomic_load(ssq + rl, __ATOMIC_RELAXED, __HIP_MEMORY_SCOPE_AGENT);
                    const float rs = __builtin_amdgcn_rsqf(sq * (1.0f / 1024.0f) + 1e-6f);
                    const unsigned offr = off0 + (unsigned)(ai * HALF + m * 16) * 1024u;
#pragma unroll
                    for (int bj = 0; bj < 2; ++bj) {
                        const f32x4 g0 = *(const f32x4*)(fg + colb + bj * HALF), g1 = *(const f32x4*)(fg + colb + bj * HALF + 4);
                        *(f32x4*)(yo + offr + bj * HALF) = acc[ai][bj][m][0] * rs * g0; *(f32x4*)(yo + offr + bj * HALF + 4) = acc[ai][bj][m][1] * rs * g1;
                        asm volatile("" ::: "memory"); }
                }
        }
    }
};
template <class Epi, class Sched, bool ALIGN_EPI = false, bool SP2 = false>
__device__ __forceinline__ void gemm_phase(PG8_LAS unsigned char* lds, const Gemm g, const Sched& S, const Epi& E, const int wv  ) {
    int tid_ = wv * 64 + lane_id_v(); asm volatile("" : "+v"(tid_));
    const int tid = tid_, wid = __builtin_amdgcn_readfirstlane(tid >> 6), lane = tid & 63, wr = wid >> 2, wc = wid & 3, fr = lane & 15, fq = lane >> 4;
    const int K = g.K, nt = K / BK;
    unsigned voffA[2], voffB[2];
#pragma unroll
    for (int i = 0; i < 2; ++i) { int R, C; stage_rc(tid * 16 + i * 8192, R, C); const int Rb = Epi::PERM ? ((R & ~31) + perm32(R & 31)) : R;
        voffA[i] = (unsigned)(R * K + C) * 2u; voffB[i] = (unsigned)(Rb * K + C) * 2u; }
    const size_t kstep = (size_t)(BK * 2);
    const size_t hstep = (size_t)HALF * K * 2;
    const size_t tstep = 2 * hstep;
    const unsigned ldsw = (unsigned)wid * 1024u;
    const int aoff = lds_byte(wr * 64 + fr, fq * 8), boff = lds_byte(wc * 32 + fr, fq * 8);
#define PG8_SA(b, h) (((b) * 2 + (h)) * HTB)
#define PG8_SB(b, h) ((4 + (b) * 2 + (h)) * HTB)
#define PG8_STAGE(bufoff, gbase, voff) do { _Pragma("unroll") for (int _i = 0; _i < 2; ++_i) \
        __builtin_amdgcn_global_load_lds((const unsigned*)((const char*)(gbase) + (voff)[_i]), (PG8_LAS unsigned*)(lds + (bufoff) + ldsw + _i * 8192), 16, 0, 0); } while (0)
#define PG8_LDA(dst, b, h) do { _Pragma("unroll") for (int m = 0; m < 4; ++m) _Pragma("unroll") for (int k = 0; k < 2; ++k) dst[m][k] = *(const PG8_LAS bf16x8*)(lds + PG8_SA(b, h) + aoff + m * 2048 + k * 1024); } while (0)
#define PG8_LDB(dst, b, h) do { _Pragma("unroll") for (int n = 0; n < 2; ++n) _Pragma("unroll") for (int k = 0; k < 2; ++k) dst[n][k] = *(const PG8_LAS bf16x8*)(lds + PG8_SB(b, h) + boff + n * 2048 + k * 1024); } while (0)
#define PG8_MMA(ai, bj, At, Bt) do { __builtin_amdgcn_s_setprio(1); _Pragma("unroll") for (int m = 0; m < 4; ++m) _Pragma("unroll") for (int n = 0; n < 2; ++n) _Pragma("unroll") for (int k = 0; k < 2; ++k) \
        acc[ai][bj][m][n] = __builtin_amdgcn_mfma_f32_16x16x32_bf16(Bt[n][k], At[m][k], acc[ai][bj][m][n], 0, 0, 0); __builtin_amdgcn_s_setprio(0); } while (0)
#define PG8_WAIT_V(n) asm volatile("s_waitcnt vmcnt(" #n ")" ::: "memory")
#define PG8_WAIT_L(n) asm volatile("s_waitcnt lgkmcnt(" #n ")" ::: "memory")
#define PG8_BAR __builtin_amdgcn_s_barrier()
#define PG8_SCHED __builtin_amdgcn_sched_barrier(0)
    Unit cur, nxt; int ui = 0;
    if (!S.next(0, cur)) return;
    f32x4 acc[2][2][4][2];
#pragma unroll
    for (int a = 0; a < 2; ++a)
#pragma unroll
        for (int b = 0; b < 2; ++b)
#pragma unroll
            for (int m = 0; m < 4; ++m)
#pragma unroll
                for (int n = 0; n < 2; ++n) acc[a][b][m][n] = (f32x4){0.f, 0.f, 0.f, 0.f};
    bf16x8 At[4][2], B0[2][2], B1[2][2];
    const char* cA = (const char*)g.A + (size_t)cur.pm * tstep; const char* cB = (const char*)g.Bt + (size_t)cur.pn * tstep;
    S.a_ready(cur);
    if constexpr (SP2) {
        PG8_STAGE(PG8_SB(0, 0), cB, voffB); PG8_STAGE(PG8_SB(0, 1), cB + hstep, voffB); PG8_STAGE(PG8_SA(0, 0), cA, voffA); PG8_STAGE(PG8_SA(0, 1), cA + hstep, voffA);
        if (wr == 1) PG8_BAR;
        PG8_WAIT_V(2); PG8_BAR;
        PG8_STAGE(PG8_SB(1, 0), cB + kstep, voffB); PG8_STAGE(PG8_SA(1, 0), cA + kstep, voffA); PG8_STAGE(PG8_SB(1, 1), cB + hstep + kstep, voffB);
        PG8_WAIT_V(6); PG8_BAR;
    } else {
        PG8_STAGE(PG8_SB(0, 0), cB, voffB); PG8_STAGE(PG8_SA(0, 0), cA, voffA); PG8_STAGE(PG8_SB(0, 1), cB + hstep, voffB); PG8_STAGE(PG8_SA(0, 1), cA + hstep, voffA);
        if (wr == 1) PG8_BAR;
        PG8_WAIT_V(4); PG8_BAR;
        PG8_STAGE(PG8_SB(1, 0), cB + kstep, voffB); PG8_STAGE(PG8_SA(1, 0), cA + kstep, voffA); PG8_STAGE(PG8_SB(1, 1), cB + hstep + kstep, voffB);
        PG8_WAIT_V(6); PG8_BAR;
    }
    for (;;) {
        const bool has_next = S.next(ui + 1, nxt);
        const char* nA = has_next ? (const char*)g.A + (size_t)nxt.pm * tstep : cA; const char* nB = has_next ? (const char*)g.Bt + (size_t)nxt.pn * tstep : cB;
        for (int t = 0; t < nt; t += 2) {
            const bool last = (t == nt - 2);
            const char* a1 = cA + (size_t)(t + 1) * kstep;
            const char* a2 = last ? nA : cA + (size_t)(t + 2) * kstep; const char* b2 = last ? nB : cB + (size_t)(t + 2) * kstep;
            const char* a3 = a2 + kstep; const char* b3 = b2 + kstep;
            if (last && has_next) S.a_ready(nxt);
            if constexpr (SP2) {
            PG8_LDB(B0, 0, 0); PG8_LDB(B1, 0, 1); PG8_SCHED; PG8_LDA(At, 0, 0); PG8_STAGE(PG8_SA(1, 1), a1 + hstep, voffA);
            PG8_WAIT_V(8); PG8_WAIT_L(0); PG8_BAR; PG8_MMA(0, 0, At, B0); PG8_MMA(0, 1, At, B1); PG8_BAR; PG8_SCHED;
            PG8_LDA(At, 0, 1); PG8_STAGE(PG8_SB(0, 0), b2, voffB); PG8_STAGE(PG8_SB(0, 1), b2 + hstep, voffB); PG8_STAGE(PG8_SA(0, 0), a2, voffA);
            PG8_WAIT_V(8); PG8_WAIT_L(0); PG8_BAR; PG8_MMA(1, 0, At, B0); PG8_MMA(1, 1, At, B1); PG8_BAR; PG8_SCHED;
            PG8_LDB(B0, 1, 0); PG8_LDB(B1, 1, 1); PG8_SCHED; PG8_LDA(At, 1, 0); PG8_STAGE(PG8_SA(0, 1), a2 + hstep, voffA);
            PG8_WAIT_V(8); PG8_WAIT_L(0); PG8_BAR; PG8_MMA(0, 0, At, B0); PG8_MMA(0, 1, At, B1); PG8_BAR; PG8_SCHED;
            PG8_LDA(At, 1, 1); PG8_STAGE(PG8_SB(1, 0), b3, voffB); PG8_STAGE(PG8_SB(1, 1), b3 + hstep, voffB); PG8_STAGE(PG8_SA(1, 0), a3, voffA);
            PG8_WAIT_V(8); PG8_WAIT_L(0); PG8_BAR; PG8_MMA(1, 0, At, B0); PG8_MMA(1, 1, At, B1); PG8_BAR; PG8_SCHED;
            } else {
            PG8_LDB(B0, 0, 0); PG8_SCHED; PG8_LDA(At, 0, 0); PG8_STAGE(PG8_SA(1, 1), a1 + hstep, voffA);
            PG8_WAIT_L(8); PG8_BAR; PG8_WAIT_L(0); PG8_MMA(0, 0, At, B0); PG8_BAR; PG8_SCHED;
            PG8_LDB(B1, 0, 1); PG8_STAGE(PG8_SB(0, 0), b2, voffB);
            PG8_BAR; PG8_WAIT_L(0); PG8_MMA(0, 1, At, B1); PG8_BAR;
            PG8_LDA(At, 0, 1); PG8_STAGE(PG8_SA(0, 0), a2, voffA);
            PG8_BAR; PG8_WAIT_L(0); PG8_MMA(1, 0, At, B0); PG8_BAR; PG8_SCHED;
            PG8_STAGE(PG8_SB(0, 1), b2 + hstep, voffB);
            PG8_WAIT_V(6); PG8_BAR; PG8_MMA(1, 1, At, B1); PG8_BAR;
            PG8_LDB(B0, 1, 0); PG8_SCHED; PG8_LDA(At, 1, 0); PG8_STAGE(PG8_SA(0, 1), a2 + hstep, voffA);
            PG8_WAIT_L(8); PG8_BAR; PG8_WAIT_L(0); PG8_MMA(0, 0, At, B0); PG8_BAR; PG8_SCHED;
            PG8_LDB(B1, 1, 1); PG8_STAGE(PG8_SB(1, 0), b3, voffB);
            PG8_BAR; PG8_WAIT_L(0); PG8_MMA(0, 1, At, B1); PG8_BAR;
            PG8_LDA(At, 1, 1); PG8_STAGE(PG8_SA(1, 0), a3, voffA);
            PG8_BAR; PG8_WAIT_L(0); PG8_MMA(1, 0, At, B0); PG8_BAR; PG8_SCHED;
            PG8_STAGE(PG8_SB(1, 1), b3 + hstep, voffB);
            PG8_WAIT_V(6); PG8_BAR; PG8_MMA(1, 1, At, B1); PG8_BAR;
            }
        }
        if constexpr (ALIGN_EPI) { if (wr == 0) PG8_BAR; }
        if constexpr (!Epi::AFTER_DRAIN) { E(acc, cur, wr, wc, fr, fq); S.done(cur); }
        if (!has_next) break;
#pragma unroll
        for (int a = 0; a < 2; ++a)
#pragma unroll
            for (int b = 0; b < 2; ++b)
#pragma unroll
                for (int m = 0; m < 4; ++m)
#pragma unroll
                    for (int n = 0; n < 2; ++n) acc[a][b][m][n] = (f32x4){0.f, 0.f, 0.f, 0.f};
        cur = nxt; cA = nA; cB = nB; ++ui;
        if constexpr (ALIGN_EPI) { if (wr == 1) PG8_BAR; }
    }
    PG8_WAIT_V(0);
    if constexpr (!ALIGN_EPI) { if (wr == 0) PG8_BAR; }
    PG8_BAR;
    if constexpr (Epi::AFTER_DRAIN) { E.fused(acc, cur, wr, wc, fr, fq, lds, wid, lane); S.done(cur); }
#undef PG8_SA
#undef PG8_SB
#undef PG8_STAGE
#undef PG8_LDA
#undef PG8_LDB
#undef PG8_MMA
#undef PG8_WAIT_V
#undef PG8_WAIT_L
#undef PG8_BAR
#undef PG8_SCHED
}
}
#define LAS __attribute__((address_space(3)))
typedef unsigned short bf16_t;
typedef LAS unsigned char* ldsp;
typedef short bf16x8 __attribute__((ext_vector_type(8)));
typedef short s16x4 __attribute__((ext_vector_type(4)));
typedef float f32x16 __attribute__((ext_vector_type(16)));
typedef float f32x4 __attribute__((ext_vector_type(4)));
typedef float f32x2 __attribute__((ext_vector_type(2)));
typedef unsigned u32x4 __attribute__((ext_vector_type(4)));
typedef unsigned u32x2 __attribute__((ext_vector_type(2)));
typedef __bf16 bf16x2_t __attribute__((ext_vector_type(2)));
using pg8::ZLD; using pg8::MROWS; using pg8::NPROMPT; using pg8::LOG2E;
__device__ __forceinline__ int crow(int r, int hi) { return (r & 3) + 8 * (r >> 2) + 4 * hi; }
__device__ __forceinline__ unsigned cvtpk(float lo, float hi) { f32x2 v = {lo, hi}; bf16x2_t b = __builtin_convertvector(v, bf16x2_t); return __builtin_bit_cast(unsigned, b); }
__device__ __forceinline__ float bf_lo(unsigned w) { return __uint_as_float(w << 16); }
__device__ __forceinline__ float bf_hi(unsigned w) { return __uint_as_float(w & 0xffff0000u); }
__device__ __forceinline__ float xhalf_max(float m) { auto rr = __builtin_amdgcn_permlane32_swap(__float_as_uint(m), __float_as_uint(m), false, false); return fmaxf(__uint_as_float(rr[0]), __uint_as_float(rr[1])); }
__device__ __forceinline__ float xhalf_sum(float m) { auto rr = __builtin_amdgcn_permlane32_swap(__float_as_uint(m), __float_as_uint(m), false, false); return __uint_as_float(rr[0]) + __uint_as_float(rr[1]); }
__device__ __forceinline__ s16x4 vtr(ldsp p) { typedef short v4i16_t __attribute__((ext_vector_type(4))); return __builtin_bit_cast(s16x4, __builtin_amdgcn_ds_read_tr16_b64_v4i16((LAS v4i16_t*)p)); }
__device__ __forceinline__ float max3f(float a, float b, float c) { float r; asm("v_max3_f32 %0, %1, %2, %3" : "=v"(r) : "v"(a), "v"(b), "v"(c)); return r; }
__device__ __forceinline__ float max2f(float a, float b) { float r; asm("v_max_f32_e32 %0, %1, %2" : "=v"(r) : "v"(a), "v"(b)); return r; }
__device__ __forceinline__ float sum8_s(float acc, float a, float b, float c, float d, float e, float f, float g, float h) {
    asm("s_nop 0\n\tv_add_f32_e32 %0, %0, %1\n\tv_add_f32_e32 %0, %0, %2\n\tv_add_f32_e32 %0, %0, %3\n\tv_add_f32_e32 %0, %0, %4\n\tv_add_f32_e32 %0, %0, %5\n\tv_add_f32_e32 %0, %0, %6\n\tv_add_f32_e32 %0, %0, %7\n\tv_add_f32_e32 %0, %0, %8"
        : "+v"(acc) : "v"(a), "v"(b), "v"(c), "v"(d), "v"(e), "v"(f), "v"(g), "v"(h));
    return acc; }
__device__ __forceinline__ float sum4_s(float acc, float a, float b, float c, float d) {
    asm("s_nop 0\n\tv_add_f32_e32 %0, %0, %1\n\tv_add_f32_e32 %0, %0, %2\n\tv_add_f32_e32 %0, %0, %3\n\tv_add_f32_e32 %0, %0, %4" : "+v"(acc) : "v"(a), "v"(b), "v"(c), "v"(d));
    return acc; }
__device__ __forceinline__ float fadd_s(float a, float b) { float r; asm("v_add_f32_e32 %0, %1, %2" : "=v"(r) : "v"(a), "v"(b)); return r; }
#define MFMA32(a, b, c) __builtin_amdgcn_mfma_f32_32x32x16_bf16((a), (b), (c), 0, 0, 0)

constexpr int KPITCH = 144, KT_BYTES = 64 * KPITCH, VT_BYTES = 8192, TILE_BYTES = KT_BYTES + VT_BYTES, BUF_BYTES = 2 * TILE_BYTES;
constexpr int COMB_OFF = 2 * BUF_BYTES, COMB_WAVE = 17408, TAB_OFF = COMB_OFF + 4 * COMB_WAVE, TAB_N = 640, TAB_DDMAX = 576, TAB1_OFF = TAB_N * 4 + 16  , MISC_OFF = TAB_OFF + 2 * TAB1_OFF, LDS_BYTES = 147456;
static_assert(MISC_OFF + 64 <= LDS_BYTES, "LDS map");
constexpr float NEG_BIG = -1.0e30f, THR = 8.0f;
#ifndef REDO_LIMIT
#define REDO_LIMIT 256.0f
#endif
struct AU {
    const bf16_t* q; int nq; int nt, ntc; const float* kc; const float* vc; int cp; const bf16_t* kz; const bf16_t* vz; int lastv; int nqg;
    int tlo0, thi0, tlo1, thi1; int qpos0, kpos0; const bf16_t* gate; bf16_t* y; const float* tabsrc;
};
#ifndef ATTN_INL
#define ATTN_INL __forceinline__
#endif
template <int MODE  >
__device__ ATTN_INL void attn_unit(const AU& d, ldsp lds, float lam, int lsel, const float* subg, const int wv) {
    constexpr bool WIDE = (MODE == 2), BIAS = (MODE != 0), DUAL = (MODE == 3);
    constexpr int NTI = DUAL ? 4 : 2, BUFB = NTI * TILE_BYTES;
#define QC(MP) ((MODE == 0) ? (MP) * 32 : (DUAL ? (MP) * 64 : 0))
    constexpr int NMAP = (MODE == 1) ? 1 : 2, NSTEP = (MODE == 0) ? 2 : 4, NSUB = WIDE ? 2 : 1;
#define KC(MP) ((MODE == 0) ? (MP) * 32 : 0)
    int tid_ = wv * 64 + lane_id_v(); asm volatile("" : "+v"(tid_));
    const int tid = tid_, lane = tid & 63, wid = wv, qg = WIDE ? wid : (wid & 3), ks = WIDE ? 0 : (wid >> 2), r32 = lane & 31, hi = lane >> 5;
    int tlo = (qg >> 1) ? d.tlo1 : d.tlo0; int thi = (qg >> 1) ? d.thi1 : d.thi0; if (qg >= d.nqg) thi = -1;
    if (WIDE) { thi = d.tlo0 + wid; tlo = max(thi - 8, 0); }
    const int qoff0 = WIDE ? 64 * wid : 32 * qg;
    const LAS float* tab = (const LAS float*)(lds + TAB_OFF);
    float tabv0 = 0.f, tabv1 = 0.f;
    float tabv2 = 0.f, tabv3 = 0.f;
    if (BIAS) { tabv0 = d.tabsrc[min(max(TAB_DDMAX - tid, -128), 128) + 128]; if (tid + 512 < TAB_N) tabv1 = d.tabsrc[min(max(TAB_DDMAX - (tid + 512), -128), 128) + 128];
        if (DUAL) { tabv2 = d.tabsrc[257 + min(max(TAB_DDMAX - tid, -128), 128) + 128]; if (tid + 512 < TAB_N) tabv3 = d.tabsrc[257 + min(max(TAB_DDMAX - (tid + 512), -128), 128) + 128]; } }
    bf16x8 qf[NMAP][NSTEP];
    const ldsp Qw = lds + COMB_OFF + wid * 8192;
    if (WIDE) {
        u32x4 qv_[8];
#pragma unroll
        for (int j = 0; j < 8; ++j) qv_[j] = *(const u32x4*)(d.q + (size_t)(qoff0 + lane) * ZLD + j * 8);
#pragma unroll
        for (int j = 0; j < 8; ++j) *(LAS u32x4*)(Qw + lane * 128 + ((j ^ (lane & 7)) * 16)) = qv_[j];
    }
#define QFRAG(MP, ST) (WIDE ? *(const LAS bf16x8*)(Qw + (32 * (MP) + r32) * 128 + ((((ST) * 2 + hi) ^ (r32 & 7)) * 16)) : qf[MP][ST])
#pragma unroll
    for (int mp = 0; mp < (WIDE ? 0 : NMAP); ++mp) { int qrow = qoff0 + r32; if (qrow >= d.nq) qrow = d.nq - 1;
      const bf16_t* qp = d.q + (size_t)qrow * ZLD;
#pragma unroll
      for (int st = 0; st < NSTEP; ++st) qf[mp][st] = *(const bf16x8*)(qp + QC(mp) + st * 16 + hi * 8); }
    f32x16 O[NMAP][2]; float mref[NMAP], lsum[NMAP];
#pragma unroll
    for (int mp = 0; mp < NMAP; ++mp) { mref[mp] = 0.f; lsum[mp] = 0.f;
#pragma unroll
        for (int db = 0; db < 2; ++db)
#pragma unroll
            for (int i = 0; i < 16; ++i) O[mp][db][i] = 0.f; }
    const int lrow = tid >> 3, lch = tid & 7;
    const int kwoff = lrow * KPITCH + lch * 16, vwoff = (lch >> 2) * 4096 + lrow * 64 + (lch & 3) * 16;
    const int kroff = r32 * KPITCH + hi * 16;
    const int vroff = (4 * hi + ((lane & 15) >> 2)) * 64 + ((lane >> 4) & 1) * 32 + (lane & 3) * 8;
    u32x4 stK[NTI], stV[NTI];
    const int nit = (d.nt + 1) >> 1; bool started = false;
#define AT_ISSUE(IT) do { if (!WIDE) _Pragma("unroll") for (int i_ = 0; i_ < NTI; ++i_) { const int t_ = 2 * (IT) + (i_ & 1); if (t_ < d.nt && t_ >= d.ntc) { int r_ = lrow; if (t_ == d.nt - 1 && r_ >= d.lastv) r_ = d.lastv - 1; \
        const size_t off_ = ((size_t)(t_ - d.ntc) * 64 + r_) * ZLD + lch * 8 + (i_ >> 1) * 64; stK[i_] = *(const u32x4*)(d.kz + off_); stV[i_] = *(const u32x4*)(d.vz + off_); } } } while (0)
#define AT_WRITE(IT, BUF) do { _Pragma("unroll") for (int i_ = 0; i_ < NTI; ++i_) { const int t_ = 2 * (IT) + (i_ & 1); if (t_ < d.nt) { u32x4 kk_, vv_; if (WIDE) { const size_t off_ = ((size_t)t_ * 64 + lrow) * ZLD + lch * 8; kk_ = *(const u32x4*)(d.kz + off_); vv_ = *(const u32x4*)(d.vz + off_); } else if (t_ >= d.ntc) { kk_ = stK[i_]; vv_ = stV[i_]; } else { \
        const size_t off_ = ((size_t)t_ * 64 + lrow) * d.cp + lch * 8; const f32x4 a_ = *(const f32x4*)(d.kc + off_), b_ = *(const f32x4*)(d.kc + off_ + 4), c_ = *(const f32x4*)(d.vc + off_), e_ = *(const f32x4*)(d.vc + off_ + 4); \
        kk_ = (u32x4){cvtpk(a_[0], a_[1]), cvtpk(a_[2], a_[3]), cvtpk(b_[0], b_[1]), cvtpk(b_[2], b_[3])}; vv_ = (u32x4){cvtpk(c_[0], c_[1]), cvtpk(c_[2], c_[3]), cvtpk(e_[0], e_[1]), cvtpk(e_[2], e_[3])}; } \
        *(LAS u32x4*)((BUF) + i_ * TILE_BYTES + kwoff) = kk_; *(LAS u32x4*)((BUF) + i_ * TILE_BYTES + KT_BYTES + vwoff) = vv_; } } } while (0)
    unsigned pf_dummy = 0;
    const int pf_tile = tid >> 8, pf_v = (tid >> 7) & 1, pf_row = (tid >> 1) & 63, pf_line = tid & 1;
#define AT_TOUCH(IT) do { const int t_ = 2 * (IT) + pf_tile; if (t_ < d.ntc) { const float* p_ = (pf_v ? d.vc : d.kc) + ((size_t)t_ * 64 + pf_row) * d.cp + pf_line * 32; \
        asm volatile("global_load_dword %0, %1, off" : "=v"(pf_dummy) : "v"(p_) : "memory"); } } while (0)
    if (d.ntc > 0) { AT_TOUCH(1); AT_TOUCH(2); }
    AT_ISSUE(0);
    if (BIAS) { ((LAS float*)(lds + TAB_OFF))[tid] = tabv0 * LOG2E; if (tid + 512 < TAB_N) ((LAS float*)(lds + TAB_OFF))[tid + 512] = tabv1 * LOG2E;
        if (DUAL) { ((LAS float*)(lds + TAB_OFF + TAB1_OFF))[tid] = tabv2 * LOG2E; if (tid + 512 < TAB_N) ((LAS float*)(lds + TAB_OFF + TAB1_OFF))[tid + 512] = tabv3 * LOG2E; } }
    for (int it = 0; it < nit; ++it) {
        const ldsp buf = lds + (it & 1) * BUFB;
        AT_WRITE(it, buf);
        __builtin_amdgcn_s_waitcnt(0); asm volatile("" : "+v"(pf_dummy));
        __syncthreads();
#pragma nounroll
        for (int sub = 0; sub < NSUB; ++sub) {
        const int t = 2 * it + (WIDE ? sub : ks);
        const bool vis = (t >= tlo && t <= thi);
        const ldsp Kt = buf + (WIDE ? sub : ks) * TILE_BYTES, Vt = Kt + KT_BYTES;
        bf16x8 kf0[2 * NSTEP];
        if (vis) {
#pragma unroll
            for (int st = 0; st < ((WIDE || DUAL) ? 2 : NSTEP); ++st) { kf0[2 * st] = *(const LAS bf16x8*)(Kt + kroff + (st * 16) * 2); kf0[2 * st + 1] = *(const LAS bf16x8*)(Kt + kroff + 32 * KPITCH + (st * 16) * 2); }
        }
        __builtin_amdgcn_sched_barrier(0);
        if (sub == 0 && it + 1 < nit) AT_ISSUE(it + 1);
        if (sub == 0 && d.ntc > 0) AT_TOUCH(it + 3);
        __builtin_amdgcn_sched_barrier(0);
        if (vis) {
            const int valid = (t == d.nt - 1) ? d.lastv : 64;
            f32x16 S0[NMAP], S1[NMAP];
#define AT_BIAS(MP) do { const int qb_ = d.qpos0 + qoff0 + (WIDE ? 32 * (MP) : 0), kp0_ = d.kpos0 + 64 * t; \
                if (qb_ - (kp0_ + 63) >= 128) { const float c_ = tab[TAB_DDMAX - 128]; _Pragma("unroll") for (int i = 0; i < 16; ++i) { S0[MP][i] += c_; S1[MP][i] += c_; } } \
                else { int j0_ = TAB_DDMAX - (qb_ + r32 - kp0_ - 4 * hi); asm volatile("" : "+v"(j0_)); const LAS float* tb_ = tab + j0_; \
                    _Pragma("unroll") for (int i = 0; i < 16; ++i) { S0[MP][i] += tb_[(i & 3) + 8 * (i >> 2)]; S1[MP][i] += tb_[(i & 3) + 8 * (i >> 2) + 32]; } } } while (0)
#define AT_QK(MP) do { f32x16 negm_; _Pragma("unroll") for (int i = 0; i < 16; ++i) negm_[i] = -mref[MP]; \
                _Pragma("unroll") for (int st = 0; st < NSTEP; ++st) { \
                    const bf16x8 a0_ = *(const LAS bf16x8*)(Kt + kroff + (KC(MP) + st * 16) * 2); \
                    const bf16x8 a1_ = *(const LAS bf16x8*)(Kt + kroff + 32 * KPITCH + (KC(MP) + st * 16) * 2); \
                    if (st == 0) { S0[MP] = MFMA32(a0_, QFRAG(MP, st), negm_); S1[MP] = MFMA32(a1_, QFRAG(MP, st), negm_); } \
                    else { S0[MP] = MFMA32(a0_, QFRAG(MP, st), S0[MP]); S1[MP] = MFMA32(a1_, QFRAG(MP, st), S1[MP]); } } \
                if (BIAS) AT_BIAS(MP); \
                if (0) { const int qpos = d.qpos0 + 32 * qg + r32, kp0 = d.kpos0 + 64 * t; \
                    if (d.qpos0 + 32 * qg - (kp0 + 63) >= 128) { const float c = tab[256]; _Pragma("unroll") for (int i = 0; i < 16; ++i) { S0[MP][i] += c; S1[MP][i] += c; } } \
                    else { _Pragma("unroll") for (int i = 0; i < 16; ++i) { int dd = qpos - (kp0 + crow(i, hi)); int d0 = min(max(dd, -128), 128), d1 = min(max(dd - 32, -128), 128); S0[MP][i] += tab[d0 + 128]; S1[MP][i] += tab[d1 + 128]; } } } \
                if (valid < 64) { _Pragma("unroll") for (int i = 0; i < 16; ++i) { const int k = crow(i, hi); if (k >= valid) S0[MP][i] = NEG_BIG; if (k + 32 >= valid) S1[MP][i] = NEG_BIG; } } } while (0)
#define AT_SLOW(MP) do { asm volatile("s_nop 15\n\ts_nop 7" : "+v"(S0[MP]), "+v"(S1[MP])); \
                float ra_ = max3f(S0[MP][0], S0[MP][1], S1[MP][0]), rb_ = max3f(S0[MP][2], S0[MP][3], S1[MP][1]); ra_ = max3f(ra_, S1[MP][2], S1[MP][3]); \
                _Pragma("unroll") for (int i = 4; i < 16; i += 4) { ra_ = max3f(ra_, S0[MP][i], S0[MP][i + 1]); rb_ = max3f(rb_, S0[MP][i + 2], S0[MP][i + 3]); ra_ = max3f(ra_, S1[MP][i], S1[MP][i + 1]); rb_ = max3f(rb_, S1[MP][i + 2], S1[MP][i + 3]); } \
                const float rm_ = xhalf_max(max2f(ra_, rb_)); \
                const float dl_ = started ? fmaxf(rm_, 0.f) : rm_, al_ = started ? __builtin_amdgcn_exp2f(-dl_) : 1.f; \
                mref[MP] += dl_; lsum[MP] *= al_; \
                _Pragma("unroll") for (int i = 0; i < 16; ++i) { S0[MP][i] -= dl_; S1[MP][i] -= dl_; } \
                _Pragma("unroll") for (int db = 0; db < 2; ++db) _Pragma("unroll") for (int i = 0; i < 16; ++i) O[MP][db][i] *= al_; } while (0)
#define AT_EXPSUM(MP) do { sa = 0.f; sb = 0.f; \
                _Pragma("unroll") for (int i = 0; i < 16; ++i) { S0[MP][i] = __builtin_amdgcn_exp2f(S0[MP][i]); S1[MP][i] = __builtin_amdgcn_exp2f(S1[MP][i]); } \
                _Pragma("unroll") for (int i = 0; i < 16; i += 8) { sa = sum8_s(sa, S0[MP][i], S0[MP][i + 1], S0[MP][i + 2], S0[MP][i + 3], S0[MP][i + 4], S0[MP][i + 5], S0[MP][i + 6], S0[MP][i + 7]); \
                    sb = sum8_s(sb, S1[MP][i], S1[MP][i + 1], S1[MP][i + 2], S1[MP][i + 3], S1[MP][i + 4], S1[MP][i + 5], S1[MP][i + 6], S1[MP][i + 7]); } } while (0)
#define AT_CVT(MP) do { _Pragma("unroll") for (int s_ = 0; s_ < 2; ++s_) { \
                u32x4 w0_ = {cvtpk(S0[MP][8 * s_], S0[MP][8 * s_ + 1]), cvtpk(S0[MP][8 * s_ + 2], S0[MP][8 * s_ + 3]), cvtpk(S0[MP][8 * s_ + 4], S0[MP][8 * s_ + 5]), cvtpk(S0[MP][8 * s_ + 6], S0[MP][8 * s_ + 7])}; \
                u32x4 w1_ = {cvtpk(S1[MP][8 * s_], S1[MP][8 * s_ + 1]), cvtpk(S1[MP][8 * s_ + 2], S1[MP][8 * s_ + 3]), cvtpk(S1[MP][8 * s_ + 4], S1[MP][8 * s_ + 5]), cvtpk(S1[MP][8 * s_ + 6], S1[MP][8 * s_ + 7])}; \
                Pf[s_] = __builtin_bit_cast(bf16x8, w0_); Pf[2 + s_] = __builtin_bit_cast(bf16x8, w1_); } } while (0)
#define AT_VF(J) ({ const s16x4 lo_ = vfr[2 * (J)], hh_ = vfr[2 * (J) + 1]; (bf16x8){lo_[0], lo_[1], lo_[2], lo_[3], hh_[0], hh_[1], hh_[2], hh_[3]}; })
#define AT_VLOAD() do { _Pragma("unroll") for (int j_ = 0; j_ < 8; ++j_) { vfr[2 * j_] = vtr(Vt + vroff + (j_ & 1) * 4096 + (j_ >> 1) * 1024); vfr[2 * j_ + 1] = vtr(Vt + vroff + (j_ & 1) * 4096 + (j_ >> 1) * 1024 + 512); } } while (0)
#define SBAR() __builtin_amdgcn_sched_barrier(0)
            float sa, sb; bf16x8 Pf[4]; s16x4 vfr[16];
            { f32x16 negm_;
#pragma unroll
              for (int i = 0; i < 16; ++i) negm_[i] = -mref[0];
#pragma unroll
              for (int st = 0; st < NSTEP; ++st) {
                  const bf16x8 q_ = QFRAG(0, st);
                  const bf16x8 ka_ = ((WIDE || DUAL) && st >= 2) ? *(const LAS bf16x8*)(Kt + kroff + (st * 16) * 2) : kf0[2 * st], kb_ = ((WIDE || DUAL) && st >= 2) ? *(const LAS bf16x8*)(Kt + kroff + 32 * KPITCH + (st * 16) * 2) : kf0[2 * st + 1];
                  if (st == 0) { S0[0] = MFMA32(ka_, q_, negm_); S1[0] = MFMA32(kb_, q_, negm_); }
                  else { S0[0] = MFMA32(ka_, q_, S0[0]); S1[0] = MFMA32(kb_, q_, S1[0]); } }
              if (BIAS) AT_BIAS(0);
              if (0) { const int qpos = d.qpos0 + 32 * qg + r32, kp0 = d.kpos0 + 64 * t;
                  if (d.qpos0 + 32 * qg - (kp0 + 63) >= 128) { const float c = tab[256];
#pragma unroll
                      for (int i = 0; i < 16; ++i) { S0[0][i] += c; S1[0][i] += c; } }
                  else {
#pragma unroll
                      for (int i = 0; i < 16; ++i) { int dd = qpos - (kp0 + crow(i, hi)); int d0 = min(max(dd, -128), 128), d1 = min(max(dd - 32, -128), 128); S0[0][i] += tab[d0 + 128]; S1[0][i] += tab[d1 + 128]; } } }
              if (valid < 64) {
#pragma unroll
                  for (int i = 0; i < 16; ++i) { const int k = crow(i, hi); if (k >= valid) S0[0][i] = NEG_BIG; if (k + 32 >= valid) S1[0][i] = NEG_BIG; } } }
            if (!started) AT_SLOW(0);
            if (NMAP == 2 && !DUAL) {
                constexpr int M1 = NMAP - 1;
                bf16x8 kf1[4]; f32x16 negm1; bf16x8 wka = kf1[0], wkb = kf1[0];
                bf16x8 wq = wka;
                if (WIDE) { wka = *(const LAS bf16x8*)(Kt + kroff); wkb = *(const LAS bf16x8*)(Kt + kroff + 32 * KPITCH); wq = QFRAG(M1, 0); }
                if (!WIDE) {
#pragma unroll
                for (int st = 0; st < 2; ++st) { kf1[2 * st] = *(const LAS bf16x8*)(Kt + kroff + (32 + st * 16) * 2); kf1[2 * st + 1] = *(const LAS bf16x8*)(Kt + kroff + 32 * KPITCH + (32 + st * 16) * 2); } }
#pragma unroll
                for (int i = 0; i < 16; ++i) negm1[i] = -mref[M1];
                sa = 0.f; sb = 0.f;
                SBAR();
#pragma unroll
                for (int g = 0; g < 4; ++g) {
                    if (WIDE) {
                        bf16x8 na_ = wka, nb_ = wkb;
                        if (g < 3) { na_ = *(const LAS bf16x8*)(Kt + kroff + ((g + 1) * 16) * 2); nb_ = *(const LAS bf16x8*)(Kt + kroff + 32 * KPITCH + ((g + 1) * 16) * 2); }
                        bf16x8 nq_ = wq;
                        if (g < 3) nq_ = QFRAG(M1, (g + 1) % NSTEP);
                        if (g == 0) { S0[M1] = MFMA32(wka, wq, negm1); S1[M1] = MFMA32(wkb, wq, negm1); }
                        else { S0[M1] = MFMA32(wka, wq, S0[M1]); S1[M1] = MFMA32(wkb, wq, S1[M1]); }
                        wka = na_; wkb = nb_; wq = nq_;
                    } else {
                    if (g == 0) S0[M1] = MFMA32(kf1[0], qf[M1][0], negm1); else if (g == 1) S1[M1] = MFMA32(kf1[1], qf[M1][0], negm1);
                    else if (g == 2) S0[M1] = MFMA32(kf1[2], qf[M1][1], S0[M1]); else S1[M1] = MFMA32(kf1[3], qf[M1][1], S1[M1]); }
                    SBAR();
#pragma unroll
                    for (int i = 4 * g; i < 4 * g + 4; ++i) { S0[0][i] = __builtin_amdgcn_exp2f(S0[0][i]); S1[0][i] = __builtin_amdgcn_exp2f(S1[0][i]); }
                    if (g & 1) sb = sum8_s(sb, S0[0][4 * g], S0[0][4 * g + 1], S0[0][4 * g + 2], S0[0][4 * g + 3], S1[0][4 * g], S1[0][4 * g + 1], S1[0][4 * g + 2], S1[0][4 * g + 3]);
                    else sa = sum8_s(sa, S0[0][4 * g], S0[0][4 * g + 1], S0[0][4 * g + 2], S0[0][4 * g + 3], S1[0][4 * g], S1[0][4 * g + 1], S1[0][4 * g + 2], S1[0][4 * g + 3]);
                    SBAR();
                }
                if (WIDE) AT_BIAS(M1);
                if (valid < 64) {
#pragma unroll
                    for (int i = 0; i < 16; ++i) { const int k = crow(i, hi); if (k >= valid) S0[M1][i] = NEG_BIG; if (k + 32 >= valid) S1[M1][i] = NEG_BIG; } }
            } else AT_EXPSUM(0);
            if (started && __any(!(sa + sb <= REDO_LIMIT))) { AT_QK(0); AT_SLOW(0); AT_EXPSUM(0); }
            lsum[0] += sa + sb;
            AT_VLOAD();
            AT_CVT(0);
            if (NMAP == 2 && !DUAL) {
                constexpr int M1 = NMAP - 1;
                if (!started) AT_SLOW(M1);
                sa = 0.f; sb = 0.f;
                SBAR();
#pragma unroll
                for (int j = 0; j < 8; ++j) {
                    O[0][j & 1] = MFMA32(AT_VF(j), Pf[j >> 1], O[0][j & 1]);
                    SBAR();
                    S0[M1][2 * j] = __builtin_amdgcn_exp2f(S0[M1][2 * j]); S0[M1][2 * j + 1] = __builtin_amdgcn_exp2f(S0[M1][2 * j + 1]);
                    S1[M1][2 * j] = __builtin_amdgcn_exp2f(S1[M1][2 * j]); S1[M1][2 * j + 1] = __builtin_amdgcn_exp2f(S1[M1][2 * j + 1]);
                    if (j & 1) sb = sum4_s(sb, S0[M1][2 * j], S0[M1][2 * j + 1], S1[M1][2 * j], S1[M1][2 * j + 1]); else sa = sum4_s(sa, S0[M1][2 * j], S0[M1][2 * j + 1], S1[M1][2 * j], S1[M1][2 * j + 1]);
                    SBAR();
                }
                if (started && __any(!(sa + sb <= REDO_LIMIT))) { AT_QK(M1); AT_SLOW(M1); AT_EXPSUM(M1); }
                lsum[M1] += sa + sb;
#pragma unroll
                for (int k = 0; k < 4; ++k) {
                    const f32x16& sx = (k < 2) ? S0[M1] : S1[M1]; const int b = 8 * (k & 1);
                    const u32x4 w_ = {cvtpk(sx[b], sx[b + 1]), cvtpk(sx[b + 2], sx[b + 3]), cvtpk(sx[b + 4], sx[b + 5]), cvtpk(sx[b + 6], sx[b + 7])};
                    Pf[k] = __builtin_bit_cast(bf16x8, w_);
                    SBAR();
                    O[M1][0] = MFMA32(AT_VF(2 * k), Pf[k], O[M1][0]); O[M1][1] = MFMA32(AT_VF(2 * k + 1), Pf[k], O[M1][1]);
                    SBAR();
                }
            } else {
#pragma unroll
                for (int j = 0; j < 8; ++j) O[0][j & 1] = MFMA32(AT_VF(j), Pf[j >> 1], O[0][j & 1]);
            }
            if (DUAL) {
                constexpr int M1 = NMAP - 1;
                const ldsp Kt1_ = Kt + 2 * TILE_BYTES; const LAS float* tab1_ = (const LAS float*)(lds + TAB_OFF + TAB1_OFF);
                { const ldsp Kt = Kt1_, Vt = Kt1_ + KT_BYTES; const LAS float* tab = tab1_;
                  AT_QK(M1);
                  if (!started) AT_SLOW(M1);
                  AT_EXPSUM(M1);
                  if (started && __any(!(sa + sb <= REDO_LIMIT))) { AT_QK(M1); AT_SLOW(M1); AT_EXPSUM(M1); }
                  lsum[M1] += sa + sb;
                  AT_VLOAD();
                  AT_CVT(M1);
#pragma unroll
                  for (int j = 0; j < 8; ++j) O[M1][j & 1] = MFMA32(AT_VF(j), Pf[j >> 1], O[M1][j & 1]); }
            }
#undef AT_SLOW
#undef AT_EXPSUM
#undef AT_CVT
#undef AT_VF
#undef AT_VLOAD
#undef SBAR
#undef AT_BIAS
            started = true;
#undef AT_QK
        }
        }
    }
#undef AT_ISSUE
#undef AT_TOUCH
#undef AT_WRITE
    __syncthreads();
    if (!started) {
#pragma unroll
        for (int mp = 0; mp < NMAP; ++mp) mref[mp] = NEG_BIG;
    }
    u32x2 gpre[8];
    if (MODE == 1 && ks == 0 && qg < d.nqg) { const int row_ = min(32 * qg + r32, d.nq - 1);
#pragma unroll
        for (int j = 0; j < 8; ++j) gpre[j] = *(const u32x2*)(d.gate + (size_t)row_ * ZLD + 32 * (j >> 2) + 8 * (j & 3) + 4 * hi); }
    const ldsp cw = lds + COMB_OFF + qg * COMB_WAVE;
    if (!WIDE && ks == 1 && qg < d.nqg) {
#pragma unroll
        for (int mp = 0; mp < NMAP; ++mp) {
#pragma unroll
            for (int db = 0; db < 2; ++db)
#pragma unroll
                for (int i = 0; i < 16; ++i) *(LAS float*)(cw + ((mp * 2 + db) * 16 + i) * 256 + lane * 4) = O[mp][db][i];
            *(LAS float*)(cw + 16384 + (mp * 2) * 256 + lane * 4) = mref[mp]; *(LAS float*)(cw + 16384 + (mp * 2 + 1) * 256 + lane * 4) = lsum[mp];
        }
    }
    __syncthreads();
    if (WIDE) {
#pragma unroll
        for (int mp = 0; mp < NMAP; ++mp) {
            const float fin = 1.0f / xhalf_sum(lsum[mp]); const int row = qoff0 + 32 * mp + r32;
#pragma unroll
            for (int db = 0; db < 2; ++db)
#pragma unroll
                for (int g4 = 0; g4 < 4; ++g4) {
                    const int d0 = 32 * db + 8 * g4 + 4 * hi;
                    const u32x2 gw = *(const u32x2*)(d.gate + (size_t)row * ZLD + d0);
                    const float y0 = O[mp][db][4 * g4] * fin * bf_lo(gw.x), y1 = O[mp][db][4 * g4 + 1] * fin * bf_hi(gw.x), y2 = O[mp][db][4 * g4 + 2] * fin * bf_lo(gw.y), y3 = O[mp][db][4 * g4 + 3] * fin * bf_hi(gw.y);
                    *(u32x2*)(d.y + (size_t)row * 1024 + d0) = (u32x2){cvtpk(y0, y1), cvtpk(y2, y3)};
                }
        }
    } else
    if (ks == 0 && qg < d.nqg) {
        float linv[NMAP];
#pragma unroll
        for (int mp = 0; mp < NMAP; ++mp) {
            const float mb = *(const LAS float*)(cw + 16384 + (mp * 2) * 256 + lane * 4), lb = *(const LAS float*)(cw + 16384 + (mp * 2 + 1) * 256 + lane * 4);
            const float mt = fmaxf(mref[mp], mb), aa = __builtin_amdgcn_exp2f(mref[mp] - mt), ab = __builtin_amdgcn_exp2f(mb - mt);
            const float l = xhalf_sum(lsum[mp] * aa + lb * ab);
            linv[mp] = 1.0f / l;
#pragma unroll
            for (int db = 0; db < 2; ++db)
#pragma unroll
                for (int i = 0; i < 16; ++i) O[mp][db][i] = O[mp][db][i] * aa + *(const LAS float*)(cw + ((mp * 2 + db) * 16 + i) * 256 + lane * 4) * ab;
        }
        float fin = 1.f;
        if (MODE == 0) {
            const float i1 = linv[0], i2 = lam * linv[NMAP - 1]; float ss = 0.f;
#pragma unroll
            for (int db = 0; db < 2; ++db)
#pragma unroll
                for (int i = 0; i < 16; ++i) { const float o = O[0][db][i] * i1 - O[NMAP - 1][db][i] * i2; O[0][db][i] = o; ss += o * o; }
            ss = xhalf_sum(ss);
            int sel_ = lsel; asm volatile("" : "+s"(sel_));
            fin = __builtin_amdgcn_rsqf(ss * (1.0f / 64.0f) + 1e-5f) * ((sel_ == 0) ? 0.8f : 0.6444909324090307f);
        } else fin = linv[0];
        int r32f_ = r32; asm volatile("" : "+v"(r32f_));
        const int row = 32 * qg + r32f_;
        if (row < d.nq) {
#pragma unroll
          for (int m2 = 0; m2 < (DUAL ? 2 : 1); ++m2) {
            const float finm = DUAL ? linv[m2] : fin;
#pragma unroll
            for (int db = 0; db < 2; ++db)
#pragma unroll
                for (int g4 = 0; g4 < 4; ++g4) {
                    const int d0 = 32 * db + 8 * g4 + 4 * hi;
                    const u32x2 gw = (MODE == 1) ? gpre[db * 4 + g4] : *(const u32x2*)(d.gate + (size_t)row * ZLD + m2 * 64 + d0);
                    f32x4 sg = {1.f, 1.f, 1.f, 1.f}; if (MODE == 0) sg = *(const f32x4*)(subg + d0);
                    const float y0 = O[m2][db][4 * g4] * finm * sg[0] * bf_lo(gw.x), y1 = O[m2][db][4 * g4 + 1] * finm * sg[1] * bf_hi(gw.x);
                    const float y2 = O[m2][db][4 * g4 + 2] * finm * sg[2] * bf_lo(gw.y), y3 = O[m2][db][4 * g4 + 3] * finm * sg[3] * bf_hi(gw.y);
                    *(u32x2*)(d.y + (size_t)row * 1024 + m2 * 64 + d0) = (u32x2){cvtpk(y0, y1), cvtpk(y2, y3)};
                }
          }
        }
    }
}
#undef KC
#undef QC
#undef QFRAG
using namespace pg8;
#ifndef P1_ALIGN
#define P1_ALIGN true
#endif
constexpr size_t WS_CTL = WSO_CTL, CTL_BYTES = 1u << 20, WS_SSQ0 = WSO_SSQ0, WS_ROPE = WSO_ROPE, WS_WIN = WSO_WIN, WS_WOUT = WSO_WOUT, WS_XB = WSO_XB, WS_YMIX = WSO_YMIX, WS_X1 = WSO_X1, WS_Z = WSO_Z, WS_END = WSO_END;
static_assert((size_t)MROWS * 1024 * 2 <= 36u * (1u << 20) && (size_t)MROWS * 1024 * 4 <= 68u * (1u << 20) && (size_t)MROWS * 4096 * 2 <= 132u * (1u << 20), "ws map");
constexpr int CTL_Q0 = 0, CTL_SI = 64, CTL_SM = 128, CTL_SSQ1 = 16384, CTL_SSQ2 = 16384 + 32768;
static_assert((CTL_SSQ2 + MROWS) * 4 <= (int)CTL_BYTES, "ctl");
constexpr size_t O_Y = OO_Y, O_CONVP = OO_CONVP, O_CONVS = OO_CONVS, O_END = OO_END;
struct Args { const float* in[18]; float* out; unsigned char* ws; };

__device__ __forceinline__ float wave_sum(float v) {
#pragma unroll
    for (int o = 1; o < 64; o <<= 1) v += __shfl_xor(v, o);
    return v;
}
__device__ __forceinline__ unsigned f2bf(float f) { unsigned u = __builtin_bit_cast(unsigned, f); return (u + 0x7fffu + ((u >> 16) & 1u)) >> 16; }
__device__ __forceinline__ unsigned pk2(float lo, float hi) { return f2bf(lo) | (f2bf(hi) << 16); }
__device__ __forceinline__ void p0_transpose_item(const float* W, const float* g, int K, int N, bf16_t* WT, LAS float* scr, int item, int lane) {
    const int nblk = N / 32, kb = item / nblk, nb = item % nblk, k0 = 64 * kb, n0 = 32 * nb;
#pragma unroll 8
    for (int i = 0; i < 32; ++i) { const int kk = 2 * i + (lane >> 5); const float gs = g ? g[k0 + kk] : 1.f; scr[kk * 33 + (lane & 31)] = W[(size_t)(k0 + kk) * N + n0 + (lane & 31)] * gs; }
    asm volatile("s_waitcnt lgkmcnt(0)" ::: "memory");
    const int c = lane & 7;
#pragma unroll
    for (int j = 0; j < 4; ++j) { const int n = (lane >> 3) + 8 * j; const LAS float* s = scr + (8 * c) * 33 + n;
        u32x4 o; o.x = pk2(s[0 * 33], s[1 * 33]); o.y = pk2(s[2 * 33], s[3 * 33]); o.z = pk2(s[4 * 33], s[5 * 33]); o.w = pk2(s[6 * 33], s[7 * 33]);
        *(u32x4*)(WT + (size_t)(n0 + n) * K + k0 + 8 * c) = o; }
    asm volatile("s_waitcnt lgkmcnt(0)" ::: "memory");
}

#define XB_TMO      128
#define XB_XCNT(j)  (256  + 64 * (j))
#define XB_XSUB(j)  (1280 + 64 * (j))
#define XB_XGEN(j)  (2304 + 64 * (j))
#define XB_TOP      3328
#define XB_TOPGEN   3392
#define XCD_BAR_WORDS 3456
#define XB_SPIN_CAP (1u << 18)

__device__ __forceinline__ unsigned xb_ld(unsigned* p)              { return __hip_atomic_load(p, __ATOMIC_RELAXED, __HIP_MEMORY_SCOPE_AGENT); }
__device__ __forceinline__ unsigned xb_add(unsigned* p, unsigned v) { return __hip_atomic_fetch_add(p, v, __ATOMIC_RELAXED, __HIP_MEMORY_SCOPE_AGENT); }
__device__ __forceinline__ unsigned xb_xcc_id() { return (unsigned)__builtin_amdgcn_s_getreg((3 << 11) | 20) & 0xFu; }
#define XB_SPIN(cond, bar) do { unsigned _sp = 0; while (cond) { __builtin_amdgcn_s_sleep(1); \
    if ((++_sp & 255u) == 0u) { if (xb_ld(&(bar)[XB_TMO])) break; if (_sp > XB_SPIN_CAP) { atomicAdd(&(bar)[XB_TMO], 1u); break; } } } } while (0)

struct XcdBarrier {
    unsigned* bar; unsigned x; int wv;
    volatile LAS unsigned* st;
};

__device__ __forceinline__ XcdBarrier xcd_barrier_post(unsigned* bar, volatile LAS unsigned* st, int wv) {
    XcdBarrier b; b.bar = bar; b.x = xb_xcc_id(); b.st = st; b.wv = wv;
    if (wv == 0 && lane_id_v() == 0) (void)xb_add(&bar[XB_XCNT(b.x)], 1u);
    return b;
}
__device__ __forceinline__ void xcd_barrier_complete(unsigned* bar, unsigned x, unsigned& nloc, unsigned& nx) {
    const unsigned G = gridDim.x * gridDim.y * gridDim.z;
    unsigned sum, cnt, mine, sp = 0u;
    for (;;) {
        sum = 0u; cnt = 0u; mine = 0u;
#pragma unroll
        for (unsigned j = 0; j < 16; ++j) { const unsigned c = xb_ld(&bar[XB_XCNT(j)]); sum += c; cnt += (c > 0u) ? 1u : 0u; mine = (j == x) ? c : mine; }
        if (sum == G) break;
        __builtin_amdgcn_s_sleep(1);
        if ((++sp & 255u) == 0u) { if (xb_ld(&bar[XB_TMO])) break; if (sp > XB_SPIN_CAP) { atomicAdd(&bar[XB_TMO], 1u); break; } }
    }
    nloc = mine > 0u ? mine : 1u; nx = cnt > 0u ? cnt : 1u;
}

__device__ __forceinline__ void xcd_barrier(const XcdBarrier& b) {
    asm volatile("s_waitcnt vmcnt(0)" ::: "memory");
    __syncthreads();
    if (b.wv == 0 && lane_id_v() == 0) {
        unsigned* bar = b.bar;
        __builtin_amdgcn_s_waitcnt(0);
        unsigned nloc = b.st[0], nx = b.st[1];
        if (nloc == 0u) { xcd_barrier_complete(bar, b.x, nloc, nx); b.st[0] = nloc; b.st[1] = nx; }
        const unsigned old = xb_add(&bar[XB_XSUB(b.x)], 1u);
        const unsigned gen = old / nloc;
        if (old + 1u == (gen + 1u) * nloc) {
            __builtin_amdgcn_fence(__ATOMIC_RELEASE, "agent");
            asm volatile("s_waitcnt vmcnt(0)" ::: "memory");
            const unsigned og = xb_add(&bar[XB_TOP], 1u);
            const unsigned tg = og / nx;
            if (og + 1u == (tg + 1u) * nx) xb_add(&bar[XB_TOPGEN], 1u);
            else XB_SPIN(xb_ld(&bar[XB_TOPGEN]) == tg, bar);
            __builtin_amdgcn_fence(__ATOMIC_ACQUIRE, "agent");
            xb_add(&bar[XB_XGEN(b.x)], 1u);
            asm volatile("s_waitcnt vmcnt(0)" ::: "memory");
        } else {
            XB_SPIN(xb_ld(&bar[XB_XGEN(b.x)]) == gen, bar);
            __builtin_amdgcn_fence(__ATOMIC_ACQUIRE, "agent");
            asm volatile("s_waitcnt vmcnt(0)" ::: "memory");
        }
    }
    __syncthreads();
}

constexpr int CTL_XBAR = 8192;
static_assert(CTL_XBAR + XCD_BAR_WORDS <= CTL_SSQ1, "ctl map");

__global__ void __launch_bounds__(512) fwd_megakernel(Args args) {
    extern __shared__ __attribute__((aligned(16))) unsigned char lds_raw[];
    cg::grid_group grid = cg::this_grid();
    const ldsp lds = (ldsp)lds_raw;
    const int tid = threadIdx.x, lane = tid & 63, wave = __builtin_amdgcn_readfirstlane(tid >> 6);
    const int G = gridDim.x, bx = blockIdx.x;
    unsigned char* ws = args.ws; float* out = args.out;
    unsigned* ctl = (unsigned*)(ws + WS_CTL);
    float* SSQ0 = (float*)(ws + WS_SSQ0); float* SSQ1 = (float*)ctl + CTL_SSQ1; float* SSQ2 = (float*)ctl + CTL_SSQ2;
    float* ROPE = (float*)(ws + WS_ROPE);
    bf16_t* WIN = (bf16_t*)(ws + WS_WIN); bf16_t* WOUT = (bf16_t*)(ws + WS_WOUT);
    bf16_t* XB = (bf16_t*)(ws + WS_XB); bf16_t* YMIX = (bf16_t*)(ws + WS_YMIX); float* X1 = (float*)(ws + WS_X1); bf16_t* Z = (bf16_t*)(ws + WS_Z);
    const float* x_p = args.in[0]; const float* x_s = args.in[1];
    volatile LAS unsigned* xb_st = (volatile LAS unsigned*)(lds + MISC_OFF + 16);
    if (tid < 2) xb_st[tid] = 0u;
    __syncthreads();
    const XcdBarrier xbar = xcd_barrier_post(ctl + CTL_XBAR, xb_st, wave);

    {
        LAS float* scr = (LAS float*)(lds + wave * 16384);
        const int gw = bx * 8 + wave, NGW = G * 8;
        constexpr int I_IN = (1024 / 64) * (4096 / 32), I_OUT = (1024 / 64) * (1024 / 32), NITEMS = 2 * I_IN + 2 * I_OUT;
        for (int it = gw; it < NITEMS; it += NGW) {
            int r = it;
            if (r < 2 * I_IN) { const int l = r / I_IN; r -= l * I_IN; p0_transpose_item(args.in[8] + (size_t)l * 1024 * 4096, args.in[7] + l * 1024, 1024, 4096, WIN + (size_t)l * 4096 * 1024, scr, r, lane); }
            else { r -= 2 * I_IN; const int l = r / I_OUT; r -= l * I_OUT; p0_transpose_item(args.in[9] + (size_t)l * 1024 * 1024, nullptr, 1024, 1024, WOUT + (size_t)l * 1024 * 1024, scr, r, lane); }
        }
        for (int m = gw; m < MROWS; m += NGW) {
            const float* xr = (m < NPROMPT) ? x_p + (size_t)m * 1024 : x_s + (size_t)(m - NPROMPT) * 1024;
            f32x4 v[4]; float s = 0.f;
#pragma unroll
            for (int j = 0; j < 4; ++j) { v[j] = *((const f32x4*)xr + lane + 64 * j); s += (v[j][0] * v[j][0] + v[j][1] * v[j][1]) + (v[j][2] * v[j][2] + v[j][3] * v[j][3]); }
            s = wave_sum(s);
            if (lane == 0) SSQ0[m] = s;
#pragma unroll
            for (int j = 0; j < 4; ++j) *((u32x2*)(XB + (size_t)m * 1024) + lane + 64 * j) = (u32x2){cvtpk(v[j][0], v[j][1]), cvtpk(v[j][2], v[j][3])};
        }
        for (int e = bx * 512 + tid; e < MROWS * 4; e += G * 512) {
            const int row = e >> 2, i = e & 3; const int pos = (row < NPROMPT) ? row : 4096 + ((row - NPROMPT) & 15);
            const float invf = (i == 0) ? 1.0f : (i == 1 ? 0.037606030930863934f : (i == 2 ? 0.0014142135623730950f : 5.318295896944988e-05f));
            const float ang = (float)pos * invf;
            const double rev = (double)ang * 0.15915494309189535; const float fr = (float)(rev - __builtin_rint(rev));
            ROPE[(size_t)row * 8 + i] = __builtin_amdgcn_cosf(fr); ROPE[(size_t)row * 8 + 4 + i] = __builtin_amdgcn_sinf(fr);
        }
    }
    xcd_barrier(xbar);
    if (gridDim.x > 65535u) grid.sync();
#ifdef PROBE_SYNCX
    for (int i_ = 0; i_ < PROBE_SYNCX; ++i_) grid.sync();
#endif

    for (int l = 0; l < 2; ++l) {
        {
            pg8::Gemm g{XB, WIN + (size_t)l * 4096 * 1024, NPROMPT, 4096, 1024}; pg8::StaticOrder S; S.init(NPROMPT, 4096, G, bx);
            pg8::EpiIn E{ws, out, l};

#ifndef NO_GEMM1
            pg8::gemm_phase<pg8::EpiIn, pg8::StaticOrder, P1_ALIGN, true>(lds, g, S, E, wave);
#ifdef PROBE_P1X
            if (l == 0) { grid.sync(); pg8::gemm_phase<pg8::EpiIn, pg8::StaticOrder, true, true>(lds, g, S, E, wave); }
#endif
#endif

        }
        xcd_barrier(xbar);
        {
            const float lam_init = (l == 0) ? 0.2f : 0.35550906759096927f;
            float d1 = 0.f, d2 = 0.f;
            for (int i = 0; i < 32; ++i) { d1 += args.in[12][l * 32 + i] * args.in[13][l * 32 + i]; d2 += args.in[14][l * 32 + i] * args.in[15][l * 32 + i]; }
            const float lam = __int_as_float(__builtin_amdgcn_readfirstlane(__float_as_int(__expf(d1) - __expf(d2) + lam_init))), dummy_oml_ = 0.f; const int oml = l;
            const float* subg = args.in[16] + l * 64;
            volatile LAS int* misc = (volatile LAS int*)(lds + MISC_OFF);
            constexpr int N_SI = 16, N_PC = 512, N_SC = 64, N_PA = 512, N_SA = 128, N_CV = 130, N_SO = 4, N_TOT = N_SI + N_PC + N_SC + N_PA + N_SA + N_CV + N_SO;
            constexpr unsigned N_SMIX = N_SC + N_SA + 2;
#ifndef PROBE_P2X
#define PROBE_P2X 1
#endif
            for (int rep = 0; rep < ((l == 0) ? PROBE_P2X : 1); ++rep) {
            if (rep > 0) grid.sync();
            const bool t0 = (wave == 0 && lane_id_v() == 0);
            for (;;) {
                __syncthreads();
                if (t0) misc[0] = (int)atomicAdd(ctl + CTL_Q0 + l + 2 * rep, 1u);
                __syncthreads();
                int ui = misc[0]; ui = __builtin_amdgcn_readfirstlane(ui);
                if (ui >= N_TOT) break;
                AU d; d.tabsrc = nullptr; d.kc = nullptr; d.vc = nullptr; d.cp = 0; d.ntc = 0; d.lastv = 64; d.nqg = 4; d.tlo1 = 0; d.thi1 = -1; d.qpos0 = 0; d.kpos0 = 0;
                int kind;
                int idx = ui;
                if (idx < 16) kind = 5; else if (idx < 256) { kind = 0; idx -= 16; } else if (idx < 320) { kind = 1; idx -= 256; } else if (idx < 448) { kind = 3; idx -= 320; } else if (idx < 450) { kind = 4; idx = 128 + (idx - 448); }
                else if (idx < 454) { kind = 6; idx -= 450; } else if (idx < 726) { kind = 0; idx = 240 + (idx - 454); } else if (idx < 1238) { kind = 2; idx -= 726; } else { kind = 4; idx -= 1238; }
#ifdef PROBE_ONLY_KIND
                if (rep > 0 && kind != PROBE_ONLY_KIND) continue;
#endif
                if (rep > 0 && kind >= 5) continue;
                const bool smp_unit = (kind == 1 || kind == 3 || (kind == 4 && idx >= 128));
                if (smp_unit || kind == 6) {
                    if (t0) {
                        unsigned* cnt = ctl + (kind == 6 ? CTL_SM : CTL_SI) + l; const unsigned want = (kind == 6) ? N_SMIX : (unsigned)N_SI;
                        while (__hip_atomic_load(cnt, __ATOMIC_RELAXED, __HIP_MEMORY_SCOPE_AGENT) < want) __builtin_amdgcn_s_sleep(8);
                        __builtin_amdgcn_fence(__ATOMIC_ACQUIRE, "agent");
                        asm volatile("s_waitcnt vmcnt(0)" ::: "memory");
                    }
                    __syncthreads();
                }
                if (kind >= 5) {
                    if (kind == 5) { pg8::Gemm g{XB, WIN + (size_t)l * 4096 * 1024, MROWS, 4096, 1024}; pg8::OneUnit S{64, idx}; pg8::EpiIn E{ws, out, l};
                        pg8::gemm_phase<pg8::EpiIn, pg8::OneUnit, false, true>(lds, g, S, E, wave); }
                    else { pg8::Gemm g{YMIX, WOUT + (size_t)l * 1024 * 1024, MROWS, 1024, 1024}; pg8::OneUnit S{64, idx}; pg8::EpiOut E{ws, x_p, x_s, l, args.in[17], out};
                        pg8::gemm_phase<pg8::EpiOut, pg8::OneUnit, false, true>(lds, g, S, E, wave); }
                }
                else if (kind == 0) {
                    const int u = 127 - (idx >> 2), h = idx & 3; const size_t r0 = (size_t)128 * u;
                    d.q = Z + r0 * ZLD + 3072 + 64 * h; d.nq = 128; d.nt = 2 * u + 2; d.kz = Z + 3328 + 64 * h; d.vz = Z + 3584 + 64 * h;
                    d.tlo0 = 0; d.thi0 = d.nt - 2; d.tlo1 = 0; d.thi1 = d.nt - 1; d.gate = Z + r0 * ZLD + 3840 + 64 * h; d.y = YMIX + r0 * 1024 + 768 + 64 * h;

#ifndef NO_ATTN0
                    attn_unit<0>(d, lds, lam, oml, subg, wave);
#endif

                } else if (kind == 1) {
                    const int b = idx >> 2, h = idx & 3; const size_t r0 = (size_t)NPROMPT + 16 * b;
                    d.q = Z + r0 * ZLD + 3072 + 64 * h; d.nq = 16; d.nt = 65; d.ntc = 64; d.cp = 256;
                    d.kc = args.in[5] + ((size_t)(l * 16 + b) * 4096) * 256 + 64 * h; d.vc = args.in[6] + ((size_t)(l * 16 + b) * 4096) * 256 + 64 * h;
                    d.kz = Z + r0 * ZLD + 3328 + 64 * h; d.vz = Z + r0 * ZLD + 3584 + 64 * h; d.lastv = 16; d.nqg = 1; d.tlo0 = 0; d.thi0 = 64;
                    d.gate = Z + r0 * ZLD + 3840 + 64 * h; d.y = YMIX + r0 * 1024 + 768 + 64 * h;

#ifndef NO_ATTN0
                    attn_unit<0>(d, lds, lam, oml, subg, wave);
#endif

                } else if (kind == 2 || kind == 3) {
                    int h;
                    if (kind == 2) {
                        h = 2 * (idx & 3); const int cp = idx >> 2, c0 = max(0, 2 * cp - 8); const size_t r0 = (size_t)128 * cp;
                        d.q = Z + r0 * ZLD + 64 * h; d.nq = 128; d.nt = 2 * cp + 2 - c0; d.kz = Z + (size_t)64 * c0 * ZLD + 512 + 64 * h; d.vz = Z + (size_t)64 * c0 * ZLD + 1024 + 64 * h;
                        d.tlo0 = 0; d.thi0 = 2 * cp - c0; d.tlo1 = max(0, 2 * cp + 1 - 8) - c0; d.thi1 = 2 * cp + 1 - c0; d.qpos0 = 128 * cp; d.kpos0 = 64 * c0;
                        d.gate = Z + r0 * ZLD + 1536 + 64 * h; d.y = YMIX + r0 * 1024 + 64 * h;
                    } else {
                        h = idx & 7; const int b = idx >> 3; const size_t r0 = (size_t)NPROMPT + 16 * b;
                        d.q = Z + r0 * ZLD + 64 * h; d.nq = 16; d.nt = 9; d.ntc = 8; d.cp = 512;
                        d.kc = args.in[2] + ((size_t)(l * 16 + b) * 512) * 512 + 64 * h; d.vc = args.in[3] + ((size_t)(l * 16 + b) * 512) * 512 + 64 * h;
                        d.kz = Z + r0 * ZLD + 512 + 64 * h; d.vz = Z + r0 * ZLD + 1024 + 64 * h; d.lastv = 16; d.nqg = 1; d.tlo0 = 0; d.thi0 = 8; d.qpos0 = 512; d.kpos0 = 0;
                        d.gate = Z + r0 * ZLD + 1536 + 64 * h; d.y = YMIX + r0 * 1024 + 64 * h;
                    }
                    d.tabsrc = args.in[10] + (size_t)(l * 8 + h) * 257;

#ifndef NO_ATTN1
                    if (kind == 2) attn_unit<3>(d, lds, 0.f, 0, nullptr, wave); else attn_unit<1>(d, lds, 0.f, 0, nullptr, wave);
#endif

                } else {
                    int tq_ = wave * 64 + lane_id_v(); asm volatile("" : "+v"(tq_));
                    const int c8 = (tq_ & 31) * 8, rr = tq_ >> 5;
                    const float* cw = args.in[11] + (size_t)l * 3 * 256 + c8;
                    float w0[8], w1[8], w2[8];
#pragma unroll
                    for (int j = 0; j < 8; ++j) { w0[j] = cw[j]; w1[j] = cw[256 + j]; w2[j] = cw[512 + j]; }
                    for (int g = 0; g < 8; ++g) {
                        const int row = 128 * idx + 16 * g + rr; const bool smp = row >= NPROMPT; const int t = smp ? ((row - NPROMPT) & 15) : row, b = (row - NPROMPT) >> 4;
                        const bf16_t* zr = Z + (size_t)row * ZLD;
                        float u0[8], u1[8], u2[8];
                        { const u32x4 c = *(const u32x4*)(zr + 2304 + c8), hh = *(const u32x4*)(zr + 2560 + c8);
#pragma unroll
                          for (int j = 0; j < 4; ++j) { u0[2 * j] = bf_lo(c[j]) * bf_lo(hh[j]); u0[2 * j + 1] = bf_hi(c[j]) * bf_hi(hh[j]); } }
                        if (t >= 1) { const u32x4 c = *(const u32x4*)(zr - ZLD + 2304 + c8), hh = *(const u32x4*)(zr - ZLD + 2560 + c8);
#pragma unroll
                          for (int j = 0; j < 4; ++j) { u1[2 * j] = bf_lo(c[j]) * bf_lo(hh[j]); u1[2 * j + 1] = bf_hi(c[j]) * bf_hi(hh[j]); } }
                        else if (smp) { const float* sp = args.in[4] + ((size_t)(l * 16 + b) * 2 + 1) * 256 + c8;
#pragma unroll
                          for (int j = 0; j < 8; ++j) u1[j] = sp[j]; }
                        else {
#pragma unroll
                          for (int j = 0; j < 8; ++j) u1[j] = 0.f; }
                        if (t >= 2) { const u32x4 c = *(const u32x4*)(zr - 2 * ZLD + 2304 + c8), hh = *(const u32x4*)(zr - 2 * ZLD + 2560 + c8);
#pragma unroll
                          for (int j = 0; j < 4; ++j) { u2[2 * j] = bf_lo(c[j]) * bf_lo(hh[j]); u2[2 * j + 1] = bf_hi(c[j]) * bf_hi(hh[j]); } }
                        else if (smp) { const float* sp = args.in[4] + ((size_t)(l * 16 + b) * 2 + t) * 256 + c8;
#pragma unroll
                          for (int j = 0; j < 8; ++j) u2[j] = sp[j]; }
                        else {
#pragma unroll
                          for (int j = 0; j < 8; ++j) u2[j] = 0.f; }
                        const u32x4 bb = *(const u32x4*)(zr + 2048 + c8), bg = *(const u32x4*)(zr + 2816 + c8);
                        float y[8];
#pragma unroll
                        for (int j = 0; j < 4; ++j) {
                            y[2 * j] = bf_lo(bb[j]) * (u2[2 * j] * w0[2 * j] + u1[2 * j] * w1[2 * j] + u0[2 * j] * w2[2 * j]) * bf_lo(bg[j]);
                            y[2 * j + 1] = bf_hi(bb[j]) * (u2[2 * j + 1] * w0[2 * j + 1] + u1[2 * j + 1] * w1[2 * j + 1] + u0[2 * j + 1] * w2[2 * j + 1]) * bf_hi(bg[j]); }
                        *(u32x4*)(YMIX + (size_t)row * 1024 + 512 + c8) = (u32x4){cvtpk(y[0], y[1]), cvtpk(y[2], y[3]), cvtpk(y[4], y[5]), cvtpk(y[6], y[7])};
                        float* so = nullptr;
                        if (!smp && row >= NPROMPT - 2) so = out + O_CONVP + (size_t)l * 512 + (size_t)(row - (NPROMPT - 2)) * 256 + c8;
                        if (smp && t >= 14) so = out + O_CONVS + (size_t)l * 8192 + (size_t)b * 512 + (size_t)(t - 14) * 256 + c8;
                        if (so) { *(f32x4*)so = (f32x4){u0[0], u0[1], u0[2], u0[3]}; *(f32x4*)(so + 4) = (f32x4){u0[4], u0[5], u0[6], u0[7]}; }
                    }
                }
                if (smp_unit || kind == 5) {
                    asm volatile("s_waitcnt vmcnt(0)" ::: "memory");
                    __syncthreads();
                    if (t0) { __builtin_amdgcn_fence(__ATOMIC_RELEASE, "agent"); asm volatile("s_waitcnt vmcnt(0)" ::: "memory");
                        __hip_atomic_fetch_add(ctl + (kind == 5 ? CTL_SI : CTL_SM) + l, 1u, __ATOMIC_RELAXED, __HIP_MEMORY_SCOPE_AGENT); }
                }
            }
            }
        }
        xcd_barrier(xbar);
        {
            pg8::Gemm g{YMIX, WOUT + (size_t)l * 1024 * 1024, NPROMPT, 1024, 1024}; pg8::StaticOrder S; S.init(NPROMPT, 1024, G, bx);
            pg8::EpiOut E{ws, x_p, x_s, l, args.in[17], out};

#ifndef NO_GEMM2
            pg8::gemm_phase<pg8::EpiOut, pg8::StaticOrder, true, true>(lds, g, S, E, wave);
#endif

            if (l == 1 && wave == 0 && bx < MROWS - NPROMPT) {
                int ln_ = lane_id_v(); asm volatile("" : "+v"(ln_));
                const int lane = ln_;
                const int m = NPROMPT + bx; const float rs = __builtin_amdgcn_rsqf(SSQ2[m] * (1.0f / 1024.0f) + 1e-6f);
#pragma unroll
                for (int j = 0; j < 4; ++j) { const f32x4 v = *((const f32x4*)(X1 + (size_t)m * 1024) + lane + 64 * j); *((f32x4*)(out + O_Y + (size_t)m * 1024) + lane + 64 * j) = v * rs * *((const f32x4*)args.in[17] + lane + 64 * j); }
            }
        }
        if (l == 0) xcd_barrier(xbar);
    }
}

extern "C" void kernel_launch(void* const* d_in, const int* in_sizes, int n_in, void* d_out, int out_size, void* d_ws, size_t ws_size, hipStream_t stream) {
    static int grid_blocks = 0;
    if (!grid_blocks) {
        if (n_in != 18 || (size_t)out_size != O_END || ws_size < WS_END) { fprintf(stderr, "kernel_launch: unexpected shapes n_in %d out %d ws %zu\n", n_in, out_size, ws_size); grid_blocks = -1; return; }
        int dev = 0, cus = 0, per_cu = 0;
        hipGetDevice(&dev); hipDeviceGetAttribute(&cus, hipDeviceAttributeMultiprocessorCount, dev);
        hipFuncSetAttribute((const void*)fwd_megakernel, hipFuncAttributeMaxDynamicSharedMemorySize, LDS_BYTES);
        hipOccupancyMaxActiveBlocksPerMultiprocessor(&per_cu, (const void*)fwd_megakernel, 512, LDS_BYTES);
        if (per_cu < 1) { fprintf(stderr, "kernel_launch: occupancy query says %d blocks per CU\n", per_cu); per_cu = 1; }
        if (per_cu > 1) per_cu = 1;
        grid_blocks = cus * per_cu;
    }
    if (grid_blocks < 0) return;
    hipMemsetAsync((char*)d_ws + WS_CTL, 0, CTL_BYTES, stream);
    Args a{};
    for (int i = 0; i < 18; ++i) a.in[i] = (const float*)d_in[i];
    a.out = (float*)d_out; a.ws = (unsigned char*)d_ws;
    void* kargs[] = {&a};
    hipError_t e = hipLaunchCooperativeKernel((const void*)fwd_megakernel, dim3(grid_blocks), dim3(512), kargs, LDS_BYTES, stream);
    if (e != hipSuccess) fprintf(stderr, "cooperative launch failed: %s (grid %d)\n", hipGetErrorString(e), grid_blocks);
}
```
